# Optimizing an MI355X kernel written in HIP

```python
import jax, jax.numpy as jnp
from jax import lax
import numpy as np

D_MODEL = 1024
BATCH = 8
SEQ = 4096
DEPTH = 4

D_MIX = D_MODEL
MLSTM_HEADS = 4
MLSTM_DQK = D_MODEL // 16
MLSTM_DV = D_MODEL // 8
GDN_HEADS = 4
GDN_DK = D_MODEL // 8
GDN_DV = D_MODEL // 8
CONV_K = 4
CHUNK = 64
GATE_SOFTCAP = 15.0
ML_QK = MLSTM_HEADS * MLSTM_DQK
ML_V = MLSTM_HEADS * MLSTM_DV
GD_QK = GDN_HEADS * GDN_DK
GD_V = GDN_HEADS * GDN_DV
SPLIT_SIZES = (ML_QK, ML_QK, ML_V, ML_V, MLSTM_HEADS, MLSTM_HEADS,
               GD_QK, GD_QK, GD_V, GD_V, GDN_HEADS, GDN_HEADS)
SPLIT_OFFSETS = tuple(int(o) for o in np.cumsum(SPLIT_SIZES)[:-1])
D_IN_PROJ = int(sum(SPLIT_SIZES))
N_MEM = 256
XA_HEADS = 4
XA_DH = D_MODEL // XA_HEADS
N_EXPERTS = 32
TOP_K = 4
D_EXPERT = D_MODEL
SWIGLU_LIMIT = 7.0
SWIGLU_ALPHA = 1.702
MOE_BLOCK = 256
DEEPNORM_ALPHA = (2.0 * DEPTH) ** 0.25
DEEPNORM_BETA = (8.0 * DEPTH) ** -0.25
LN_EPS = 1e-5
NORM_EPS = 1e-6

kernel_name = 'hybrid_mlstm_gdn_memxattn_moe_deepnorm'


def layer_norm(x, g, b):
    xf = x.astype(jnp.float32)
    mu = jnp.mean(xf, axis=-1, keepdims=True)
    var = jnp.mean(jnp.square(xf - mu), axis=-1, keepdims=True)
    return ((xf - mu) * lax.rsqrt(var + LN_EPS) * g + b).astype(x.dtype)


def rms_norm(x, g):
    return x * lax.rsqrt(jnp.mean(x * x, axis=-1, keepdims=True) + NORM_EPS) * g


def l2_normalize(x):
    return x * lax.rsqrt(jnp.sum(x * x, axis=-1, keepdims=True) + NORM_EPS)


def soft_cap(x):
    return GATE_SOFTCAP * jnp.tanh(x / GATE_SOFTCAP)


def to_head_chunks(t, n_heads):
    b, s, _ = t.shape
    return t.reshape(b, s // CHUNK, CHUNK, n_heads, -1).transpose(0, 3, 1, 2, 4)


def gate_chunks(t):
    b, s, h = t.shape
    return t.reshape(b, s // CHUNK, CHUNK, h).transpose(0, 3, 1, 2)


def from_head_chunks(t):
    b, h, n, l, d = t.shape
    return t.transpose(0, 2, 3, 1, 4).reshape(b, n * l, h * d)


def causal_depthwise_conv(x, w):
    s = x.shape[1]
    xp = jnp.pad(x, ((0, 0), (CONV_K - 1, 0), (0, 0)))
    y = w[0] * xp[:, 0:s]
    for j in range(1, CONV_K):
        y = y + w[j] * xp[:, j:j + s]
    return y


def mlstm_chunkwise(q, k, v, i_pre, f_pre):
    log_f = jax.nn.log_sigmoid(f_pre)
    b_cum = jnp.cumsum(log_f, axis=-1)
    causal = jnp.tril(jnp.ones((CHUNK, CHUNK), dtype=bool))
    d_intra = jnp.where(causal, b_cum[..., :, None] - b_cum[..., None, :] + i_pre[..., None, :], -jnp.inf)
    b_last = b_cum[..., -1]
    log_w_end = b_last[..., None] - b_cum + i_pre

    def step(carry, xs):
        c, n, m = carry
        k_j, v_j, bl_j, lw_j = xs
        m_new = jnp.maximum(bl_j + m, jnp.max(lw_j, axis=-1))
        decay = jnp.exp(bl_j + m - m_new)
        kw = k_j * jnp.exp(lw_j - m_new[..., None])[..., None]
        c_new = decay[..., None, None] * c + jnp.einsum('bhlk,bhlv->bhkv', kw, v_j)
        n_new = decay[..., None] * n + jnp.sum(kw, axis=-2)
        return (c_new, n_new, m_new), (c, n, m)

    bsz, nh = q.shape[0], q.shape[1]
    init = (jnp.zeros((bsz, nh, q.shape[-1], v.shape[-1]), jnp.float32),
            jnp.zeros((bsz, nh, q.shape[-1]), jnp.float32),
            jnp.zeros((bsz, nh), jnp.float32))
    xs = (jnp.moveaxis(k, 2, 0), jnp.moveaxis(v, 2, 0), jnp.moveaxis(b_last, 2, 0), jnp.moveaxis(log_w_end, 2, 0))
    _, (c_prev, n_prev, m_prev) = lax.scan(step, init, xs)
    c_prev = jnp.moveaxis(c_prev, 0, 2)
    n_prev = jnp.moveaxis(n_prev, 0, 2)
    m_prev = jnp.moveaxis(m_prev, 0, 2)

    m_inter = b_cum + m_prev[..., None]
    m_t = jnp.maximum(m_inter, jnp.max(d_intra, axis=-1))
    s_intra = jnp.einsum('bhntk,bhnsk->bhnts', q, k) * jnp.exp(d_intra - m_t[..., None])
    w_inter = jnp.exp(m_inter - m_t)
    num = (w_inter[..., None] * jnp.einsum('bhntk,bhnkv->bhntv', q, c_prev)
           + jnp.einsum('bhnts,bhnsv->bhntv', s_intra, v))
    den = w_inter * jnp.einsum('bhntk,bhnk->bhnt', q, n_prev) + jnp.sum(s_intra, axis=-1)
    return num / jnp.maximum(jnp.abs(den), jnp.exp(-m_t))[..., None]


def gated_delta_chunkwise(q, k, v, g, beta):
    gc = jnp.cumsum(g, axis=-1)
    causal = jnp.tril(jnp.ones((CHUNK, CHUNK), dtype=bool))
    strict = jnp.tril(jnp.ones((CHUNK, CHUNK), dtype=bool), -1)
    decay = jnp.exp(jnp.where(causal, gc[..., :, None] - gc[..., None, :], -jnp.inf))
    kk = jnp.einsum('bhntk,bhnsk->bhnts', k, k)
    a_mat = jnp.where(strict, beta[..., None] * kk * decay, 0.0) + jnp.eye(CHUNK, dtype=jnp.float32)
    rhs = jnp.concatenate([v * beta[..., None], k * (beta * jnp.exp(gc))[..., None]], axis=-1)
    sol = lax.linalg.triangular_solve(a_mat, rhs, left_side=True, lower=True, unit_diagonal=True)
    u, w = sol[..., :v.shape[-1]], sol[..., v.shape[-1]:]
    g_last = gc[..., -1]
    k_end = k * jnp.exp(g_last[..., None] - gc)[..., None]

    def step(s, xs):
        u_j, w_j, ke_j, gl_j = xs
        v_new = u_j - jnp.einsum('bhlk,bhkv->bhlv', w_j, s)
        s_next = jnp.exp(gl_j)[..., None, None] * s + jnp.einsum('bhlk,bhlv->bhkv', ke_j, v_new)
        return s_next, (s, v_new)

    s0 = jnp.zeros((q.shape[0], q.shape[1], k.shape[-1], v.shape[-1]), jnp.float32)
    xs = (jnp.moveaxis(u, 2, 0), jnp.moveaxis(w, 2, 0), jnp.moveaxis(k_end, 2, 0), jnp.moveaxis(g_last, 2, 0))
    _, (s_prev, v_new) = lax.scan(step, s0, xs)
    s_prev = jnp.moveaxis(s_prev, 0, 2)
    v_new = jnp.moveaxis(v_new, 0, 2)
    qk = jnp.einsum('bhntk,bhnsk->bhnts', q, k) * decay
    return (jnp.einsum('bhntk,bhnkv->bhntv', q * jnp.exp(gc)[..., None], s_prev)
            + jnp.einsum('bhnts,bhnsv->bhntv', qk, v_new))


def hybrid_mixer(x, w_in, ml_b_i, ml_b_f, ml_norm, gd_conv, gd_a_log, gd_dt_bias, gd_norm, w_out):
    proj = (x @ w_in).astype(jnp.float32)
    (ml_q, ml_k, ml_v, ml_o, ml_i, ml_f,
     gd_q, gd_k, gd_v, gd_z, gd_b, gd_a) = jnp.split(proj, SPLIT_OFFSETS, axis=-1)

    i_pre = gate_chunks(soft_cap(ml_i + ml_b_i))
    f_pre = gate_chunks(soft_cap(ml_f + ml_b_f))
    h_ml = mlstm_chunkwise(to_head_chunks(ml_q, MLSTM_HEADS) * MLSTM_DQK ** -0.5,
                           to_head_chunks(ml_k, MLSTM_HEADS),
                           to_head_chunks(ml_v, MLSTM_HEADS), i_pre, f_pre)
    h_ml = rms_norm(h_ml, ml_norm.reshape(MLSTM_HEADS, 1, 1, MLSTM_DV))
    h_ml = from_head_chunks(h_ml) * jax.nn.sigmoid(ml_o)

    qkv = jax.nn.silu(causal_depthwise_conv(jnp.concatenate([gd_q, gd_k, gd_v], axis=-1), gd_conv))
    cq, ck, cv = qkv[..., :GD_QK], qkv[..., GD_QK:2 * GD_QK], qkv[..., 2 * GD_QK:]
    beta = gate_chunks(jax.nn.sigmoid(gd_b))
    g = gate_chunks(-jnp.exp(gd_a_log) * jax.nn.softplus(gd_a + gd_dt_bias))
    h_gd = gated_delta_chunkwise(l2_normalize(to_head_chunks(cq, GDN_HEADS)) * GDN_DK ** -0.5,
                                 l2_normalize(to_head_chunks(ck, GDN_HEADS)),
                                 to_head_chunks(cv, GDN_HEADS), g, beta)
    h_gd = rms_norm(h_gd, gd_norm) * jax.nn.silu(to_head_chunks(gd_z, GDN_HEADS))
    h_gd = from_head_chunks(h_gd)

    mixed = jnp.concatenate([h_ml, h_gd], axis=-1).astype(x.dtype)
    return mixed @ w_out


def memory_cross_attention(x, mem, wq, wk, wv, wo):
    b, s, d = x.shape
    m = mem.shape[1]
    q = (x @ wq).reshape(b, s, XA_HEADS, XA_DH)
    k = (mem @ wk).reshape(b, m, XA_HEADS, XA_DH)
    v = (mem @ wv).reshape(b, m, XA_HEADS, XA_DH)
    scores = jnp.einsum('bshd,bmhd->bhsm', q, k).astype(jnp.float32) * XA_DH ** -0.5
    p = jax.nn.softmax(scores, axis=-1).astype(x.dtype)
    o = jnp.einsum('bhsm,bmhd->bshd', p, v).reshape(b, s, d)
    return o @ wo


def moe_ffn(h, router_w, router_b, w_gu, b_gu, w_down, b_down):
    bsz, seq, d = h.shape
    tokens = h.reshape(-1, d)
    n_tok = tokens.shape[0]
    logits = (tokens @ router_w + router_b).astype(jnp.float32)
    top_logit, top_idx = lax.top_k(logits, TOP_K)
    gates = jax.nn.softmax(top_logit, axis=-1)
    n_assign = n_tok * TOP_K
    flat_e = top_idx.reshape(-1).astype(jnp.int32)
    flat_tok = jnp.arange(n_assign, dtype=jnp.int32) // TOP_K
    order = jnp.argsort(flat_e)
    sorted_e = flat_e[order]
    counts = jnp.zeros((N_EXPERTS,), jnp.int32).at[flat_e].add(1)
    start = jnp.cumsum(counts) - counts
    padded = (counts + MOE_BLOCK - 1) // MOE_BLOCK * MOE_BLOCK
    pad_end = jnp.cumsum(padded)
    pad_start = pad_end - padded
    dest = pad_start[sorted_e] + jnp.arange(n_assign, dtype=jnp.int32) - start[sorted_e]
    n_blocks = n_assign // MOE_BLOCK + N_EXPERTS
    cap = n_blocks * MOE_BLOCK
    row_tok = jnp.full((cap,), n_tok, jnp.int32).at[dest].set(flat_tok[order])
    row_gate = jnp.zeros((cap,), jnp.float32).at[dest].set(gates.reshape(-1)[order])
    block_expert = jnp.minimum(
        jnp.searchsorted(pad_end, jnp.arange(n_blocks, dtype=jnp.int32) * MOE_BLOCK, side='right'),
        N_EXPERTS - 1)
    tokens_pad = jnp.concatenate([tokens, jnp.zeros((1, d), tokens.dtype)], axis=0)

    def expert_block(args):
        tok_ids, gate, e = args
        xb = tokens_pad[tok_ids]
        gu = xb @ w_gu[e] + b_gu[e]
        glu = jnp.minimum(gu[:, :D_EXPERT], SWIGLU_LIMIT)
        lin = jnp.clip(gu[:, D_EXPERT:], -SWIGLU_LIMIT, SWIGLU_LIMIT)
        act = (lin + 1.0) * glu * jax.nn.sigmoid(SWIGLU_ALPHA * glu)
        yb = act @ w_down[e] + b_down[e]
        return yb * gate[:, None].astype(yb.dtype)

    y_rows = lax.map(expert_block, (row_tok.reshape(n_blocks, MOE_BLOCK),
                                    row_gate.reshape(n_blocks, MOE_BLOCK), block_expert))
    out = jnp.zeros((n_tok + 1, d), y_rows.dtype).at[row_tok].add(y_rows.reshape(cap, d))
    return out[:n_tok].reshape(bsz, seq, d).astype(h.dtype)


def setup_inputs(seed: int = 0) -> dict:
    key = jax.random.key(seed)
    ks = jax.random.split(key, 27)
    L = DEPTH

    def nrm(k, shape, scale):
        return scale * jax.random.normal(k, shape, jnp.float32)

    return {
        'x': nrm(ks[0], (BATCH, SEQ, D_MODEL), 1.0),
        'mem': nrm(ks[1], (BATCH, N_MEM, D_MODEL), 1.0),
        'w_in': nrm(ks[2], (L, D_MODEL, D_IN_PROJ), D_MODEL ** -0.5),
        'mlstm_b_i': nrm(ks[3], (L, MLSTM_HEADS), 0.1),
        'mlstm_b_f': 3.0 + nrm(ks[4], (L, MLSTM_HEADS), 0.5),
        'mlstm_norm_w': 1.0 + nrm(ks[5], (L, ML_V), 0.02),
        'gdn_conv_w': nrm(ks[6], (L, CONV_K, 2 * GD_QK + GD_V), CONV_K ** -0.5),
        'gdn_a_log': jnp.log(jax.random.uniform(ks[7], (L, GDN_HEADS), jnp.float32, 1.0, 16.0)),
        'gdn_dt_bias': 1.0 + nrm(ks[8], (L, GDN_HEADS), 0.1),
        'gdn_norm_w': 1.0 + nrm(ks[9], (L, GDN_DV), 0.02),
        'w_out': nrm(ks[10], (L, D_MIX, D_MODEL), DEEPNORM_BETA * D_MIX ** -0.5),
        'ln1_g': 1.0 + nrm(ks[11], (L, D_MODEL), 0.02),
        'ln1_b': nrm(ks[12], (L, D_MODEL), 0.02),
        'xa_wq': nrm(ks[13], (L, D_MODEL, D_MODEL), D_MODEL ** -0.5),
        'xa_wk': nrm(ks[14], (L, D_MODEL, D_MODEL), D_MODEL ** -0.5),
        'xa_wv': nrm(ks[15], (L, D_MODEL, D_MODEL), D_MODEL ** -0.5),
        'xa_wo': nrm(ks[16], (L, D_MODEL, D_MODEL), DEEPNORM_BETA * D_MODEL ** -0.5),
        'ln2_g': 1.0 + nrm(ks[17], (L, D_MODEL), 0.02),
        'ln2_b': nrm(ks[18], (L, D_MODEL), 0.02),
        'router_w': nrm(ks[19], (L, D_MODEL, N_EXPERTS), D_MODEL ** -0.5),
        'router_b': nrm(ks[20], (L, N_EXPERTS), 0.01),
        'exp_w_gu': nrm(ks[21], (L, N_EXPERTS, D_MODEL, 2 * D_EXPERT), D_MODEL ** -0.5),
        'exp_b_gu': nrm(ks[22], (L, N_EXPERTS, 2 * D_EXPERT), 0.01),
        'exp_w_down': nrm(ks[23], (L, N_EXPERTS, D_EXPERT, D_MODEL), DEEPNORM_BETA * D_EXPERT ** -0.5),
        'exp_b_down': nrm(ks[24], (L, N_EXPERTS, D_MODEL), 0.01),
        'ln3_g': 1.0 + nrm(ks[25], (L, D_MODEL), 0.02),
        'ln3_b': nrm(ks[26], (L, D_MODEL), 0.02),
    }


def reference(x, mem, w_in, mlstm_b_i, mlstm_b_f, mlstm_norm_w, gdn_conv_w, gdn_a_log, gdn_dt_bias,
              gdn_norm_w, w_out, ln1_g, ln1_b, xa_wq, xa_wk, xa_wv, xa_wo, ln2_g, ln2_b,
              router_w, router_b, exp_w_gu, exp_b_gu, exp_w_down, exp_b_down, ln3_g, ln3_b):
    for l in range(DEPTH):
        h = hybrid_mixer(x, w_in[l], mlstm_b_i[l], mlstm_b_f[l], mlstm_norm_w[l], gdn_conv_w[l],
                         gdn_a_log[l], gdn_dt_bias[l], gdn_norm_w[l], w_out[l])
        x = layer_norm(DEEPNORM_ALPHA * x + h, ln1_g[l], ln1_b[l])
        h = memory_cross_attention(x, mem, xa_wq[l], xa_wk[l], xa_wv[l], xa_wo[l])
        x = layer_norm(DEEPNORM_ALPHA * x + h, ln2_g[l], ln2_b[l])
        h = moe_ffn(x, router_w[l], router_b[l], exp_w_gu[l], exp_b_gu[l], exp_w_down[l], exp_b_down[l])
        x = layer_norm(DEEPNORM_ALPHA * x + h, ln3_g[l], ln3_b[l])
    return x
```

```cpp
#include <hip/hip_runtime.h>
#include <cstdio>
#include <cstdint>

#define LAS __attribute__((address_space(3)))
typedef unsigned short bf16;
typedef short bf16x8 __attribute__((ext_vector_type(8)));
typedef short s16x4 __attribute__((ext_vector_type(4)));
typedef float f32x4 __attribute__((ext_vector_type(4)));
typedef float f32x2 __attribute__((ext_vector_type(2)));
typedef unsigned u32x4 __attribute__((ext_vector_type(4)));
typedef unsigned u32x2 __attribute__((ext_vector_type(2)));
#define DI __device__ __forceinline__
#define GAS __attribute__((address_space(1)))

constexpr int T = 32768, D = 1024, NB = 8, SEQ = 4096, NL = 4, NCH = 64, CH = 64;
constexpr int NPROJ = 3584;
constexpr int NE = 32, TOPK = 4;
constexpr int MAXTILES = 544, CAP = MAXTILES * 256;
constexpr float DN_ALPHA = 1.6817928305074290f;
constexpr int NWAVES = 8, NTHREADS = 512;
constexpr int LDS_RING = 131072, LDS_X = 131072  , LDS_MISC = 131072 + 12288, LDS_BYTES = 147456;

constexpr size_t MiB = 1ull << 20;
constexpr size_t WS_CTL = 0;
constexpr size_t WS_WIN = 1 * MiB;
constexpr size_t WS_WGATE = WS_WIN + 4ull * NPROJ * D * 2;
constexpr size_t WS_WRT = WS_WGATE + 4ull * 2 * 16 * D * 2;
constexpr size_t WS_WOUT = WS_WRT + 4ull * 2 * 32 * D * 2;
constexpr size_t WS_WQ = WS_WOUT + 4ull * D * D * 2;
constexpr size_t WS_WKV = WS_WQ + 4ull * D * D * 2;
constexpr size_t WS_WO = WS_WKV + 8ull * D * D * 2;
constexpr size_t WS_WGU = WS_WO + 4ull * D * D * 2;
constexpr size_t WS_WDN = WS_WGU + 4ull * 32 * 2048 * D * 2;
constexpr size_t WS_MEMB = WS_WDN + 4ull * 32 * D * D * 2;
constexpr size_t WS_KV = WS_MEMB + 2048ull * D * 2;
constexpr size_t WS_WQK = WS_KV + 8ull * 2048 * D * 2;
constexpr size_t WS_WVO = WS_WQK + 32ull * D * D * 2;
constexpr size_t WS_XB = WS_WVO + 32ull * D * D * 2;
constexpr size_t WS_PROJ = WS_XB + (size_t)T * D * 2;
constexpr size_t WS_GATES = WS_PROJ + (size_t)T * NPROJ * 2;
constexpr size_t WS_MIXED = WS_GATES + (size_t)T * 16 * 4;
constexpr size_t WS_HB = WS_MIXED + (size_t)T * D * 2;
constexpr size_t WS_PB = WS_HB + (size_t)T * D * 2;
constexpr size_t WS_TOPE = WS_PB + (size_t)T * D * 2;
constexpr size_t WS_TOPP = WS_TOPE + (size_t)T * 16;
constexpr size_t WS_TOPG = WS_TOPP + (size_t)T * 16;
constexpr size_t WS_SLOT = WS_TOPG + (size_t)T * 16;
constexpr size_t WS_XG = WS_SLOT + (size_t)T * 16;
constexpr size_t WS_ACT = WS_XG + (size_t)CAP * D * 2;
constexpr size_t WS_Y = WS_ACT + (size_t)CAP * D * 2;
constexpr size_t WS_MLU = WS_Y + (size_t)CAP * D * 2;
constexpr size_t WS_MLKN = WS_MLU + 2048ull * 8192 * 4;
constexpr size_t WS_MLSC = WS_MLKN + 2048ull * 64 * 4;
constexpr size_t WS_MLCT = WS_MLSC + 2048ull * 16;
constexpr size_t WS_MLNP = WS_MLCT + 2048ull * 8192 * 2;
constexpr size_t WS_MLMP = WS_MLNP + 2048ull * 64 * 4;
constexpr size_t WS_GDUT = WS_MLMP + 2048ull * 4;
constexpr size_t WS_GDW = WS_GDUT + 2048ull * 8192 * 2;
constexpr size_t WS_GDKE = WS_GDW + 2048ull * 8192 * 2;
constexpr size_t WS_GDQG = WS_GDKE + 2048ull * 8192 * 2;
constexpr size_t WS_GDQK = WS_GDQG + 2048ull * 8192 * 2;
constexpr size_t WS_GDGL = WS_GDQK + 2048ull * 4096 * 2;
constexpr size_t WS_GDVN = WS_GDGL + 2048ull * 4;
constexpr size_t WS_GDSP = WS_GDVN + 2048ull * 8192 * 2;
constexpr size_t WS_END = WS_GDSP + 2048ull * 16384 * 2;
constexpr int CW_BAR = 1024, CW_ECNT = 8192, CW_NT = 8192 + 256, CW_TILE_E = 8192 + 512, CW_DBG = 16384;

typedef __bf16 bf16x2_t __attribute__((ext_vector_type(2)));
DI unsigned cvt_pk_bf16(float lo, float hi) { const f32x2 v = {lo, hi}; const bf16x2_t r = __builtin_convertvector(v, bf16x2_t); return __builtin_bit_cast(unsigned, r); }
DI bf16 f2bf(float f) { return (bf16)(cvt_pk_bf16(f, 0.f) & 0xffffu); }
DI float bf2f(bf16 b) { return __uint_as_float(((unsigned)b) << 16); }
DI float bflo(unsigned w) { return __uint_as_float(w << 16); }
DI float bfhi(unsigned w) { return __uint_as_float(w & 0xffff0000u); }
DI float sigmoidf_(float x) { return __builtin_amdgcn_rcpf(1.f + __expf(-x)); }
DI float wave_sum(float v) {
#pragma unroll
    for (int o = 1; o < 64; o <<= 1) v += __shfl_xor(v, o);
    return v;
}
DI float wave_max(float v) {
#pragma unroll
    for (int o = 1; o < 64; o <<= 1) v = fmaxf(v, __shfl_xor(v, o));
    return v;
}
#define LDS_WAIT() asm volatile("s_waitcnt lgkmcnt(0)" ::: "memory")
#define VM_WAIT() asm volatile("s_waitcnt vmcnt(0)" ::: "memory")
#define MFMA16(a, b, c) __builtin_amdgcn_mfma_f32_16x16x32_bf16((a), (b), (c), 0, 0, 0)

#define XB_TMO      128
#define XB_XCNT(j)  (256  + 64 * (j))
#define XB_XSUB(j)  (1280 + 64 * (j))
#define XB_XGEN(j)  (2304 + 64 * (j))
#define XB_TOP      3328
#define XB_TOPGEN   3392
#define XCD_BAR_WORDS 3456
#define XB_SPIN_CAP (1u << 22)
__device__ __forceinline__ unsigned xb_ld(unsigned* p)              { return __hip_atomic_load(p, __ATOMIC_RELAXED, __HIP_MEMORY_SCOPE_AGENT); }
__device__ __forceinline__ unsigned xb_add(unsigned* p, unsigned v) { return __hip_atomic_fetch_add(p, v, __ATOMIC_RELAXED, __HIP_MEMORY_SCOPE_AGENT); }
__device__ __forceinline__ unsigned xb_xcc_id() { return (unsigned)__builtin_amdgcn_s_getreg((3 << 11) | 20) & 0xFu; }
#define XB_SPIN(cond, bar) do { unsigned _sp = 0; while (cond) { __builtin_amdgcn_s_sleep(1); \
    if ((++_sp & 255u) == 0u) { if (xb_ld(&(bar)[XB_TMO])) break; if (_sp > XB_SPIN_CAP) { atomicAdd(&(bar)[XB_TMO], 1u); break; } } } } while (0)
struct XcdBarrier { unsigned* bar; unsigned x; volatile LAS unsigned* st; };
__device__ __forceinline__ XcdBarrier xcd_barrier_post(unsigned* bar, volatile LAS unsigned* st) {
    XcdBarrier b; b.bar = bar; b.x = xb_xcc_id(); b.st = st;
    if (threadIdx.x == 0) (void)xb_add(&bar[XB_XCNT(b.x)], 1u);
    return b;
}
__device__ __forceinline__ void xcd_barrier_complete(unsigned* bar, unsigned x, unsigned& nloc, unsigned& nx) {
    const unsigned G = gridDim.x * gridDim.y * gridDim.z;
    unsigned sum, cnt, mine, sp = 0u;
    for (;;) {
        sum = 0u; cnt = 0u; mine = 0u;
#pragma unroll
        for (unsigned j = 0; j < 16; ++j) { const unsigned c = xb_ld(&bar[XB_XCNT(j)]); sum += c; cnt += (c > 0u) ? 1u : 0u; mine = (j == x) ? c : mine; }
        if (sum == G) break;
        __builtin_amdgcn_s_sleep(1);
        if ((++sp & 255u) == 0u) { if (xb_ld(&bar[XB_TMO])) break; if (sp > XB_SPIN_CAP) { atomicAdd(&bar[XB_TMO], 1u); break; } }
    }
    nloc = mine > 0u ? mine : 1u; nx = cnt > 0u ? cnt : 1u;
}
__device__ __forceinline__ void xcd_barrier(const XcdBarrier& b) {
    asm volatile("s_waitcnt vmcnt(0)" ::: "memory");
    __syncthreads();
    if (threadIdx.x == 0) {
        unsigned* bar = b.bar;
        __builtin_amdgcn_s_waitcnt(0);
        unsigned nloc = b.st[0], nx = b.st[1];
        if (nloc == 0u) { xcd_barrier_complete(bar, b.x, nloc, nx); b.st[0] = nloc; b.st[1] = nx; }
        const unsigned old = xb_add(&bar[XB_XSUB(b.x)], 1u);
        const unsigned gen = old / nloc;
        if (old + 1u == (gen + 1u) * nloc) {
            __builtin_amdgcn_fence(__ATOMIC_RELEASE, "agent");
            asm volatile("s_waitcnt vmcnt(0)" ::: "memory");
            const unsigned og = xb_add(&bar[XB_TOP], 1u);
            const unsigned tg = og / nx;
            if (og + 1u == (tg + 1u) * nx) xb_add(&bar[XB_TOPGEN], 1u);
            else XB_SPIN(xb_ld(&bar[XB_TOPGEN]) == tg, bar);
            __builtin_amdgcn_fence(__ATOMIC_ACQUIRE, "agent");
            xb_add(&bar[XB_XGEN(b.x)], 1u);
            asm volatile("s_waitcnt vmcnt(0)" ::: "memory");
        } else {
            XB_SPIN(xb_ld(&bar[XB_XGEN(b.x)]) == gen, bar);
            __builtin_amdgcn_fence(__ATOMIC_ACQUIRE, "agent");
            asm volatile("s_waitcnt vmcnt(0)" ::: "memory");
        }
    }
    __syncthreads();
}

namespace g8 {
constexpr int BM = 256, BK = 64, HALF = 128, HTB = HALF * BK * 2;
__host__ __device__ __forceinline__ int lds_byte(int r, int c) { const int st = (r >> 4) * 2 + (c >> 5), rr = r & 15, cc = c & 31, ob = rr * 64 + cc * 2; return st * 1024 + (ob ^ (((ob >> 9) & 1) << 5)); }
__host__ __device__ __forceinline__ void stage_rc(int b, int& R, int& C) { const int st = b / 1024, sb = b % 1024, swz = sb ^ (((sb >> 9) & 1) << 5); R = (st >> 1) * 16 + swz / 64; C = (st & 1) * 32 + (swz % 64) / 2; }
__host__ __device__ __forceinline__ int perm32(int rho) { const int n = rho >> 4, i = rho & 15; return 8 * (i >> 2) + 4 * n + (i & 3); }

struct Unit { const char* a; const char* b; char* c; int pm, pn, aux; };
DI void tile_of(int L, int nM, int nN, int& pm, int& pn) {
    const int nig = 8 * nN, gid = L / nig, fm = gid * 8, gsz = (nM - fm) < 8 ? (nM - fm) : 8, w = L % nig;
    pm = fm + (w % gsz); pn = w / gsz;
}
struct AffineOrder {
    const char* A; const char* B; char* C; size_t aM, bB, bN, cM, cS, cN; int nM, nN, bdiv, csp, G, c0;
    DI bool next(int i, Unit& u) const {
        const int L = i * G + c0; if (L >= nM * nN) return false;
        int pm, pn; tile_of(L, nM, nN, pm, pn); u.pm = pm; u.pn = pn; u.aux = 0;
        u.a = A + (size_t)pm * aM; u.b = B + (size_t)(pm / bdiv) * bB + (size_t)pn * bN; u.c = C + (size_t)pm * cM + (size_t)(pn / csp) * cS + (size_t)(pn % csp) * cN; return true;
    }
};
DI AffineOrder dense_order(const void* A, const void* B, void* C, int M, int N, int K, int ldc_bytes, int esz, int G, int c0) {
    AffineOrder o; o.A = (const char*)A; o.B = (const char*)B; o.C = (char*)C; o.aM = 256ull * K * 2; o.bB = 0; o.bN = 256ull * K * 2; o.cM = 256ull * ldc_bytes; o.cS = 0; o.cN = 256ull * esz;
    o.nM = M / 256; o.nN = N / 256; o.bdiv = 1 << 30; o.csp = 1 << 30; o.G = G; o.c0 = c0; return o;
}

struct EpiBf16 {
    static constexpr bool PERM = true;
    int ldc; const float* bias; int bias_stride; float scl;
    DI void operator()(f32x4 (&acc)[2][2][4][2], const Unit& u, int wr, int wc, int fr, int fq, LAS unsigned char*) const {
        const int col0 = wc * 32 + 8 * fq; const float sc = (u.aux < 0) ? scl : 1.f;
        f32x4 bv[2][2];
#pragma unroll
        for (int bj = 0; bj < 2; ++bj)
#pragma unroll
            for (int n = 0; n < 2; ++n) bv[bj][n] = bias ? *(const f32x4*)(bias + (size_t)u.aux * bias_stride + u.pn * 256 + col0 + bj * HALF + 4 * n) : (f32x4){0.f, 0.f, 0.f, 0.f};
#pragma unroll
        for (int ai = 0; ai < 2; ++ai)
#pragma unroll
            for (int m = 0; m < 4; ++m) { bf16* rowp = (bf16*)u.c + (size_t)(ai * HALF + wr * 64 + m * 16 + fr) * ldc + col0;
#pragma unroll
                for (int bj = 0; bj < 2; ++bj) { const f32x4 v0 = acc[ai][bj][m][0] * sc + bv[bj][0], v1 = acc[ai][bj][m][1] * sc + bv[bj][1];
                    u32x4 w; w.x = cvt_pk_bf16(v0[0], v0[1]); w.y = cvt_pk_bf16(v0[2], v0[3]); w.z = cvt_pk_bf16(v1[0], v1[1]); w.w = cvt_pk_bf16(v1[2], v1[3]);
                    *(u32x4*)(rowp + bj * HALF) = w; } }
    }
};
struct EpiSoftmax {
    static constexpr bool PERM = true;
    int ldc;
    DI void operator()(f32x4 (&acc)[2][2][4][2], const Unit& u, int wr, int wc, int fr, int fq, LAS unsigned char* lds) const {
        LAS f32x2* X = (LAS f32x2*)(lds + LDS_X);
#pragma unroll
        for (int ai = 0; ai < 2; ++ai)
#pragma unroll
            for (int m = 0; m < 4; ++m) {
                float v = -3.0e38f;
#pragma unroll
                for (int bj = 0; bj < 2; ++bj)
#pragma unroll
                    for (int n = 0; n < 2; ++n) { const f32x4 x = acc[ai][bj][m][n]; v = fmaxf(v, fmaxf(fmaxf(x[0], x[1]), fmaxf(x[2], x[3]))); }
                v = fmaxf(v, __shfl_xor(v, 16)); v = fmaxf(v, __shfl_xor(v, 32));
                float s = 0.f;
#pragma unroll
                for (int bj = 0; bj < 2; ++bj)
#pragma unroll
                    for (int n = 0; n < 2; ++n) { f32x4 x = acc[ai][bj][m][n]; x[0] = __expf(x[0] - v); x[1] = __expf(x[1] - v); x[2] = __expf(x[2] - v); x[3] = __expf(x[3] - v); acc[ai][bj][m][n] = x; s += (x[0] + x[1]) + (x[2] + x[3]); }
                s += __shfl_xor(s, 16); s += __shfl_xor(s, 32);
                if (fq == 0) X[(ai * HALF + wr * 64 + m * 16 + fr) * 4 + wc] = (f32x2){v, s};
            }
        LDS_WAIT(); __builtin_amdgcn_s_barrier(); asm volatile("" ::: "memory");
        const int col0 = wc * 32 + 8 * fq;
#pragma unroll
        for (int ai = 0; ai < 2; ++ai)
#pragma unroll
            for (int m = 0; m < 4; ++m) {
                const int r = ai * HALF + wr * 64 + m * 16 + fr;
                const f32x4 p01 = *(const LAS f32x4*)(X + r * 4), p23 = *(const LAS f32x4*)(X + r * 4 + 2);
                const float M = fmaxf(fmaxf(p01[0], p01[2]), fmaxf(p23[0], p23[2]));
                const float S = p01[1] * __expf(p01[0] - M) + p01[3] * __expf(p01[2] - M) + p23[1] * __expf(p23[0] - M) + p23[3] * __expf(p23[2] - M);
                const float f = __expf(X[r * 4 + wc][0] - M) * __builtin_amdgcn_rcpf(S);
                bf16* rowp = (bf16*)u.c + (size_t)r * ldc + col0;
#pragma unroll
                for (int bj = 0; bj < 2; ++bj) { const f32x4 v0 = acc[ai][bj][m][0] * f, v1 = acc[ai][bj][m][1] * f;
                    u32x4 w; w.x = cvt_pk_bf16(v0[0], v0[1]); w.y = cvt_pk_bf16(v0[2], v0[3]); w.z = cvt_pk_bf16(v1[0], v1[1]); w.w = cvt_pk_bf16(v1[2], v1[3]);
                    *(u32x4*)(rowp + bj * HALF) = w; }
            }
    }
};
struct EpiSwiglu {
    static constexpr bool PERM = true;
    const float* bgu;
    DI void operator()(f32x4 (&acc)[2][2][4][2], const Unit& u, int wr, int wc, int fr, int fq, LAS unsigned char*) const {
        const int col0 = u.pn * 128 + wc * 32 + 8 * fq;
        const float* bp = bgu + (size_t)u.aux * 2048 + col0;
        f32x4 bg[2], bl[2];
#pragma unroll
        for (int n = 0; n < 2; ++n) { bg[n] = *(const f32x4*)(bp + 4 * n); bl[n] = *(const f32x4*)(bp + 1024 + 4 * n); }
#pragma unroll
        for (int ai = 0; ai < 2; ++ai)
#pragma unroll
            for (int m = 0; m < 4; ++m) {
                float o[8];
#pragma unroll
                for (int n = 0; n < 2; ++n)
#pragma unroll
                    for (int j = 0; j < 4; ++j) {
                        const float glu = fminf(acc[ai][0][m][n][j] + bg[n][j], 7.0f);
                        const float lin = fminf(fmaxf(acc[ai][1][m][n][j] + bl[n][j], -7.0f), 7.0f);
                        o[4 * n + j] = (lin + 1.0f) * glu * sigmoidf_(1.702f * glu);
                    }
                u32x4 w; w.x = cvt_pk_bf16(o[0], o[1]); w.y = cvt_pk_bf16(o[2], o[3]); w.z = cvt_pk_bf16(o[4], o[5]); w.w = cvt_pk_bf16(o[6], o[7]);
                *(u32x4*)((bf16*)u.c + (size_t)(ai * HALF + wr * 64 + m * 16 + fr) * 1024 + wc * 32 + 8 * fq) = w;
            }
    }
};

template <class Epi, class Sched>
__device__ __forceinline__ void gemm_phase(LAS unsigned char* lds, const int lda, const int ldb, const int nt, const Sched& S, const Epi& E) {
    int tid = threadIdx.x; asm volatile("" : "+v"(tid));
    const int wid = __builtin_amdgcn_readfirstlane(tid >> 6), lane = tid & 63, wr = wid >> 2, wc = wid & 3, fr = lane & 15, fq = lane >> 4;
    unsigned voffA[2], voffB[2];
#pragma unroll
    for (int i = 0; i < 2; ++i) { int R, C; stage_rc(tid * 16 + i * 8192, R, C); const int Rb = Epi::PERM ? ((R & ~31) + perm32(R & 31)) : R;
        voffA[i] = (unsigned)(R * lda + C * 2); voffB[i] = (unsigned)(Rb * ldb + C * 2); }
    const size_t kstep = (size_t)(BK * 2);
    const size_t hstepA = (size_t)HALF * lda, hstepB = (size_t)HALF * ldb;
    const unsigned ldsw = (unsigned)wid * 1024u;
    const int aoff = lds_byte(wr * 64 + fr, fq * 8), boff = lds_byte(wc * 32 + fr, fq * 8);
#define PG8_SA(b, h) (((b) * 2 + (h)) * HTB)
#define PG8_SB(b, h) ((4 + (b) * 2 + (h)) * HTB)
#define PG8_STAGE(bufoff, gbase, voff) do { _Pragma("unroll") for (int _i = 0; _i < 2; ++_i) \
        __builtin_amdgcn_global_load_lds((const unsigned*)((const char*)(gbase) + (voff)[_i]), (LAS unsigned*)(lds + (bufoff) + ldsw + _i * 8192), 16, 0, 0); } while (0)
#define PG8_LDA(dst, b, h) do { _Pragma("unroll") for (int m = 0; m < 4; ++m) _Pragma("unroll") for (int k = 0; k < 2; ++k) dst[m][k] = *(const LAS bf16x8*)(lds + PG8_SA(b, h) + aoff + m * 2048 + k * 1024); } while (0)
#define PG8_LDB(dst, b, h) do { _Pragma("unroll") for (int n = 0; n < 2; ++n) _Pragma("unroll") for (int k = 0; k < 2; ++k) dst[n][k] = *(const LAS bf16x8*)(lds + PG8_SB(b, h) + boff + n * 2048 + k * 1024); } while (0)
#define PG8_MMA(ai, bj, At, Bt) do { __builtin_amdgcn_s_setprio(1); _Pragma("unroll") for (int m = 0; m < 4; ++m) _Pragma("unroll") for (int n = 0; n < 2; ++n) _Pragma("unroll") for (int k = 0; k < 2; ++k) \
        acc[ai][bj][m][n] = __builtin_amdgcn_mfma_f32_16x16x32_bf16(Bt[n][k], At[m][k], acc[ai][bj][m][n], 0, 0, 0); __builtin_amdgcn_s_setprio(0); } while (0)
#define PG8_WAIT_V(n) asm volatile("s_waitcnt vmcnt(" #n ")" ::: "memory")
#define PG8_WAIT_L(n) asm volatile("s_waitcnt lgkmcnt(" #n ")" ::: "memory")
#define PG8_BAR __builtin_amdgcn_s_barrier()
#define PG8_SCHED __builtin_amdgcn_sched_barrier(0)
    Unit cur, nxt; int ui = 0;
    if (!S.next(0, cur)) return;
    f32x4 acc[2][2][4][2];
#pragma unroll
    for (int a = 0; a < 2; ++a)
#pragma unroll
        for (int b = 0; b < 2; ++b)
#pragma unroll
            for (int m = 0; m < 4; ++m)
#pragma unroll
                for (int n = 0; n < 2; ++n) acc[a][b][m][n] = (f32x4){0.f, 0.f, 0.f, 0.f};
    bf16x8 At[4][2], B0[2][2], B1[2][2];
    const char* cA = cur.a; const char* cB = cur.b;
    PG8_STAGE(PG8_SB(0, 0), cB, voffB); PG8_STAGE(PG8_SB(0, 1), cB + hstepB, voffB); PG8_STAGE(PG8_SA(0, 0), cA, voffA); PG8_STAGE(PG8_SA(0, 1), cA + hstepA, voffA);
    if (wr == 1) PG8_BAR;
    PG8_WAIT_V(2); PG8_BAR;
    PG8_STAGE(PG8_SB(1, 0), cB + kstep, voffB); PG8_STAGE(PG8_SA(1, 0), cA + kstep, voffA); PG8_STAGE(PG8_SB(1, 1), cB + hstepB + kstep, voffB);
    PG8_WAIT_V(6); PG8_BAR;
    for (;;) {
        const bool has_next = S.next(ui + 1, nxt);
        const char* nA = has_next ? nxt.a : cA; const char* nB = has_next ? nxt.b : cB;
#pragma unroll 1
        for (int t = 0; t < nt; t += 2) {
            const bool last = (t == nt - 2);
            const char* a1 = cA + (size_t)(t + 1) * kstep;
            const char* a2 = last ? nA : cA + (size_t)(t + 2) * kstep; const char* b2 = last ? nB : cB + (size_t)(t + 2) * kstep;
            const char* a3 = a2 + kstep; const char* b3 = b2 + kstep;
            PG8_LDB(B0, 0, 0); PG8_LDB(B1, 0, 1); PG8_SCHED; PG8_LDA(At, 0, 0); PG8_STAGE(PG8_SA(1, 1), a1 + hstepA, voffA);
            PG8_WAIT_V(8); PG8_WAIT_L(0); PG8_BAR; PG8_MMA(0, 0, At, B0); PG8_MMA(0, 1, At, B1); PG8_BAR; PG8_SCHED;
            PG8_LDA(At, 0, 1); PG8_STAGE(PG8_SB(0, 0), b2, voffB); PG8_STAGE(PG8_SB(0, 1), b2 + hstepB, voffB); PG8_STAGE(PG8_SA(0, 0), a2, voffA);
            PG8_WAIT_V(8); PG8_WAIT_L(0); PG8_BAR; PG8_MMA(1, 0, At, B0); PG8_MMA(1, 1, At, B1); PG8_BAR; PG8_SCHED;
            PG8_LDB(B0, 1, 0); PG8_LDB(B1, 1, 1); PG8_SCHED; PG8_LDA(At, 1, 0); PG8_STAGE(PG8_SA(0, 1), a2 + hstepA, voffA);
            PG8_WAIT_V(8); PG8_WAIT_L(0); PG8_BAR; PG8_MMA(0, 0, At, B0); PG8_MMA(0, 1, At, B1); PG8_BAR; PG8_SCHED;
            PG8_LDA(At, 1, 1); PG8_STAGE(PG8_SB(1, 0), b3, voffB); PG8_STAGE(PG8_SB(1, 1), b3 + hstepB, voffB); PG8_STAGE(PG8_SA(1, 0), a3, voffA);
            PG8_WAIT_V(8); PG8_WAIT_L(0); PG8_BAR; PG8_MMA(1, 0, At, B0); PG8_MMA(1, 1, At, B1); PG8_BAR; PG8_SCHED;
        }
        if (wr == 0) PG8_BAR;
        { int fr_e = fr, fq_e = fq; asm volatile("" : "+v"(fr_e), "+v"(fq_e)); E(acc, cur, wr, wc, fr_e, fq_e, lds); }
        if (!has_next) break;
#pragma unroll
        for (int a = 0; a < 2; ++a)
#pragma unroll
            for (int b = 0; b < 2; ++b)
#pragma unroll
                for (int m = 0; m < 4; ++m)
#pragma unroll
                    for (int n = 0; n < 2; ++n) acc[a][b][m][n] = (f32x4){0.f, 0.f, 0.f, 0.f};
        cur = nxt; cA = nA; cB = nB; ++ui;
        if (wr == 1) PG8_BAR;
    }
    PG8_WAIT_V(0);
    PG8_BAR;
#undef PG8_SA
#undef PG8_SB
#undef PG8_STAGE
#undef PG8_LDA
#undef PG8_LDB
#undef PG8_MMA
#undef PG8_WAIT_V
#undef PG8_WAIT_L
#undef PG8_BAR
#undef PG8_SCHED
}
}

struct Args { const float* in[27]; float* out; unsigned char* ws; int ph_lo, ph_hi; };
struct Ctx {
    LAS unsigned char* lds; unsigned char* ws; unsigned* ctl;
    int tid, lane, wave, vcu, G;
};
constexpr int LDS_PTAB = LDS_MISC + 1024;
DI void refresh(Ctx& F, unsigned char* wsb) { int t = threadIdx.x; asm volatile("" : "+v"(t)); F.tid = t; F.lane = t & 63; F.wave = __builtin_amdgcn_readfirstlane(t >> 6);
    unsigned lo = (unsigned)(unsigned long long)wsb, hi = (unsigned)((unsigned long long)wsb >> 32); asm volatile("" : "+v"(lo), "+v"(hi));
    lo = __builtin_amdgcn_readfirstlane(lo); hi = __builtin_amdgcn_readfirstlane(hi); F.ws = (unsigned char*)(GAS unsigned char*)(((unsigned long long)hi << 32) | lo); F.ctl = (unsigned*)F.ws; }
DI const float* inp(const Ctx& F, int i) {
    const LAS unsigned* p = (const LAS unsigned*)(F.lds + LDS_PTAB) + 2 * i; const unsigned lo = __builtin_amdgcn_readfirstlane(p[0]), hi = __builtin_amdgcn_readfirstlane(p[1]);
    return (const float*)(GAS const float*)(((unsigned long long)hi << 32) | lo);
}
DI unsigned ldu(const unsigned* p) { return __hip_atomic_load(p, __ATOMIC_RELAXED, __HIP_MEMORY_SCOPE_AGENT); }
DI float ldf(const float* p) { return __uint_as_float(__hip_atomic_load((const unsigned*)p, __ATOMIC_RELAXED, __HIP_MEMORY_SCOPE_AGENT)); }

template <int MAP> DI int map_row(int n) {
    if (MAP == 0) return n;
    if (MAP == 1) return n < 1536 ? n : (n < 1544 ? -1 : (n < 3592 ? n - 8 : -1));
    return 256 * ((n & 1023) >> 7) + 128 * (n >> 10) + (n & 127);
}
template <int MAP> DI void tr_item(const float* W, int K, int N, bf16* WT, LAS float* scr, int item, int lane) {
    const int nblk = (N + 31) / 32, kb = item / nblk, nb = item % nblk, k0 = 64 * kb, n0 = 32 * nb;
    const int nl = n0 + (lane & 31);
#pragma unroll 8
    for (int i = 0; i < 32; ++i) { const int kk = 2 * i + (lane >> 5); scr[kk * 33 + (lane & 31)] = nl < N ? W[(size_t)(k0 + kk) * N + nl] : 0.f; }
    LDS_WAIT(); asm volatile("" ::: "memory");
    const int c = lane & 7;
#pragma unroll
    for (int j = 0; j < 4; ++j) { const int nn = (lane >> 3) + 8 * j; const int n = n0 + nn; const LAS float* s = scr + (8 * c) * 33 + nn;
        const int dr = n < N ? map_row<MAP>(n) : -1;
        u32x4 o; o.x = cvt_pk_bf16(s[0 * 33], s[1 * 33]); o.y = cvt_pk_bf16(s[2 * 33], s[3 * 33]); o.z = cvt_pk_bf16(s[4 * 33], s[5 * 33]); o.w = cvt_pk_bf16(s[6 * 33], s[7 * 33]);
        if (dr >= 0) *(u32x4*)(WT + (size_t)dr * K + k0 + 8 * c) = o; }
    LDS_WAIT(); asm volatile("" ::: "memory");
}
DI void phase_convert(Ctx& F, const Args& a) {
    LAS float* scr = (LAS float*)(F.lds + F.wave * 16384);
    const int gw = F.vcu * NWAVES + F.wave, NGW = F.G * NWAVES;
    constexpr int I_WIN = 16 * 113, I_SQ = 16 * 32, I_GU = 16 * 64;
    constexpr int E0 = 4 * I_WIN, E1 = E0 + 4 * I_SQ, E2 = E1 + 4 * I_SQ, E3 = E2 + 4 * I_SQ, E4 = E3 + 4 * I_SQ, E5 = E4 + 128 * I_GU, E6 = E5 + 128 * I_SQ;
    for (int it = gw; it < E6; it += NGW) {
        if (it < E0) { const int l = it / I_WIN, r = it % I_WIN; tr_item<1>(inp(F, 2) + (size_t)l * D * 3600, D, 3600, (bf16*)(F.ws + WS_WIN) + (size_t)l * NPROJ * D, scr, r, F.lane); }
        else if (it < E1) { const int q = it - E0, l = q / I_SQ, r = q % I_SQ; tr_item<0>(inp(F, 10) + (size_t)l * D * D, D, D, (bf16*)(F.ws + WS_WOUT) + (size_t)l * D * D, scr, r, F.lane); }
        else if (it < E2) { const int q = it - E1, l = q / I_SQ, r = q % I_SQ; tr_item<0>(inp(F, 14) + (size_t)l * D * D, D, D, (bf16*)(F.ws + WS_WKV) + (size_t)(2 * l) * D * D, scr, r, F.lane); }
        else if (it < E3) { const int q = it - E2, l = q / I_SQ, r = q % I_SQ; tr_item<0>(inp(F, 15) + (size_t)l * D * D, D, D, (bf16*)(F.ws + WS_WKV) + (size_t)(2 * l + 1) * D * D, scr, r, F.lane); }
        else if (it < E4) { const int q = it - E3, l = q / I_SQ, r = q % I_SQ; tr_item<0>(inp(F, 16) + (size_t)l * D * D, D, D, (bf16*)(F.ws + WS_WO) + (size_t)l * D * D, scr, r, F.lane); }
        else if (it < E5) { const int q = it - E4, le = q / I_GU, r = q % I_GU; tr_item<2>(inp(F, 21) + (size_t)le * D * 2048, D, 2048, (bf16*)(F.ws + WS_WGU) + (size_t)le * 2048 * D, scr, r, F.lane); }
        else { const int q = it - E5, le = q / I_SQ, r = q % I_SQ; tr_item<0>(inp(F, 23) + (size_t)le * D * D, D, D, (bf16*)(F.ws + WS_WDN) + (size_t)le * D * D, scr, r, F.lane); }
    }
    const size_t gt = (size_t)blockIdx.x * NTHREADS + F.tid, NGT = (size_t)F.G * NTHREADS;
    for (size_t i = gt; i < (4ull * D * D + 2048ull * D) / 8; i += NGT) {
        const bool isq = i < 4ull * D * D / 8; const size_t j = isq ? i : i - 4ull * D * D / 8;
        const float* src = (isq ? inp(F, 13) : inp(F, 1)) + j * 8; bf16* dst = (bf16*)(F.ws + (isq ? WS_WQ : WS_MEMB)) + j * 8;
        const f32x4 v0 = *(const f32x4*)src, v1 = *(const f32x4*)(src + 4);
        u32x4 o; o.x = cvt_pk_bf16(v0[0], v0[1]); o.y = cvt_pk_bf16(v0[2], v0[3]); o.z = cvt_pk_bf16(v1[0], v1[1]); o.w = cvt_pk_bf16(v1[2], v1[3]);
        *(u32x4*)dst = o;
    }
    for (size_t i = gt; i < 4ull * 48 * D; i += NGT) {
        const int l = (int)(i / (48 * D)), r = (int)(i % (48 * D)), j = r / D, k = r % D;
        float w; bf16* dh; bf16* dl;
        if (j < 16) { const int col = j < 8 ? 1536 + j : 3592 + (j - 8); w = inp(F, 2)[((size_t)l * D + k) * 3600 + col];
            dh = (bf16*)(F.ws + WS_WGATE) + ((size_t)(l * 2 + 0) * 16 + j) * D + k; dl = dh + 16 * D; }
        else { const int e = j - 16; w = inp(F, 19)[((size_t)l * D + k) * 32 + e];
            dh = (bf16*)(F.ws + WS_WRT) + ((size_t)(l * 2 + 0) * 32 + e) * D + k; dl = dh + 32 * D; }
        const bf16 h = f2bf(w); *dh = h; *dl = f2bf(w - bf2f(h));
    }
}

DI void unpack8(const u32x4 w, float* v) { v[0] = bflo(w.x); v[1] = bfhi(w.x); v[2] = bflo(w.y); v[3] = bfhi(w.y); v[4] = bflo(w.z); v[5] = bfhi(w.z); v[6] = bflo(w.w); v[7] = bfhi(w.w); }
DI u32x4 pack8(const float* v) { u32x4 o; o.x = cvt_pk_bf16(v[0], v[1]); o.y = cvt_pk_bf16(v[2], v[3]); o.z = cvt_pk_bf16(v[4], v[5]); o.w = cvt_pk_bf16(v[6], v[7]); return o; }
template <int MODE> DI void row_pass(Ctx& F, const Args& a, int l) {
    const int lane = F.lane, r0 = (F.vcu * NWAVES + F.wave) * 16;
    bf16* XB = (bf16*)(F.ws + WS_XB); const bf16* HB = (const bf16*)(F.ws + WS_HB); const bf16* Y = (const bf16*)(F.ws + WS_Y);
    const int c0 = 8 * lane, c1 = 512 + 8 * lane;
    LAS unsigned* ecnt = (LAS unsigned*)(F.lds + LDS_MISC + 256);
    if (MODE == 2) { if (F.tid < 64) ecnt[F.tid] = 0u; __syncthreads(); }
    float g[16], bb[16];
    if (MODE >= 1) {
        const float* gp = inp(F, MODE == 1 ? 11 : (MODE == 2 ? 17 : 25)) + (size_t)l * D; const float* bp = inp(F, MODE == 1 ? 12 : (MODE == 2 ? 18 : 26)) + (size_t)l * D;
#pragma unroll
        for (int q = 0; q < 2; ++q) { const int c = q ? c1 : c0;
            const f32x4 g0 = *(const f32x4*)(gp + c), g1 = *(const f32x4*)(gp + c + 4), b0 = *(const f32x4*)(bp + c), b1 = *(const f32x4*)(bp + c + 4);
#pragma unroll
            for (int j = 0; j < 4; ++j) { g[8 * q + j] = g0[j]; g[8 * q + 4 + j] = g1[j]; bb[8 * q + j] = b0[j]; bb[8 * q + 4 + j] = b1[j]; } }
    }
    for (int i = 0; i < 16; ++i) {
        const int r = r0 + i; float v[16];
        if (MODE == 0) {
            const float* xr = inp(F, 0) + (size_t)r * D;
            const f32x4 x0 = *(const f32x4*)(xr + c0), x1 = *(const f32x4*)(xr + c0 + 4), x2 = *(const f32x4*)(xr + c1), x3 = *(const f32x4*)(xr + c1 + 4);
#pragma unroll
            for (int j = 0; j < 4; ++j) { v[j] = x0[j]; v[4 + j] = x1[j]; v[8 + j] = x2[j]; v[12 + j] = x3[j]; }
        } else {
            float xv[16]; unpack8(*(const u32x4*)(XB + (size_t)r * D + c0), xv); unpack8(*(const u32x4*)(XB + (size_t)r * D + c1), xv + 8);
            if (MODE == 3) {
                const int* sl = (const int*)(F.ws + WS_SLOT) + (size_t)r * 4; const float* tg = (const float*)(F.ws + WS_TOPG) + (size_t)r * 4;
#pragma unroll
                for (int j = 0; j < 16; ++j) v[j] = DN_ALPHA * xv[j];
#pragma unroll
                for (int k = 0; k < 4; ++k) { const int s = (int)ldu((const unsigned*)sl + k); const float gk = ldf(tg + k); float yv[16];
                    unpack8(*(const u32x4*)(Y + (size_t)s * D + c0), yv); unpack8(*(const u32x4*)(Y + (size_t)s * D + c1), yv + 8);
#pragma unroll
                    for (int j = 0; j < 16; ++j) v[j] += gk * yv[j]; }
            } else {
                float hv[16]; unpack8(*(const u32x4*)(HB + (size_t)r * D + c0), hv); unpack8(*(const u32x4*)(HB + (size_t)r * D + c1), hv + 8);
#pragma unroll
                for (int j = 0; j < 16; ++j) v[j] = DN_ALPHA * xv[j] + hv[j];
            }
            float s = 0.f;
#pragma unroll
            for (int j = 0; j < 16; ++j) s += v[j];
            const float mean = wave_sum(s) * (1.f / D); float q = 0.f;
#pragma unroll
            for (int j = 0; j < 16; ++j) { v[j] -= mean; q += v[j] * v[j]; }
            const float rstd = rsqrtf(wave_sum(q) * (1.f / D) + 1e-5f);
#pragma unroll
            for (int j = 0; j < 16; ++j) v[j] = v[j] * rstd * g[j] + bb[j];
        }
        if (MODE == 3 && l == NL - 1) {
            float* orow = ((float*)inp(F, 27)) + (size_t)r * D;
            *(f32x4*)(orow + c0) = (f32x4){v[0], v[1], v[2], v[3]}; *(f32x4*)(orow + c0 + 4) = (f32x4){v[4], v[5], v[6], v[7]};
            *(f32x4*)(orow + c1) = (f32x4){v[8], v[9], v[10], v[11]}; *(f32x4*)(orow + c1 + 4) = (f32x4){v[12], v[13], v[14], v[15]};
        } else {
            *(u32x4*)(XB + (size_t)r * D + c0) = pack8(v); *(u32x4*)(XB + (size_t)r * D + c1) = pack8(v + 8);
        }
    }
    if (MODE == 1 || (MODE == 3 && l == NL - 1)) return;
    VM_WAIT(); __builtin_amdgcn_fence(__ATOMIC_ACQUIRE, "agent"); VM_WAIT(); asm volatile("" ::: "memory");
    constexpr int N16 = (MODE == 2) ? 2 : 1, NN = 16 * N16;
    const bf16* Wb = (MODE == 2) ? (const bf16*)(F.ws + WS_WRT) + (size_t)l * 2 * 32 * D : (const bf16*)(F.ws + WS_WGATE) + (size_t)(MODE == 0 ? 0 : l + 1) * 2 * 16 * D;
    const bf16* arow = XB + (size_t)(r0 + (lane & 15)) * D + 8 * (lane >> 4);
    const bf16* wrow = Wb + (size_t)(lane & 15) * D + 8 * (lane >> 4);
    f32x4 acc[N16];
#pragma unroll
    for (int n = 0; n < N16; ++n) acc[n] = (f32x4){0.f, 0.f, 0.f, 0.f};
#pragma unroll 4
    for (int ks = 0; ks < 32; ++ks) {
        const bf16x8 af = *(const bf16x8*)(arow + 32 * ks);
#pragma unroll
        for (int n = 0; n < N16; ++n) {
            const bf16x8 bh = *(const bf16x8*)(wrow + (size_t)n * 16 * D + 32 * ks), bl = *(const bf16x8*)(wrow + (size_t)(NN + n * 16) * D + 32 * ks);
            acc[n] = MFMA16(af, bh, acc[n]); acc[n] = MFMA16(af, bl, acc[n]);
        }
    }
    if (MODE != 2) {
        float* G = (float*)(F.ws + WS_GATES);
#pragma unroll
        for (int i = 0; i < 4; ++i) G[(size_t)(r0 + 4 * (lane >> 4) + i) * 16 + (lane & 15)] = acc[0][i];
        return;
    }
    if (MODE == 2) {
        LAS float* LG = (LAS float*)(F.lds + F.wave * 4096);
#pragma unroll
        for (int n = 0; n < N16; ++n)
#pragma unroll
            for (int i = 0; i < 4; ++i) LG[(4 * (lane >> 4) + i) * 33 + n * 16 + (lane & 15)] = acc[n][i];
        LDS_WAIT(); asm volatile("" ::: "memory");
        int te[4] = {0, 0, 0, 0}; float tv[4] = {0.f, 0.f, 0.f, 0.f}; unsigned rk[4] = {0u, 0u, 0u, 0u};
        if (lane < 16) {
            float lg[32]; const float* rb = inp(F, 20) + (size_t)l * 32;
#pragma unroll
            for (int e = 0; e < 32; ++e) lg[e] = LG[lane * 33 + e] + rb[e];
#pragma unroll
            for (int k = 0; k < 4; ++k) {
                float best = -3.0e38f; int bi = 0;
#pragma unroll
                for (int e = 0; e < 32; ++e) { const bool gt = lg[e] > best; best = gt ? lg[e] : best; bi = gt ? e : bi; }
                te[k] = bi; tv[k] = best;
#pragma unroll
                for (int e = 0; e < 32; ++e) lg[e] = (e == bi) ? -3.0e38f : lg[e];
            }
            const float e1 = __expf(tv[1] - tv[0]), e2 = __expf(tv[2] - tv[0]), e3 = __expf(tv[3] - tv[0]); const float inv = 1.f / (1.f + e1 + e2 + e3);
            tv[0] = inv; tv[1] = e1 * inv; tv[2] = e2 * inv; tv[3] = e3 * inv;
#pragma unroll
            for (int k = 0; k < 4; ++k) rk[k] = __hip_atomic_fetch_add(ecnt + te[k], 1u, __ATOMIC_RELAXED, __HIP_MEMORY_SCOPE_WORKGROUP);
        }
        __syncthreads();
        if (F.tid < 32) ecnt[32 + F.tid] = __hip_atomic_fetch_add(F.ctl + CW_ECNT + l * 32 + F.tid, ecnt[F.tid], __ATOMIC_RELAXED, __HIP_MEMORY_SCOPE_AGENT);
        __syncthreads();
        if (lane < 16) {
            const int r = r0 + lane; int* pe = (int*)(F.ws + WS_TOPE) + (size_t)r * 4; int* pp = (int*)(F.ws + WS_TOPP) + (size_t)r * 4; float* pg = (float*)(F.ws + WS_TOPG) + (size_t)r * 4;
#pragma unroll
            for (int k = 0; k < 4; ++k) { pe[k] = te[k]; pp[k] = (int)(ecnt[32 + te[k]] + rk[k]); pg[k] = tv[k]; }
        }
    }
}

DI void phase_scatter(Ctx& F, int l) {
    LAS int* ts = (LAS int*)(F.lds + LDS_MISC + 512);
    if (F.tid == 0) { int acc = 0; for (int e = 0; e < 32; ++e) { ts[e] = acc; acc += (int)((ldu(F.ctl + CW_ECNT + l * 32 + e) + 255u) >> 8); } ts[32] = acc; }
    __syncthreads();
    if (blockIdx.x == 0) {
        if (F.tid == 0) __hip_atomic_store(F.ctl + CW_NT + l, (unsigned)ts[32], __ATOMIC_RELAXED, __HIP_MEMORY_SCOPE_AGENT);
        for (int t = F.tid; t < ts[32]; t += NTHREADS) { int e = 0; while (e < 31 && t >= ts[e + 1]) ++e; F.ctl[CW_TILE_E + l * MAXTILES + t] = (unsigned)e; }
    }
    const int r0 = (F.vcu * NWAVES + F.wave) * 16, lane = F.lane;
    const bf16* XB = (const bf16*)(F.ws + WS_XB); bf16* XG = (bf16*)(F.ws + WS_XG);
    for (int i = 0; i < 16; ++i) {
        const int r = r0 + i;
        const u32x4 x0 = *(const u32x4*)(XB + (size_t)r * D + 8 * lane), x1 = *(const u32x4*)(XB + (size_t)r * D + 512 + 8 * lane);
#pragma unroll
        for (int k = 0; k < 4; ++k) {
            const int e = ((const int*)(F.ws + WS_TOPE))[(size_t)r * 4 + k], p = ((const int*)(F.ws + WS_TOPP))[(size_t)r * 4 + k];
            const int slot = ts[e] * 256 + p;
            if (lane == 0) ((int*)(F.ws + WS_SLOT))[(size_t)r * 4 + k] = slot;
            *(u32x4*)(XG + (size_t)slot * D + 8 * lane) = x0; *(u32x4*)(XG + (size_t)slot * D + 512 + 8 * lane) = x1;
        }
    }
}
struct MoeOrder {
    const char* A; const char* B; char* C; const unsigned* tile_e; int NT, nN; size_t bE, bN, cN; int G, c0;
    DI bool next(int i, g8::Unit& u) const {
        const int L = i * G + c0; if (L >= NT * nN) return false;
        int pm, pn; g8::tile_of(L, NT, nN, pm, pn); const int e = __builtin_amdgcn_readfirstlane((int)ldu(tile_e + pm));
        u.pm = pm; u.pn = pn; u.aux = e; u.a = A + (size_t)pm * 256 * 2048; u.b = B + (size_t)e * bE + (size_t)pn * bN; u.c = C + (size_t)pm * 256 * 2048 + (size_t)pn * cN; return true;
    }
};

DI unsigned lds_addr(const LAS void* p) { return (unsigned)(size_t)p; }
DI bf16x8 tr_frag8(unsigned img, int ld_bytes, int row_lo, int row_hi, int m0, int lane) {
    const int i = lane & 15; const unsigned a_lo = img + (unsigned)((row_lo + (i >> 2)) * ld_bytes + (m0 + 4 * (i & 3)) * 2), a_hi = img + (unsigned)((row_hi + (i >> 2)) * ld_bytes + (m0 + 4 * (i & 3)) * 2);
    s16x4 lo, hi;
    asm volatile("ds_read_b64_tr_b16 %0, %2\n\tds_read_b64_tr_b16 %1, %3\n\ts_waitcnt lgkmcnt(0)" : "=&v"(lo), "=&v"(hi) : "v"(a_lo), "v"(a_hi) : "memory");
    return __builtin_shufflevector(lo, hi, 0, 1, 2, 3, 4, 5, 6, 7);
}
DI s16x4 tr_read4(unsigned addr) { s16x4 r; asm volatile("ds_read_b64_tr_b16 %0, %1\n\ts_waitcnt lgkmcnt(0)" : "=&v"(r) : "v"(addr) : "memory"); return r; }
DI bf16x8 pack_frag(const f32x4 a, const f32x4 b) {
    u32x4 p; p.x = cvt_pk_bf16(a[0], a[1]); p.y = cvt_pk_bf16(a[2], a[3]); p.z = cvt_pk_bf16(b[0], b[1]); p.w = cvt_pk_bf16(b[2], b[3]); return __builtin_bit_cast(bf16x8, p);
}
DI u32x2 pack4(const f32x4 a) { u32x2 p; p.x = cvt_pk_bf16(a[0], a[1]); p.y = cvt_pk_bf16(a[2], a[3]); return p; }
DI f32x4 unpack4(const u32x2 w) { return (f32x4){bflo(w.x), bfhi(w.x), bflo(w.y), bfhi(w.y)}; }
DI float softcap15(float x) { const float y = x * (1.f / 15.f); const float e = __expf(2.f * y); return 15.f * (1.f - 2.f * __builtin_amdgcn_rcpf(e + 1.f)); }
DI float log_sigmoid(float x) { return fminf(x, 0.f) - log1pf(__expf(-fabsf(x))); }
DI float softplusf_(float x) { return fmaxf(x, 0.f) + log1pf(__expf(-fabsf(x))); }
DI float wave_incl_sum(float v, int lane) {
#pragma unroll
    for (int o = 1; o < 64; o <<= 1) { const float t = __shfl_up(v, o); v += (lane >= o) ? t : 0.f; }
    return v;
}
DI float wave_incl_max(float v, int lane) {
#pragma unroll
    for (int o = 1; o < 64; o <<= 1) { const float t = __shfl_up(v, o); v = (lane >= o) ? fmaxf(v, t) : v; }
    return v;
}
constexpr int LDI = 136 * 2;
constexpr int LDK = 72 * 2;

DI void ml_a_unit(Ctx& F, const Args& a, int l, int cid) {
    const int b = cid >> 8, h = (cid >> 6) & 3, n = cid & 63, t0 = b * SEQ + n * CH, lane = F.lane, tid = F.tid;
    const bf16* PROJ = (const bf16*)(F.ws + WS_PROJ); const float* GT = (const float*)(F.ws + WS_GATES);
    LAS unsigned char* KE = F.lds; LAS unsigned char* VI = F.lds + 16384; LAS float* es = (LAS float*)(F.lds + 40960);
    if (F.wave == 0) {
        const float ip = softcap15(GT[(size_t)(t0 + lane) * 16 + h] + inp(F, 3)[l * 4 + h]), fp = softcap15(GT[(size_t)(t0 + lane) * 16 + 4 + h] + inp(F, 4)[l * 4 + h]);
        const float bc = wave_incl_sum(log_sigmoid(fp), lane), blast = __shfl(bc, 63), lw = blast - bc + ip, amax = wave_max(lw);
        es[lane] = __expf(lw - amax);
        if (lane == 0) { float* sc = (float*)(F.ws + WS_MLSC) + (size_t)cid * 4; sc[0] = blast; sc[1] = amax; }
    }
    __syncthreads();
    { const int s = tid >> 3, c8 = (tid & 7) * 8; float v[8]; unpack8(*(const u32x4*)(PROJ + (size_t)(t0 + s) * NPROJ + 256 + h * 64 + c8), v); const float e = es[s];
#pragma unroll
      for (int j = 0; j < 8; ++j) v[j] *= e;
      *(LAS u32x4*)(KE + s * LDK + c8 * 2) = pack8(v); }
#pragma unroll
    for (int q = 0; q < 2; ++q) { const int idx = tid + 512 * q, s = idx >> 4, c8 = (idx & 15) * 8;
        *(LAS u32x4*)(VI + s * LDI + c8 * 2) = *(const u32x4*)(PROJ + (size_t)(t0 + s) * NPROJ + 512 + h * 128 + c8); }
    __syncthreads();
    { const int g = lane >> 4, w = F.wave; f32x4 acc[4];
#pragma unroll
      for (int nt = 0; nt < 4; ++nt) acc[nt] = (f32x4){0.f, 0.f, 0.f, 0.f};
#pragma unroll
      for (int ks = 0; ks < 2; ++ks) { const int rb = 32 * ks + 8 * g;
          const bf16x8 af = tr_frag8(lds_addr(VI), LDI, rb, rb + 4, 16 * w, lane);
#pragma unroll
          for (int nt = 0; nt < 4; ++nt) { const bf16x8 bf = tr_frag8(lds_addr(KE), LDK, rb, rb + 4, 16 * nt, lane); acc[nt] = MFMA16(af, bf, acc[nt]); } }
      float* U = (float*)(F.ws + WS_MLU) + (size_t)cid * 8192;
#pragma unroll
      for (int nt = 0; nt < 4; ++nt)
#pragma unroll
          for (int i = 0; i < 4; ++i) U[(16 * w + 4 * g + i) * 64 + 16 * nt + (lane & 15)] = acc[nt][i];
    }
    if (tid < 64) { float s = 0.f; for (int r = 0; r < 64; ++r) s += bf2f(*(const LAS bf16*)(KE + r * LDK + tid * 2)); ((float*)(F.ws + WS_MLKN))[(size_t)cid * 64 + tid] = s; }
    __syncthreads();
}
DI void ml_b_unit(Ctx& F, int u) {
    const int bh = u >> 4, p = u & 15, tid = F.tid, j = p * 512 + tid;
    const float* U = (const float*)(F.ws + WS_MLU); const float* SC = (const float*)(F.ws + WS_MLSC); const float* KN = (const float*)(F.ws + WS_MLKN);
    bf16* CT = (bf16*)(F.ws + WS_MLCT); float* NP = (float*)(F.ws + WS_MLNP); float* MP = (float*)(F.ws + WS_MLMP);
    float C = 0.f, nv = 0.f, m = 0.f; const bool dn = (p == 0 && tid < 64);
    for (int nb = 0; nb < 64; nb += 8) {
        float uv[8], kv[8];
#pragma unroll
        for (int q = 0; q < 8; ++q) { const size_t cid = (size_t)bh * 64 + nb + q; uv[q] = U[cid * 8192 + j]; kv[q] = dn ? KN[cid * 64 + tid] : 0.f; }
#pragma unroll
        for (int q = 0; q < 8; ++q) { const size_t cid = (size_t)bh * 64 + nb + q;
            const float blast = ldf(SC + cid * 4), amax = ldf(SC + cid * 4 + 1);
            CT[cid * 8192 + j] = f2bf(C); if (dn) NP[cid * 64 + tid] = nv; if (p == 0 && tid == 0) MP[cid] = m;
            const float mn = fmaxf(blast + m, amax), d1 = __expf(blast + m - mn), d2 = __expf(amax - mn);
            C = d1 * C + d2 * uv[q]; nv = d1 * nv + d2 * kv[q]; m = mn; }
    }
}
DI void ml_c_unit(Ctx& F, const Args& a, int l, int cid) {
    const int b = cid >> 8, h = (cid >> 6) & 3, n = cid & 63, t0 = b * SEQ + n * CH, lane = F.lane, tid = F.tid, g = lane >> 4, ln = lane & 15, w = F.wave, tt = w & 3, dh = w >> 2;
    const bf16* PROJ = (const bf16*)(F.ws + WS_PROJ); const float* GT = (const float*)(F.ws + WS_GATES);
    LAS unsigned char* VI = F.lds; LAS float* ib = (LAS float*)(F.lds + 20480); LAS float* Mt = ib + 64; LAS float* bcs = ib + 128; LAS float* ss = ib + 192;
    const float mprev = ldf((const float*)(F.ws + WS_MLMP) + cid);
    if (w == 0) {
        const float ip = softcap15(GT[(size_t)(t0 + lane) * 16 + h] + inp(F, 3)[l * 4 + h]), fp = softcap15(GT[(size_t)(t0 + lane) * 16 + 4 + h] + inp(F, 4)[l * 4 + h]);
        const float bc = wave_incl_sum(log_sigmoid(fp), lane), ibs = ip - bc, pm = wave_incl_max(ibs, lane);
        ib[lane] = ibs; Mt[lane] = fmaxf(mprev, pm); bcs[lane] = bc;
    }
#pragma unroll
    for (int q = 0; q < 2; ++q) { const int idx = tid + 512 * q, s = idx >> 4, c8 = (idx & 15) * 8;
        *(LAS u32x4*)(VI + s * LDI + c8 * 2) = *(const u32x4*)(PROJ + (size_t)(t0 + s) * NPROJ + 512 + h * 128 + c8); }
    __syncthreads();
    bf16x8 qf[2];
#pragma unroll
    for (int ks = 0; ks < 2; ++ks) qf[ks] = *(const bf16x8*)(PROJ + (size_t)(t0 + 16 * tt + ln) * NPROJ + h * 64 + 32 * ks + 8 * g);
    f32x4 sacc[4];
#pragma unroll
    for (int ms = 0; ms < 4; ++ms) { sacc[ms] = (f32x4){0.f, 0.f, 0.f, 0.f};
#pragma unroll
        for (int ks = 0; ks < 2; ++ks) { const bf16x8 kf = *(const bf16x8*)(PROJ + (size_t)(t0 + 16 * ms + ln) * NPROJ + 256 + h * 64 + 32 * ks + 8 * g); sacc[ms] = MFMA16(kf, qf[ks], sacc[ms]); } }
    const int tl = 16 * tt + ln; const float Mtt = Mt[tl];
#pragma unroll
    for (int ms = 0; ms < 4; ++ms) { const f32x4 ibv = *(const LAS f32x4*)(ib + 16 * ms + 4 * g);
#pragma unroll
        for (int i = 0; i < 4; ++i) { const int s = 16 * ms + 4 * g + i; sacc[ms][i] = (s <= tl) ? sacc[ms][i] * 0.125f * __expf(ibv[i] - Mtt) : 0.f; } }
    bf16x8 sb[2]; sb[0] = pack_frag(sacc[0], sacc[1]); sb[1] = pack_frag(sacc[2], sacc[3]);
    const bf16* CT = (const bf16*)(F.ws + WS_MLCT) + (size_t)cid * 8192; const float* NPv = (const float*)(F.ws + WS_MLNP) + (size_t)cid * 64;
    f32x4 xacc[5];
#pragma unroll
    for (int mt = 0; mt < 5; ++mt) { xacc[mt] = (f32x4){0.f, 0.f, 0.f, 0.f};
#pragma unroll
        for (int ks = 0; ks < 2; ++ks) { bf16x8 af;
            if (mt < 4) af = *(const bf16x8*)(CT + (size_t)(16 * (4 * dh + mt) + ln) * 64 + 32 * ks + 8 * g);
            else { float nvv[8];
#pragma unroll
                for (int j = 0; j < 8; ++j) nvv[j] = (ln == 0) ? NPv[32 * ks + 8 * g + j] : 0.f;
                af = __builtin_bit_cast(bf16x8, pack8(nvv)); }
            xacc[mt] = MFMA16(af, qf[ks], xacc[mt]); } }
    const float wint = 0.125f * __expf(mprev - Mtt);
#pragma unroll
    for (int mt = 0; mt < 5; ++mt) xacc[mt] *= wint;
    const bf16x8 ones = (ln == 0) ? (bf16x8){0x3f80, 0x3f80, 0x3f80, 0x3f80, 0x3f80, 0x3f80, 0x3f80, 0x3f80} : (bf16x8){0, 0, 0, 0, 0, 0, 0, 0};
#pragma unroll
    for (int kk = 0; kk < 2; ++kk) {
#pragma unroll
        for (int mt = 0; mt < 4; ++mt) { const bf16x8 vf = tr_frag8(lds_addr(VI), LDI, 32 * kk + 4 * g, 32 * kk + 16 + 4 * g, 16 * (4 * dh + mt), lane); xacc[mt] = MFMA16(vf, sb[kk], xacc[mt]); }
        xacc[4] = MFMA16(ones, sb[kk], xacc[4]);
    }
    const float den = __shfl(xacc[4][0], ln), mt_ = bcs[tl] + Mtt, dinv = __builtin_amdgcn_rcpf(fmaxf(fabsf(den), __expf(-mt_)));
    float ssq = 0.f;
#pragma unroll
    for (int mt = 0; mt < 4; ++mt) { xacc[mt] *= dinv; ssq += (xacc[mt][0] * xacc[mt][0] + xacc[mt][1] * xacc[mt][1]) + (xacc[mt][2] * xacc[mt][2] + xacc[mt][3] * xacc[mt][3]); }
    ssq += __shfl_xor(ssq, 16); ssq += __shfl_xor(ssq, 32);
    if (g == 0) ss[tl * 2 + dh] = ssq;
    __syncthreads();
    const float rinv = rsqrtf((ss[tl * 2] + ss[tl * 2 + 1]) * (1.f / 128.f) + 1e-6f);
    bf16* MX = (bf16*)(F.ws + WS_MIXED);
#pragma unroll
    for (int mt = 0; mt < 4; ++mt) { const int dv = 16 * (4 * dh + mt) + 4 * g;
        const f32x4 nw = *(const f32x4*)(inp(F, 5) + (size_t)l * 512 + h * 128 + dv);
        const f32x4 og = unpack4(*(const u32x2*)(PROJ + (size_t)(t0 + tl) * NPROJ + 1024 + h * 128 + dv));
        f32x4 o;
#pragma unroll
        for (int i = 0; i < 4; ++i) o[i] = xacc[mt][i] * rinv * nw[i] * sigmoidf_(og[i]);
        *(u32x2*)(MX + (size_t)(t0 + tl) * D + h * 128 + dv) = pack4(o); }
    __syncthreads();
}

constexpr int GA_QH = 0, GA_KH = 17408, GA_VB = 34816, GA_KB = 52224, GA_NA = 69632, GA_AD = 78848, GA_TI = 82944, GA_GC = 84992, GA_KEI = 86016;
DI void gd_a_unit(Ctx& F, const Args& a, int l, int cid) {
    const int b = cid >> 8, h = (cid >> 6) & 3, n = cid & 63, t0 = b * SEQ + n * CH, lane = F.lane, tid = F.tid, g = lane >> 4, ln = lane & 15, w = F.wave;
    const bf16* PROJ = (const bf16*)(F.ws + WS_PROJ); const float* GT = (const float*)(F.ws + WS_GATES);
    LAS unsigned char* L = F.lds; LAS float* gcs = (LAS float*)(L + GA_GC); LAS float* bts = gcs + 64;
    if (w == 0) {
        const float beta = sigmoidf_(GT[(size_t)(t0 + lane) * 16 + 8 + h]);
        const float gg = -__expf(inp(F, 7)[l * 4 + h]) * softplusf_(GT[(size_t)(t0 + lane) * 16 + 12 + h] + inp(F, 8)[l * 4 + h]);
        const float gc = wave_incl_sum(gg, lane);
        gcs[lane] = gc; bts[lane] = beta;
        if (lane == 63) ((float*)(F.ws + WS_GDGL))[cid] = __expf(gc);
    }
    __syncthreads();
    const float glast = gcs[63];
    { const int cg = tid & 15;
#pragma unroll 1
      for (int ten = 0; ten < 3; ++ten) {
          float wv[4][8];
#pragma unroll
          for (int j = 0; j < 4; ++j) { const float* wp = inp(F, 6) + ((size_t)l * 4 + j) * 1536 + ten * 512 + h * 128 + 8 * cg; const f32x4 w0 = *(const f32x4*)wp, w1 = *(const f32x4*)(wp + 4);
#pragma unroll
              for (int c = 0; c < 4; ++c) { wv[j][c] = w0[c]; wv[j][4 + c] = w1[c]; } }
#pragma unroll
          for (int pass = 0; pass < 2; ++pass) { const int t = (tid >> 4) + 32 * pass; float y[8];
#pragma unroll
              for (int c = 0; c < 8; ++c) y[c] = 0.f;
#pragma unroll
              for (int j = 0; j < 4; ++j) { const int row = t - 3 + j;
                  if (n > 0 || row >= 0) { float xv[8]; unpack8(*(const u32x4*)(PROJ + (size_t)(t0 + row) * NPROJ + 1536 + ten * 512 + h * 128 + 8 * cg), xv);
#pragma unroll
                      for (int c = 0; c < 8; ++c) y[c] += wv[j][c] * xv[c]; } }
#pragma unroll
              for (int c = 0; c < 8; ++c) y[c] = y[c] * sigmoidf_(y[c]);
              const float gct = gcs[t], bt = bts[t];
              if (ten < 2) { float s2 = 0.f;
#pragma unroll
                  for (int c = 0; c < 8; ++c) s2 += y[c] * y[c];
                  s2 += __shfl_xor(s2, 1); s2 += __shfl_xor(s2, 2); s2 += __shfl_xor(s2, 4); s2 += __shfl_xor(s2, 8);
                  const float rn = rsqrtf(s2 + 1e-6f) * (ten == 0 ? 0.08838834764831845f : 1.f);
#pragma unroll
                  for (int c = 0; c < 8; ++c) y[c] *= rn; }
              float z[8];
              if (ten == 0) { *(LAS u32x4*)(L + GA_QH + t * LDI + 16 * cg) = pack8(y); const float e = __expf(gct);
#pragma unroll
                  for (int c = 0; c < 8; ++c) z[c] = y[c] * e;
                  *(u32x4*)((bf16*)(F.ws + WS_GDQG) + (size_t)cid * 8192 + t * 128 + 8 * cg) = pack8(z); }
              else if (ten == 1) { *(LAS u32x4*)(L + GA_KH + t * LDI + 16 * cg) = pack8(y); const float e1 = bt * __expf(gct), e2 = __expf(glast - gct);
#pragma unroll
                  for (int c = 0; c < 8; ++c) z[c] = y[c] * e1;
                  *(LAS u32x4*)(L + GA_KB + t * LDI + 16 * cg) = pack8(z);
#pragma unroll
                  for (int c = 0; c < 8; ++c) z[c] = y[c] * e2;
                  *(LAS u32x4*)(L + GA_KEI + t * LDI + 16 * cg) = pack8(z); }
              else {
#pragma unroll
                  for (int c = 0; c < 8; ++c) z[c] = y[c] * bt;
                  *(LAS u32x4*)(L + GA_VB + t * LDI + 16 * cg) = pack8(z); }
          }
      } }
    __syncthreads();
    { const int ti = w & 3, kind = w >> 2; const int tl = 16 * ti + ln; const float gct = gcs[tl], bt = bts[tl];
      bf16* QKD = (bf16*)(F.ws + WS_GDQK) + (size_t)cid * 4096;
#pragma unroll
      for (int si = 0; si < 4; ++si) {
          if (si <= ti) {
              f32x4 acc = (f32x4){0.f, 0.f, 0.f, 0.f};
#pragma unroll
              for (int ks = 0; ks < 4; ++ks) { const bf16x8 af = *(const LAS bf16x8*)(L + GA_KH + (16 * si + ln) * LDI + (32 * ks + 8 * g) * 2);
                  const bf16x8 bfr = *(const LAS bf16x8*)(L + (kind ? GA_QH : GA_KH) + tl * LDI + (32 * ks + 8 * g) * 2); acc = MFMA16(af, bfr, acc); }
              const f32x4 gs = *(const LAS f32x4*)(gcs + 16 * si + 4 * g);
              f32x4 v;
#pragma unroll
              for (int i = 0; i < 4; ++i) { const int s = 16 * si + 4 * g + i; const float dec = __expf(gct - gs[i]);
                  v[i] = kind ? ((s <= tl) ? acc[i] * dec : 0.f) : ((s < tl) ? bt * acc[i] * dec : 0.f); }
              if (kind) *(u32x2*)(QKD + tl * 64 + 16 * si + 4 * g) = pack4(v);
              else { *(LAS u32x2*)(L + GA_NA + tl * LDK + (16 * si + 4 * g) * 2) = pack4(-v);
                  if (si == ti) { LAS float* AD = (LAS float*)(L + GA_AD) + ti * 256 + ln * 16 + 4 * g; AD[0] = v[0]; AD[1] = v[1]; AD[2] = v[2]; AD[3] = v[3]; } }
          } else if (kind) *(u32x2*)(QKD + tl * 64 + 16 * si + 4 * g) = (u32x2){0u, 0u};
      } }
    __syncthreads();
    if (w == 0) { const LAS float* AD = (const LAS float*)(L + GA_AD) + g * 256; float Tc[16];
#pragma unroll
        for (int t = 0; t < 16; ++t) { float v = (t == ln) ? 1.f : 0.f;
#pragma unroll
            for (int s = 0; s < t; ++s) v -= AD[t * 16 + s] * Tc[s];
            Tc[t] = v; *(LAS bf16*)(L + GA_TI + (16 * g + t) * 32 + ln * 2) = f2bf(v); } }
    __syncthreads();
    { const int src = (w < 4) ? GA_VB : GA_KB, cb = 32 * (w & 3);
      u32x2 Ub[4][2]; bf16* UT = (bf16*)(F.ws + WS_GDUT) + (size_t)cid * 8192;
#pragma unroll
      for (int i = 0; i < 4; ++i) {
          f32x4 acc[2];
#pragma unroll
          for (int nt = 0; nt < 2; ++nt)
#pragma unroll
              for (int r = 0; r < 4; ++r) acc[nt][r] = bf2f(*(const LAS bf16*)(L + src + (16 * i + 4 * g + r) * LDI + (cb + 16 * nt + ln) * 2));
#pragma unroll
          for (int jp = 0; jp < 2; ++jp) { if (2 * jp < i) {
              const u32x2 alo = *(const LAS u32x2*)(L + GA_NA + (16 * i + ln) * LDK + (32 * jp + 4 * g) * 2);
              const u32x2 ahi = (2 * jp + 1 < i) ? *(const LAS u32x2*)(L + GA_NA + (16 * i + ln) * LDK + (32 * jp + 16 + 4 * g) * 2) : (u32x2){0u, 0u};
              const bf16x8 af = __builtin_bit_cast(bf16x8, (u32x4){alo.x, alo.y, ahi.x, ahi.y});
#pragma unroll
              for (int nt = 0; nt < 2; ++nt) { const u32x2 blo = Ub[2 * jp][nt], bhi = (2 * jp + 1 < i) ? Ub[2 * jp + 1][nt] : (u32x2){0u, 0u};
                  acc[nt] = MFMA16(af, __builtin_bit_cast(bf16x8, (u32x4){blo.x, blo.y, bhi.x, bhi.y}), acc[nt]); } } }
          const u32x2 tlo = *(const LAS u32x2*)(L + GA_TI + (16 * i + ln) * 32 + (4 * g) * 2);
          const bf16x8 tf = __builtin_bit_cast(bf16x8, (u32x4){tlo.x, tlo.y, 0u, 0u});
#pragma unroll
          for (int nt = 0; nt < 2; ++nt) { const u32x2 p = pack4(acc[nt]);
              const f32x4 u = MFMA16(tf, __builtin_bit_cast(bf16x8, (u32x4){p.x, p.y, 0u, 0u}), ((f32x4){0.f, 0.f, 0.f, 0.f}));
              Ub[i][nt] = pack4(u);
              if (w < 4) *(u32x2*)(UT + (size_t)(cb + 16 * nt + ln) * 64 + 16 * i + 4 * g) = Ub[i][nt];
              else {
#pragma unroll
                  for (int r = 0; r < 4; ++r) *(LAS bf16*)(L + GA_QH + (16 * i + 4 * g + r) * LDI + (cb + 16 * nt + ln) * 2) = f2bf(u[r]); } }
      } }
    __syncthreads();
    { bf16* W = (bf16*)(F.ws + WS_GDW) + (size_t)cid * 8192; bf16* KET = (bf16*)(F.ws + WS_GDKE) + (size_t)cid * 8192;
#pragma unroll
      for (int q = 0; q < 2; ++q) { const int item = tid + 512 * q, t = item >> 4, c = item & 15, kk = c >> 2, gp = c & 3;
          const u32x2 lo = *(const LAS u32x2*)(L + GA_QH + t * LDI + (32 * kk + 4 * gp) * 2), hi = *(const LAS u32x2*)(L + GA_QH + t * LDI + (32 * kk + 16 + 4 * gp) * 2);
          *(u32x4*)(W + t * 128 + 32 * kk + 8 * gp) = (u32x4){lo.x, lo.y, hi.x, hi.y}; }
#pragma unroll
      for (int q = 0; q < 4; ++q) { const int rg = 4 * q + g, kk = rg >> 3, idx = rg & 7, pos = 32 * kk + ((idx < 4) ? 8 * idx : 8 * (idx - 4) + 4);
          const int trow = 32 * kk + ((idx < 4) ? 4 * idx : 16 + 4 * (idx - 4));
          const s16x4 v = tr_read4(lds_addr(L + GA_KEI) + (unsigned)((trow + (ln >> 2)) * LDI + (16 * w + 4 * (ln & 3)) * 2));
          *(s16x4*)(KET + (size_t)(16 * w + ln) * 64 + pos) = v; }
    }
    __syncthreads();
}
DI void gd_b_task(Ctx& F, int task) {
    const int bh = task >> 3, dv0 = 16 * (task & 7), lane = F.lane, g = lane >> 4, ln = lane & 15;
    const bf16* UT = (const bf16*)(F.ws + WS_GDUT); const bf16* W = (const bf16*)(F.ws + WS_GDW); const bf16* KET = (const bf16*)(F.ws + WS_GDKE);
    bf16* VNT = (bf16*)(F.ws + WS_GDVN); bf16* SPT = (bf16*)(F.ws + WS_GDSP); const float* GL = (const float*)(F.ws + WS_GDGL);
    f32x4 S[8];
#pragma unroll
    for (int j = 0; j < 8; ++j) S[j] = (f32x4){0.f, 0.f, 0.f, 0.f};
#pragma unroll 1
    for (int n = 0; n < 64; ++n) {
        const size_t cid = (size_t)bh * 64 + n;
        const float egl = ldf(GL + cid);
        bf16x8 wf[4][4], kef[8][2]; f32x4 vacc[4];
#pragma unroll
        for (int mt = 0; mt < 4; ++mt) { vacc[mt] = unpack4(*(const u32x2*)(UT + cid * 8192 + (size_t)(dv0 + ln) * 64 + 16 * mt + 4 * g));
#pragma unroll
            for (int kk = 0; kk < 4; ++kk) wf[mt][kk] = *(const bf16x8*)(W + cid * 8192 + (size_t)(16 * mt + ln) * 128 + 32 * kk + 8 * g); }
#pragma unroll
        for (int j = 0; j < 8; ++j)
#pragma unroll
            for (int k2 = 0; k2 < 2; ++k2) kef[j][k2] = *(const bf16x8*)(KET + cid * 8192 + (size_t)(16 * j + ln) * 64 + 32 * k2 + 8 * g);
        bf16x8 sbn[4];
#pragma unroll
        for (int kk = 0; kk < 4; ++kk) sbn[kk] = pack_frag(-S[2 * kk], -S[2 * kk + 1]);
#pragma unroll
        for (int j = 0; j < 8; ++j) *(u32x2*)(SPT + cid * 16384 + (size_t)(dv0 + ln) * 128 + 16 * j + 4 * g) = pack4(S[j]);
#pragma unroll
        for (int mt = 0; mt < 4; ++mt)
#pragma unroll
            for (int kk = 0; kk < 4; ++kk) vacc[mt] = MFMA16(wf[mt][kk], sbn[kk], vacc[mt]);
#pragma unroll
        for (int mt = 0; mt < 4; ++mt) *(u32x2*)(VNT + cid * 8192 + (size_t)(dv0 + ln) * 64 + 16 * mt + 4 * g) = pack4(vacc[mt]);
        bf16x8 vb[2]; vb[0] = pack_frag(vacc[0], vacc[1]); vb[1] = pack_frag(vacc[2], vacc[3]);
#pragma unroll
        for (int j = 0; j < 8; ++j) { S[j] *= egl;
#pragma unroll
            for (int k2 = 0; k2 < 2; ++k2) S[j] = MFMA16(kef[j][k2], vb[k2], S[j]); }
    }
}
DI void gd_c_unit(Ctx& F, const Args& a, int l, int cid) {
    const int b = cid >> 8, h = (cid >> 6) & 3, n = cid & 63, t0 = b * SEQ + n * CH, lane = F.lane, g = lane >> 4, ln = lane & 15, w = F.wave, tt = w & 3, dh = w >> 2, tl = 16 * tt + ln;
    const bf16* PROJ = (const bf16*)(F.ws + WS_PROJ);
    const bf16* SPT = (const bf16*)(F.ws + WS_GDSP) + (size_t)cid * 16384; const bf16* QG = (const bf16*)(F.ws + WS_GDQG) + (size_t)cid * 8192;
    const bf16* VNT = (const bf16*)(F.ws + WS_GDVN) + (size_t)cid * 8192; const bf16* QKD = (const bf16*)(F.ws + WS_GDQK) + (size_t)cid * 4096;
    LAS float* ss = (LAS float*)(F.lds);
    bf16x8 qf[4], pf[2];
#pragma unroll
    for (int ks = 0; ks < 4; ++ks) qf[ks] = *(const bf16x8*)(QG + tl * 128 + 32 * ks + 8 * g);
#pragma unroll
    for (int ks = 0; ks < 2; ++ks) pf[ks] = *(const bf16x8*)(QKD + tl * 64 + 32 * ks + 8 * g);
    f32x4 o[4]; float ssq = 0.f;
#pragma unroll
    for (int mt = 0; mt < 4; ++mt) { o[mt] = (f32x4){0.f, 0.f, 0.f, 0.f}; const int dvr = 16 * (4 * dh + mt) + ln;
#pragma unroll
        for (int ks = 0; ks < 4; ++ks) o[mt] = MFMA16(*(const bf16x8*)(SPT + (size_t)dvr * 128 + 32 * ks + 8 * g), qf[ks], o[mt]);
#pragma unroll
        for (int ks = 0; ks < 2; ++ks) o[mt] = MFMA16(*(const bf16x8*)(VNT + (size_t)dvr * 64 + 32 * ks + 8 * g), pf[ks], o[mt]);
        ssq += (o[mt][0] * o[mt][0] + o[mt][1] * o[mt][1]) + (o[mt][2] * o[mt][2] + o[mt][3] * o[mt][3]); }
    ssq += __shfl_xor(ssq, 16); ssq += __shfl_xor(ssq, 32);
    if (g == 0) ss[tl * 2 + dh] = ssq;
    __syncthreads();
    const float rinv = rsqrtf((ss[tl * 2] + ss[tl * 2 + 1]) * (1.f / 128.f) + 1e-6f);
    bf16* MX = (bf16*)(F.ws + WS_MIXED);
#pragma unroll
    for (int mt = 0; mt < 4; ++mt) { const int dv = 16 * (4 * dh + mt) + 4 * g;
        const f32x4 nw = *(const f32x4*)(inp(F, 9) + (size_t)l * 128 + dv);
        const f32x4 z = unpack4(*(const u32x2*)(PROJ + (size_t)(t0 + tl) * NPROJ + 3072 + h * 128 + dv));
        f32x4 r;
#pragma unroll
        for (int i = 0; i < 4; ++i) r[i] = o[mt][i] * rinv * nw[i] * z[i] * sigmoidf_(z[i]);
        *(u32x2*)(MX + (size_t)(t0 + tl) * D + 512 + h * 128 + dv) = pack4(r); }
    __syncthreads();
}

struct P2Order {
    unsigned char* ws; int G, c0;
    DI bool next(int i, g8::Unit& u) const {
        const int L = i * G + c0; if (L >= 1024) return false;
        const int q = L & 511, t4 = q & 3, h = (q >> 2) & 3, b = (q >> 4) & 7, l = q >> 7;
        if (L < 512) { u.a = (const char*)(ws + WS_KV) + ((size_t)(2 * l) * 2048 + b * 256) * 2048 + h * 512; u.b = (const char*)(ws + WS_WQ) + ((size_t)l * 1024 + t4 * 256) * 2048 + h * 512;
            u.c = (char*)(ws + WS_WQK) + ((size_t)(l * 8 + b) * 1024 + h * 256) * 2048 + t4 * 512; u.aux = -1; }
        else { u.a = (const char*)(ws + WS_WO) + ((size_t)l * 1024 + t4 * 256) * 2048 + h * 512; u.b = (const char*)(ws + WS_KV) + ((size_t)(2 * l + 1) * 2048 + b * 256) * 2048 + h * 512;
            u.c = (char*)(ws + WS_WVO) + ((size_t)(l * 8 + b) * 1024 + t4 * 256) * 2048 + h * 512; u.aux = 0; }
        u.pm = 0; u.pn = 0; return true;
    }
};

constexpr int NPH_LAYER = 13, NPH = 3 + NL * NPH_LAYER;
__global__ void __launch_bounds__(NTHREADS, 2) mega(Args a) {
    extern __shared__ __attribute__((aligned(16))) unsigned char lds_raw[];
    Ctx F; F.lds = (LAS unsigned char*)lds_raw; F.ws = a.ws; F.ctl = (unsigned*)(a.ws + WS_CTL);
    F.tid = threadIdx.x; F.lane = F.tid & 63; F.wave = __builtin_amdgcn_readfirstlane(F.tid >> 6); F.G = gridDim.x;
    { const int bx = blockIdx.x; F.vcu = (F.G % 8 == 0) ? (bx % 8) * (F.G / 8) + bx / 8 : bx; }
    volatile LAS unsigned* MISC = (volatile LAS unsigned*)(F.lds + LDS_MISC);
    if (F.tid < 64) MISC[F.tid] = 0u;
    if (F.tid < 28) { const unsigned long long pv = (unsigned long long)(F.tid < 27 ? (const void*)a.in[F.tid] : (const void*)a.out); ((LAS unsigned long long*)(F.lds + LDS_PTAB))[F.tid] = pv; }
    __syncthreads();
    const bool multi = (a.ph_hi - a.ph_lo) > 1;
    XcdBarrier bar; bar.bar = F.ctl + CW_BAR; bar.x = 0; bar.st = MISC;
    if (multi) bar = xcd_barrier_post(F.ctl + CW_BAR, MISC);
#ifndef PMASK
#define PMASK 0xffff
#endif
#define EN(j) (((PMASK) >> (j)) & 1)
#define PH(k) (a.ph_lo <= (k) && (k) < a.ph_hi && (refresh(F, a.ws), true))
#define SEAM(k) do { if (PH(k) && PH((k) + 1)) xcd_barrier(bar); } while (0)
    const int G = F.G, vcu = F.vcu;

    if (EN(13) && PH(0)) { phase_convert(F, a); }
    SEAM(0);
    if (EN(14) && PH(1)) {
        g8::AffineOrder S; S.A = (const char*)(F.ws + WS_MEMB); S.B = (const char*)(F.ws + WS_WKV); S.C = (char*)(F.ws + WS_KV);
        S.aM = 256ull * 2048; S.bB = 0; S.bN = 256ull * 2048; S.cM = 256ull * 2048; S.cS = 2048ull * 2048; S.cN = 512; S.nM = 8; S.nN = 32; S.bdiv = 1 << 30; S.csp = 4; S.G = G; S.c0 = vcu;
        g8::EpiBf16 E{1024, nullptr, 0, 1.f};
        g8::gemm_phase(F.lds, 2048, 2048, 16, S, E);
        row_pass<0>(F, a, 0);
    }
    SEAM(1);
    if (EN(15) && PH(2)) { P2Order S{F.ws, G, vcu}; g8::EpiBf16 E{1024, nullptr, 0, 0.0625f}; g8::gemm_phase(F.lds, 2048, 2048, 4, S, E); }
    SEAM(2);
#pragma unroll 1
    for (int l = 0; l < NL; ++l) {
        const int pb = 3 + l * NPH_LAYER;
        if (EN(0) && PH(pb + 0)) {
            g8::AffineOrder S = g8::dense_order(F.ws + WS_XB, F.ws + WS_WIN + (size_t)l * NPROJ * D * 2, F.ws + WS_PROJ, T, NPROJ, D, NPROJ * 2, 2, G, vcu);
            g8::EpiBf16 E{NPROJ, nullptr, 0, 1.f}; g8::gemm_phase(F.lds, 2048, 2048, 16, S, E);
        }
        SEAM(pb + 0);
        if (EN(1) && PH(pb + 1)) {
            for (int u = vcu; u < 4096; u += G) { if (u < 2048) ml_a_unit(F, a, l, u); else gd_a_unit(F, a, l, u - 2048); }
        }
        SEAM(pb + 1);
        if (EN(2) && PH(pb + 2)) {
            for (int u = vcu; u < 512; u += G) ml_b_unit(F, u);
            if (F.wave == 0 && vcu < 256) gd_b_task(F, vcu);
        }
        SEAM(pb + 2);
        if (EN(3) && PH(pb + 3)) {
            for (int u = vcu; u < 4096; u += G) { if (u < 2048) ml_c_unit(F, a, l, u); else gd_c_unit(F, a, l, u - 2048); }
        }
        SEAM(pb + 3);
        if (EN(4) && PH(pb + 4)) {
            g8::AffineOrder S = g8::dense_order(F.ws + WS_MIXED, F.ws + WS_WOUT + (size_t)l * D * D * 2, F.ws + WS_HB, T, D, D, D * 2, 2, G, vcu);
            g8::EpiBf16 E{D, nullptr, 0, 1.f}; g8::gemm_phase(F.lds, 2048, 2048, 16, S, E);
        }
        SEAM(pb + 4);
        if (EN(5) && PH(pb + 5)) row_pass<1>(F, a, l);
        SEAM(pb + 5);
        if (EN(6) && PH(pb + 6)) {
            g8::AffineOrder S = g8::dense_order(F.ws + WS_XB, F.ws + WS_WQK + (size_t)l * 8 * D * D * 2, F.ws + WS_PB, T, D, D, D * 2, 2, G, vcu);
            S.bB = (size_t)D * D * 2; S.bdiv = 16;
            g8::EpiSoftmax E{D}; g8::gemm_phase(F.lds, 2048, 2048, 16, S, E);
        }
        SEAM(pb + 6);
        if (EN(7) && PH(pb + 7)) {
            g8::AffineOrder S = g8::dense_order(F.ws + WS_PB, F.ws + WS_WVO + (size_t)l * 8 * D * D * 2, F.ws + WS_HB, T, D, D, D * 2, 2, G, vcu);
            S.bB = (size_t)D * D * 2; S.bdiv = 16;
            g8::EpiBf16 E{D, nullptr, 0, 1.f}; g8::gemm_phase(F.lds, 2048, 2048, 16, S, E);
        }
        SEAM(pb + 7);
        if (EN(8) && PH(pb + 8)) row_pass<2>(F, a, l);
        SEAM(pb + 8);
        if (EN(9) && PH(pb + 9)) phase_scatter(F, l);
        SEAM(pb + 9);
        if (EN(10) && PH(pb + 10)) {
            MoeOrder S; S.A = (const char*)(F.ws + WS_XG); S.B = (const char*)(F.ws + WS_WGU) + (size_t)l * 32 * 2048 * D * 2; S.C = (char*)(F.ws + WS_ACT); S.tile_e = F.ctl + CW_TILE_E + l * MAXTILES;
            S.NT = __builtin_amdgcn_readfirstlane((int)ldu(F.ctl + CW_NT + l)); S.nN = 8; S.bE = 2048ull * D * 2; S.bN = 256ull * 2048; S.cN = 256; S.G = G; S.c0 = vcu;
            g8::EpiSwiglu E{inp(F, 22) + (size_t)l * 32 * 2048}; g8::gemm_phase(F.lds, 2048, 2048, 16, S, E);
        }
        SEAM(pb + 10);
        if (EN(11) && PH(pb + 11)) {
            MoeOrder S; S.A = (const char*)(F.ws + WS_ACT); S.B = (const char*)(F.ws + WS_WDN) + (size_t)l * 32 * D * D * 2; S.C = (char*)(F.ws + WS_Y); S.tile_e = F.ctl + CW_TILE_E + l * MAXTILES;
            S.NT = __builtin_amdgcn_readfirstlane((int)ldu(F.ctl + CW_NT + l)); S.nN = 4; S.bE = (size_t)D * D * 2; S.bN = 256ull * 2048; S.cN = 512; S.G = G; S.c0 = vcu;
            g8::EpiBf16 E{D, inp(F, 24) + (size_t)l * 32 * D, D, 1.f}; g8::gemm_phase(F.lds, 2048, 2048, 16, S, E);
        }
        SEAM(pb + 11);
        if (EN(12) && PH(pb + 12)) row_pass<3>(F, a, l);
        SEAM(pb + 12);
    }
}

#ifndef DBG_STOP
#define DBG_STOP 0
#endif
#ifndef DBG_OFF
#define DBG_OFF WS_MIXED
#endif
#ifndef DBG_N
#define DBG_N ((size_t)T * D)
#endif
#ifndef DBG_F32
#define DBG_F32 0
#endif
__global__ void dbg_dump(const unsigned char* ws, float* out, size_t off) {
    const bf16* b = (const bf16*)(ws + off); const float* f = (const float*)(ws + off);
    for (size_t i = (size_t)blockIdx.x * blockDim.x + threadIdx.x; i < (size_t)T * D; i += (size_t)gridDim.x * blockDim.x) out[i] = (i < (size_t)(DBG_N)) ? (DBG_F32 ? f[i] : bf2f(b[i])) : 0.f;
}
#ifndef N_LAUNCH_MODE
#define N_LAUNCH_MODE 0
#endif
extern "C" void kernel_launch(void* const* d_in, const int* in_sizes, int n_in, void* d_out, int out_size, void* d_ws, size_t ws_size, hipStream_t stream) {
    static int ready = 0;
    if (ready == 0) {
        if (n_in != 27 || ws_size < WS_END) { fprintf(stderr, "kernel_launch: need 27 inputs and %zu bytes of workspace (got %d, %zu)\n", (size_t)WS_END, n_in, ws_size); ready = -1; return; }
        if (hipFuncSetAttribute((const void*)mega, hipFuncAttributeMaxDynamicSharedMemorySize, LDS_BYTES) != hipSuccess) { fprintf(stderr, "kernel_launch: hipFuncSetAttribute failed\n"); ready = -1; return; }
        int per_cu = 0; (void)hipOccupancyMaxActiveBlocksPerMultiprocessor(&per_cu, (const void*)mega, NTHREADS, LDS_BYTES); (void)hipGetLastError();
        ready = 1;
    }
    if (ready < 0) return;
    (void)hipMemsetAsync((char*)d_ws + WS_CTL, 0, 1 << 20, stream);
    Args a{};
    for (int i = 0; i < 27; ++i) a.in[i] = (const float*)d_in[i];
    a.out = (float*)d_out; a.ws = (unsigned char*)d_ws;
#if N_LAUNCH_MODE == 1
    a.ph_lo = 0; a.ph_hi = NPH;
    hipLaunchKernelGGL(mega, dim3(256), dim3(NTHREADS), LDS_BYTES, stream, a);
#else
    for (int p = 0; p < (DBG_STOP > 0 ? DBG_STOP : NPH); ++p) { a.ph_lo = p; a.ph_hi = p + 1; hipLaunchKernelGGL(mega, dim3(256), dim3(NTHREADS), LDS_BYTES, stream, a); }
    if (DBG_STOP > 0) hipLaunchKernelGGL(dbg_dump, dim3(2048), dim3(256), 0, stream, (const unsigned char*)d_ws, (float*)d_out, (size_t)(DBG_OFF));
#endif
}
```

```cpp
#include <hip/hip_runtime.h>
#include <cstdio>
#include <cstdint>

#define LAS __attribute__((address_space(3)))
typedef unsigned short bf16;
typedef short bf16x8 __attribute__((ext_vector_type(8)));
typedef short s16x4 __attribute__((ext_vector_type(4)));
typedef float f32x4 __attribute__((ext_vector_type(4)));
typedef float f32x2 __attribute__((ext_vector_type(2)));
typedef unsigned u32x4 __attribute__((ext_vector_type(4)));
typedef unsigned u32x2 __attribute__((ext_vector_type(2)));
#define DI __device__ __forceinline__
#define GAS __attribute__((address_space(1)))

constexpr int T = 32768, D = 1024, NB = 8, SEQ = 4096, NL = 4, NCH = 64, CH = 64;
constexpr int NPROJ = 3584;
constexpr int NE = 32, TOPK = 4;
constexpr int MAXTILES = 544, CAP = MAXTILES * 256;
constexpr float DN_ALPHA = 1.6817928305074290f;
constexpr int NWAVES = 8, NTHREADS = 512;
constexpr int LDS_RING = 131072, LDS_X = 131072  , LDS_MISC = 131072 + 12288, LDS_BYTES = 147456;

constexpr size_t MiB = 1ull << 20;
constexpr size_t WS_CTL = 0;
constexpr size_t WS_WIN = 1 * MiB;
constexpr size_t WS_WGATE = WS_WIN + 4ull * NPROJ * D * 2;
constexpr size_t WS_WRT = WS_WGATE + 4ull * 2 * 16 * D * 2;
constexpr size_t WS_WOUT = WS_WRT + 4ull * 2 * 32 * D * 2;
constexpr size_t WS_WQ = WS_WOUT + 4ull * D * D * 2;
constexpr size_t WS_WKV = WS_WQ + 4ull * D * D * 2;
constexpr size_t WS_WO = WS_WKV + 8ull * D * D * 2;
constexpr size_t WS_WGU = WS_WO + 4ull * D * D * 2;
constexpr size_t WS_WDN = WS_WGU + 4ull * 32 * 2048 * D * 2;
constexpr size_t WS_MEMB = WS_WDN + 4ull * 32 * D * D * 2;
constexpr size_t WS_KV = WS_MEMB + 2048ull * D * 2;
constexpr size_t WS_WQK = WS_KV + 8ull * 2048 * D * 2;
constexpr size_t WS_WVO = WS_WQK + 32ull * D * D * 2;
constexpr size_t WS_XB = WS_WVO + 32ull * D * D * 2;
constexpr size_t WS_PROJ = WS_XB + (size_t)T * D * 2;
constexpr size_t WS_GATES = WS_PROJ + (size_t)T * NPROJ * 2;
constexpr size_t WS_MIXED = WS_GATES + (size_t)T * 16 * 4;
constexpr size_t WS_HB = WS_MIXED + (size_t)T * D * 2;
constexpr size_t WS_PB = WS_HB + (size_t)T * D * 2;
constexpr size_t WS_TOPE = WS_PB + (size_t)T * D * 2;
constexpr size_t WS_TOPP = WS_TOPE + (size_t)T * 16;
constexpr size_t WS_TOPG = WS_TOPP + (size_t)T * 16;
constexpr size_t WS_SLOT = WS_TOPG + (size_t)T * 16;
constexpr size_t WS_XG = WS_SLOT + (size_t)T * 16;
constexpr size_t WS_ACT = WS_XG + (size_t)CAP * D * 2;
constexpr size_t WS_Y = WS_ACT + (size_t)CAP * D * 2;
constexpr size_t WS_MLU = WS_Y + (size_t)CAP * D * 2;
constexpr size_t WS_MLKN = WS_MLU + 2048ull * 8192 * 4;
constexpr size_t WS_MLSC = WS_MLKN + 2048ull * 64 * 4;
constexpr size_t WS_MLCT = WS_MLSC + 2048ull * 16;
constexpr size_t WS_MLNP = WS_MLCT + 2048ull * 8192 * 2;
constexpr size_t WS_MLMP = WS_MLNP + 2048ull * 64 * 4;
constexpr size_t WS_GDUT = WS_MLMP + 2048ull * 4;
constexpr size_t WS_GDW = WS_GDUT + 2048ull * 8192 * 2;
constexpr size_t WS_GDKE = WS_GDW + 2048ull * 8192 * 2;
constexpr size_t WS_GDQG = WS_GDKE + 2048ull * 8192 * 2;
constexpr size_t WS_GDQK = WS_GDQG + 2048ull * 8192 * 2;
constexpr size_t WS_GDGL = WS_GDQK + 2048ull * 4096 * 2;
constexpr size_t WS_GDVN = WS_GDGL + 2048ull * 4;
constexpr size_t WS_GDSP = WS_GDVN + 2048ull * 8192 * 2;
constexpr size_t WS_END = WS_GDSP + 2048ull * 16384 * 2;
constexpr int CW_BAR = 1024, CW_ECNT = 8192, CW_NT = 8192 + 256, CW_TILE_E = 8192 + 512, CW_DBG = 16384;

typedef __bf16 bf16x2_t __attribute__((ext_vector_type(2)));
DI unsigned cvt_pk_bf16(float lo, float hi) { const f32x2 v = {lo, hi}; const bf16x2_t r = __builtin_convertvector(v, bf16x2_t); return __builtin_bit_cast(unsigned, r); }
DI bf16 f2bf(float f) { return (bf16)(cvt_pk_bf16(f, 0.f) & 0xffffu); }
DI float bf2f(bf16 b) { return __uint_as_float(((unsigned)b) << 16); }
DI float bflo(unsigned w) { return __uint_as_float(w << 16); }
DI float bfhi(unsigned w) { return __uint_as_float(w & 0xffff0000u); }
DI float sigmoidf_(float x) { return __builtin_amdgcn_rcpf(1.f + __expf(-x)); }
DI float wave_sum(float v) {
#pragma unroll
    for (int o = 1; o < 64; o <<= 1) v += __shfl_xor(v, o);
    return v;
}
DI float wave_max(float v) {
#pragma unroll
    for (int o = 1; o < 64; o <<= 1) v = fmaxf(v, __shfl_xor(v, o));
    return v;
}
#define LDS_WAIT() asm volatile("s_waitcnt lgkmcnt(0)" ::: "memory")
#define VM_WAIT() asm volatile("s_waitcnt vmcnt(0)" ::: "memory")
#define MFMA16(a, b, c) __builtin_amdgcn_mfma_f32_16x16x32_bf16((a), (b), (c), 0, 0, 0)

#define XB_TMO      128
#define XB_XCNT(j)  (256  + 64 * (j))
#define XB_XSUB(j)  (1280 + 64 * (j))
#define XB_XGEN(j)  (2304 + 64 * (j))
#define XB_TOP      3328
#define XB_TOPGEN   3392
#define XCD_BAR_WORDS 3456
#define XB_SPIN_CAP (1u << 22)
__device__ __forceinline__ unsigned xb_ld(unsigned* p)              { return __hip_atomic_load(p, __ATOMIC_RELAXED, __HIP_MEMORY_SCOPE_AGENT); }
__device__ __forceinline__ unsigned xb_add(unsigned* p, unsigned v) { return __hip_atomic_fetch_add(p, v, __ATOMIC_RELAXED, __HIP_MEMORY_SCOPE_AGENT); }
__device__ __forceinline__ unsigned xb_xcc_id() { return (unsigned)__builtin_amdgcn_s_getreg((3 << 11) | 20) & 0xFu; }
#define XB_SPIN(cond, bar) do { unsigned _sp = 0; while (cond) { __builtin_amdgcn_s_sleep(1); \
    if ((++_sp & 255u) == 0u) { if (xb_ld(&(bar)[XB_TMO])) break; if (_sp > XB_SPIN_CAP) { atomicAdd(&(bar)[XB_TMO], 1u); break; } } } } while (0)
struct XcdBarrier { unsigned* bar; unsigned x; volatile LAS unsigned* st; };
__device__ __forceinline__ XcdBarrier xcd_barrier_post(unsigned* bar, volatile LAS unsigned* st) {
    XcdBarrier b; b.bar = bar; b.x = xb_xcc_id(); b.st = st;
    if (threadIdx.x == 0) (void)xb_add(&bar[XB_XCNT(b.x)], 1u);
    return b;
}
__device__ __forceinline__ void xcd_barrier_complete(unsigned* bar, unsigned x, unsigned& nloc, unsigned& nx) {
    const unsigned G = gridDim.x * gridDim.y * gridDim.z;
    unsigned sum, cnt, mine, sp = 0u;
    for (;;) {
        sum = 0u; cnt = 0u; mine = 0u;
#pragma unroll
        for (unsigned j = 0; j < 16; ++j) { const unsigned c = xb_ld(&bar[XB_XCNT(j)]); sum += c; cnt += (c > 0u) ? 1u : 0u; mine = (j == x) ? c : mine; }
        if (sum == G) break;
        __builtin_amdgcn_s_sleep(1);
        if ((++sp & 255u) == 0u) { if (xb_ld(&bar[XB_TMO])) break; if (sp > XB_SPIN_CAP) { atomicAdd(&bar[XB_TMO], 1u); break; } }
    }
    nloc = mine > 0u ? mine : 1u; nx = cnt > 0u ? cnt : 1u;
}
__device__ __forceinline__ void xcd_barrier(const XcdBarrier& b) {
    asm volatile("s_waitcnt vmcnt(0)" ::: "memory");
    __syncthreads();
    if (threadIdx.x == 0) {
        unsigned* bar = b.bar;
        __builtin_amdgcn_s_waitcnt(0);
        unsigned nloc = b.st[0], nx = b.st[1];
        if (nloc == 0u) { xcd_barrier_complete(bar, b.x, nloc, nx); b.st[0] = nloc; b.st[1] = nx; }
        const unsigned old = xb_add(&bar[XB_XSUB(b.x)], 1u);
        const unsigned gen = old / nloc;
        if (old + 1u == (gen + 1u) * nloc) {
            __builtin_amdgcn_fence(__ATOMIC_RELEASE, "agent");
            asm volatile("s_waitcnt vmcnt(0)" ::: "memory");
            const unsigned og = xb_add(&bar[XB_TOP], 1u);
            const unsigned tg = og / nx;
            if (og + 1u == (tg + 1u) * nx) xb_add(&bar[XB_TOPGEN], 1u);
            else XB_SPIN(xb_ld(&bar[XB_TOPGEN]) == tg, bar);
            __builtin_amdgcn_fence(__ATOMIC_ACQUIRE, "agent");
            xb_add(&bar[XB_XGEN(b.x)], 1u);
            asm volatile("s_waitcnt vmcnt(0)" ::: "memory");
        } else {
            XB_SPIN(xb_ld(&bar[XB_XGEN(b.x)]) == gen, bar);
            __builtin_amdgcn_fence(__ATOMIC_ACQUIRE, "agent");
            asm volatile("s_waitcnt vmcnt(0)" ::: "memory");
        }
    }
    __syncthreads();
}

namespace g8 {
constexpr int BM = 256, BK = 64, HALF = 128, HTB = HALF * BK * 2;
__host__ __device__ __forceinline__ int lds_byte(int r, int c) { const int st = (r >> 4) * 2 + (c >> 5), rr = r & 15, cc = c & 31, ob = rr * 64 + cc * 2; return st * 1024 + (ob ^ (((ob >> 9) & 1) << 5)); }
__host__ __device__ __forceinline__ void stage_rc(int b, int& R, int& C) { const int st = b / 1024, sb = b % 1024, swz = sb ^ (((sb >> 9) & 1) << 5); R = (st >> 1) * 16 + swz / 64; C = (st & 1) * 32 + (swz % 64) / 2; }
__host__ __device__ __forceinline__ int perm32(int rho) { const int n = rho >> 4, i = rho & 15; return 8 * (i >> 2) + 4 * n + (i & 3); }

struct Unit { const char* a; const char* b; char* c; int pm, pn, aux; };
DI void tile_of(int L, int nM, int nN, int& pm, int& pn) {
    const int nig = 8 * nN, gid = L / nig, fm = gid * 8, gsz = (nM - fm) < 8 ? (nM - fm) : 8, w = L % nig;
    pm = fm + (w % gsz); pn = w / gsz;
}
struct AffineOrder {
    const char* A; const char* B; char* C; size_t aM, bB, bN, cM, cS, cN; int nM, nN, bdiv, csp, G, c0;
    DI bool next(int i, Unit& u) const {
        const int L = i * G + c0; if (L >= nM * nN) return false;
        int pm, pn; tile_of(L, nM, nN, pm, pn); u.pm = pm; u.pn = pn; u.aux = 0;
        u.a = A + (size_t)pm * aM; u.b = B + (size_t)(pm / bdiv) * bB + (size_t)pn * bN; u.c = C + (size_t)pm * cM + (size_t)(pn / csp) * cS + (size_t)(pn % csp) * cN; return true;
    }
};
DI AffineOrder dense_order(const void* A, const void* B, void* C, int M, int N, int K, int ldc_bytes, int esz, int G, int c0) {
    AffineOrder o; o.A = (const char*)A; o.B = (const char*)B; o.C = (char*)C; o.aM = 256ull * K * 2; o.bB = 0; o.bN = 256ull * K * 2; o.cM = 256ull * ldc_bytes; o.cS = 0; o.cN = 256ull * esz;
    o.nM = M / 256; o.nN = N / 256; o.bdiv = 1 << 30; o.csp = 1 << 30; o.G = G; o.c0 = c0; return o;
}

struct EpiBf16 {
    static constexpr bool PERM = true;
    int ldc; const float* bias; int bias_stride; float scl;
    DI void operator()(f32x4 (&acc)[2][2][4][2], const Unit& u, int wr, int wc, int fr, int fq, LAS unsigned char*) const {
        const int col0 = wc * 32 + 8 * fq; const float sc = (u.aux < 0) ? scl : 1.f;
        f32x4 bv[2][2];
#pragma unroll
        for (int bj = 0; bj < 2; ++bj)
#pragma unroll
            for (int n = 0; n < 2; ++n) bv[bj][n] = bias ? *(const f32x4*)(bias + (size_t)u.aux * bias_stride + u.pn * 256 + col0 + bj * HALF + 4 * n) : (f32x4){0.f, 0.f, 0.f, 0.f};
#pragma unroll
        for (int ai = 0; ai < 2; ++ai)
#pragma unroll
            for (int m = 0; m < 4; ++m) { bf16* rowp = (bf16*)u.c + (size_t)(ai * HALF + wr * 64 + m * 16 + fr) * ldc + col0;
#pragma unroll
                for (int bj = 0; bj < 2; ++bj) { const f32x4 v0 = acc[ai][bj][m][0] * sc + bv[bj][0], v1 = acc[ai][bj][m][1] * sc + bv[bj][1];
                    u32x4 w; w.x = cvt_pk_bf16(v0[0], v0[1]); w.y = cvt_pk_bf16(v0[2], v0[3]); w.z = cvt_pk_bf16(v1[0], v1[1]); w.w = cvt_pk_bf16(v1[2], v1[3]);
                    *(u32x4*)(rowp + bj * HALF) = w; } }
    }
};
struct EpiSoftmax {
    static constexpr bool PERM = true;
    int ldc;
    DI void operator()(f32x4 (&acc)[2][2][4][2], const Unit& u, int wr, int wc, int fr, int fq, LAS unsigned char* lds) const {
        LAS f32x2* X = (LAS f32x2*)(lds + LDS_X);
#pragma unroll
        for (int ai = 0; ai < 2; ++ai)
#pragma unroll
            for (int m = 0; m < 4; ++m) {
                float v = -3.0e38f;
#pragma unroll
                for (int bj = 0; bj < 2; ++bj)
#pragma unroll
                    for (int n = 0; n < 2; ++n) { const f32x4 x = acc[ai][bj][m][n]; v = fmaxf(v, fmaxf(fmaxf(x[0], x[1]), fmaxf(x[2], x[3]))); }
                v = fmaxf(v, __shfl_xor(v, 16)); v = fmaxf(v, __shfl_xor(v, 32));
                float s = 0.f;
#pragma unroll
                for (int bj = 0; bj < 2; ++bj)
#pragma unroll
                    for (int n = 0; n < 2; ++n) { f32x4 x = acc[ai][bj][m][n]; x[0] = __expf(x[0] - v); x[1] = __expf(x[1] - v); x[2] = __expf(x[2] - v); x[3] = __expf(x[3] - v); acc[ai][bj][m][n] = x; s += (x[0] + x[1]) + (x[2] + x[3]); }
                s += __shfl_xor(s, 16); s += __shfl_xor(s, 32);
                if (fq == 0) X[(ai * HALF + wr * 64 + m * 16 + fr) * 4 + wc] = (f32x2){v, s};
            }
        LDS_WAIT(); __builtin_amdgcn_s_barrier(); asm volatile("" ::: "memory");
        const int col0 = wc * 32 + 8 * fq;
#pragma unroll
        for (int ai = 0; ai < 2; ++ai)
#pragma unroll
            for (int m = 0; m < 4; ++m) {
                const int r = ai * HALF + wr * 64 + m * 16 + fr;
                const f32x4 p01 = *(const LAS f32x4*)(X + r * 4), p23 = *(const LAS f32x4*)(X + r * 4 + 2);
                const float M = fmaxf(fmaxf(p01[0], p01[2]), fmaxf(p23[0], p23[2]));
                const float S = p01[1] * __expf(p01[0] - M) + p01[3] * __expf(p01[2] - M) + p23[1] * __expf(p23[0] - M) + p23[3] * __expf(p23[2] - M);
                const float f = __expf(X[r * 4 + wc][0] - M) * __builtin_amdgcn_rcpf(S);
                bf16* rowp = (bf16*)u.c + (size_t)r * ldc + col0;
#pragma unroll
                for (int bj = 0; bj < 2; ++bj) { const f32x4 v0 = acc[ai][bj][m][0] * f, v1 = acc[ai][bj][m][1] * f;
                    u32x4 w; w.x = cvt_pk_bf16(v0[0], v0[1]); w.y = cvt_pk_bf16(v0[2], v0[3]); w.z = cvt_pk_bf16(v1[0], v1[1]); w.w = cvt_pk_bf16(v1[2], v1[3]);
                    *(u32x4*)(rowp + bj * HALF) = w; }
            }
    }
};
struct EpiSwiglu {
    static constexpr bool PERM = true;
    const float* bgu;
    DI void operator()(f32x4 (&acc)[2][2][4][2], const Unit& u, int wr, int wc, int fr, int fq, LAS unsigned char*) const {
        const int col0 = u.pn * 128 + wc * 32 + 8 * fq;
        const float* bp = bgu + (size_t)u.aux * 2048 + col0;
        f32x4 bg[2], bl[2];
#pragma unroll
        for (int n = 0; n < 2; ++n) { bg[n] = *(const f32x4*)(bp + 4 * n); bl[n] = *(const f32x4*)(bp + 1024 + 4 * n); }
#pragma unroll
        for (int ai = 0; ai < 2; ++ai)
#pragma unroll
            for (int m = 0; m < 4; ++m) {
                float o[8];
#pragma unroll
                for (int n = 0; n < 2; ++n)
#pragma unroll
                    for (int j = 0; j < 4; ++j) {
                        const float glu = fminf(acc[ai][0][m][n][j] + bg[n][j], 7.0f);
                        const float lin = fminf(fmaxf(acc[ai][1][m][n][j] + bl[n][j], -7.0f), 7.0f);
                        o[4 * n + j] = (lin + 1.0f) * glu * sigmoidf_(1.702f * glu);
                    }
                u32x4 w; w.x = cvt_pk_bf16(o[0], o[1]); w.y = cvt_pk_bf16(o[2], o[3]); w.z = cvt_pk_bf16(o[4], o[5]); w.w = cvt_pk_bf16(o[6], o[7]);
                *(u32x4*)((bf16*)u.c + (size_t)(ai * HALF + wr * 64 + m * 16 + fr) * 1024 + wc * 32 + 8 * fq) = w;
            }
    }
};

template <class Epi, class Sched>
__device__ __forceinline__ void gemm_phase(LAS unsigned char* lds, const int lda, const int ldb, const int nt, const Sched& S, const Epi& E) {
    int tid = threadIdx.x; asm volatile("" : "+v"(tid));
    const int wid = __builtin_amdgcn_readfirstlane(tid >> 6), lane = tid & 63, wr = wid >> 2, wc = wid & 3, fr = lane & 15, fq = lane >> 4;
    unsigned voffA[2], voffB[2];
#pragma unroll
    for (int i = 0; i < 2; ++i) { int R, C; stage_rc(tid * 16 + i * 8192, R, C); const int Rb = Epi::PERM ? ((R & ~31) + perm32(R & 31)) : R;
        voffA[i] = (unsigned)(R * lda + C * 2); voffB[i] = (unsigned)(Rb * ldb + C * 2); }
    const size_t kstep = (size_t)(BK * 2);
    const size_t hstepA = (size_t)HALF * lda, hstepB = (size_t)HALF * ldb;
    const unsigned ldsw = (unsigned)wid * 1024u;
    const int aoff = lds_byte(wr * 64 + fr, fq * 8), boff = lds_byte(wc * 32 + fr, fq * 8);
#define PG8_SA(b, h) (((b) * 2 + (h)) * HTB)
#define PG8_SB(b, h) ((4 + (b) * 2 + (h)) * HTB)
#define PG8_STAGE(bufoff, gbase, voff) do { _Pragma("unroll") for (int _i = 0; _i < 2; ++_i) \
        __builtin_amdgcn_global_load_lds((const unsigned*)((const char*)(gbase) + (voff)[_i]), (LAS unsigned*)(lds + (bufoff) + ldsw + _i * 8192), 16, 0, 0); } while (0)
#define PG8_LDA(dst, b, h) do { _Pragma("unroll") for (int m = 0; m < 4; ++m) _Pragma("unroll") for (int k = 0; k < 2; ++k) dst[m][k] = *(const LAS bf16x8*)(lds + PG8_SA(b, h) + aoff + m * 2048 + k * 1024); } while (0)
#define PG8_LDB(dst, b, h) do { _Pragma("unroll") for (int n = 0; n < 2; ++n) _Pragma("unroll") for (int k = 0; k < 2; ++k) dst[n][k] = *(const LAS bf16x8*)(lds + PG8_SB(b, h) + boff + n * 2048 + k * 1024); } while (0)
#define PG8_MMA(ai, bj, At, Bt) do { __builtin_amdgcn_s_setprio(1); _Pragma("unroll") for (int m = 0; m < 4; ++m) _Pragma("unroll") for (int n = 0; n < 2; ++n) _Pragma("unroll") for (int k = 0; k < 2; ++k) \
        acc[ai][bj][m][n] = __builtin_amdgcn_mfma_f32_16x16x32_bf16(Bt[n][k], At[m][k], acc[ai][bj][m][n], 0, 0, 0); __builtin_amdgcn_s_setprio(0); } while (0)
#define PG8_WAIT_V(n) asm volatile("s_waitcnt vmcnt(" #n ")" ::: "memory")
#define PG8_WAIT_L(n) asm volatile("s_waitcnt lgkmcnt(" #n ")" ::: "memory")
#define PG8_BAR __builtin_amdgcn_s_barrier()
#define PG8_SCHED __builtin_amdgcn_sched_barrier(0)
    Unit cur, nxt; int ui = 0;
    if (!S.next(0, cur)) return;
    f32x4 acc[2][2][4][2];
#pragma unroll
    for (int a = 0; a < 2; ++a)
#pragma unroll
        for (int b = 0; b < 2; ++b)
#pragma unroll
            for (int m = 0; m < 4; ++m)
#pragma unroll
                for (int n = 0; n < 2; ++n) acc[a][b][m][n] = (f32x4){0.f, 0.f, 0.f, 0.f};
    bf16x8 At[4][2], B0[2][2], B1[2][2];
    const char* cA = cur.a; const char* cB = cur.b;
    PG8_STAGE(PG8_SB(0, 0), cB, voffB); PG8_STAGE(PG8_SB(0, 1), cB + hstepB, voffB); PG8_STAGE(PG8_SA(0, 0), cA, voffA); PG8_STAGE(PG8_SA(0, 1), cA + hstepA, voffA);
    if (wr == 1) PG8_BAR;
    PG8_WAIT_V(2); PG8_BAR;
    PG8_STAGE(PG8_SB(1, 0), cB + kstep, voffB); PG8_STAGE(PG8_SA(1, 0), cA + kstep, voffA); PG8_STAGE(PG8_SB(1, 1), cB + hstepB + kstep, voffB);
    PG8_WAIT_V(6); PG8_BAR;
    for (;;) {
        const bool has_next = S.next(ui + 1, nxt);
        const char* nA = has_next ? nxt.a : cA; const char* nB = has_next ? nxt.b : cB;
#pragma unroll 1
        for (int t = 0; t < nt; t += 2) {
            const bool last = (t == nt - 2);
            const char* a1 = cA + (size_t)(t + 1) * kstep;
            const char* a2 = last ? nA : cA + (size_t)(t + 2) * kstep; const char* b2 = last ? nB : cB + (size_t)(t + 2) * kstep;
            const char* a3 = a2 + kstep; const char* b3 = b2 + kstep;
            PG8_LDB(B0, 0, 0); PG8_LDB(B1, 0, 1); PG8_SCHED; PG8_LDA(At, 0, 0); PG8_STAGE(PG8_SA(1, 1), a1 + hstepA, voffA);
            PG8_WAIT_V(8); PG8_WAIT_L(0); PG8_BAR; PG8_MMA(0, 0, At, B0); PG8_MMA(0, 1, At, B1); PG8_BAR; PG8_SCHED;
            PG8_LDA(At, 0, 1); PG8_STAGE(PG8_SB(0, 0), b2, voffB); PG8_STAGE(PG8_SB(0, 1), b2 + hstepB, voffB); PG8_STAGE(PG8_SA(0, 0), a2, voffA);
            PG8_WAIT_V(8); PG8_WAIT_L(0); PG8_BAR; PG8_MMA(1, 0, At, B0); PG8_MMA(1, 1, At, B1); PG8_BAR; PG8_SCHED;
            PG8_LDB(B0, 1, 0); PG8_LDB(B1, 1, 1); PG8_SCHED; PG8_LDA(At, 1, 0); PG8_STAGE(PG8_SA(0, 1), a2 + hstepA, voffA);
            PG8_WAIT_V(8); PG8_WAIT_L(0); PG8_BAR; PG8_MMA(0, 0, At, B0); PG8_MMA(0, 1, At, B1); PG8_BAR; PG8_SCHED;
            PG8_LDA(At, 1, 1); PG8_STAGE(PG8_SB(1, 0), b3, voffB); PG8_STAGE(PG8_SB(1, 1), b3 + hstepB, voffB); PG8_STAGE(PG8_SA(1, 0), a3, voffA);
            PG8_WAIT_V(8); PG8_WAIT_L(0); PG8_BAR; PG8_MMA(1, 0, At, B0); PG8_MMA(1, 1, At, B1); PG8_BAR; PG8_SCHED;
        }
        if (wr == 0) PG8_BAR;
        { int fr_e = fr, fq_e = fq; asm volatile("" : "+v"(fr_e), "+v"(fq_e)); E(acc, cur, wr, wc, fr_e, fq_e, lds); }
        if (!has_next) break;
#pragma unroll
        for (int a = 0; a < 2; ++a)
#pragma unroll
            for (int b = 0; b < 2; ++b)
#pragma unroll
                for (int m = 0; m < 4; ++m)
#pragma unroll
                    for (int n = 0; n < 2; ++n) acc[a][b][m][n] = (f32x4){0.f, 0.f, 0.f, 0.f};
        cur = nxt; cA = nA; cB = nB; ++ui;
        if (wr == 1) PG8_BAR;
    }
    PG8_WAIT_V(0);
    PG8_BAR;
#undef PG8_SA
#undef PG8_SB
#undef PG8_STAGE
#undef PG8_LDA
#undef PG8_LDB
#undef PG8_MMA
#undef PG8_WAIT_V
#undef PG8_WAIT_L
#undef PG8_BAR
#undef PG8_SCHED
}
}

struct Args { const float* in[27]; float* out; unsigned char* ws; int ph_lo, ph_hi; };
struct Ctx {
    LAS unsigned char* lds; unsigned char* ws; unsigned* ctl;
    int tid, lane, wave, vcu, G;
};
constexpr int LDS_PTAB = LDS_MISC + 1024;
DI void refresh(Ctx& F, unsigned char* wsb) { int t = threadIdx.x; asm volatile("" : "+v"(t)); F.tid = t; F.lane = t & 63; F.wave = __builtin_amdgcn_readfirstlane(t >> 6);
    unsigned lo = (unsigned)(unsigned long long)wsb, hi = (unsigned)((unsigned long long)wsb >> 32); asm volatile("" : "+v"(lo), "+v"(hi));
    lo = __builtin_amdgcn_readfirstlane(lo); hi = __builtin_amdgcn_readfirstlane(hi); F.ws = (unsigned char*)(GAS unsigned char*)(((unsigned long long)hi << 32) | lo); F.ctl = (unsigned*)F.ws; }
DI const float* inp(const Ctx& F, int i) {
    const LAS unsigned* p = (const LAS unsigned*)(F.lds + LDS_PTAB) + 2 * i; const unsigned lo = __builtin_amdgcn_readfirstlane(p[0]), hi = __builtin_amdgcn_readfirstlane(p[1]);
    return (const float*)(GAS const float*)(((unsigned long long)hi << 32) | lo);
}
DI unsigned ldu(const unsigned* p) { return __hip_atomic_load(p, __ATOMIC_RELAXED, __HIP_MEMORY_SCOPE_AGENT); }
DI float ldf(const float* p) { return __uint_as_float(__hip_atomic_load((const unsigned*)p, __ATOMIC_RELAXED, __HIP_MEMORY_SCOPE_AGENT)); }

template <int MAP> DI int map_row(int n) {
    if (MAP == 0) return n;
    if (MAP == 1) return n < 1536 ? n : (n < 1544 ? -1 : (n < 3592 ? n - 8 : -1));
    return 256 * ((n & 1023) >> 7) + 128 * (n >> 10) + (n & 127);
}
template <int MAP> DI void tr_item(const float* W, int K, int N, bf16* WT, LAS float* scr, int item, int lane) {
    const int nblk = (N + 31) / 32, kb = item / nblk, nb = item % nblk, k0 = 64 * kb, n0 = 32 * nb;
    const int nl = n0 + (lane & 31);
#pragma unroll 8
    for (int i = 0; i < 32; ++i) { const int kk = 2 * i + (lane >> 5); scr[kk * 33 + (lane & 31)] = nl < N ? W[(size_t)(k0 + kk) * N + nl] : 0.f; }
    LDS_WAIT(); asm volatile("" ::: "memory");
    const int c = lane & 7;
#pragma unroll
    for (int j = 0; j < 4; ++j) { const int nn = (lane >> 3) + 8 * j; const int n = n0 + nn; const LAS float* s = scr + (8 * c) * 33 + nn;
        const int dr = n < N ? map_row<MAP>(n) : -1;
        u32x4 o; o.x = cvt_pk_bf16(s[0 * 33], s[1 * 33]); o.y = cvt_pk_bf16(s[2 * 33], s[3 * 33]); o.z = cvt_pk_bf16(s[4 * 33], s[5 * 33]); o.w = cvt_pk_bf16(s[6 * 33], s[7 * 33]);
        if (dr >= 0) *(u32x4*)(WT + (size_t)dr * K + k0 + 8 * c) = o; }
    LDS_WAIT(); asm volatile("" ::: "memory");
}
DI void phase_convert(Ctx& F, const Args& a) {
    LAS float* scr = (LAS float*)(F.lds + F.wave * 16384);
    const int gw = F.vcu * NWAVES + F.wave, NGW = F.G * NWAVES;
    constexpr int I_WIN = 16 * 113, I_SQ = 16 * 32, I_GU = 16 * 64;
    constexpr int E0 = 4 * I_WIN, E1 = E0 + 4 * I_SQ, E2 = E1 + 4 * I_SQ, E3 = E2 + 4 * I_SQ, E4 = E3 + 4 * I_SQ, E5 = E4 + 128 * I_GU, E6 = E5 + 128 * I_SQ;
    for (int it = gw; it < E6; it += NGW) {
        if (it < E0) { const int l = it / I_WIN, r = it % I_WIN; tr_item<1>(inp(F, 2) + (size_t)l * D * 3600, D, 3600, (bf16*)(F.ws + WS_WIN) + (size_t)l * NPROJ * D, scr, r, F.lane); }
        else if (it < E1) { const int q = it - E0, l = q / I_SQ, r = q % I_SQ; tr_item<0>(inp(F, 10) + (size_t)l * D * D, D, D, (bf16*)(F.ws + WS_WOUT) + (size_t)l * D * D, scr, r, F.lane); }
        else if (it < E2) { const int q = it - E1, l = q / I_SQ, r = q % I_SQ; tr_item<0>(inp(F, 14) + (size_t)l * D * D, D, D, (bf16*)(F.ws + WS_WKV) + (size_t)(2 * l) * D * D, scr, r, F.lane); }
        else if (it < E3) { const int q = it - E2, l = q / I_SQ, r = q % I_SQ; tr_item<0>(inp(F, 15) + (size_t)l * D * D, D, D, (bf16*)(F.ws + WS_WKV) + (size_t)(2 * l + 1) * D * D, scr, r, F.lane); }
        else if (it < E4) { const int q = it - E3, l = q / I_SQ, r = q % I_SQ; tr_item<0>(inp(F, 16) + (size_t)l * D * D, D, D, (bf16*)(F.ws + WS_WO) + (size_t)l * D * D, scr, r, F.lane); }
        else if (it < E5) { const int q = it - E4, le = q / I_GU, r = q % I_GU; tr_item<2>(inp(F, 21) + (size_t)le * D * 2048, D, 2048, (bf16*)(F.ws + WS_WGU) + (size_t)le * 2048 * D, scr, r, F.lane); }
        else { const int q = it - E5, le = q / I_SQ, r = q % I_SQ; tr_item<0>(inp(F, 23) + (size_t)le * D * D, D, D, (bf16*)(F.ws + WS_WDN) + (size_t)le * D * D, scr, r, F.lane); }
    }
    const size_t gt = (size_t)blockIdx.x * NTHREADS + F.tid, NGT = (size_t)F.G * NTHREADS;
    for (size_t i = gt; i < (4ull * D * D + 2048ull * D) / 8; i += NGT) {
        const bool isq = i < 4ull * D * D / 8; const size_t j = isq ? i : i - 4ull * D * D / 8;
        const float* src = (isq ? inp(F, 13) : inp(F, 1)) + j * 8; bf16* dst = (bf16*)(F.ws + (isq ? WS_WQ : WS_MEMB)) + j * 8;
        const f32x4 v0 = *(const f32x4*)src, v1 = *(const f32x4*)(src + 4);
        u32x4 o; o.x = cvt_pk_bf16(v0[0], v0[1]); o.y = cvt_pk_bf16(v0[2], v0[3]); o.z = cvt_pk_bf16(v1[0], v1[1]); o.w = cvt_pk_bf16(v1[2], v1[3]);
        *(u32x4*)dst = o;
    }
    for (size_t i = gt; i < 4ull * 48 * D; i += NGT) {
        const int l = (int)(i / (48 * D)), r = (int)(i % (48 * D)), j = r / D, k = r % D;
        float w; bf16* dh; bf16* dl;
        if (j < 16) { const int col = j < 8 ? 1536 + j : 3592 + (j - 8); w = inp(F, 2)[((size_t)l * D + k) * 3600 + col];
            dh = (bf16*)(F.ws + WS_WGATE) + ((size_t)(l * 2 + 0) * 16 + j) * D + k; dl = dh + 16 * D; }
        else { const int e = j - 16; w = inp(F, 19)[((size_t)l * D + k) * 32 + e];
            dh = (bf16*)(F.ws + WS_WRT) + ((size_t)(l * 2 + 0) * 32 + e) * D + k; dl = dh + 32 * D; }
        const bf16 h = f2bf(w); *dh = h; *dl = f2bf(w - bf2f(h));
    }
}

DI void unpack8(const u32x4 w, float* v) { v[0] = bflo(w.x); v[1] = bfhi(w.x); v[2] = bflo(w.y); v[3] = bfhi(w.y); v[4] = bflo(w.z); v[5] = bfhi(w.z); v[6] = bflo(w.w); v[7] = bfhi(w.w); }
DI u32x4 pack8(const float* v) { u32x4 o; o.x = cvt_pk_bf16(v[0], v[1]); o.y = cvt_pk_bf16(v[2], v[3]); o.z = cvt_pk_bf16(v[4], v[5]); o.w = cvt_pk_bf16(v[6], v[7]); return o; }
template <int MODE> DI void row_pass(Ctx& F, const Args& a, int l) {
    const int lane = F.lane, r0 = (F.vcu * NWAVES + F.wave) * 16;
    bf16* XB = (bf16*)(F.ws + WS_XB); const bf16* HB = (const bf16*)(F.ws + WS_HB); const bf16* Y = (const bf16*)(F.ws + WS_Y);
    const int c0 = 8 * lane, c1 = 512 + 8 * lane;
    LAS unsigned* ecnt = (LAS unsigned*)(F.lds + LDS_MISC + 256);
    if (MODE == 2) { if (F.tid < 64) ecnt[F.tid] = 0u; __syncthreads(); }
    float g[16], bb[16];
    if (MODE >= 1) {
        const float* gp = inp(F, MODE == 1 ? 11 : (MODE == 2 ? 17 : 25)) + (size_t)l * D; const float* bp = inp(F, MODE == 1 ? 12 : (MODE == 2 ? 18 : 26)) + (size_t)l * D;
#pragma unroll
        for (int q = 0; q < 2; ++q) { const int c = q ? c1 : c0;
            const f32x4 g0 = *(const f32x4*)(gp + c), g1 = *(const f32x4*)(gp + c + 4), b0 = *(const f32x4*)(bp + c), b1 = *(const f32x4*)(bp + c + 4);
#pragma unroll
            for (int j = 0; j < 4; ++j) { g[8 * q + j] = g0[j]; g[8 * q + 4 + j] = g1[j]; bb[8 * q + j] = b0[j]; bb[8 * q + 4 + j] = b1[j]; } }
    }
    for (int i = 0; i < 16; ++i) {
        const int r = r0 + i; float v[16];
        if (MODE == 0) {
            const float* xr = inp(F, 0) + (size_t)r * D;
            const f32x4 x0 = *(const f32x4*)(xr + c0), x1 = *(const f32x4*)(xr + c0 + 4), x2 = *(const f32x4*)(xr + c1), x3 = *(const f32x4*)(xr + c1 + 4);
#pragma unroll
            for (int j = 0; j < 4; ++j) { v[j] = x0[j]; v[4 + j] = x1[j]; v[8 + j] = x2[j]; v[12 + j] = x3[j]; }
        } else {
            float xv[16]; unpack8(*(const u32x4*)(XB + (size_t)r * D + c0), xv); unpack8(*(const u32x4*)(XB + (size_t)r * D + c1), xv + 8);
            if (MODE == 3) {
                const int* sl = (const int*)(F.ws + WS_SLOT) + (size_t)r * 4; const float* tg = (const float*)(F.ws + WS_TOPG) + (size_t)r * 4;
#pragma unroll
                for (int j = 0; j < 16; ++j) v[j] = DN_ALPHA * xv[j];
#pragma unroll
                for (int k = 0; k < 4; ++k) { const int s = (int)ldu((const unsigned*)sl + k); const float gk = ldf(tg + k); float yv[16];
                    unpack8(*(const u32x4*)(Y + (size_t)s * D + c0), yv); unpack8(*(const u32x4*)(Y + (size_t)s * D + c1), yv + 8);
#pragma unroll
                    for (int j = 0; j < 16; ++j) v[j] += gk * yv[j]; }
            } else {
                float hv[16]; unpack8(*(const u32x4*)(HB + (size_t)r * D + c0), hv); unpack8(*(const u32x4*)(HB + (size_t)r * D + c1), hv + 8);
#pragma unroll
                for (int j = 0; j < 16; ++j) v[j] = DN_ALPHA * xv[j] + hv[j];
            }
            float s = 0.f;
#pragma unroll
            for (int j = 0; j < 16; ++j) s += v[j];
            const float mean = wave_sum(s) * (1.f / D); float q = 0.f;
#pragma unroll
            for (int j = 0; j < 16; ++j) { v[j] -= mean; q += v[j] * v[j]; }
            const float rstd = rsqrtf(wave_sum(q) * (1.f / D) + 1e-5f);
#pragma unroll
            for (int j = 0; j < 16; ++j) v[j] = v[j] * rstd * g[j] + bb[j];
        }
        if (MODE == 3 && l == NL - 1) {
            float* orow = ((float*)inp(F, 27)) + (size_t)r * D;
            *(f32x4*)(orow + c0) = (f32x4){v[0], v[1], v[2], v[3]}; *(f32x4*)(orow + c0 + 4) = (f32x4){v[4], v[5], v[6], v[7]};
            *(f32x4*)(orow + c1) = (f32x4){v[8], v[9], v[10], v[11]}; *(f32x4*)(orow + c1 + 4) = (f32x4){v[12], v[13], v[14], v[15]};
        } else {
            *(u32x4*)(XB + (size_t)r * D + c0) = pack8(v); *(u32x4*)(XB + (size_t)r * D + c1) = pack8(v + 8);
        }
    }
    if (MODE == 1 || (MODE == 3 && l == NL - 1)) return;
    VM_WAIT(); __builtin_amdgcn_fence(__ATOMIC_ACQUIRE, "agent"); VM_WAIT(); asm volatile("" ::: "memory");
    constexpr int N16 = (MODE == 2) ? 2 : 1, NN = 16 * N16;
    const bf16* Wb = (MODE == 2) ? (const bf16*)(F.ws + WS_WRT) + (size_t)l * 2 * 32 * D : (const bf16*)(F.ws + WS_WGATE) + (size_t)(MODE == 0 ? 0 : l + 1) * 2 * 16 * D;
    const bf16* arow = XB + (size_t)(r0 + (lane & 15)) * D + 8 * (lane >> 4);
    const bf16* wrow = Wb + (size_t)(lane & 15) * D + 8 * (lane >> 4);
    f32x4 acc[N16];
#pragma unroll
    for (int n = 0; n < N16; ++n) acc[n] = (f32x4){0.f, 0.f, 0.f, 0.f};
#pragma unroll 4
    for (int ks = 0; ks < 32; ++ks) {
        const bf16x8 af = *(const bf16x8*)(arow + 32 * ks);
#pragma unroll
        for (int n = 0; n < N16; ++n) {
            const bf16x8 bh = *(const bf16x8*)(wrow + (size_t)n * 16 * D + 32 * ks), bl = *(const bf16x8*)(wrow + (size_t)(NN + n * 16) * D + 32 * ks);
            acc[n] = MFMA16(af, bh, acc[n]); acc[n] = MFMA16(af, bl, acc[n]);
        }
    }
    if (MODE != 2) {
        float* G = (float*)(F.ws + WS_GATES);
#pragma unroll
        for (int i = 0; i < 4; ++i) G[(size_t)(r0 + 4 * (lane >> 4) + i) * 16 + (lane & 15)] = acc[0][i];
        return;
    }
    if (MODE == 2) {
        LAS float* LG = (LAS float*)(F.lds + F.wave * 4096);
#pragma unroll
        for (int n = 0; n < N16; ++n)
#pragma unroll
            for (int i = 0; i < 4; ++i) LG[(4 * (lane >> 4) + i) * 33 + n * 16 + (lane & 15)] = acc[n][i];
        LDS_WAIT(); asm volatile("" ::: "memory");
        int te[4] = {0, 0, 0, 0}; float tv[4] = {0.f, 0.f, 0.f, 0.f}; unsigned rk[4] = {0u, 0u, 0u, 0u};
        if (lane < 16) {
            float lg[32]; const float* rb = inp(F, 20) + (size_t)l * 32;
#pragma unroll
            for (int e = 0; e < 32; ++e) lg[e] = LG[lane * 33 + e] + rb[e];
#pragma unroll
            for (int k = 0; k < 4; ++k) {
                float best = -3.0e38f; int bi = 0;
#pragma unroll
                for (int e = 0; e < 32; ++e) { const bool gt = lg[e] > best; best = gt ? lg[e] : best; bi = gt ? e : bi; }
                te[k] = bi; tv[k] = best;
#pragma unroll
                for (int e = 0; e < 32; ++e) lg[e] = (e == bi) ? -3.0e38f : lg[e];
            }
            const float e1 = __expf(tv[1] - tv[0]), e2 = __expf(tv[2] - tv[0]), e3 = __expf(tv[3] - tv[0]); const float inv = 1.f / (1.f + e1 + e2 + e3);
            tv[0] = inv; tv[1] = e1 * inv; tv[2] = e2 * inv; tv[3] = e3 * inv;
#pragma unroll
            for (int k = 0; k < 4; ++k) rk[k] = __hip_atomic_fetch_add(ecnt + te[k], 1u, __ATOMIC_RELAXED, __HIP_MEMORY_SCOPE_WORKGROUP);
        }
        __syncthreads();
        if (F.tid < 32) ecnt[32 + F.tid] = __hip_atomic_fetch_add(F.ctl + CW_ECNT + l * 32 + F.tid, ecnt[F.tid], __ATOMIC_RELAXED, __HIP_MEMORY_SCOPE_AGENT);
        __syncthreads();
        if (lane < 16) {
            const int r = r0 + lane; int* pe = (int*)(F.ws + WS_TOPE) + (size_t)r * 4; int* pp = (int*)(F.ws + WS_TOPP) + (size_t)r * 4; float* pg = (float*)(F.ws + WS_TOPG) + (size_t)r * 4;
#pragma unroll
            for (int k = 0; k < 4; ++k) { pe[k] = te[k]; pp[k] = (int)(ecnt[32 + te[k]] + rk[k]); pg[k] = tv[k]; }
        }
    }
}

DI void phase_scatter(Ctx& F, int l) {
    LAS int* ts = (LAS int*)(F.lds + LDS_MISC + 512);
    if (F.tid == 0) { int acc = 0; for (int e = 0; e < 32; ++e) { ts[e] = acc; acc += (int)((ldu(F.ctl + CW_ECNT + l * 32 + e) + 255u) >> 8); } ts[32] = acc; }
    __syncthreads();
    if (blockIdx.x == 0) {
        if (F.tid == 0) __hip_atomic_store(F.ctl + CW_NT + l, (unsigned)ts[32], __ATOMIC_RELAXED, __HIP_MEMORY_SCOPE_AGENT);
        for (int t = F.tid; t < ts[32]; t += NTHREADS) { int e = 0; while (e < 31 && t >= ts[e + 1]) ++e; F.ctl[CW_TILE_E + l * MAXTILES + t] = (unsigned)e; }
    }
    const int r0 = (F.vcu * NWAVES + F.wave) * 16, lane = F.lane;
    const bf16* XB = (const bf16*)(F.ws + WS_XB); bf16* XG = (bf16*)(F.ws + WS_XG);
    for (int i = 0; i < 16; ++i) {
        const int r = r0 + i;
        const u32x4 x0 = *(const u32x4*)(XB + (size_t)r * D + 8 * lane), x1 = *(const u32x4*)(XB + (size_t)r * D + 512 + 8 * lane);
#pragma unroll
        for (int k = 0; k < 4; ++k) {
            const int e = ((const int*)(F.ws + WS_TOPE))[(size_t)r * 4 + k], p = ((const int*)(F.ws + WS_TOPP))[(size_t)r * 4 + k];
            const int slot = ts[e] * 256 + p;
            if (lane == 0) ((int*)(F.ws + WS_SLOT))[(size_t)r * 4 + k] = slot;
            *(u32x4*)(XG + (size_t)slot * D + 8 * lane) = x0; *(u32x4*)(XG + (size_t)slot * D + 512 + 8 * lane) = x1;
        }
    }
}
struct MoeOrder {
    const char* A; const char* B; char* C; const unsigned* tile_e; int NT, nN; size_t bE, bN, cN; int G, c0;
    DI bool next(int i, g8::Unit& u) const {
        const int L = i * G + c0; if (L >= NT * nN) return false;
        int pm, pn; g8::tile_of(L, NT, nN, pm, pn); const int e = __builtin_amdgcn_readfirstlane((int)ldu(tile_e + pm));
        u.pm = pm; u.pn = pn; u.aux = e; u.a = A + (size_t)pm * 256 * 2048; u.b = B + (size_t)e * bE + (size_t)pn * bN; u.c = C + (size_t)pm * 256 * 2048 + (size_t)pn * cN; return true;
    }
};

DI unsigned lds_addr(const LAS void* p) { return (unsigned)(size_t)p; }
DI bf16x8 tr_frag8(unsigned img, int ld_bytes, int row_lo, int row_hi, int m0, int lane) {
    const int i = lane & 15; const unsigned a_lo = img + (unsigned)((row_lo + (i >> 2)) * ld_bytes + (m0 + 4 * (i & 3)) * 2), a_hi = img + (unsigned)((row_hi + (i >> 2)) * ld_bytes + (m0 + 4 * (i & 3)) * 2);
    s16x4 lo, hi;
    asm volatile("ds_read_b64_tr_b16 %0, %2\n\tds_read_b64_tr_b16 %1, %3\n\ts_waitcnt lgkmcnt(0)" : "=&v"(lo), "=&v"(hi) : "v"(a_lo), "v"(a_hi) : "memory");
    return __builtin_shufflevector(lo, hi, 0, 1, 2, 3, 4, 5, 6, 7);
}
DI s16x4 tr_read4(unsigned addr) { s16x4 r; asm volatile("ds_read_b64_tr_b16 %0, %1\n\ts_waitcnt lgkmcnt(0)" : "=&v"(r) : "v"(addr) : "memory"); return r; }
DI bf16x8 pack_frag(const f32x4 a, const f32x4 b) {
    u32x4 p; p.x = cvt_pk_bf16(a[0], a[1]); p.y = cvt_pk_bf16(a[2], a[3]); p.z = cvt_pk_bf16(b[0], b[1]); p.w = cvt_pk_bf16(b[2], b[3]); return __builtin_bit_cast(bf16x8, p);
}
DI u32x2 pack4(const f32x4 a) { u32x2 p; p.x = cvt_pk_bf16(a[0], a[1]); p.y = cvt_pk_bf16(a[2], a[3]); return p; }
DI f32x4 unpack4(const u32x2 w) { return (f32x4){bflo(w.x), bfhi(w.x), bflo(w.y), bfhi(w.y)}; }
DI float softcap15(float x) { const float y = x * (1.f / 15.f); const float e = __expf(2.f * y); return 15.f * (1.f - 2.f * __builtin_amdgcn_rcpf(e + 1.f)); }
DI float log_sigmoid(float x) { return fminf(x, 0.f) - log1pf(__expf(-fabsf(x))); }
DI float softplusf_(float x) { return fmaxf(x, 0.f) + log1pf(__expf(-fabsf(x))); }
DI float wave_incl_sum(float v, int lane) {
#pragma unroll
    for (int o = 1; o < 64; o <<= 1) { const float t = __shfl_up(v, o); v += (lane >= o) ? t : 0.f; }
    return v;
}
DI float wave_incl_max(float v, int lane) {
#pragma unroll
    for (int o = 1; o < 64; o <<= 1) { const float t = __shfl_up(v, o); v = (lane >= o) ? fmaxf(v, t) : v; }
    return v;
}
constexpr int LDI = 136 * 2;
constexpr int LDK = 72 * 2;

DI void ml_a_unit(Ctx& F, const Args& a, int l, int cid) {
    const int b = cid >> 8, h = (cid >> 6) & 3, n = cid & 63, t0 = b * SEQ + n * CH, lane = F.lane, tid = F.tid;
    const bf16* PROJ = (const bf16*)(F.ws + WS_PROJ); const float* GT = (const float*)(F.ws + WS_GATES);
    LAS unsigned char* KE = F.lds; LAS unsigned char* VI = F.lds + 16384; LAS float* es = (LAS float*)(F.lds + 40960);
    if (F.wave == 0) {
        const float ip = softcap15(GT[(size_t)(t0 + lane) * 16 + h] + inp(F, 3)[l * 4 + h]), fp = softcap15(GT[(size_t)(t0 + lane) * 16 + 4 + h] + inp(F, 4)[l * 4 + h]);
        const float bc = wave_incl_sum(log_sigmoid(fp), lane), blast = __shfl(bc, 63), lw = blast - bc + ip, amax = wave_max(lw);
        es[lane] = __expf(lw - amax);
        if (lane == 0) { float* sc = (float*)(F.ws + WS_MLSC) + (size_t)cid * 4; sc[0] = blast; sc[1] = amax; }
    }
    __syncthreads();
    { const int s = tid >> 3, c8 = (tid & 7) * 8; float v[8]; unpack8(*(const u32x4*)(PROJ + (size_t)(t0 + s) * NPROJ + 256 + h * 64 + c8), v); const float e = es[s];
#pragma unroll
      for (int j = 0; j < 8; ++j) v[j] *= e;
      *(LAS u32x4*)(KE + s * LDK + c8 * 2) = pack8(v); }
#pragma unroll
    for (int q = 0; q < 2; ++q) { const int idx = tid + 512 * q, s = idx >> 4, c8 = (idx & 15) * 8;
        *(LAS u32x4*)(VI + s * LDI + c8 * 2) = *(const u32x4*)(PROJ + (size_t)(t0 + s) * NPROJ + 512 + h * 128 + c8); }
    __syncthreads();
    { const int g = lane >> 4, w = F.wave; f32x4 acc[4];
#pragma unroll
      for (int nt = 0; nt < 4; ++nt) acc[nt] = (f32x4){0.f, 0.f, 0.f, 0.f};
#pragma unroll
      for (int ks = 0; ks < 2; ++ks) { const int rb = 32 * ks + 8 * g;
          const bf16x8 af = tr_frag8(lds_addr(VI), LDI, rb, rb + 4, 16 * w, lane);
#pragma unroll
          for (int nt = 0; nt < 4; ++nt) { const bf16x8 bf = tr_frag8(lds_addr(KE), LDK, rb, rb + 4, 16 * nt, lane); acc[nt] = MFMA16(af, bf, acc[nt]); } }
      float* U = (float*)(F.ws + WS_MLU) + (size_t)cid * 8192;
#pragma unroll
      for (int nt = 0; nt < 4; ++nt)
#pragma unroll
          for (int i = 0; i < 4; ++i) U[(16 * w + 4 * g + i) * 64 + 16 * nt + (lane & 15)] = acc[nt][i];
    }
    if (tid < 64) { float s = 0.f; for (int r = 0; r < 64; ++r) s += bf2f(*(const LAS bf16*)(KE + r * LDK + tid * 2)); ((float*)(F.ws + WS_MLKN))[(size_t)cid * 64 + tid] = s; }
    __syncthreads();
}
DI void ml_b_unit(Ctx& F, int u) {
    const int bh = u >> 4, p = u & 15, tid = F.tid, j = p * 512 + tid;
    const float* U = (const float*)(F.ws + WS_MLU); const float* SC = (const float*)(F.ws + WS_MLSC); const float* KN = (const float*)(F.ws + WS_MLKN);
    bf16* CT = (bf16*)(F.ws + WS_MLCT); float* NP = (float*)(F.ws + WS_MLNP); float* MP = (float*)(F.ws + WS_MLMP);
    float C = 0.f, nv = 0.f, m = 0.f; const bool dn = (p == 0 && tid < 64);
    for (int nb = 0; nb < 64; nb += 8) {
        float uv[8], kv[8];
#pragma unroll
        for (int q = 0; q < 8; ++q) { const size_t cid = (size_t)bh * 64 + nb + q; uv[q] = U[cid * 8192 + j]; kv[q] = dn ? KN[cid * 64 + tid] : 0.f; }
#pragma unroll
        for (int q = 0; q < 8; ++q) { const size_t cid = (size_t)bh * 64 + nb + q;
            const float blast = ldf(SC + cid * 4), amax = ldf(SC + cid * 4 + 1);
            CT[cid * 8192 + j] = f2bf(C); if (dn) NP[cid * 64 + tid] = nv; if (p == 0 && tid == 0) MP[cid] = m;
            const float mn = fmaxf(blast + m, amax), d1 = __expf(blast + m - mn), d2 = __expf(amax - mn);
            C = d1 * C + d2 * uv[q]; nv = d1 * nv + d2 * kv[q]; m = mn; }
    }
}
DI void ml_c_unit(Ctx& F, const Args& a, int l, int cid) {
    const int b = cid >> 8, h = (cid >> 6) & 3, n = cid & 63, t0 = b * SEQ + n * CH, lane = F.lane, tid = F.tid, g = lane >> 4, ln = lane & 15, w = F.wave, tt = w & 3, dh = w >> 2;
    const bf16* PROJ = (const bf16*)(F.ws + WS_PROJ); const float* GT = (const float*)(F.ws + WS_GATES);
    LAS unsigned char* VI = F.lds; LAS float* ib = (LAS float*)(F.lds + 20480); LAS float* Mt = ib + 64; LAS float* bcs = ib + 128; LAS float* ss = ib + 192;
    const float mprev = ldf((const float*)(F.ws + WS_MLMP) + cid);
    if (w == 0) {
        const float ip = softcap15(GT[(size_t)(t0 + lane) * 16 + h] + inp(F, 3)[l * 4 + h]), fp = softcap15(GT[(size_t)(t0 + lane) * 16 + 4 + h] + inp(F, 4)[l * 4 + h]);
        const float bc = wave_incl_sum(log_sigmoid(fp), lane), ibs = ip - bc, pm = wave_incl_max(ibs, lane);
        ib[lane] = ibs; Mt[lane] = fmaxf(mprev, pm); bcs[lane] = bc;
    }
#pragma unroll
    for (int q = 0; q < 2; ++q) { const int idx = tid + 512 * q, s = idx >> 4, c8 = (idx & 15) * 8;
        *(LAS u32x4*)(VI + s * LDI + c8 * 2) = *(const u32x4*)(PROJ + (size_t)(t0 + s) * NPROJ + 512 + h * 128 + c8); }
    __syncthreads();
    bf16x8 qf[2];
#pragma unroll
    for (int ks = 0; ks < 2; ++ks) qf[ks] = *(const bf16x8*)(PROJ + (size_t)(t0 + 16 * tt + ln) * NPROJ + h * 64 + 32 * ks + 8 * g);
    f32x4 sacc[4];
#pragma unroll
    for (int ms = 0; ms < 4; ++ms) { sacc[ms] = (f32x4){0.f, 0.f, 0.f, 0.f};
#pragma unroll
        for (int ks = 0; ks < 2; ++ks) { const bf16x8 kf = *(const bf16x8*)(PROJ + (size_t)(t0 + 16 * ms + ln) * NPROJ + 256 + h * 64 + 32 * ks + 8 * g); sacc[ms] = MFMA16(kf, qf[ks], sacc[ms]); } }
    const int tl = 16 * tt + ln; const float Mtt = Mt[tl];
#pragma unroll
    for (int ms = 0; ms < 4; ++ms) { const f32x4 ibv = *(const LAS f32x4*)(ib + 16 * ms + 4 * g);
#pragma unroll
        for (int i = 0; i < 4; ++i) { const int s = 16 * ms + 4 * g + i; sacc[ms][i] = (s <= tl) ? sacc[ms][i] * 0.125f * __expf(ibv[i] - Mtt) : 0.f; } }
    bf16x8 sb[2]; sb[0] = pack_frag(sacc[0], sacc[1]); sb[1] = pack_frag(sacc[2], sacc[3]);
    const bf16* CT = (const bf16*)(F.ws + WS_MLCT) + (size_t)cid * 8192; const float* NPv = (const float*)(F.ws + WS_MLNP) + (size_t)cid * 64;
    f32x4 xacc[5];
#pragma unroll
    for (int mt = 0; mt < 5; ++mt) { xacc[mt] = (f32x4){0.f, 0.f, 0.f, 0.f};
#pragma unroll
        for (int ks = 0; ks < 2; ++ks) { bf16x8 af;
            if (mt < 4) af = *(const bf16x8*)(CT + (size_t)(16 * (4 * dh + mt) + ln) * 64 + 32 * ks + 8 * g);
            else { float nvv[8];
#pragma unroll
                for (int j = 0; j < 8; ++j) nvv[j] = (ln == 0) ? NPv[32 * ks + 8 * g + j] : 0.f;
                af = __builtin_bit_cast(bf16x8, pack8(nvv)); }
            xacc[mt] = MFMA16(af, qf[ks], xacc[mt]); } }
    const float wint = 0.125f * __expf(mprev - Mtt);
#pragma unroll
    for (int mt = 0; mt < 5; ++mt) xacc[mt] *= wint;
    const bf16x8 ones = (ln == 0) ? (bf16x8){0x3f80, 0x3f80, 0x3f80, 0x3f80, 0x3f80, 0x3f80, 0x3f80, 0x3f80} : (bf16x8){0, 0, 0, 0, 0, 0, 0, 0};
#pragma unroll
    for (int kk = 0; kk < 2; ++kk) {
#pragma unroll
        for (int mt = 0; mt < 4; ++mt) { const bf16x8 vf = tr_frag8(lds_addr(VI), LDI, 32 * kk + 4 * g, 32 * kk + 16 + 4 * g, 16 * (4 * dh + mt), lane); xacc[mt] = MFMA16(vf, sb[kk], xacc[mt]); }
        xacc[4] = MFMA16(ones, sb[kk], xacc[4]);
    }
    const float den = __shfl(xacc[4][0], ln), mt_ = bcs[tl] + Mtt, dinv = __builtin_amdgcn_rcpf(fmaxf(fabsf(den), __expf(-mt_)));
    float ssq = 0.f;
#pragma unroll
    for (int mt = 0; mt < 4; ++mt) { xacc[mt] *= dinv; ssq += (xacc[mt][0] * xacc[mt][0] + xacc[mt][1] * xacc[mt][1]) + (xacc[mt][2] * xacc[mt][2] + xacc[mt][3] * xacc[mt][3]); }
    ssq += __shfl_xor(ssq, 16); ssq += __shfl_xor(ssq, 32);
    if (g == 0) ss[tl * 2 + dh] = ssq;
    __syncthreads();
    const float rinv = rsqrtf((ss[tl * 2] + ss[tl * 2 + 1]) * (1.f / 128.f) + 1e-6f);
    bf16* MX = (bf16*)(F.ws + WS_MIXED);
#pragma unroll
    for (int mt = 0; mt < 4; ++mt) { const int dv = 16 * (4 * dh + mt) + 4 * g;
        const f32x4 nw = *(const f32x4*)(inp(F, 5) + (size_t)l * 512 + h * 128 + dv);
        const f32x4 og = unpack4(*(const u32x2*)(PROJ + (size_t)(t0 + tl) * NPROJ + 1024 + h * 128 + dv));
        f32x4 o;
#pragma unroll
        for (int i = 0; i < 4; ++i) o[i] = xacc[mt][i] * rinv * nw[i] * sigmoidf_(og[i]);
        *(u32x2*)(MX + (size_t)(t0 + tl) * D + h * 128 + dv) = pack4(o); }
    __syncthreads();
}

constexpr int GA_QH = 0, GA_KH = 17408, GA_VB = 34816, GA_KB = 52224, GA_NA = 69632, GA_AD = 78848, GA_TI = 82944, GA_GC = 84992, GA_KEI = 86016;
DI void gd_a_unit(Ctx& F, const Args& a, int l, int cid) {
    const int b = cid >> 8, h = (cid >> 6) & 3, n = cid & 63, t0 = b * SEQ + n * CH, lane = F.lane, tid = F.tid, g = lane >> 4, ln = lane & 15, w = F.wave;
    const bf16* PROJ = (const bf16*)(F.ws + WS_PROJ); const float* GT = (const float*)(F.ws + WS_GATES);
    LAS unsigned char* L = F.lds; LAS float* gcs = (LAS float*)(L + GA_GC); LAS float* bts = gcs + 64;
    if (w == 0) {
        const float beta = sigmoidf_(GT[(size_t)(t0 + lane) * 16 + 8 + h]);
        const float gg = -__expf(inp(F, 7)[l * 4 + h]) * softplusf_(GT[(size_t)(t0 + lane) * 16 + 12 + h] + inp(F, 8)[l * 4 + h]);
        const float gc = wave_incl_sum(gg, lane);
        gcs[lane] = gc; bts[lane] = beta;
        if (lane == 63) ((float*)(F.ws + WS_GDGL))[cid] = __expf(gc);
    }
    __syncthreads();
    const float glast = gcs[63];
    { const int cg = tid & 15;
#pragma unroll 1
      for (int ten = 0; ten < 3; ++ten) {
          float wv[4][8];
#pragma unroll
          for (int j = 0; j < 4; ++j) { const float* wp = inp(F, 6) + ((size_t)l * 4 + j) * 1536 + ten * 512 + h * 128 + 8 * cg; const f32x4 w0 = *(const f32x4*)wp, w1 = *(const f32x4*)(wp + 4);
#pragma unroll
              for (int c = 0; c < 4; ++c) { wv[j][c] = w0[c]; wv[j][4 + c] = w1[c]; } }
#pragma unroll
          for (int pass = 0; pass < 2; ++pass) { const int t = (tid >> 4) + 32 * pass; float y[8];
#pragma unroll
              for (int c = 0; c < 8; ++c) y[c] = 0.f;
#pragma unroll
              for (int j = 0; j < 4; ++j) { const int row = t - 3 + j;
                  if (n > 0 || row >= 0) { float xv[8]; unpack8(*(const u32x4*)(PROJ + (size_t)(t0 + row) * NPROJ + 1536 + ten * 512 + h * 128 + 8 * cg), xv);
#pragma unroll
                      for (int c = 0; c < 8; ++c) y[c] += wv[j][c] * xv[c]; } }
#pragma unroll
              for (int c = 0; c < 8; ++c) y[c] = y[c] * sigmoidf_(y[c]);
              const float gct = gcs[t], bt = bts[t];
              if (ten < 2) { float s2 = 0.f;
#pragma unroll
                  for (int c = 0; c < 8; ++c) s2 += y[c] * y[c];
                  s2 += __shfl_xor(s2, 1); s2 += __shfl_xor(s2, 2); s2 += __shfl_xor(s2, 4); s2 += __shfl_xor(s2, 8);
                  const float rn = rsqrtf(s2 + 1e-6f) * (ten == 0 ? 0.08838834764831845f : 1.f);
#pragma unroll
                  for (int c = 0; c < 8; ++c) y[c] *= rn; }
              float z[8];
              if (ten == 0) { *(LAS u32x4*)(L + GA_QH + t * LDI + 16 * cg) = pack8(y); const float e = __expf(gct);
#pragma unroll
                  for (int c = 0; c < 8; ++c) z[c] = y[c] * e;
                  *(u32x4*)((bf16*)(F.ws + WS_GDQG) + (size_t)cid * 8192 + t * 128 + 8 * cg) = pack8(z); }
              else if (ten == 1) { *(LAS u32x4*)(L + GA_KH + t * LDI + 16 * cg) = pack8(y); const float e1 = bt * __expf(gct), e2 = __expf(glast - gct);
#pragma unroll
                  for (int c = 0; c < 8; ++c) z[c] = y[c] * e1;
                  *(LAS u32x4*)(L + GA_KB + t * LDI + 16 * cg) = pack8(z);
#pragma unroll
                  for (int c = 0; c < 8; ++c) z[c] = y[c] * e2;
                  *(LAS u32x4*)(L + GA_KEI + t * LDI + 16 * cg) = pack8(z); }
              else {
#pragma unroll
                  for (int c = 0; c < 8; ++c) z[c] = y[c] * bt;
                  *(LAS u32x4*)(L + GA_VB + t * LDI + 16 * cg) = pack8(z); }
          }
      } }
    __syncthreads();
    { const int ti = w & 3, kind = w >> 2; const int tl = 16 * ti + ln; const float gct = gcs[tl], bt = bts[tl];
      bf16* QKD = (bf16*)(F.ws + WS_GDQK) + (size_t)cid * 4096;
#pragma unroll
      for (int si = 0; si < 4; ++si) {
          if (si <= ti) {
              f32x4 acc = (f32x4){0.f, 0.f, 0.f, 0.f};
#pragma unroll
              for (int ks = 0; ks < 4; ++ks) { const bf16x8 af = *(const LAS bf16x8*)(L + GA_KH + (16 * si + ln) * LDI + (32 * ks + 8 * g) * 2);
                  const bf16x8 bfr = *(const LAS bf16x8*)(L + (kind ? GA_QH : GA_KH) + tl * LDI + (32 * ks + 8 * g) * 2); acc = MFMA16(af, bfr, acc); }
              const f32x4 gs = *(const LAS f32x4*)(gcs + 16 * si + 4 * g);
              f32x4 v;
#pragma unroll
              for (int i = 0; i < 4; ++i) { const int s = 16 * si + 4 * g + i; const float dec = __expf(gct - gs[i]);
                  v[i] = kind ? ((s <= tl) ? acc[i] * dec : 0.f) : ((s < tl) ? bt * acc[i] * dec : 0.f); }
              if (kind) *(u32x2*)(QKD + tl * 64 + 16 * si + 4 * g) = pack4(v);
              else { *(LAS u32x2*)(L + GA_NA + tl * LDK + (16 * si + 4 * g) * 2) = pack4(-v);
                  if (si == ti) { LAS float* AD = (LAS float*)(L + GA_AD) + ti * 256 + ln * 16 + 4 * g; AD[0] = v[0]; AD[1] = v[1]; AD[2] = v[2]; AD[3] = v[3]; } }
          } else if (kind) *(u32x2*)(QKD + tl * 64 + 16 * si + 4 * g) = (u32x2){0u, 0u};
      } }
    __syncthreads();
    if (w == 0) { const LAS float* AD = (const LAS float*)(L + GA_AD) + g * 256; float Tc[16];
#pragma unroll
        for (int t = 0; t < 16; ++t) { float v = (t == ln) ? 1.f : 0.f;
#pragma unroll
            for (int s = 0; s < t; ++s) v -= AD[t * 16 + s] * Tc[s];
            Tc[t] = v; *(LAS bf16*)(L + GA_TI + (16 * g + t) * 32 + ln * 2) = f2bf(v); } }
    __syncthreads();
    { const int src = (w < 4) ? GA_VB : GA_KB, cb = 32 * (w & 3);
      u32x2 Ub[4][2]; bf16* UT = (bf16*)(F.ws + WS_GDUT) + (size_t)cid * 8192;
#pragma unroll
      for (int i = 0; i < 4; ++i) {
          f32x4 acc[2];
#pragma unroll
          for (int nt = 0; nt < 2; ++nt)
#pragma unroll
              for (int r = 0; r < 4; ++r) acc[nt][r] = bf2f(*(const LAS bf16*)(L + src + (16 * i + 4 * g + r) * LDI + (cb + 16 * nt + ln) * 2));
#pragma unroll
          for (int jp = 0; jp < 2; ++jp) { if (2 * jp < i) {
              const u32x2 alo = *(const LAS u32x2*)(L + GA_NA + (16 * i + ln) * LDK + (32 * jp + 4 * g) * 2);
              const u32x2 ahi = (2 * jp + 1 < i) ? *(const LAS u32x2*)(L + GA_NA + (16 * i + ln) * LDK + (32 * jp + 16 + 4 * g) * 2) : (u32x2){0u, 0u};
              const bf16x8 af = __builtin_bit_cast(bf16x8, (u32x4){alo.x, alo.y, ahi.x, ahi.y});
#pragma unroll
              for (int nt = 0; nt < 2; ++nt) { const u32x2 blo = Ub[2 * jp][nt], bhi = (2 * jp + 1 < i) ? Ub[2 * jp + 1][nt] : (u32x2){0u, 0u};
                  acc[nt] = MFMA16(af, __builtin_bit_cast(bf16x8, (u32x4){blo.x, blo.y, bhi.x, bhi.y}), acc[nt]); } } }
          const u32x2 tlo = *(const LAS u32x2*)(L + GA_TI + (16 * i + ln) * 32 + (4 * g) * 2);
          const bf16x8 tf = __builtin_bit_cast(bf16x8, (u32x4){tlo.x, tlo.y, 0u, 0u});
#pragma unroll
          for (int nt = 0; nt < 2; ++nt) { const u32x2 p = pack4(acc[nt]);
              const f32x4 u = MFMA16(tf, __builtin_bit_cast(bf16x8, (u32x4){p.x, p.y, 0u, 0u}), ((f32x4){0.f, 0.f, 0.f, 0.f}));
              Ub[i][nt] = pack4(u);
              if (w < 4) *(u32x2*)(UT + (size_t)(cb + 16 * nt + ln) * 64 + 16 * i + 4 * g) = Ub[i][nt];
              else {
#pragma unroll
                  for (int r = 0; r < 4; ++r) *(LAS bf16*)(L + GA_QH + (16 * i + 4 * g + r) * LDI + (cb + 16 * nt + ln) * 2) = f2bf(u[r]); } }
      } }
    __syncthreads();
    { bf16* W = (bf16*)(F.ws + WS_GDW) + (size_t)cid * 8192; bf16* KET = (bf16*)(F.ws + WS_GDKE) + (size_t)cid * 8192;
#pragma unroll
      for (int q = 0; q < 2; ++q) { const int item = tid + 512 * q, t = item >> 4, c = item & 15, kk = c >> 2, gp = c & 3;
          const u32x2 lo = *(const LAS u32x2*)(L + GA_QH + t * LDI + (32 * kk + 4 * gp) * 2), hi = *(const LAS u32x2*)(L + GA_QH + t * LDI + (32 * kk + 16 + 4 * gp) * 2);
          *(u32x4*)(W + t * 128 + 32 * kk + 8 * gp) = (u32x4){lo.x, lo.y, hi.x, hi.y}; }
#pragma unroll
      for (int q = 0; q < 4; ++q) { const int rg = 4 * q + g, kk = rg >> 3, idx = rg & 7, pos = 32 * kk + ((idx < 4) ? 8 * idx : 8 * (idx - 4) + 4);
          const int trow = 32 * kk + ((idx < 4) ? 4 * idx : 16 + 4 * (idx - 4));
          const s16x4 v = tr_read4(lds_addr(L + GA_KEI) + (unsigned)((trow + (ln >> 2)) * LDI + (16 * w + 4 * (ln & 3)) * 2));
          *(s16x4*)(KET + (size_t)(16 * w + ln) * 64 + pos) = v; }
    }
    __syncthreads();
}
DI void gd_b_task(Ctx& F, int task) {
    const int bh = task >> 3, dv0 = 16 * (task & 7), lane = F.lane, g = lane >> 4, ln = lane & 15;
    const bf16* UT = (const bf16*)(F.ws + WS_GDUT); const bf16* W = (const bf16*)(F.ws + WS_GDW); const bf16* KET = (const bf16*)(F.ws + WS_GDKE);
    bf16* VNT = (bf16*)(F.ws + WS_GDVN); bf16* SPT = (bf16*)(F.ws + WS_GDSP); const float* GL = (const float*)(F.ws + WS_GDGL);
    f32x4 S[8];
#pragma unroll
    for (int j = 0; j < 8; ++j) S[j] = (f32x4){0.f, 0.f, 0.f, 0.f};
#pragma unroll 1
    for (int n = 0; n < 64; ++n) {
        const size_t cid = (size_t)bh * 64 + n;
        const float egl = ldf(GL + cid);
        bf16x8 wf[4][4], kef[8][2]; f32x4 vacc[4];
#pragma unroll
        for (int mt = 0; mt < 4; ++mt) { vacc[mt] = unpack4(*(const u32x2*)(UT + cid * 8192 + (size_t)(dv0 + ln) * 64 + 16 * mt + 4 * g));
#pragma unroll
            for (int kk = 0; kk < 4; ++kk) wf[mt][kk] = *(const bf16x8*)(W + cid * 8192 + (size_t)(16 * mt + ln) * 128 + 32 * kk + 8 * g); }
#pragma unroll
        for (int j = 0; j < 8; ++j)
#pragma unroll
            for (int k2 = 0; k2 < 2; ++k2) kef[j][k2] = *(const bf16x8*)(KET + cid * 8192 + (size_t)(16 * j + ln) * 64 + 32 * k2 + 8 * g);
        bf16x8 sbn[4];
#pragma unroll
        for (int kk = 0; kk < 4; ++kk) sbn[kk] = pack_frag(-S[2 * kk], -S[2 * kk + 1]);
#pragma unroll
        for (int j = 0; j < 8; ++j) *(u32x2*)(SPT + cid * 16384 + (size_t)(dv0 + ln) * 128 + 16 * j + 4 * g) = pack4(S[j]);
#pragma unroll
        for (int mt = 0; mt < 4; ++mt)
#pragma unroll
            for (int kk = 0; kk < 4; ++kk) vacc[mt] = MFMA16(wf[mt][kk], sbn[kk], vacc[mt]);
#pragma unroll
        for (int mt = 0; mt < 4; ++mt) *(u32x2*)(VNT + cid * 8192 + (size_t)(dv0 + ln) * 64 + 16 * mt + 4 * g) = pack4(vacc[mt]);
        bf16x8 vb[2]; vb[0] = pack_frag(vacc[0], vacc[1]); vb[1] = pack_frag(vacc[2], vacc[3]);
#pragma unroll
        for (int j = 0; j < 8; ++j) { S[j] *= egl;
#pragma unroll
            for (int k2 = 0; k2 < 2; ++k2) S[j] = MFMA16(kef[j][k2], vb[k2], S[j]); }
    }
}
DI void gd_c_unit(Ctx& F, const Args& a, int l, int cid) {
    const int b = cid >> 8, h = (cid >> 6) & 3, n = cid & 63, t0 = b * SEQ + n * CH, lane = F.lane, g = lane >> 4, ln = lane & 15, w = F.wave, tt = w & 3, dh = w >> 2, tl = 16 * tt + ln;
    const bf16* PROJ = (const bf16*)(F.ws + WS_PROJ);
    const bf16* SPT = (const bf16*)(F.ws + WS_GDSP) + (size_t)cid * 16384; const bf16* QG = (const bf16*)(F.ws + WS_GDQG) + (size_t)cid * 8192;
    const bf16* VNT = (const bf16*)(F.ws + WS_GDVN) + (size_t)cid * 8192; const bf16* QKD = (const bf16*)(F.ws + WS_GDQK) + (size_t)cid * 4096;
    LAS float* ss = (LAS float*)(F.lds);
    bf16x8 qf[4], pf[2];
#pragma unroll
    for (int ks = 0; ks < 4; ++ks) qf[ks] = *(const bf16x8*)(QG + tl * 128 + 32 * ks + 8 * g);
#pragma unroll
    for (int ks = 0; ks < 2; ++ks) pf[ks] = *(const bf16x8*)(QKD + tl * 64 + 32 * ks + 8 * g);
    f32x4 o[4]; float ssq = 0.f;
#pragma unroll
    for (int mt = 0; mt < 4; ++mt) { o[mt] = (f32x4){0.f, 0.f, 0.f, 0.f}; const int dvr = 16 * (4 * dh + mt) + ln;
#pragma unroll
        for (int ks = 0; ks < 4; ++ks) o[mt] = MFMA16(*(const bf16x8*)(SPT + (size_t)dvr * 128 + 32 * ks + 8 * g), qf[ks], o[mt]);
#pragma unroll
        for (int ks = 0; ks < 2; ++ks) o[mt] = MFMA16(*(const bf16x8*)(VNT + (size_t)dvr * 64 + 32 * ks + 8 * g), pf[ks], o[mt]);
        ssq += (o[mt][0] * o[mt][0] + o[mt][1] * o[mt][1]) + (o[mt][2] * o[mt][2] + o[mt][3] * o[mt][3]); }
    ssq += __shfl_xor(ssq, 16); ssq += __shfl_xor(ssq, 32);
    if (g == 0) ss[tl * 2 + dh] = ssq;
    __syncthreads();
    const float rinv = rsqrtf((ss[tl * 2] + ss[tl * 2 + 1]) * (1.f / 128.f) + 1e-6f);
    bf16* MX = (bf16*)(F.ws + WS_MIXED);
#pragma unroll
    for (int mt = 0; mt < 4; ++mt) { const int dv = 16 * (4 * dh + mt) + 4 * g;
        const f32x4 nw = *(const f32x4*)(inp(F, 9) + (size_t)l * 128 + dv);
        const f32x4 z = unpack4(*(const u32x2*)(PROJ + (size_t)(t0 + tl) * NPROJ + 3072 + h * 128 + dv));
        f32x4 r;
#pragma unroll
        for (int i = 0; i < 4; ++i) r[i] = o[mt][i] * rinv * nw[i] * z[i] * sigmoidf_(z[i]);
        *(u32x2*)(MX + (size_t)(t0 + tl) * D + 512 + h * 128 + dv) = pack4(r); }
    __syncthreads();
}

struct P2Order {
    unsigned char* ws; int G, c0;
    DI bool next(int i, g8::Unit& u) const {
        const int L = i * G + c0; if (L >= 1024) return false;
        const int q = L & 511, t4 = q & 3, h = (q >> 2) & 3, b = (q >> 4) & 7, l = q >> 7;
        if (L < 512) { u.a = (const char*)(ws + WS_KV) + ((size_t)(2 * l) * 2048 + b * 256) * 2048 + h * 512; u.b = (const char*)(ws + WS_WQ) + ((size_t)l * 1024 + t4 * 256) * 2048 + h * 512;
            u.c = (char*)(ws + WS_WQK) + ((size_t)(l * 8 + b) * 1024 + h * 256) * 2048 + t4 * 512; u.aux = -1; }
        else { u.a = (const char*)(ws + WS_WO) + ((size_t)l * 1024 + t4 * 256) * 2048 + h * 512; u.b = (const char*)(ws + WS_KV) + ((size_t)(2 * l + 1) * 2048 + b * 256) * 2048 + h * 512;
            u.c = (char*)(ws + WS_WVO) + ((size_t)(l * 8 + b) * 1024 + t4 * 256) * 2048 + h * 512; u.aux = 0; }
        u.pm = 0; u.pn = 0; return true;
    }
};

constexpr int NPH_LAYER = 13, NPH = 3 + NL * NPH_LAYER;
__global__ void __launch_bounds__(NTHREADS, 2) mega(Args a) {
    extern __shared__ __attribute__((aligned(16))) unsigned char lds_raw[];
    Ctx F; F.lds = (LAS unsigned char*)lds_raw; F.ws = a.ws; F.ctl = (unsigned*)(a.ws + WS_CTL);
    F.tid = threadIdx.x; F.lane = F.tid & 63; F.wave = __builtin_amdgcn_readfirstlane(F.tid >> 6); F.G = gridDim.x;
    { const int bx = blockIdx.x; F.vcu = (F.G % 8 == 0) ? (bx % 8) * (F.G / 8) + bx / 8 : bx; }
    volatile LAS unsigned* MISC = (volatile LAS unsigned*)(F.lds + LDS_MISC);
    if (F.tid < 64) MISC[F.tid] = 0u;
    if (F.tid < 28) { const unsigned long long pv = (unsigned long long)(F.tid < 27 ? (const void*)a.in[F.tid] : (const void*)a.out); ((LAS unsigned long long*)(F.lds + LDS_PTAB))[F.tid] = pv; }
    __syncthreads();
    const bool multi = (a.ph_hi - a.ph_lo) > 1;
    XcdBarrier bar; bar.bar = F.ctl + CW_BAR; bar.x = 0; bar.st = MISC;
    if (multi) bar = xcd_barrier_post(F.ctl + CW_BAR, MISC);
#ifndef PMASK
#define PMASK 0xffff
#endif
#define EN(j) (((PMASK) >> (j)) & 1)
#define PH(k) (a.ph_lo <= (k) && (k) < a.ph_hi && (refresh(F, a.ws), true))
#define SEAM(k) do { if (PH(k) && PH((k) + 1)) xcd_barrier(bar); } while (0)
    const int G = F.G, vcu = F.vcu;

    if (EN(13) && PH(0)) { phase_convert(F, a); }
    SEAM(0);
    if (EN(14) && PH(1)) {
        g8::AffineOrder S; S.A = (const char*)(F.ws + WS_MEMB); S.B = (const char*)(F.ws + WS_WKV); S.C = (char*)(F.ws + WS_KV);
        S.aM = 256ull * 2048; S.bB = 0; S.bN = 256ull * 2048; S.cM = 256ull * 2048; S.cS = 2048ull * 2048; S.cN = 512; S.nM = 8; S.nN = 32; S.bdiv = 1 << 30; S.csp = 4; S.G = G; S.c0 = vcu;
        g8::EpiBf16 E{1024, nullptr, 0, 1.f};
        g8::gemm_phase(F.lds, 2048, 2048, 16, S, E);
        row_pass<0>(F, a, 0);
    }
    SEAM(1);
    if (EN(15) && PH(2)) { P2Order S{F.ws, G, vcu}; g8::EpiBf16 E{1024, nullptr, 0, 0.0625f}; g8::gemm_phase(F.lds, 2048, 2048, 4, S, E); }
    SEAM(2);
#pragma unroll 1
    for (int l = 0; l < NL; ++l) {
        const int pb = 3 + l * NPH_LAYER;
        if (EN(0) && PH(pb + 0)) {
            g8::AffineOrder S = g8::dense_order(F.ws + WS_XB, F.ws + WS_WIN + (size_t)l * NPROJ * D * 2, F.ws + WS_PROJ, T, NPROJ, D, NPROJ * 2, 2, G, vcu);
            g8::EpiBf16 E{NPROJ, nullptr, 0, 1.f}; g8::gemm_phase(F.lds, 2048, 2048, 16, S, E);
        }
        SEAM(pb + 0);
        if (EN(1) && PH(pb + 1)) {
            for (int u = vcu; u < 4096; u += G) { if (u < 2048) ml_a_unit(F, a, l, u); else gd_a_unit(F, a, l, u - 2048); }
        }
        SEAM(pb + 1);
        if (EN(2) && PH(pb + 2)) {
            for (int u = vcu; u < 512; u += G) ml_b_unit(F, u);
            if (F.wave == 0 && vcu < 256) gd_b_task(F, vcu);
        }
        SEAM(pb + 2);
        if (EN(3) && PH(pb + 3)) {
            for (int u = vcu; u < 4096; u += G) { if (u < 2048) ml_c_unit(F, a, l, u); else gd_c_unit(F, a, l, u - 2048); }
        }
        SEAM(pb + 3);
        if (EN(4) && PH(pb + 4)) {
            g8::AffineOrder S = g8::dense_order(F.ws + WS_MIXED, F.ws + WS_WOUT + (size_t)l * D * D * 2, F.ws + WS_HB, T, D, D, D * 2, 2, G, vcu);
            g8::EpiBf16 E{D, nullptr, 0, 1.f}; g8::gemm_phase(F.lds, 2048, 2048, 16, S, E);
        }
        SEAM(pb + 4);
        if (EN(5) && PH(pb + 5)) row_pass<1>(F, a, l);
        SEAM(pb + 5);
        if (EN(6) && PH(pb + 6)) {
            g8::AffineOrder S = g8::dense_order(F.ws + WS_XB, F.ws + WS_WQK + (size_t)l * 8 * D * D * 2, F.ws + WS_PB, T, D, D, D * 2, 2, G, vcu);
            S.bB = (size_t)D * D * 2; S.bdiv = 16;
            g8::EpiSoftmax E{D}; g8::gemm_phase(F.lds, 2048, 2048, 16, S, E);
        }
        SEAM(pb + 6);
        if (EN(7) && PH(pb + 7)) {
            g8::AffineOrder S = g8::dense_order(F.ws + WS_PB, F.ws + WS_WVO + (size_t)l * 8 * D * D * 2, F.ws + WS_HB, T, D, D, D * 2, 2, G, vcu);
            S.bB = (size_t)D * D * 2; S.bdiv = 16;
            g8::EpiBf16 E{D, nullptr, 0, 1.f}; g8::gemm_phase(F.lds, 2048, 2048, 16, S, E);
        }
        SEAM(pb + 7);
        if (EN(8) && PH(pb + 8)) row_pass<2>(F, a, l);
        SEAM(pb + 8);
        if (EN(9) && PH(pb + 9)) phase_scatter(F, l);
        SEAM(pb + 9);
        if (EN(10) && PH(pb + 10)) {
            MoeOrder S; S.A = (const char*)(F.ws + WS_XG); S.B = (const char*)(F.ws + WS_WGU) + (size_t)l * 32 * 2048 * D * 2; S.C = (char*)(F.ws + WS_ACT); S.tile_e = F.ctl + CW_TILE_E + l * MAXTILES;
            S.NT = __builtin_amdgcn_readfirstlane((int)ldu(F.ctl + CW_NT + l)); S.nN = 8; S.bE = 2048ull * D * 2; S.bN = 256ull * 2048; S.cN = 256; S.G = G; S.c0 = vcu;
            g8::EpiSwiglu E{inp(F, 22) + (size_t)l * 32 * 2048}; g8::gemm_phase(F.lds, 2048, 2048, 16, S, E);
        }
        SEAM(pb + 10);
        if (EN(11) && PH(pb + 11)) {
            MoeOrder S; S.A = (const char*)(F.ws + WS_ACT); S.B = (const char*)(F.ws + WS_WDN) + (size_t)l * 32 * D * D * 2; S.C = (char*)(F.ws + WS_Y); S.tile_e = F.ctl + CW_TILE_E + l * MAXTILES;
            S.NT = __builtin_amdgcn_readfirstlane((int)ldu(F.ctl + CW_NT + l)); S.nN = 4; S.bE = (size_t)D * D * 2; S.bN = 256ull * 2048; S.cN = 512; S.G = G; S.c0 = vcu;
            g8::EpiBf16 E{D, inp(F, 24) + (size_t)l * 32 * D, D, 1.f}; g8::gemm_phase(F.lds, 2048, 2048, 16, S, E);
        }
        SEAM(pb + 11);
        if (EN(12) && PH(pb + 12)) row_pass<3>(F, a, l);
        SEAM(pb + 12);
    }
}

#ifndef DBG_STOP
#define DBG_STOP 0
#endif
#ifndef DBG_OFF
#define DBG_OFF WS_MIXED
#endif
#ifndef DBG_N
#define DBG_N ((size_t)T * D)
#endif
#ifndef DBG_F32
#define DBG_F32 0
#endif
__global__ void dbg_dump(const unsigned char* ws, float* out, size_t off) {
    const bf16* b = (const bf16*)(ws + off); const float* f = (const float*)(ws + off);
    for (size_t i = (size_t)blockIdx.x * blockDim.x + threadIdx.x; i < (size_t)T * D; i += (size_t)gridDim.x * blockDim.x) out[i] = (i < (size_t)(DBG_N)) ? (DBG_F32 ? f[i] : bf2f(b[i])) : 0.f;
}
#ifndef N_LAUNCH_MODE
#define N_LAUNCH_MODE 1
#endif
extern "C" void kernel_launch(void* const* d_in, const int* in_sizes, int n_in, void* d_out, int out_size, void* d_ws, size_t ws_size, hipStream_t stream) {
    static int ready = 0;
    if (ready == 0) {
        if (n_in != 27 || ws_size < WS_END) { fprintf(stderr, "kernel_launch: need 27 inputs and %zu bytes of workspace (got %d, %zu)\n", (size_t)WS_END, n_in, ws_size); ready = -1; return; }
        if (hipFuncSetAttribute((const void*)mega, hipFuncAttributeMaxDynamicSharedMemorySize, LDS_BYTES) != hipSuccess) { fprintf(stderr, "kernel_launch: hipFuncSetAttribute failed\n"); ready = -1; return; }
        int per_cu = 0; (void)hipOccupancyMaxActiveBlocksPerMultiprocessor(&per_cu, (const void*)mega, NTHREADS, LDS_BYTES); (void)hipGetLastError();
        ready = 1;
    }
    if (ready < 0) return;
    (void)hipMemsetAsync((char*)d_ws + WS_CTL, 0, 1 << 20, stream);
    Args a{};
    for (int i = 0; i < 27; ++i) a.in[i] = (const float*)d_in[i];
    a.out = (float*)d_out; a.ws = (unsigned char*)d_ws;
#if N_LAUNCH_MODE == 1
    a.ph_lo = 0; a.ph_hi = NPH;
    hipLaunchKernelGGL(mega, dim3(256), dim3(NTHREADS), LDS_BYTES, stream, a);
#else
    for (int p = 0; p < (DBG_STOP > 0 ? DBG_STOP : NPH); ++p) { a.ph_lo = p; a.ph_hi = p + 1; hipLaunchKernelGGL(mega, dim3(256), dim3(NTHREADS), LDS_BYTES, stream, a); }
    if (DBG_STOP > 0) hipLaunchKernelGGL(dbg_dump, dim3(2048), dim3(256), 0, stream, (const unsigned char*)d_ws, (float*)d_out, (size_t)(DBG_OFF));
#endif
}
```

```cpp
#include <hip/hip_runtime.h>
#include <cstdio>
#include <cstdint>
#define PROF_SCALE 16
#define PROF_OFS 1
#ifndef PROF_MASK
#define PROF_MASK 0x0
#endif

#define LAS __attribute__((address_space(3)))
typedef unsigned short bf16;
typedef short bf16x8 __attribute__((ext_vector_type(8)));
typedef short s16x4 __attribute__((ext_vector_type(4)));
typedef float f32x4 __attribute__((ext_vector_type(4)));
typedef float f32x2 __attribute__((ext_vector_type(2)));
typedef unsigned u32x4 __attribute__((ext_vector_type(4)));
typedef unsigned u32x2 __attribute__((ext_vector_type(2)));
#define DI __device__ __forceinline__
#define GAS __attribute__((address_space(1)))

constexpr int T = 32768, D = 1024, NB = 8, SEQ = 4096, NL = 4, NCH = 64, CH = 64;
constexpr int NPROJ = 3584;
constexpr int NE = 32, TOPK = 4;
constexpr int MAXTILES = 544, CAP = MAXTILES * 256;
constexpr float DN_ALPHA = 1.6817928305074290f;
constexpr int NWAVES = 8, NTHREADS = 512;
constexpr int LDS_RING = 131072, LDS_X = 131072  , LDS_MISC = 163840 - 4096, LDS_BYTES = 163840;

constexpr size_t MiB = 1ull << 20;
constexpr size_t WS_CTL = 0;
constexpr size_t WS_WIN = 1 * MiB;
constexpr size_t WS_WGATE = WS_WIN + 4ull * NPROJ * D * 2;
constexpr size_t WS_WRT = WS_WGATE + 4ull * 2 * 16 * D * 2;
constexpr size_t WS_WOUT = WS_WRT + 4ull * 2 * 32 * D * 2;
constexpr size_t WS_WQ = WS_WOUT + 4ull * D * D * 2;
constexpr size_t WS_WKV = WS_WQ + 4ull * D * D * 2;
constexpr size_t WS_WO = WS_WKV + 8ull * D * D * 2;
constexpr size_t WS_WGU = WS_WO + 4ull * D * D * 2;
constexpr size_t WS_WDN = WS_WGU + 4ull * 32 * 2048 * D * 2;
constexpr size_t WS_MEMB = WS_WDN + 4ull * 32 * D * D * 2;
constexpr size_t WS_KV = WS_MEMB + 2048ull * D * 2;
constexpr size_t WS_WQK = WS_KV + 8ull * 2048 * D * 2;
constexpr size_t WS_WVO = WS_WQK + 32ull * D * D * 2;
constexpr size_t WS_XB = WS_WVO + 32ull * D * D * 2;
constexpr size_t WS_PROJ = WS_XB + (size_t)T * D * 2;
constexpr size_t WS_GATES = WS_PROJ + (size_t)T * NPROJ * 2;
constexpr size_t WS_MIXED = WS_GATES + (size_t)T * 16 * 4;
constexpr size_t WS_HB = WS_MIXED + (size_t)T * D * 2;
constexpr size_t WS_PB = WS_HB + (size_t)T * D * 2;
constexpr size_t WS_TOPE = WS_PB + (size_t)T * D * 2;
constexpr size_t WS_TOPP = WS_TOPE + (size_t)T * 16;
constexpr size_t WS_TOPG = WS_TOPP + (size_t)T * 16;
constexpr size_t WS_SLOT = WS_TOPG + (size_t)T * 16;
constexpr size_t WS_XG = WS_SLOT + (size_t)T * 16;
constexpr size_t WS_ACT = WS_XG + (size_t)CAP * D * 2;
constexpr size_t WS_Y = WS_ACT + (size_t)CAP * D * 2;
constexpr size_t WS_MLU = WS_Y + (size_t)CAP * D * 2;
constexpr size_t WS_MLKN = WS_MLU + 2048ull * 8192 * 4;
constexpr size_t WS_MLSC = WS_MLKN + 2048ull * 64 * 4;
constexpr size_t WS_MLCT = WS_MLSC + 2048ull * 16;
constexpr size_t WS_MLNP = WS_MLCT + 2048ull * 8192 * 2;
constexpr size_t WS_MLMP = WS_MLNP + 2048ull * 64 * 4;
constexpr size_t WS_GDUT = WS_MLMP + 2048ull * 4;
constexpr size_t WS_GDW = WS_GDUT + 2048ull * 8192 * 2;
constexpr size_t WS_GDKE = WS_GDW + 2048ull * 8192 * 2;
constexpr size_t WS_GDQG = WS_GDKE + 2048ull * 8192 * 2;
constexpr size_t WS_GDQK = WS_GDQG + 2048ull * 8192 * 2;
constexpr size_t WS_GDGL = WS_GDQK + 2048ull * 4096 * 2;
constexpr size_t WS_GDVN = WS_GDGL + 2048ull * 4;
constexpr size_t WS_GDSP = WS_GDVN + 2048ull * 8192 * 2;
constexpr size_t WS_END = WS_GDSP + 2048ull * 16384 * 2;
constexpr int CW_BAR = 1024, CW_NT = 8192 + 256, CW_TILE_E = 8192 + 512, CW_DBG = 16384, CW_ECNT = 32768;

typedef __bf16 bf16x2_t __attribute__((ext_vector_type(2)));
DI unsigned cvt_pk_bf16(float lo, float hi) { const f32x2 v = {lo, hi}; const bf16x2_t r = __builtin_convertvector(v, bf16x2_t); return __builtin_bit_cast(unsigned, r); }
DI bf16 f2bf(float f) { return (bf16)(cvt_pk_bf16(f, 0.f) & 0xffffu); }
DI float bf2f(bf16 b) { return __uint_as_float(((unsigned)b) << 16); }
DI float bflo(unsigned w) { return __uint_as_float(w << 16); }
DI float bfhi(unsigned w) { return __uint_as_float(w & 0xffff0000u); }
DI float sigmoidf_(float x) { return __builtin_amdgcn_rcpf(1.f + __expf(-x)); }
DI float wave_sum(float v) {
#pragma unroll
    for (int o = 1; o < 64; o <<= 1) v += __shfl_xor(v, o);
    return v;
}
DI float wave_max(float v) {
#pragma unroll
    for (int o = 1; o < 64; o <<= 1) v = fmaxf(v, __shfl_xor(v, o));
    return v;
}
#define LDS_WAIT() asm volatile("s_waitcnt lgkmcnt(0)" ::: "memory")
#define VM_WAIT() asm volatile("s_waitcnt vmcnt(0)" ::: "memory")
#define MFMA16(a, b, c) __builtin_amdgcn_mfma_f32_16x16x32_bf16((a), (b), (c), 0, 0, 0)

#define XB_TMO      128
#define XB_XCNT(j)  (256  + 64 * (j))
#define XB_XSUB(j)  (1280 + 64 * (j))
#define XB_XGEN(j)  (2304 + 64 * (j))
#define XB_TOP      3328
#define XB_TOPGEN   3392
#define XCD_BAR_WORDS 3456
#define XB_SPIN_CAP (1u << 22)
__device__ __forceinline__ unsigned xb_ld(unsigned* p)              { return __hip_atomic_load(p, __ATOMIC_RELAXED, __HIP_MEMORY_SCOPE_AGENT); }
__device__ __forceinline__ unsigned xb_add(unsigned* p, unsigned v) { return __hip_atomic_fetch_add(p, v, __ATOMIC_RELAXED, __HIP_MEMORY_SCOPE_AGENT); }
__device__ __forceinline__ unsigned xb_xcc_id() { return (unsigned)__builtin_amdgcn_s_getreg((3 << 11) | 20) & 0xFu; }
#define XB_SPIN(cond, bar) do { unsigned _sp = 0; while (cond) { __builtin_amdgcn_s_sleep(1); \
    if ((++_sp & 255u) == 0u) { if (xb_ld(&(bar)[XB_TMO])) break; if (_sp > XB_SPIN_CAP) { atomicAdd(&(bar)[XB_TMO], 1u); break; } } } } while (0)
struct XcdBarrier { unsigned* bar; unsigned x; volatile LAS unsigned* st; };
__device__ __forceinline__ XcdBarrier xcd_barrier_post(unsigned* bar, volatile LAS unsigned* st) {
    XcdBarrier b; b.bar = bar; b.x = xb_xcc_id(); b.st = st;
    if (threadIdx.x == 0) (void)xb_add(&bar[XB_XCNT(b.x)], 1u);
    return b;
}
__device__ __attribute__((noinline)) unsigned long long xcd_barrier_complete(unsigned* bar, unsigned x) {
    const unsigned G = gridDim.x * gridDim.y * gridDim.z;
    unsigned sum, cnt, mine, sp = 0u;
    for (;;) {
        sum = 0u; cnt = 0u; mine = 0u;
#pragma unroll
        for (unsigned j = 0; j < 16; ++j) { const unsigned c = xb_ld(&bar[XB_XCNT(j)]); sum += c; cnt += (c > 0u) ? 1u : 0u; mine = (j == x) ? c : mine; }
        if (sum == G) break;
        __builtin_amdgcn_s_sleep(1);
        if ((++sp & 255u) == 0u) { if (xb_ld(&bar[XB_TMO])) break; if (sp > XB_SPIN_CAP) { atomicAdd(&bar[XB_TMO], 1u); break; } }
    }
    const unsigned nloc = mine > 0u ? mine : 1u, nx = cnt > 0u ? cnt : 1u;
    return ((unsigned long long)nx << 32) | nloc;
}
__device__ __forceinline__ void xcd_barrier(const XcdBarrier& b) {
    asm volatile("s_waitcnt vmcnt(0)" ::: "memory");
    __syncthreads();
    if (threadIdx.x == 0) {
        unsigned* bar = b.bar;
        __builtin_amdgcn_s_waitcnt(0);
        unsigned nloc = b.st[0], nx = b.st[1];
        if (nloc == 0u) { const unsigned long long r = xcd_barrier_complete(bar, b.x); nloc = (unsigned)r; nx = (unsigned)(r >> 32); b.st[0] = nloc; b.st[1] = nx; }
        const unsigned old = xb_add(&bar[XB_XSUB(b.x)], 1u);
        const unsigned gen = old / nloc;
        if (old + 1u == (gen + 1u) * nloc) {
            __builtin_amdgcn_fence(__ATOMIC_RELEASE, "agent");
            asm volatile("s_waitcnt vmcnt(0)" ::: "memory");
            const unsigned og = xb_add(&bar[XB_TOP], 1u);
            const unsigned tg = og / nx;
            if (og + 1u == (tg + 1u) * nx) xb_add(&bar[XB_TOPGEN], 1u);
            else XB_SPIN(xb_ld(&bar[XB_TOPGEN]) == tg, bar);
            __builtin_amdgcn_fence(__ATOMIC_ACQUIRE, "agent");
            xb_add(&bar[XB_XGEN(b.x)], 1u);
            asm volatile("s_waitcnt vmcnt(0)" ::: "memory");
        } else {
            XB_SPIN(xb_ld(&bar[XB_XGEN(b.x)]) == gen, bar);
            __builtin_amdgcn_fence(__ATOMIC_ACQUIRE, "agent");
            asm volatile("s_waitcnt vmcnt(0)" ::: "memory");
        }
    }
    __syncthreads();
}

namespace g8 {
constexpr int BM = 256, BK = 64, HALF = 128, HTB = HALF * BK * 2;
__host__ __device__ __forceinline__ int lds_byte(int r, int c) { const int st = (r >> 4) * 2 + (c >> 5), rr = r & 15, cc = c & 31, ob = rr * 64 + cc * 2; return st * 1024 + (ob ^ (((ob >> 9) & 1) << 5)); }
__host__ __device__ __forceinline__ void stage_rc(int b, int& R, int& C) { const int st = b / 1024, sb = b % 1024, swz = sb ^ (((sb >> 9) & 1) << 5); R = (st >> 1) * 16 + swz / 64; C = (st & 1) * 32 + (swz % 64) / 2; }
__host__ __device__ __forceinline__ int perm32(int rho) { const int n = rho >> 4, i = rho & 15; return 8 * (i >> 2) + 4 * n + (i & 3); }

struct Unit { const char* a; const char* b; char* c; int pm, pn, aux; };
DI void tile_of(int L, int nM, int nN, int& pm, int& pn) {
    const int nig = 8 * nN, gid = L / nig, fm = gid * 8, gsz = (nM - fm) < 8 ? (nM - fm) : 8, w = L % nig;
    pm = fm + (w % gsz); pn = w / gsz;
}
struct AffineOrder {
    const char* A; const char* B; char* C; size_t aM, bB, bN, cM, cS, cN; int nM, nN, bdiv, csp, G, c0;
    DI bool next(int i, Unit& u) const {
        const int L = i * G + c0; if (L >= nM * nN) return false;
        int pm, pn; tile_of(L, nM, nN, pm, pn); u.pm = pm; u.pn = pn; u.aux = 0;
        u.a = A + (size_t)pm * aM; u.b = B + (size_t)(pm / bdiv) * bB + (size_t)pn * bN; u.c = C + (size_t)pm * cM + (size_t)(pn / csp) * cS + (size_t)(pn % csp) * cN; return true;
    }
};
DI AffineOrder dense_order(const void* A, const void* B, void* C, int M, int N, int K, int ldc_bytes, int esz, int G, int c0) {
    AffineOrder o; o.A = (const char*)A; o.B = (const char*)B; o.C = (char*)C; o.aM = 256ull * K * 2; o.bB = 0; o.bN = 256ull * K * 2; o.cM = 256ull * ldc_bytes; o.cS = 0; o.cN = 256ull * esz;
    o.nM = M / 256; o.nN = N / 256; o.bdiv = 1 << 30; o.csp = 1 << 30; o.G = G; o.c0 = c0; return o;
}

DI void lds_rd2x16(unsigned addr, f32x4& a, f32x4& b) { asm volatile("ds_read_b128 %0, %2\n\tds_read_b128 %1, %2 offset:16\n\ts_waitcnt lgkmcnt(0)" : "=&v"(a), "=&v"(b) : "v"(addr) : "memory"); }
struct EpiBf16 {
    static constexpr bool PERM = true;
    int ldc; const float* bias; int bias_stride; float scl;
    DI void issue(const Unit& u, LAS unsigned char* lds, int wid, int lane) const {
        if (bias) __builtin_amdgcn_global_load_lds((const unsigned*)(bias + (size_t)u.aux * bias_stride + u.pn * 256 + (lane >> 5) * HALF + (wid & 3) * 32 + (lane & 31)), (LAS unsigned*)(lds + LDS_X + wid * 256), 4, 0, 0);
    }
    DI void operator()(f32x4 (&acc)[2][2][4][2], const Unit& u, int wr, int wc, int fr, int fq, LAS unsigned char* lds) const {
        const int col0 = wc * 32 + 8 * fq; const float sc = (u.aux < 0) ? scl : 1.f;
        f32x4 bv[2][2];
#pragma unroll
        for (int bj = 0; bj < 2; ++bj) { if (bias) lds_rd2x16((unsigned)(size_t)lds + LDS_X + (wr * 4 + wc) * 256 + bj * 128 + fq * 32, bv[bj][0], bv[bj][1]); else { bv[bj][0] = (f32x4){0.f, 0.f, 0.f, 0.f}; bv[bj][1] = (f32x4){0.f, 0.f, 0.f, 0.f}; } }
#pragma unroll
        for (int ai = 0; ai < 2; ++ai)
#pragma unroll
            for (int m = 0; m < 4; ++m) { bf16* rowp = (bf16*)u.c + (size_t)(ai * HALF + wr * 64 + m * 16 + fr) * ldc + col0;
#pragma unroll
                for (int bj = 0; bj < 2; ++bj) { const f32x4 v0 = acc[ai][bj][m][0] * sc + bv[bj][0], v1 = acc[ai][bj][m][1] * sc + bv[bj][1];
                    u32x4 w; w.x = cvt_pk_bf16(v0[0], v0[1]); w.y = cvt_pk_bf16(v0[2], v0[3]); w.z = cvt_pk_bf16(v1[0], v1[1]); w.w = cvt_pk_bf16(v1[2], v1[3]);
                    *(u32x4*)(rowp + bj * HALF) = w; } }
    }
};
struct EpiSoftmax {
    static constexpr bool PERM = true;
    int ldc;
    DI void issue(const Unit&, LAS unsigned char*, int, int) const {}
    DI void operator()(f32x4 (&acc)[2][2][4][2], const Unit& u, int wr, int wc, int fr, int fq, LAS unsigned char* lds) const {
        LAS f32x2* X = (LAS f32x2*)(lds + LDS_X);
#pragma unroll
        for (int ai = 0; ai < 2; ++ai)
#pragma unroll
            for (int m = 0; m < 4; ++m) {
                float v = -3.0e38f;
#pragma unroll
                for (int bj = 0; bj < 2; ++bj)
#pragma unroll
                    for (int n = 0; n < 2; ++n) { const f32x4 x = acc[ai][bj][m][n]; v = fmaxf(v, fmaxf(fmaxf(x[0], x[1]), fmaxf(x[2], x[3]))); }
                v = fmaxf(v, __shfl_xor(v, 16)); v = fmaxf(v, __shfl_xor(v, 32));
                float s = 0.f;
#pragma unroll
                for (int bj = 0; bj < 2; ++bj)
#pragma unroll
                    for (int n = 0; n < 2; ++n) { f32x4 x = acc[ai][bj][m][n]; x[0] = __expf(x[0] - v); x[1] = __expf(x[1] - v); x[2] = __expf(x[2] - v); x[3] = __expf(x[3] - v); acc[ai][bj][m][n] = x; s += (x[0] + x[1]) + (x[2] + x[3]); }
                s += __shfl_xor(s, 16); s += __shfl_xor(s, 32);
                if (fq == 0) X[(ai * HALF + wr * 64 + m * 16 + fr) * 4 + wc] = (f32x2){v, s};
            }
        LDS_WAIT(); __builtin_amdgcn_s_barrier(); asm volatile("" ::: "memory");
        const int col0 = wc * 32 + 8 * fq;
#pragma unroll
        for (int ai = 0; ai < 2; ++ai)
#pragma unroll
            for (int m = 0; m < 4; ++m) {
                const int r = ai * HALF + wr * 64 + m * 16 + fr;
                const f32x4 p01 = *(const LAS f32x4*)(X + r * 4), p23 = *(const LAS f32x4*)(X + r * 4 + 2);
                const float M = fmaxf(fmaxf(p01[0], p01[2]), fmaxf(p23[0], p23[2]));
                const float S = p01[1] * __expf(p01[0] - M) + p01[3] * __expf(p01[2] - M) + p23[1] * __expf(p23[0] - M) + p23[3] * __expf(p23[2] - M);
                const float f = __expf(X[r * 4 + wc][0] - M) * __builtin_amdgcn_rcpf(S);
                bf16* rowp = (bf16*)u.c + (size_t)r * ldc + col0;
#pragma unroll
                for (int bj = 0; bj < 2; ++bj) { const f32x4 v0 = acc[ai][bj][m][0] * f, v1 = acc[ai][bj][m][1] * f;
                    u32x4 w; w.x = cvt_pk_bf16(v0[0], v0[1]); w.y = cvt_pk_bf16(v0[2], v0[3]); w.z = cvt_pk_bf16(v1[0], v1[1]); w.w = cvt_pk_bf16(v1[2], v1[3]);
                    *(u32x4*)(rowp + bj * HALF) = w; }
                asm volatile("" ::: "memory");
            }
    }
};
struct EpiSwiglu {
    static constexpr bool PERM = true;
    const float* bgu;
    DI void issue(const Unit& u, LAS unsigned char* lds, int wid, int lane) const {
        __builtin_amdgcn_global_load_lds((const unsigned*)(bgu + (size_t)u.aux * 2048 + (lane >> 5) * 1024 + u.pn * 128 + (wid & 3) * 32 + (lane & 31)), (LAS unsigned*)(lds + LDS_X + wid * 256), 4, 0, 0);
    }
    DI void operator()(f32x4 (&acc)[2][2][4][2], const Unit& u, int wr, int wc, int fr, int fq, LAS unsigned char* lds) const {
        f32x4 bg[2], bl[2];
        lds_rd2x16((unsigned)(size_t)lds + LDS_X + (wr * 4 + wc) * 256 + fq * 32, bg[0], bg[1]);
        lds_rd2x16((unsigned)(size_t)lds + LDS_X + (wr * 4 + wc) * 256 + 128 + fq * 32, bl[0], bl[1]);
#pragma unroll
        for (int ai = 0; ai < 2; ++ai)
#pragma unroll
            for (int m = 0; m < 4; ++m) {
                float o[8];
#pragma unroll
                for (int n = 0; n < 2; ++n)
#pragma unroll
                    for (int j = 0; j < 4; ++j) {
                        const float glu = fminf(acc[ai][0][m][n][j] + bg[n][j], 7.0f);
                        const float lin = fminf(fmaxf(acc[ai][1][m][n][j] + bl[n][j], -7.0f), 7.0f);
                        o[4 * n + j] = (lin + 1.0f) * glu * sigmoidf_(1.702f * glu);
                    }
                u32x4 w; w.x = cvt_pk_bf16(o[0], o[1]); w.y = cvt_pk_bf16(o[2], o[3]); w.z = cvt_pk_bf16(o[4], o[5]); w.w = cvt_pk_bf16(o[6], o[7]);
                *(u32x4*)((bf16*)u.c + (size_t)(ai * HALF + wr * 64 + m * 16 + fr) * 1024 + wc * 32 + 8 * fq) = w;
            }
    }
};

template <class Epi, class Sched, bool GATHER = false>
__device__ __forceinline__ void gemm_phase(LAS unsigned char* lds, const int lda, const int ldb, const int nt, const Sched& S, const Epi& E, const unsigned* rowtab = nullptr) {
    int tid = threadIdx.x; asm volatile("" : "+v"(tid));
    const int wid = __builtin_amdgcn_readfirstlane(tid >> 6), lane = tid & 63, wr = wid >> 2, wc = wid & 3, fr = lane & 15, fq = lane >> 4;
    unsigned voffA[2], voffB[2];
#pragma unroll
    for (int i = 0; i < 2; ++i) { int R, C; stage_rc(tid * 16 + i * 8192, R, C); const int Rb = Epi::PERM ? ((R & ~31) + perm32(R & 31)) : R;
        voffA[i] = GATHER ? 0u : (unsigned)(R * lda + C * 2); voffB[i] = (unsigned)(Rb * ldb + C * 2); }
    unsigned gc[2][2] = {{0u, 0u}, {0u, 0u}}, gn[2][2] = {{0u, 0u}, {0u, 0u}};
#define PG8_GLOAD(dst, pm_) do { int _t = tid; asm volatile("" : "+v"(_t)); _Pragma("unroll") for (int _i = 0; _i < 2; ++_i) { int _R, _C; stage_rc(_t * 16 + _i * 8192, _R, _C); \
        _Pragma("unroll") for (int _h = 0; _h < 2; ++_h) dst[_h][_i] = __hip_atomic_load(rowtab + (size_t)(pm_) * 256 + _h * 128 + _R, __ATOMIC_RELAXED, __HIP_MEMORY_SCOPE_AGENT) * (unsigned)lda + (unsigned)(_C * 2); } } while (0)
    const size_t kstep = (size_t)(BK * 2);
    const size_t hstepA = (size_t)HALF * lda, hstepB = (size_t)HALF * ldb;
    const unsigned ldsw = (unsigned)wid * 1024u;
    const int aoff = lds_byte(wr * 64 + fr, fq * 8), boff = lds_byte(wc * 32 + fr, fq * 8);
#define PG8_SA(b, h) (((b) * 2 + (h)) * HTB)
#define PG8_SB(b, h) ((4 + (b) * 2 + (h)) * HTB)
#define PG8_STAGE(bufoff, gbase, voff) do { _Pragma("unroll") for (int _i = 0; _i < 2; ++_i) \
        __builtin_amdgcn_global_load_lds((const unsigned*)((const char*)(gbase) + (voff)[_i]), (LAS unsigned*)(lds + (bufoff) + ldsw + _i * 8192), 16, 0, 0); } while (0)
#define PG8_STAGE_A(bufoff, gbase, hh, nx) do { if (GATHER) { _Pragma("unroll") for (int _i = 0; _i < 2; ++_i) \
        __builtin_amdgcn_global_load_lds((const unsigned*)((const char*)(gbase) + ((nx) ? gn[hh][_i] : gc[hh][_i])), (LAS unsigned*)(lds + (bufoff) + ldsw + _i * 8192), 16, 0, 0); } \
        else PG8_STAGE(bufoff, (gbase) + (hh) * hstepA, voffA); } while (0)
#define PG8_LDA(dst, b, h) do { _Pragma("unroll") for (int m = 0; m < 4; ++m) _Pragma("unroll") for (int k = 0; k < 2; ++k) dst[m][k] = *(const LAS bf16x8*)(lds + PG8_SA(b, h) + aoff + m * 2048 + k * 1024); } while (0)
#define PG8_LDB(dst, b, h) do { _Pragma("unroll") for (int n = 0; n < 2; ++n) _Pragma("unroll") for (int k = 0; k < 2; ++k) dst[n][k] = *(const LAS bf16x8*)(lds + PG8_SB(b, h) + boff + n * 2048 + k * 1024); } while (0)
#define PG8_MMA(ai, bj, At, Bt) do { __builtin_amdgcn_s_setprio(1); _Pragma("unroll") for (int m = 0; m < 4; ++m) _Pragma("unroll") for (int n = 0; n < 2; ++n) _Pragma("unroll") for (int k = 0; k < 2; ++k) \
        acc[ai][bj][m][n] = __builtin_amdgcn_mfma_f32_16x16x32_bf16(Bt[n][k], At[m][k], acc[ai][bj][m][n], 0, 0, 0); __builtin_amdgcn_s_setprio(0); } while (0)
#define PG8_WAIT_V(n) asm volatile("s_waitcnt vmcnt(" #n ")" ::: "memory")
#define PG8_WAIT_L(n) asm volatile("s_waitcnt lgkmcnt(" #n ")" ::: "memory")
#define PG8_BAR __builtin_amdgcn_s_barrier()
#define PG8_SCHED __builtin_amdgcn_sched_barrier(0)
    Unit cur, nxt; int ui = 0;
    if (!S.next(0, cur)) return;
    f32x4 acc[2][2][4][2];
#pragma unroll
    for (int a = 0; a < 2; ++a)
#pragma unroll
        for (int b = 0; b < 2; ++b)
#pragma unroll
            for (int m = 0; m < 4; ++m)
#pragma unroll
                for (int n = 0; n < 2; ++n) acc[a][b][m][n] = (f32x4){0.f, 0.f, 0.f, 0.f};
    bf16x8 At[4][2], B0[2][2], B1[2][2];
    const char* cA = cur.a; const char* cB = cur.b;
    if (GATHER) { PG8_GLOAD(gc, cur.pm); }
    PG8_STAGE(PG8_SB(0, 0), cB, voffB); PG8_STAGE(PG8_SB(0, 1), cB + hstepB, voffB); PG8_STAGE_A(PG8_SA(0, 0), cA, 0, false); PG8_STAGE_A(PG8_SA(0, 1), cA, 1, false);
    if (wr == 1) PG8_BAR;
    PG8_WAIT_V(2); PG8_BAR;
    PG8_STAGE(PG8_SB(1, 0), cB + kstep, voffB); PG8_STAGE_A(PG8_SA(1, 0), cA + kstep, 0, false); PG8_STAGE(PG8_SB(1, 1), cB + hstepB + kstep, voffB);
    PG8_WAIT_V(6); PG8_BAR;
    for (;;) {
        const bool has_next = S.next(ui + 1, nxt);
        const char* nA = has_next ? nxt.a : cA; const char* nB = has_next ? nxt.b : cB;
        if (GATHER) { if (has_next) { PG8_GLOAD(gn, nxt.pm); } else { _Pragma("unroll") for (int _h = 0; _h < 2; ++_h) { gn[_h][0] = gc[_h][0]; gn[_h][1] = gc[_h][1]; } } }
#pragma unroll 1
        for (int t = 0; t < nt; t += 2) {
            const bool last = (t == nt - 2);
            const char* a1 = cA + (size_t)(t + 1) * kstep;
            const char* a2 = last ? nA : cA + (size_t)(t + 2) * kstep; const char* b2 = last ? nB : cB + (size_t)(t + 2) * kstep;
            const char* a3 = a2 + kstep; const char* b3 = b2 + kstep;
            PG8_LDB(B0, 0, 0); PG8_LDB(B1, 0, 1); PG8_SCHED; PG8_LDA(At, 0, 0); PG8_STAGE_A(PG8_SA(1, 1), a1, 1, false);
            if (t == 0) E.issue(cur, lds, wid, lane);
            PG8_WAIT_V(8); PG8_WAIT_L(0); PG8_BAR; PG8_MMA(0, 0, At, B0); PG8_MMA(0, 1, At, B1); PG8_BAR; PG8_SCHED;
            PG8_LDA(At, 0, 1); PG8_STAGE(PG8_SB(0, 0), b2, voffB); PG8_STAGE(PG8_SB(0, 1), b2 + hstepB, voffB); PG8_STAGE_A(PG8_SA(0, 0), a2, 0, last);
            PG8_WAIT_V(8); PG8_WAIT_L(0); PG8_BAR; PG8_MMA(1, 0, At, B0); PG8_MMA(1, 1, At, B1); PG8_BAR; PG8_SCHED;
            PG8_LDB(B0, 1, 0); PG8_LDB(B1, 1, 1); PG8_SCHED; PG8_LDA(At, 1, 0); PG8_STAGE_A(PG8_SA(0, 1), a2, 1, last);
            PG8_WAIT_V(8); PG8_WAIT_L(0); PG8_BAR; PG8_MMA(0, 0, At, B0); PG8_MMA(0, 1, At, B1); PG8_BAR; PG8_SCHED;
            PG8_LDA(At, 1, 1); PG8_STAGE(PG8_SB(1, 0), b3, voffB); PG8_STAGE(PG8_SB(1, 1), b3 + hstepB, voffB); PG8_STAGE_A(PG8_SA(1, 0), a3, 0, last);
            PG8_WAIT_V(8); PG8_WAIT_L(0); PG8_BAR; PG8_MMA(1, 0, At, B0); PG8_MMA(1, 1, At, B1); PG8_BAR; PG8_SCHED;
        }
        if (wr == 0) PG8_BAR;
        { int fr_e = fr, fq_e = fq; asm volatile("" : "+v"(fr_e), "+v"(fq_e)); E(acc, cur, wr, wc, fr_e, fq_e, lds); }
        if (!has_next) break;
#pragma unroll
        for (int a = 0; a < 2; ++a)
#pragma unroll
            for (int b = 0; b < 2; ++b)
#pragma unroll
                for (int m = 0; m < 4; ++m)
#pragma unroll
                    for (int n = 0; n < 2; ++n) acc[a][b][m][n] = (f32x4){0.f, 0.f, 0.f, 0.f};
        cur = nxt; cA = nA; cB = nB; ++ui;
        if (GATHER) { _Pragma("unroll") for (int _h = 0; _h < 2; ++_h) { gc[_h][0] = gn[_h][0]; gc[_h][1] = gn[_h][1]; } }
        if (wr == 1) PG8_BAR;
    }
    PG8_WAIT_V(0);
    PG8_BAR;
#undef PG8_SA
#undef PG8_SB
#undef PG8_STAGE
#undef PG8_LDA
#undef PG8_STAGE_A
#undef PG8_GLOAD
#undef PG8_LDB
#undef PG8_MMA
#undef PG8_WAIT_V
#undef PG8_WAIT_L
#undef PG8_BAR
#undef PG8_SCHED
}
}

struct Args { const float* in[27]; float* out; unsigned char* ws; int ph_lo, ph_hi; };
struct Ctx {
    LAS unsigned char* lds; unsigned char* ws; unsigned* ctl;
    int tid, lane, wave, vcu, G;
};
constexpr int LDS_PTAB = LDS_MISC + 1024;
DI void refresh(Ctx& F, unsigned char* wsb) { int t = threadIdx.x; asm volatile("" : "+v"(t)); F.tid = t; F.lane = t & 63; F.wave = __builtin_amdgcn_readfirstlane(t >> 6);
    unsigned lo = (unsigned)(unsigned long long)wsb, hi = (unsigned)((unsigned long long)wsb >> 32); asm volatile("" : "+v"(lo), "+v"(hi));
    lo = __builtin_amdgcn_readfirstlane(lo); hi = __builtin_amdgcn_readfirstlane(hi); F.ws = (unsigned char*)(GAS unsigned char*)(((unsigned long long)hi << 32) | lo); F.ctl = (unsigned*)F.ws;
    int bx = blockIdx.x; asm volatile("" : "+v"(bx)); bx = __builtin_amdgcn_readfirstlane(bx); F.G = 256; F.vcu = (bx & 7) * 32 + (bx >> 3);
    unsigned zb = 0u; asm volatile("" : "+v"(zb)); F.lds = (LAS unsigned char*)(unsigned)__builtin_amdgcn_readfirstlane(zb); }
DI const float* inp(const Ctx& F, int i) {
    const LAS unsigned* p = (const LAS unsigned*)(F.lds + LDS_PTAB) + 2 * i; const unsigned lo = __builtin_amdgcn_readfirstlane(p[0]), hi = __builtin_amdgcn_readfirstlane(p[1]);
    return (const float*)(GAS const float*)(((unsigned long long)hi << 32) | lo);
}
DI unsigned ldu(const unsigned* p) { return __hip_atomic_load(p, __ATOMIC_RELAXED, __HIP_MEMORY_SCOPE_AGENT); }
DI float ldf(const float* p) { return __uint_as_float(__hip_atomic_load((const unsigned*)p, __ATOMIC_RELAXED, __HIP_MEMORY_SCOPE_AGENT)); }

template <int MAP> DI int map_row(int n) {
    if (MAP == 0) return n;
    if (MAP == 1) return n < 1536 ? n : (n < 1544 ? -1 : (n < 3592 ? n - 8 : -1));
    return 256 * ((n & 1023) >> 7) + 128 * (n >> 10) + (n & 127);
}
template <int MAP> DI void tr_item(const float* W, int K, int N, bf16* WT, LAS float* scr, int item, int lane) {
    const int nblk = (N + 31) / 32, kb = item / nblk, nb = item % nblk, k0 = 64 * kb, n0 = 32 * nb;
    const int c4 = 4 * (lane & 7), nl = n0 + c4;
    f32x4 ld[8];
#pragma unroll
    for (int i = 0; i < 8; ++i) { const int kk = 8 * i + (lane >> 3); ld[i] = nl < N ? *(const f32x4*)(W + (size_t)(k0 + kk) * N + nl) : (f32x4){0.f, 0.f, 0.f, 0.f}; }
#pragma unroll
    for (int i = 0; i < 8; ++i) { const int kk = 8 * i + (lane >> 3); LAS float* d = scr + kk * 33 + c4; d[0] = ld[i][0]; d[1] = ld[i][1]; d[2] = ld[i][2]; d[3] = ld[i][3]; }
    LDS_WAIT(); asm volatile("" ::: "memory");
    const int c = lane & 7;
#pragma unroll
    for (int j = 0; j < 4; ++j) { const int nn = (lane >> 3) + 8 * j; const int n = n0 + nn; const LAS float* s = scr + (8 * c) * 33 + nn;
        const int dr = n < N ? map_row<MAP>(n) : -1;
        u32x4 o; o.x = cvt_pk_bf16(s[0 * 33], s[1 * 33]); o.y = cvt_pk_bf16(s[2 * 33], s[3 * 33]); o.z = cvt_pk_bf16(s[4 * 33], s[5 * 33]); o.w = cvt_pk_bf16(s[6 * 33], s[7 * 33]);
        if (dr >= 0) *(u32x4*)(WT + (size_t)dr * K + k0 + 8 * c) = o; }
    LDS_WAIT(); asm volatile("" ::: "memory");
}
DI void phase_convert(Ctx& F, const Args& a) {
    LAS float* scr = (LAS float*)(F.lds + F.wave * 16384);
    const int gw = F.vcu * NWAVES + F.wave, NGW = F.G * NWAVES;
    constexpr int I_WIN = 16 * 113, I_SQ = 16 * 32, I_GU = 16 * 64;
    constexpr int E0 = 4 * I_WIN, E1 = E0 + 4 * I_SQ, E2 = E1 + 4 * I_SQ, E3 = E2 + 4 * I_SQ, E4 = E3 + 4 * I_SQ, E5 = E4 + 128 * I_GU, E6 = E5 + 128 * I_SQ;
    for (int it = gw; it < E6; it += NGW) {
        if (it < E0) { const int l = it / I_WIN, r = it % I_WIN; tr_item<1>(inp(F, 2) + (size_t)l * D * 3600, D, 3600, (bf16*)(F.ws + WS_WIN) + (size_t)l * NPROJ * D, scr, r, F.lane); }
        else if (it < E1) { const int q = it - E0, l = q / I_SQ, r = q % I_SQ; tr_item<0>(inp(F, 10) + (size_t)l * D * D, D, D, (bf16*)(F.ws + WS_WOUT) + (size_t)l * D * D, scr, r, F.lane); }
        else if (it < E2) { const int q = it - E1, l = q / I_SQ, r = q % I_SQ; tr_item<0>(inp(F, 14) + (size_t)l * D * D, D, D, (bf16*)(F.ws + WS_WKV) + (size_t)(2 * l) * D * D, scr, r, F.lane); }
        else if (it < E3) { const int q = it - E2, l = q / I_SQ, r = q % I_SQ; tr_item<0>(inp(F, 15) + (size_t)l * D * D, D, D, (bf16*)(F.ws + WS_WKV) + (size_t)(2 * l + 1) * D * D, scr, r, F.lane); }
        else if (it < E4) { const int q = it - E3, l = q / I_SQ, r = q % I_SQ; tr_item<0>(inp(F, 16) + (size_t)l * D * D, D, D, (bf16*)(F.ws + WS_WO) + (size_t)l * D * D, scr, r, F.lane); }
        else if (it < E5) { const int q = it - E4, le = q / I_GU, r = q % I_GU; tr_item<2>(inp(F, 21) + (size_t)le * D * 2048, D, 2048, (bf16*)(F.ws + WS_WGU) + (size_t)le * 2048 * D, scr, r, F.lane); }
        else { const int q = it - E5, le = q / I_SQ, r = q % I_SQ; tr_item<0>(inp(F, 23) + (size_t)le * D * D, D, D, (bf16*)(F.ws + WS_WDN) + (size_t)le * D * D, scr, r, F.lane); }
    }
    const size_t gt = (size_t)blockIdx.x * NTHREADS + F.tid, NGT = (size_t)F.G * NTHREADS;
    for (size_t i = gt; i < (4ull * D * D + 2048ull * D) / 8; i += NGT) {
        const bool isq = i < 4ull * D * D / 8; const size_t j = isq ? i : i - 4ull * D * D / 8;
        const float* src = (isq ? inp(F, 13) : inp(F, 1)) + j * 8; bf16* dst = (bf16*)(F.ws + (isq ? WS_WQ : WS_MEMB)) + j * 8;
        const f32x4 v0 = *(const f32x4*)src, v1 = *(const f32x4*)(src + 4);
        u32x4 o; o.x = cvt_pk_bf16(v0[0], v0[1]); o.y = cvt_pk_bf16(v0[2], v0[3]); o.z = cvt_pk_bf16(v1[0], v1[1]); o.w = cvt_pk_bf16(v1[2], v1[3]);
        *(u32x4*)dst = o;
    }
    for (size_t i = gt; i < 4ull * 48 * D; i += NGT) {
        const int l = (int)(i / (48 * D)), r = (int)(i % (48 * D)), j = r / D, k = r % D;
        float w; bf16* dh; bf16* dl;
        if (j < 16) { const int col = j < 8 ? 1536 + j : 3592 + (j - 8); w = inp(F, 2)[((size_t)l * D + k) * 3600 + col];
            dh = (bf16*)(F.ws + WS_WGATE) + ((size_t)(l * 2 + 0) * 16 + j) * D + k; dl = dh + 16 * D; }
        else { const int e = j - 16; w = inp(F, 19)[((size_t)l * D + k) * 32 + e];
            dh = (bf16*)(F.ws + WS_WRT) + ((size_t)(l * 2 + 0) * 32 + e) * D + k; dl = dh + 32 * D; }
        const bf16 h = f2bf(w); *dh = h; *dl = f2bf(w - bf2f(h));
    }
}

DI void unpack8(const u32x4 w, float* v) { v[0] = bflo(w.x); v[1] = bfhi(w.x); v[2] = bflo(w.y); v[3] = bfhi(w.y); v[4] = bflo(w.z); v[5] = bfhi(w.z); v[6] = bflo(w.w); v[7] = bfhi(w.w); }
DI u32x4 pack8(const float* v) { u32x4 o; o.x = cvt_pk_bf16(v[0], v[1]); o.y = cvt_pk_bf16(v[2], v[3]); o.z = cvt_pk_bf16(v[4], v[5]); o.w = cvt_pk_bf16(v[6], v[7]); return o; }
#define PROF_RP(k) do { if (MODE == 2 && ((PROF_MASK) >> 23)) { if (blockIdx.x == 0 && threadIdx.x == 0) { volatile LAS unsigned long long* pw = (volatile LAS unsigned long long*)(F.lds + LDS_MISC + 128); \
        const unsigned long long now_ = __builtin_amdgcn_s_memrealtime(); if ((k) >= 0 && (((PROF_MASK) >> (23 + (k))) & 1)) pw[1] += now_ - pw[3]; pw[3] = now_; } } } while (0)
DI void ld2x16_sc1(const void* p0, const void* p1, u32x4& a, u32x4& b) {
    asm volatile("global_load_dwordx4 %0, %2, off sc0 sc1\n\tglobal_load_dwordx4 %1, %3, off sc0 sc1\n\ts_waitcnt vmcnt(0)" : "=&v"(a), "=&v"(b) : "v"(p0), "v"(p1) : "memory");
}
template <int MODE> DI void row_pass(Ctx& F, const Args& a, int l, const bool dummy = false) {
    const int lane = F.lane, r0 = (F.vcu * NWAVES + F.wave) * 16;
    bf16* XB = (bf16*)(F.ws + WS_XB); bf16* XBo = dummy ? (bf16*)(F.ws + WS_XG + 16 * MiB) : XB; const bf16* HB = (const bf16*)(F.ws + WS_HB); const bf16* Y = (const bf16*)(F.ws + WS_Y);
    const int c0 = 8 * lane, c1 = 512 + 8 * lane;
    LAS unsigned* ecnt = (LAS unsigned*)(F.lds + LDS_MISC + 256);
    if (MODE == 2) { if (F.tid < 64 && !dummy) ecnt[F.tid] = 0u; __syncthreads(); }
    PROF_RP(-1);
    constexpr int N16 = (MODE == 2) ? 2 : 1, NN = 16 * N16, NBLK = 32 * N16 * 2;
    const bool has_tail = !(MODE == 1 || (MODE == 3 && l == NL - 1));
    const bf16* Wb = (MODE == 2) ? (const bf16*)(F.ws + WS_WRT) + (size_t)l * 2 * 32 * D : (const bf16*)(F.ws + WS_WGATE) + (size_t)(MODE == 0 ? 0 : (l + 1 < NL ? l + 1 : 0)) * 2 * 16 * D;
    if (has_tail) {
#pragma unroll
        for (int q = 0; q < NBLK / 8; ++q) { const int blk = F.wave * (NBLK / 8) + q, ks = blk / (2 * N16), n = (blk >> 1) % N16, hl = blk & 1;
            __builtin_amdgcn_global_load_lds((const unsigned*)(Wb + (size_t)(hl * NN + n * 16 + (lane & 15)) * D + 32 * ks + 8 * (lane >> 4)), (LAS unsigned*)(F.lds + blk * 1024), 16, 0, 0); }
    }
    float g[16], bb[16];
    if (MODE >= 1) {
        const float* gp = inp(F, MODE == 1 ? 11 : (MODE == 2 ? 17 : 25)) + (size_t)l * D; const float* bp = inp(F, MODE == 1 ? 12 : (MODE == 2 ? 18 : 26)) + (size_t)l * D;
#pragma unroll
        for (int q = 0; q < 2; ++q) { const int c = q ? c1 : c0;
            const f32x4 g0 = *(const f32x4*)(gp + c), g1 = *(const f32x4*)(gp + c + 4), b0 = *(const f32x4*)(bp + c), b1 = *(const f32x4*)(bp + c + 4);
#pragma unroll
            for (int j = 0; j < 4; ++j) { g[8 * q + j] = g0[j]; g[8 * q + 4 + j] = g1[j]; bb[8 * q + j] = b0[j]; bb[8 * q + 4 + j] = b1[j]; } }
    }
    constexpr int RB = (MODE == 3) ? 2 : 4;
#pragma unroll 1
    for (int i0 = 0; i0 < 16; i0 += RB) {
        float v[RB][16];
        if (MODE == 0) {
            f32x4 xi[RB][4];
#pragma unroll
            for (int q = 0; q < RB; ++q) { const float* xr = inp(F, 0) + (size_t)(r0 + i0 + q) * D;
                xi[q][0] = *(const f32x4*)(xr + c0); xi[q][1] = *(const f32x4*)(xr + c0 + 4); xi[q][2] = *(const f32x4*)(xr + c1); xi[q][3] = *(const f32x4*)(xr + c1 + 4); }
#pragma unroll
            for (int q = 0; q < RB; ++q)
#pragma unroll
                for (int j = 0; j < 4; ++j) { v[q][j] = xi[q][0][j]; v[q][4 + j] = xi[q][1][j]; v[q][8 + j] = xi[q][2][j]; v[q][12 + j] = xi[q][3][j]; }
        } else {
            u32x4 xr[RB][2];
#pragma unroll
            for (int q = 0; q < RB; ++q) { xr[q][0] = *(const u32x4*)(XB + (size_t)(r0 + i0 + q) * D + c0); xr[q][1] = *(const u32x4*)(XB + (size_t)(r0 + i0 + q) * D + c1); }
            if (MODE == 3) {
                int slv = 0; float gkv = 0.f;
                if (lane < 4 * RB) { slv = (int)ldu((const unsigned*)(F.ws + WS_SLOT) + (size_t)(r0 + i0) * 4 + lane); gkv = ldf((const float*)(F.ws + WS_TOPG) + (size_t)(r0 + i0) * 4 + lane); }
                u32x4 yr[RB][4][2]; float gk[RB][4];
#pragma unroll
                for (int q = 0; q < RB; ++q)
#pragma unroll
                    for (int k = 0; k < 4; ++k) { const int sl = __shfl(slv, q * 4 + k); gk[q][k] = __shfl(gkv, q * 4 + k);
                        yr[q][k][0] = *(const u32x4*)(Y + (size_t)sl * D + c0); yr[q][k][1] = *(const u32x4*)(Y + (size_t)sl * D + c1); }
#pragma unroll
                for (int q = 0; q < RB; ++q) { float xv[16]; unpack8(xr[q][0], xv); unpack8(xr[q][1], xv + 8);
#pragma unroll
                    for (int j = 0; j < 16; ++j) v[q][j] = DN_ALPHA * xv[j];
#pragma unroll
                    for (int k = 0; k < 4; ++k) { float yv[16]; unpack8(yr[q][k][0], yv); unpack8(yr[q][k][1], yv + 8);
#pragma unroll
                        for (int j = 0; j < 16; ++j) v[q][j] += gk[q][k] * yv[j]; } }
            } else {
                u32x4 hr[RB][2];
#pragma unroll
                for (int q = 0; q < RB; ++q) { hr[q][0] = *(const u32x4*)(HB + (size_t)(r0 + i0 + q) * D + c0); hr[q][1] = *(const u32x4*)(HB + (size_t)(r0 + i0 + q) * D + c1); }
#pragma unroll
                for (int q = 0; q < RB; ++q) { float xv[16], hv[16]; unpack8(xr[q][0], xv); unpack8(xr[q][1], xv + 8); unpack8(hr[q][0], hv); unpack8(hr[q][1], hv + 8);
#pragma unroll
                    for (int j = 0; j < 16; ++j) v[q][j] = DN_ALPHA * xv[j] + hv[j]; }
            }
            float sm[RB];
#pragma unroll
            for (int q = 0; q < RB; ++q) { float t = 0.f;
#pragma unroll
                for (int j = 0; j < 16; ++j) t += v[q][j];
                sm[q] = t; }
#pragma unroll
            for (int o = 1; o < 64; o <<= 1)
#pragma unroll
                for (int q = 0; q < RB; ++q) sm[q] += __shfl_xor(sm[q], o);
            float sq[RB];
#pragma unroll
            for (int q = 0; q < RB; ++q) { const float mean = sm[q] * (1.f / D); float t = 0.f;
#pragma unroll
                for (int j = 0; j < 16; ++j) { v[q][j] -= mean; t += v[q][j] * v[q][j]; }
                sq[q] = t; }
#pragma unroll
            for (int o = 1; o < 64; o <<= 1)
#pragma unroll
                for (int q = 0; q < RB; ++q) sq[q] += __shfl_xor(sq[q], o);
#pragma unroll
            for (int q = 0; q < RB; ++q) { const float rstd = rsqrtf(sq[q] * (1.f / D) + 1e-5f);
#pragma unroll
                for (int j = 0; j < 16; ++j) v[q][j] = v[q][j] * rstd * g[j] + bb[j]; }
        }
#pragma unroll
        for (int q = 0; q < RB; ++q) { const int r = r0 + i0 + q;
            if (MODE == 3 && l == NL - 1) {
                float* orow = (float*)inp(F, 27) + (size_t)r * D;
                *(f32x4*)(orow + c0) = (f32x4){v[q][0], v[q][1], v[q][2], v[q][3]}; *(f32x4*)(orow + c0 + 4) = (f32x4){v[q][4], v[q][5], v[q][6], v[q][7]};
                *(f32x4*)(orow + c1) = (f32x4){v[q][8], v[q][9], v[q][10], v[q][11]}; *(f32x4*)(orow + c1 + 4) = (f32x4){v[q][12], v[q][13], v[q][14], v[q][15]};
            } else {
                *(u32x4*)(XBo + (size_t)r * D + c0) = pack8(v[q]); *(u32x4*)(XBo + (size_t)r * D + c1) = pack8(v[q] + 8);
            } }
    }
    if (MODE == 1 || (MODE == 3 && l == NL - 1)) return;
#ifdef DBG_NOROUTER
    if (MODE == 2) return;
#endif
    VM_WAIT(); __syncthreads(); PROF_RP(0); asm volatile("" ::: "memory");
    const bf16* arow = XBo + (size_t)(r0 + (lane & 15)) * D + 8 * (lane >> 4);
    f32x4 acc[N16];
#pragma unroll
    for (int n = 0; n < N16; ++n) acc[n] = (f32x4){0.f, 0.f, 0.f, 0.f};
#pragma unroll 8
    for (int ks = 0; ks < 32; ++ks) {
        const bf16x8 af = *(const bf16x8*)(arow + 32 * ks);
#pragma unroll
        for (int n = 0; n < N16; ++n) {
            const bf16x8 bh = *(const LAS bf16x8*)(F.lds + ((ks * N16 + n) * 2 + 0) * 1024 + lane * 16), bl = *(const LAS bf16x8*)(F.lds + ((ks * N16 + n) * 2 + 1) * 1024 + lane * 16);
            acc[n] = MFMA16(af, bh, acc[n]); acc[n] = MFMA16(af, bl, acc[n]);
        }
    }
    if (MODE != 2) {
        float* G = dummy ? (float*)(F.ws + WS_XG + 160 * MiB) : (float*)(F.ws + WS_GATES);
#pragma unroll
        for (int i = 0; i < 4; ++i) G[(size_t)(r0 + 4 * (lane >> 4) + i) * 16 + (lane & 15)] = acc[0][i];
        return;
    }
    if (MODE == 2) {
        if ((PROF_MASK) >> 23) __syncthreads(); PROF_RP(1);
        LAS float* LG = (LAS float*)(F.lds + 131072 + F.wave * 2176);
#pragma unroll
        for (int n = 0; n < N16; ++n)
#pragma unroll
            for (int i = 0; i < 4; ++i) LG[(4 * (lane >> 4) + i) * 33 + n * 16 + (lane & 15)] = acc[n][i];
        LDS_WAIT(); asm volatile("" ::: "memory");
        int te[4] = {0, 0, 0, 0}; float tv[4] = {0.f, 0.f, 0.f, 0.f}; unsigned rk[4] = {0u, 0u, 0u, 0u};
        if (lane < 16) {
            float lg[32]; const float* rb = inp(F, 20) + (size_t)l * 32;
#pragma unroll
            for (int e = 0; e < 32; ++e) lg[e] = LG[lane * 33 + e] + rb[e];
#pragma unroll
            for (int k = 0; k < 4; ++k) {
                float best = -3.0e38f; int bi = 0;
#pragma unroll
                for (int e = 0; e < 32; ++e) { const bool gt = lg[e] > best; best = gt ? lg[e] : best; bi = gt ? e : bi; }
                te[k] = bi; tv[k] = best;
#pragma unroll
                for (int e = 0; e < 32; ++e) lg[e] = (e == bi) ? -3.0e38f : lg[e];
            }
            const float e1 = __expf(tv[1] - tv[0]), e2 = __expf(tv[2] - tv[0]), e3 = __expf(tv[3] - tv[0]); const float inv = 1.f / (1.f + e1 + e2 + e3);
            tv[0] = inv; tv[1] = e1 * inv; tv[2] = e2 * inv; tv[3] = e3 * inv;
#pragma unroll
            for (int k = 0; k < 4; ++k) rk[k] = __hip_atomic_fetch_add(ecnt + (dummy ? 40 : 0) + te[k], 1u, __ATOMIC_RELAXED, __HIP_MEMORY_SCOPE_WORKGROUP);
        }
        __syncthreads(); PROF_RP(2);
        if (F.tid < 32 && !dummy) ecnt[32 + F.tid] = __hip_atomic_fetch_add(F.ctl + CW_ECNT + (l * 32 + F.tid) * 64, ecnt[F.tid], __ATOMIC_RELAXED, __HIP_MEMORY_SCOPE_AGENT);
        __syncthreads();
        if (lane < 16 && !dummy) {
            const int r = r0 + lane; int* pe = (int*)(F.ws + WS_TOPE) + (size_t)r * 4; int* pp = (int*)(F.ws + WS_TOPP) + (size_t)r * 4; float* pg = (float*)(F.ws + WS_TOPG) + (size_t)r * 4;
#pragma unroll
            for (int k = 0; k < 4; ++k) { pe[k] = te[k]; pp[k] = (int)(ecnt[32 + te[k]] + rk[k]); pg[k] = tv[k]; }
        }
        if ((PROF_MASK) >> 23) { VM_WAIT(); __syncthreads(); } PROF_RP(3);
    }
}

DI void phase_scatter(Ctx& F, int l) {
    LAS int* ts = (LAS int*)(F.lds + LDS_MISC + 512);
    if (F.tid < 64) {
        const int lane = F.tid; const int nt_ = (lane < 32) ? (int)((ldu(F.ctl + CW_ECNT + (l * 32 + lane) * 64) + 255u) >> 8) : 0;
        int inc = nt_;
#pragma unroll
        for (int o = 1; o < 32; o <<= 1) { const int t_ = __shfl_up(inc, o); inc += (lane >= o) ? t_ : 0; }
        if (lane < 32) ts[lane] = inc - nt_;
        if (lane == 31) ts[32] = inc; }
    __syncthreads();
    if (blockIdx.x == 0) {
        if (F.tid == 0) __hip_atomic_store(F.ctl + CW_NT + l, (unsigned)ts[32], __ATOMIC_RELAXED, __HIP_MEMORY_SCOPE_AGENT);
        for (int t = F.tid; t < ts[32]; t += NTHREADS) { int e = 0; while (e < 31 && t >= ts[e + 1]) ++e; F.ctl[CW_TILE_E + l * MAXTILES + t] = (unsigned)e; }
    }
    { const int r = F.vcu * 128 + (F.tid >> 2), k = F.tid & 3;
      const int e = ((const int*)(F.ws + WS_TOPE))[(size_t)r * 4 + k], p = ((const int*)(F.ws + WS_TOPP))[(size_t)r * 4 + k];
      const int slot = ts[e] * 256 + p;
      ((int*)(F.ws + WS_SLOT))[(size_t)r * 4 + k] = slot; ((unsigned*)(F.ws + WS_XG))[slot] = (unsigned)r; }
}
struct MoeOrder {
    const char* A; const char* B; char* C; const unsigned* tile_e; int NT, nN; size_t bE, bN, cN; int G, c0, gather, rev;
    DI bool next(int i, g8::Unit& u) const {
        const int L = i * G + c0; if (L >= NT * nN) return false;
        int pm, pn; g8::tile_of(L, NT, nN, pm, pn); if (rev) pm = NT - 1 - pm;
        const int e = __builtin_amdgcn_readfirstlane((int)ldu(tile_e + pm));
        u.pm = pm; u.pn = pn; u.aux = e; u.a = gather ? A : A + (size_t)pm * 256 * 2048; u.b = B + (size_t)e * bE + (size_t)pn * bN; u.c = C + (size_t)pm * 256 * 2048 + (size_t)pn * cN; return true;
    }
};

DI unsigned lds_addr(const LAS void* p) { return (unsigned)(size_t)p; }
DI bf16x8 tr_frag8(unsigned img, int ld_bytes, int row_lo, int row_hi, int m0, int lane) {
    const int i = lane & 15; const unsigned a_lo = img + (unsigned)((row_lo + (i >> 2)) * ld_bytes + (m0 + 4 * (i & 3)) * 2), a_hi = img + (unsigned)((row_hi + (i >> 2)) * ld_bytes + (m0 + 4 * (i & 3)) * 2);
    s16x4 lo, hi;
    asm volatile("ds_read_b64_tr_b16 %0, %2\n\tds_read_b64_tr_b16 %1, %3\n\ts_waitcnt lgkmcnt(0)" : "=&v"(lo), "=&v"(hi) : "v"(a_lo), "v"(a_hi) : "memory");
    return __builtin_shufflevector(lo, hi, 0, 1, 2, 3, 4, 5, 6, 7);
}
DI s16x4 tr_read4(unsigned addr) { s16x4 r; asm volatile("ds_read_b64_tr_b16 %0, %1\n\ts_waitcnt lgkmcnt(0)" : "=&v"(r) : "v"(addr) : "memory"); return r; }
DI bf16x8 pack_frag(const f32x4 a, const f32x4 b) {
    u32x4 p; p.x = cvt_pk_bf16(a[0], a[1]); p.y = cvt_pk_bf16(a[2], a[3]); p.z = cvt_pk_bf16(b[0], b[1]); p.w = cvt_pk_bf16(b[2], b[3]); return __builtin_bit_cast(bf16x8, p);
}
DI u32x2 pack4(const f32x4 a) { u32x2 p; p.x = cvt_pk_bf16(a[0], a[1]); p.y = cvt_pk_bf16(a[2], a[3]); return p; }
DI f32x4 unpack4(const u32x2 w) { return (f32x4){bflo(w.x), bfhi(w.x), bflo(w.y), bfhi(w.y)}; }
DI float softcap15(float x) { const float y = x * (1.f / 15.f); const float e = __expf(2.f * y); return 15.f * (1.f - 2.f * __builtin_amdgcn_rcpf(e + 1.f)); }
DI float log_sigmoid(float x) { return fminf(x, 0.f) - log1pf(__expf(-fabsf(x))); }
DI float softplusf_(float x) { return fmaxf(x, 0.f) + log1pf(__expf(-fabsf(x))); }
DI float wave_incl_sum(float v, int lane) {
#pragma unroll
    for (int o = 1; o < 64; o <<= 1) { const float t = __shfl_up(v, o); v += (lane >= o) ? t : 0.f; }
    return v;
}
DI float wave_incl_max(float v, int lane) {
#pragma unroll
    for (int o = 1; o < 64; o <<= 1) { const float t = __shfl_up(v, o); v = (lane >= o) ? fmaxf(v, t) : v; }
    return v;
}
constexpr int GA_QH = 0, GA_KH = 17408, GA_VB = 34816, GA_KB = 52224, GA_NA = 69632, GA_AD = 78848, GA_TI = 82944, GA_GC = 84992, GA_KEI = 86016;
constexpr int LDI = 136 * 2;
constexpr int LDK = 72 * 2;

#define DMA16(src, dst) __builtin_amdgcn_global_load_lds((const unsigned*)(src), (LAS unsigned*)(dst), 16, 0, 0)
DI u32x2 gld8(const void* p) { u32x2 r; asm volatile("global_load_dwordx2 %0, %1, off" : "=v"(r) : "v"(p) : "memory"); return r; }
DI float gld4(const void* p) { float r; asm volatile("global_load_dword %0, %1, off" : "=v"(r) : "v"(p) : "memory"); return r; }
DI u32x4 gld16(const void* p) { u32x4 r; asm volatile("global_load_dwordx4 %0, %1, off" : "=v"(r) : "v"(p) : "memory"); return r; }
struct MlAPre { u32x4 kraw, vraw[2]; float gi, gf; };
#define PROF_SUB(k) do { if ((PROF_MASK) >> 16) { if (blockIdx.x == 0 && threadIdx.x == 0) { volatile LAS unsigned long long* pw = (volatile LAS unsigned long long*)(F.lds + LDS_MISC + 128); \
        const unsigned long long now_ = __builtin_amdgcn_s_memrealtime(); if (((PROF_MASK) >> (16 + (k))) & 1) pw[1] += now_ - pw[3]; pw[3] = now_; } } } while (0)
DI void ml_a_fetch(Ctx& F, int cid, MlAPre& P) {
    const int b = cid >> 8, h = (cid >> 6) & 3, n = cid & 63, t0 = b * SEQ + n * CH, tid = F.tid, lane = F.lane;
    const bf16* PROJ = (const bf16*)(F.ws + WS_PROJ); const float* GT = (const float*)(F.ws + WS_GATES);
    P.kraw = gld16(PROJ + (size_t)(t0 + (tid >> 3)) * NPROJ + 256 + h * 64 + (tid & 7) * 8);
#pragma unroll
    for (int q = 0; q < 2; ++q) { const int idx = tid + 512 * q; P.vraw[q] = gld16(PROJ + (size_t)(t0 + (idx >> 4)) * NPROJ + 512 + h * 128 + (idx & 15) * 8); }
    P.gi = gld4(GT + (size_t)(t0 + lane) * 16 + h); P.gf = gld4(GT + (size_t)(t0 + lane) * 16 + 4 + h);
}
DI void ml_a_unit(Ctx& F, int l, int cid, int par, MlAPre& P, float bi, float bf_, float& gb, float& ga, float nalog, float dtb) {
    int tid = F.tid; asm volatile("" : "+v"(tid)); const int lane = tid & 63;
    LAS unsigned char* KE = F.lds + par * 45056; LAS unsigned char* VI = KE + 16384; LAS float* es = (LAS float*)(KE + 40960);
    asm volatile("s_waitcnt vmcnt(7)" : "+v"(P.kraw), "+v"(P.vraw[0]), "+v"(P.vraw[1]), "+v"(P.gi), "+v"(P.gf), "+v"(gb), "+v"(ga) :: "memory");
    const int ks_ = tid >> 3, kc8 = (tid & 7) * 8;
    const u32x4 kraw = P.kraw; const u32x4 vraw[2] = {P.vraw[0], P.vraw[1]};
    if (F.wave == 7) {
        const float ip = softcap15(P.gi + bi), fp = softcap15(P.gf + bf_);
        const float bc = wave_incl_sum(log_sigmoid(fp), lane), blast = __shfl(bc, 63), lw = blast - bc + ip, amax = wave_max(lw);
        es[lane] = __expf(lw - amax);
        if (lane == 0) { float* sc = (float*)(F.ws + WS_MLSC) + (size_t)cid * 4; sc[0] = blast; sc[1] = amax; }
    }
    if (F.wave == 6) {
        LAS float* gcs = (LAS float*)(F.lds + GA_GC); LAS float* bts = gcs + 64;
        const float beta = sigmoidf_(gb), gg = nalog * softplusf_(ga + dtb), gc = wave_incl_sum(gg, lane);
        gcs[lane] = gc; bts[lane] = beta;
        if (lane == 63) ((float*)(F.ws + WS_GDGL))[cid] = __expf(gc);
    }
#pragma unroll
    for (int q = 0; q < 2; ++q) { const int idx = tid + 512 * q, s_ = idx >> 4, c8 = (idx & 15) * 8; *(LAS u32x4*)(VI + s_ * LDI + c8 * 2) = vraw[q]; }
    __syncthreads();
    { float v[8]; unpack8(kraw, v); const float e = es[ks_];
#pragma unroll
      for (int j = 0; j < 8; ++j) v[j] *= e;
      *(LAS u32x4*)(KE + ks_ * LDK + kc8 * 2) = pack8(v); }
    __syncthreads();
    { const int g = lane >> 4, w = F.wave, ln = lane & 15; f32x4 acc[4], kacc[4];
#pragma unroll
      for (int nt = 0; nt < 4; ++nt) { acc[nt] = (f32x4){0.f, 0.f, 0.f, 0.f}; kacc[nt] = (f32x4){0.f, 0.f, 0.f, 0.f}; }
      const bf16x8 ones = (ln == 0) ? (bf16x8){0x3f80, 0x3f80, 0x3f80, 0x3f80, 0x3f80, 0x3f80, 0x3f80, 0x3f80} : (bf16x8){0, 0, 0, 0, 0, 0, 0, 0};
#pragma unroll
      for (int ks = 0; ks < 2; ++ks) { const int rb = 32 * ks + 8 * g;
          const bf16x8 af = tr_frag8(lds_addr(VI), LDI, rb, rb + 4, 16 * w, lane);
#pragma unroll
          for (int nt = 0; nt < 4; ++nt) { const bf16x8 bf = tr_frag8(lds_addr(KE), LDK, rb, rb + 4, 16 * nt, lane); acc[nt] = MFMA16(bf, af, acc[nt]);
              if (w == 0) kacc[nt] = MFMA16(ones, bf, kacc[nt]); } }
      bf16* U = (bf16*)(F.ws + WS_MLU) + (size_t)cid * 8192;
#pragma unroll
      for (int nt = 0; nt < 4; ++nt)
          *(u32x2*)(U + (w * 2 + (nt >> 1)) * 512 + ((2 * (nt & 1) + (g >> 1)) * 16 + ln) * 8 + 4 * (g & 1)) = pack4(acc[nt]);
      if (w == 0 && g == 0) {
#pragma unroll
          for (int nt = 0; nt < 4; ++nt) ((float*)(F.ws + WS_MLKN))[(size_t)cid * 64 + 16 * nt + ln] = kacc[nt][0]; }
    }
}
struct MlBBatch { u32x2 ub[8]; float kv[8]; u32x2 sc; };
DI void ml_b_fetch(const bf16* U, const float* SC, const float* KN, size_t cid0, int e0, int t, bool dn, MlBBatch& B) {
#pragma unroll
    for (int q = 0; q < 8; ++q) { const size_t cid = cid0 + q;
        B.ub[q] = gld8(U + cid * 8192 + e0);
        B.kv[q] = 0.f; if (dn) asm volatile("global_load_dword %0, %1, off" : "+v"(B.kv[q]) : "v"(KN + cid * 64 + t) : "memory"); }
    B.sc = gld8(SC + (cid0 + (t & 7)) * 4);
}
DI void ml_b_compute(const MlBBatch& B, bf16* CT, float* NP, float* MP, size_t cid0, int e0, int t, int p, bool dn, f32x4& C, float& nv, float& m) {
#pragma unroll
    for (int q = 0; q < 8; ++q) { const size_t cid = cid0 + q;
        *(u32x2*)(CT + cid * 8192 + e0) = pack4(C);
        if (dn) NP[cid * 64 + t] = nv; if (p == 0 && t == 0) MP[cid] = m;
        const float blq = __uint_as_float(__builtin_amdgcn_readlane(B.sc.x, q)), amq = __uint_as_float(__builtin_amdgcn_readlane(B.sc.y, q));
        const float mn = fmaxf(blq + m, amq), d1 = __expf(blq + m - mn), d2 = __expf(amq - mn);
        const f32x4 uv = unpack4(B.ub[q]);
#pragma unroll
        for (int k = 0; k < 4; ++k) C[k] = d1 * C[k] + d2 * uv[k];
        nv = d1 * nv + d2 * (dn ? B.kv[q] : 0.f); m = mn; }
}
#define MLB_TIE(B) do { _Pragma("unroll") for (int q_ = 0; q_ < 8; ++q_) asm volatile("" : "+v"(B.ub[q_]), "+v"(B.kv[q_])); asm volatile("" : "+v"(B.sc)); } while (0)
DI void ml_b_unit(Ctx& F, int u) {
    const int bh = u >> 3, p = u & 7, t = F.tid - 256, e0 = p * 1024 + 4 * t;
    const bf16* U = (const bf16*)(F.ws + WS_MLU); const float* SC = (const float*)(F.ws + WS_MLSC); const float* KN = (const float*)(F.ws + WS_MLKN);
    bf16* CT = (bf16*)(F.ws + WS_MLCT); float* NP = (float*)(F.ws + WS_MLNP); float* MP = (float*)(F.ws + WS_MLMP);
    f32x4 C = (f32x4){0.f, 0.f, 0.f, 0.f}; float nv = 0.f, m = 0.f; const bool dn = (p == 0 && t < 64);
    const size_t c0 = (size_t)bh * 64;
    MlBBatch A, B;
    ml_b_fetch(U, SC, KN, c0, e0, t, dn, A);
#pragma unroll
    for (int nb = 0; nb < 8; nb += 2) {
        ml_b_fetch(U, SC, KN, c0 + 8 * (nb + 1), e0, t, dn, B); asm volatile("s_waitcnt vmcnt(9)" ::: "memory"); MLB_TIE(A);
        ml_b_compute(A, CT, NP, MP, c0 + 8 * nb, e0, t, p, dn, C, nv, m);
        if (nb + 2 < 8) { ml_b_fetch(U, SC, KN, c0 + 8 * (nb + 2), e0, t, dn, A); asm volatile("s_waitcnt vmcnt(9)" ::: "memory"); } else asm volatile("s_waitcnt vmcnt(0)" ::: "memory");
        MLB_TIE(B);
        ml_b_compute(B, CT, NP, MP, c0 + 8 * (nb + 1), e0, t, p, dn, C, nv, m);
    }
}
DI void ml_c_unit(Ctx& F, const Args& a, int l, int cid, int par) {
    const int b = cid >> 8, h = (cid >> 6) & 3, n = cid & 63, t0 = b * SEQ + n * CH, lane = F.lane, tid = F.tid, g = lane >> 4, ln = lane & 15, w = F.wave, tt = w & 3, dh = w >> 2;
    const bf16* PROJ = (const bf16*)(F.ws + WS_PROJ); const float* GT = (const float*)(F.ws + WS_GATES);
    LAS unsigned char* VI = F.lds + par * 24576; LAS float* ib = (LAS float*)(VI + 20480); LAS float* Mt = ib + 64; LAS float* bcs = ib + 128; LAS float* ss = ib + 192;
    const float mprev = ldf((const float*)(F.ws + WS_MLMP) + cid);
    const bf16* CT = (const bf16*)(F.ws + WS_MLCT) + (size_t)cid * 8192; const float* NPv = (const float*)(F.ws + WS_MLNP) + (size_t)cid * 64;
    const int tl = 16 * tt + ln;
    bf16x8 qf[2], kf[4][2], ctf[5][2]; u32x2 ogr[4]; f32x4 nwr[4]; u32x4 vraw[2];
#pragma unroll
    for (int ks = 0; ks < 2; ++ks) { qf[ks] = *(const bf16x8*)(PROJ + (size_t)(t0 + tl) * NPROJ + h * 64 + 32 * ks + 8 * g);
#pragma unroll
        for (int ms = 0; ms < 4; ++ms) kf[ms][ks] = *(const bf16x8*)(PROJ + (size_t)(t0 + 16 * ms + ln) * NPROJ + 256 + h * 64 + 32 * ks + 8 * g);
#pragma unroll
        for (int mt = 0; mt < 4; ++mt) ctf[mt][ks] = *(const bf16x8*)(CT + (size_t)(16 * (4 * dh + mt) + ln) * 64 + 32 * ks + 8 * g);
        const f32x4 n0 = *(const f32x4*)(NPv + 32 * ks + 8 * g), n1 = *(const f32x4*)(NPv + 32 * ks + 8 * g + 4);
        float nvv[8];
#pragma unroll
        for (int j = 0; j < 4; ++j) { nvv[j] = (ln == 0) ? n0[j] : 0.f; nvv[4 + j] = (ln == 0) ? n1[j] : 0.f; }
        ctf[4][ks] = __builtin_bit_cast(bf16x8, pack8(nvv)); }
#pragma unroll
    for (int mt = 0; mt < 4; ++mt) { const int dv = 16 * (4 * dh + mt) + 4 * g;
        nwr[mt] = *(const f32x4*)(inp(F, 5) + (size_t)l * 512 + h * 128 + dv); ogr[mt] = *(const u32x2*)(PROJ + (size_t)(t0 + tl) * NPROJ + 1024 + h * 128 + dv); }
#pragma unroll
    for (int q = 0; q < 2; ++q) { const int idx = tid + 512 * q, s_ = idx >> 4, c8 = (idx & 15) * 8; vraw[q] = *(const u32x4*)(PROJ + (size_t)(t0 + s_) * NPROJ + 512 + h * 128 + c8); }
    if (w == 7) {
        const float ip = softcap15(GT[(size_t)(t0 + lane) * 16 + h] + inp(F, 3)[l * 4 + h]), fp = softcap15(GT[(size_t)(t0 + lane) * 16 + 4 + h] + inp(F, 4)[l * 4 + h]);
        const float bc = wave_incl_sum(log_sigmoid(fp), lane), ibs = ip - bc, pm = wave_incl_max(ibs, lane);
        ib[lane] = ibs; Mt[lane] = fmaxf(mprev, pm); bcs[lane] = bc;
    }
#pragma unroll
    for (int q = 0; q < 2; ++q) { const int idx = tid + 512 * q, s_ = idx >> 4, c8 = (idx & 15) * 8; *(LAS u32x4*)(VI + s_ * LDI + c8 * 2) = vraw[q]; }
    __syncthreads();
    f32x4 sacc[4];
#pragma unroll
    for (int ms = 0; ms < 4; ++ms) { sacc[ms] = (f32x4){0.f, 0.f, 0.f, 0.f};
#pragma unroll
        for (int ks = 0; ks < 2; ++ks) sacc[ms] = MFMA16(kf[ms][ks], qf[ks], sacc[ms]); }
    const float Mtt = Mt[tl];
#pragma unroll
    for (int ms = 0; ms < 4; ++ms) { const f32x4 ibv = *(const LAS f32x4*)(ib + 16 * ms + 4 * g);
#pragma unroll
        for (int i = 0; i < 4; ++i) { const int s = 16 * ms + 4 * g + i; sacc[ms][i] = (s <= tl) ? sacc[ms][i] * 0.125f * __expf(ibv[i] - Mtt) : 0.f; } }
    bf16x8 sb[2]; sb[0] = pack_frag(sacc[0], sacc[1]); sb[1] = pack_frag(sacc[2], sacc[3]);
    f32x4 xacc[5];
#pragma unroll
    for (int mt = 0; mt < 5; ++mt) { xacc[mt] = (f32x4){0.f, 0.f, 0.f, 0.f};
#pragma unroll
        for (int ks = 0; ks < 2; ++ks) xacc[mt] = MFMA16(ctf[mt][ks], qf[ks], xacc[mt]); }
    const float wint = 0.125f * __expf(mprev - Mtt);
#pragma unroll
    for (int mt = 0; mt < 5; ++mt) xacc[mt] *= wint;
    const bf16x8 ones = (ln == 0) ? (bf16x8){0x3f80, 0x3f80, 0x3f80, 0x3f80, 0x3f80, 0x3f80, 0x3f80, 0x3f80} : (bf16x8){0, 0, 0, 0, 0, 0, 0, 0};
#pragma unroll
    for (int kk = 0; kk < 2; ++kk) {
#pragma unroll
        for (int mt = 0; mt < 4; ++mt) { const bf16x8 vf = tr_frag8(lds_addr(VI), LDI, 32 * kk + 4 * g, 32 * kk + 16 + 4 * g, 16 * (4 * dh + mt), lane); xacc[mt] = MFMA16(vf, sb[kk], xacc[mt]); }
        xacc[4] = MFMA16(ones, sb[kk], xacc[4]);
    }
    const float den = __shfl(xacc[4][0], ln), mt_ = bcs[tl] + Mtt, dinv = __builtin_amdgcn_rcpf(fmaxf(fabsf(den), __expf(-mt_)));
    float ssq = 0.f;
#pragma unroll
    for (int mt = 0; mt < 4; ++mt) { xacc[mt] *= dinv; ssq += (xacc[mt][0] * xacc[mt][0] + xacc[mt][1] * xacc[mt][1]) + (xacc[mt][2] * xacc[mt][2] + xacc[mt][3] * xacc[mt][3]); }
    ssq += __shfl_xor(ssq, 16); ssq += __shfl_xor(ssq, 32);
    if (g == 0) ss[tl * 2 + dh] = ssq;
    __syncthreads();
    const float rinv = rsqrtf((ss[tl * 2] + ss[tl * 2 + 1]) * (1.f / 128.f) + 1e-6f);
    bf16* MX = (bf16*)(F.ws + WS_MIXED);
#pragma unroll
    for (int mt = 0; mt < 4; ++mt) { const int dv = 16 * (4 * dh + mt) + 4 * g;
        const f32x4 nw = nwr[mt]; const f32x4 og = unpack4(ogr[mt]);
        f32x4 o;
#pragma unroll
        for (int i = 0; i < 4; ++i) o[i] = xacc[mt][i] * rinv * nw[i] * sigmoidf_(og[i]);
        *(u32x2*)(MX + (size_t)(t0 + tl) * D + h * 128 + dv) = pack4(o); }
}

constexpr int GA_WT = 155648;
constexpr int GA_ST = 103424;
DI void gd_a_issue(Ctx& F, int cid, int w, int lane) {
    const int b = cid >> 8, h = (cid >> 6) & 3, n = cid & 63, t0 = b * SEQ + n * CH;
    const bf16* PROJ = (const bf16*)(F.ws + WS_PROJ);
#pragma unroll
    for (int q = 0; q < 7; ++q) { const int jj = (w + 8 * q) % 51, ten = jj / 17, grp = jj % 17;
        DMA16(PROJ + ((long)t0 - 3 + 4 * grp + (lane >> 4)) * NPROJ + 1536 + ten * 512 + h * 128 + 8 * (lane & 15), F.lds + GA_ST + ten * 17408 + grp * 1024); }
}
DI void gd_a_unit(Ctx& F, int l, int cid, float& gb, float& ga, float nalog, float dtb, bool has_next, MlAPre& P) {
    int tid = F.tid; asm volatile("" : "+v"(tid));
    const int b = cid >> 8, h = (cid >> 6) & 3, n = cid & 63, t0 = b * SEQ + n * CH, lane = tid & 63, g = lane >> 4, ln = lane & 15, w = F.wave;
    const float* GT = (const float*)(F.ws + WS_GATES);
    LAS unsigned char* L = F.lds; LAS float* gcs = (LAS float*)(L + GA_GC); LAS float* bts = gcs + 64;
    const int ten = tid >> 7, tg = (tid >> 4) & 7, cg = tid & 15;
    asm volatile("s_waitcnt vmcnt(0)" ::: "memory");
    __syncthreads();
    u32x4 raw[11];
    if (ten < 3) { const unsigned sa = lds_addr(L) + GA_ST + ten * 17408 + (8 * tg) * 256 + cg * 16;
        asm volatile("ds_read_b128 %0, %11\n\tds_read_b128 %1, %11 offset:256\n\tds_read_b128 %2, %11 offset:512\n\tds_read_b128 %3, %11 offset:768\n\tds_read_b128 %4, %11 offset:1024\n\tds_read_b128 %5, %11 offset:1280\n\t"
                     "ds_read_b128 %6, %11 offset:1536\n\tds_read_b128 %7, %11 offset:1792\n\tds_read_b128 %8, %11 offset:2048\n\tds_read_b128 %9, %11 offset:2304\n\tds_read_b128 %10, %11 offset:2560\n\ts_waitcnt lgkmcnt(0)"
                     : "=&v"(raw[0]), "=&v"(raw[1]), "=&v"(raw[2]), "=&v"(raw[3]), "=&v"(raw[4]), "=&v"(raw[5]), "=&v"(raw[6]), "=&v"(raw[7]), "=&v"(raw[8]), "=&v"(raw[9]), "=&v"(raw[10]) : "v"(sa) : "memory");
        if (n == 0 && tg == 0) { raw[0] = (u32x4){0u, 0u, 0u, 0u}; raw[1] = raw[0]; raw[2] = raw[0]; }
    }
    float wv[4][8];
#pragma unroll
    for (int j = 0; j < 4; ++j) unpack8(*(const LAS u32x4*)(L + GA_WT + (((ten < 3 ? ten : 0) * 4 + j) * 128 + 8 * cg) * 2), wv[j]);
    const float glast = gcs[63];
    bf16* qgb = (bf16*)(F.ws + WS_GDQG) + (size_t)cid * 8192 + (8 * tg) * 128 + 8 * cg; asm volatile("" : "+v"(qgb));
    if (ten < 3) {
#pragma unroll
        for (int i = 0; i < 8; ++i) { const int t = 8 * tg + i; float y[8];
#pragma unroll
            for (int c = 0; c < 8; ++c) y[c] = 0.f;
#pragma unroll
            for (int j = 0; j < 4; ++j) { float xv[8]; unpack8(raw[i + j], xv);
#pragma unroll
                for (int c = 0; c < 8; ++c) y[c] += wv[j][c] * xv[c]; }
#pragma unroll
            for (int c = 0; c < 8; ++c) y[c] = y[c] * sigmoidf_(y[c]);
            const float gct = gcs[t], bt = bts[t];
            if (ten < 2) { float s2 = 0.f;
#pragma unroll
                for (int c = 0; c < 8; ++c) s2 += y[c] * y[c];
                s2 += __shfl_xor(s2, 1); s2 += __shfl_xor(s2, 2); s2 += __shfl_xor(s2, 4); s2 += __shfl_xor(s2, 8);
                const float rn = rsqrtf(s2 + 1e-6f) * (ten == 0 ? 0.08838834764831845f : 1.f);
#pragma unroll
                for (int c = 0; c < 8; ++c) y[c] *= rn; }
            float z[8];
            if (ten == 0) { *(LAS u32x4*)(L + GA_QH + t * LDI + 16 * cg) = pack8(y); const float e = __expf(gct);
#pragma unroll
                for (int c = 0; c < 8; ++c) z[c] = y[c] * e;
                *(u32x4*)(qgb + i * 128) = pack8(z); }
            else if (ten == 1) { *(LAS u32x4*)(L + GA_KH + t * LDI + 16 * cg) = pack8(y); const float e1 = bt * __expf(gct), e2 = __expf(glast - gct);
#pragma unroll
                for (int c = 0; c < 8; ++c) z[c] = y[c] * e1;
                *(LAS u32x4*)(L + GA_KB + t * LDI + 16 * cg) = pack8(z);
#pragma unroll
                for (int c = 0; c < 8; ++c) z[c] = y[c] * e2;
                *(LAS u32x4*)(L + GA_KEI + t * LDI + 16 * cg) = pack8(z); }
            else {
#pragma unroll
                for (int c = 0; c < 8; ++c) z[c] = y[c] * bt;
                *(LAS u32x4*)(L + GA_VB + t * LDI + 16 * cg) = pack8(z); }
        }
    }
    __syncthreads(); PROF_SUB(1);
    if (has_next) {
        ml_a_fetch(F, cid + 256, P);
        gb = gld4(GT + (size_t)(t0 + SEQ + lane) * 16 + 8 + h); ga = gld4(GT + (size_t)(t0 + SEQ + lane) * 16 + 12 + h);
        gd_a_issue(F, cid + 256, w, lane); }
    { const int ti = w & 3, kind = w >> 2; const int tl = 16 * ti + ln; const float gct = gcs[tl], bt = bts[tl];
      bf16* QKD = (bf16*)(F.ws + WS_GDQK) + (size_t)cid * 4096;
#pragma unroll
      for (int si = 0; si < 4; ++si) {
          if (si <= ti) {
              f32x4 acc = (f32x4){0.f, 0.f, 0.f, 0.f};
#pragma unroll
              for (int ks = 0; ks < 4; ++ks) { const bf16x8 af = *(const LAS bf16x8*)(L + GA_KH + (16 * si + ln) * LDI + (32 * ks + 8 * g) * 2);
                  const bf16x8 bfr = *(const LAS bf16x8*)(L + (kind ? GA_QH : GA_KH) + tl * LDI + (32 * ks + 8 * g) * 2); acc = MFMA16(af, bfr, acc); }
              const f32x4 gs = *(const LAS f32x4*)(gcs + 16 * si + 4 * g);
              f32x4 v;
#pragma unroll
              for (int i = 0; i < 4; ++i) { const int s = 16 * si + 4 * g + i; const float dec = __expf(gct - gs[i]);
                  v[i] = kind ? ((s <= tl) ? acc[i] * dec : 0.f) : ((s < tl) ? bt * acc[i] * dec : 0.f); }
              if (kind) *(u32x2*)(QKD + (ti * 2 + (si >> 1)) * 512 + ((2 * (si & 1) + (g >> 1)) * 16 + ln) * 8 + (g & 1) * 4) = pack4(v);
              else { *(LAS u32x2*)(L + GA_NA + tl * LDK + (16 * si + 4 * g) * 2) = pack4(-v);
                  if (si == ti) { LAS float* AD = (LAS float*)(L + GA_AD) + ti * 256 + ln * 16 + 4 * g; AD[0] = v[0]; AD[1] = v[1]; AD[2] = v[2]; AD[3] = v[3]; } }
          } else if (kind) *(u32x2*)(QKD + (ti * 2 + (si >> 1)) * 512 + ((2 * (si & 1) + (g >> 1)) * 16 + ln) * 8 + (g & 1) * 4) = (u32x2){0u, 0u};
      } }
    __syncthreads(); PROF_SUB(2);
    if (w == 0) {
        const LAS float* AD = (const LAS float*)(L + GA_AD) + g * 256; float a_[16][16], acc[16];
#pragma unroll
        for (int t = 1; t < 16; ++t)
#pragma unroll
            for (int q = 0; q < 4; ++q) { if (4 * q < t) { const f32x4 r = *(const LAS f32x4*)(AD + t * 16 + 4 * q); a_[t][4 * q] = r[0]; a_[t][4 * q + 1] = r[1]; a_[t][4 * q + 2] = r[2]; a_[t][4 * q + 3] = r[3]; } }
#pragma unroll
        for (int t = 0; t < 16; ++t) acc[t] = (t == ln) ? 1.f : 0.f;
#pragma unroll
        for (int s_ = 0; s_ < 16; ++s_) { const float tc = acc[s_]; *(LAS bf16*)(L + GA_TI + (16 * g + s_) * 32 + ln * 2) = f2bf(tc);
#pragma unroll
            for (int t = s_ + 1; t < 16; ++t) acc[t] -= a_[t][s_] * tc; }
    }
    __syncthreads(); PROF_SUB(3);
    { const int src = (w < 4) ? GA_VB : GA_KB, cb = 32 * (w & 3);
      u32x2 Ub[4][2]; bf16* UT = (bf16*)(F.ws + WS_GDUT) + (size_t)cid * 8192;
#pragma unroll
      for (int i = 0; i < 4; ++i) {
          f32x4 acc[2];
#pragma unroll
          for (int nt = 0; nt < 2; ++nt)
#pragma unroll
              for (int r = 0; r < 4; ++r) acc[nt][r] = bf2f(*(const LAS bf16*)(L + src + (16 * i + 4 * g + r) * LDI + (cb + 16 * nt + ln) * 2));
#pragma unroll
          for (int jp = 0; jp < 2; ++jp) { if (2 * jp < i) {
              const u32x2 alo = *(const LAS u32x2*)(L + GA_NA + (16 * i + ln) * LDK + (32 * jp + 4 * g) * 2);
              const u32x2 ahi = (2 * jp + 1 < i) ? *(const LAS u32x2*)(L + GA_NA + (16 * i + ln) * LDK + (32 * jp + 16 + 4 * g) * 2) : (u32x2){0u, 0u};
              const bf16x8 af = __builtin_bit_cast(bf16x8, (u32x4){alo.x, alo.y, ahi.x, ahi.y});
#pragma unroll
              for (int nt = 0; nt < 2; ++nt) { const u32x2 blo = Ub[2 * jp][nt], bhi = (2 * jp + 1 < i) ? Ub[2 * jp + 1][nt] : (u32x2){0u, 0u};
                  acc[nt] = MFMA16(af, __builtin_bit_cast(bf16x8, (u32x4){blo.x, blo.y, bhi.x, bhi.y}), acc[nt]); } } }
          const u32x2 tlo = *(const LAS u32x2*)(L + GA_TI + (16 * i + ln) * 32 + (4 * g) * 2);
          const bf16x8 tf = __builtin_bit_cast(bf16x8, (u32x4){tlo.x, tlo.y, 0u, 0u});
#pragma unroll
          for (int nt = 0; nt < 2; ++nt) { const u32x2 p = pack4(acc[nt]);
              const f32x4 u = MFMA16(tf, __builtin_bit_cast(bf16x8, (u32x4){p.x, p.y, 0u, 0u}), ((f32x4){0.f, 0.f, 0.f, 0.f}));
              Ub[i][nt] = pack4(u);
              if (w < 4) *(u32x2*)(UT + ((cb >> 4) + nt) * 1024 + i * 256 + lane * 4) = Ub[i][nt];
              else {
#pragma unroll
                  for (int r = 0; r < 4; ++r) *(LAS bf16*)(L + GA_QH + (16 * i + 4 * g + r) * LDI + (cb + 16 * nt + ln) * 2) = f2bf(-u[r]); } }
      } }
    __syncthreads(); PROF_SUB(4);
    { bf16* W = (bf16*)(F.ws + WS_GDW) + (size_t)cid * 8192; bf16* KET = (bf16*)(F.ws + WS_GDKE) + (size_t)cid * 8192;
#pragma unroll
      for (int q = 0; q < 2; ++q) { const int item = tid + 512 * q, f = item >> 6, lp = item & 63, t = 16 * (f >> 2) + (lp & 15), kk = f & 3, gp = lp >> 4;
          const u32x2 lo = *(const LAS u32x2*)(L + GA_QH + t * LDI + (32 * kk + 4 * gp) * 2), hi = *(const LAS u32x2*)(L + GA_QH + t * LDI + (32 * kk + 16 + 4 * gp) * 2);
          *(u32x4*)(W + item * 8) = (u32x4){lo.x, lo.y, hi.x, hi.y}; }
#pragma unroll
      for (int q = 0; q < 4; ++q) { const int rg = 4 * q + g, kk = rg >> 3, idx = rg & 7, pos = 32 * kk + ((idx < 4) ? 8 * idx : 8 * (idx - 4) + 4);
          const int trow = 32 * kk + ((idx < 4) ? 4 * idx : 16 + 4 * (idx - 4));
          const s16x4 v = tr_read4(lds_addr(L + GA_KEI) + (unsigned)((trow + (ln >> 2)) * LDI + (16 * w + 4 * (ln & 3)) * 2));
          *(s16x4*)(KET + (w * 2 + kk) * 512 + ((idx & 3) * 16 + ln) * 8 + ((idx < 4) ? 0 : 4)) = v; }
    }
    __syncthreads(); PROF_SUB(5);
}
constexpr int GB_STAGE = 36864;
DI void gd_b_issue(const bf16* W, const bf16* KET, const bf16* UT, size_t cid, int dv0, int ln, int g, LAS unsigned char* buf) {
#pragma unroll
    for (int mt = 0; mt < 4; ++mt)
#pragma unroll
        for (int kk = 0; kk < 4; ++kk) __builtin_amdgcn_global_load_lds((const unsigned*)(W + cid * 8192 + (mt * 4 + kk) * 512 + (16 * g + ln) * 8), (LAS unsigned*)(buf + (mt * 4 + kk) * 1024), 16, 0, 0);
#pragma unroll
    for (int j = 0; j < 8; ++j)
#pragma unroll
        for (int k2 = 0; k2 < 2; ++k2) __builtin_amdgcn_global_load_lds((const unsigned*)(KET + cid * 8192 + (j * 2 + k2) * 512 + (16 * g + ln) * 8), (LAS unsigned*)(buf + (16 + j * 2 + k2) * 1024), 16, 0, 0);
#pragma unroll
    for (int q = 0; q < 2; ++q) __builtin_amdgcn_global_load_lds((const unsigned*)(UT + cid * 8192 + dv0 * 64 + q * 512 + (16 * g + ln) * 8), (LAS unsigned*)(buf + (32 + q) * 1024), 16, 0, 0);
}
#define GB_RD16(f, addr, WAITSTR) asm volatile( \
    "ds_read_b128 %0, %16\n\tds_read_b128 %1, %16 offset:1024\n\tds_read_b128 %2, %16 offset:2048\n\tds_read_b128 %3, %16 offset:3072\n\t" \
    "ds_read_b128 %4, %16 offset:4096\n\tds_read_b128 %5, %16 offset:5120\n\tds_read_b128 %6, %16 offset:6144\n\tds_read_b128 %7, %16 offset:7168\n\t" \
    "ds_read_b128 %8, %16 offset:8192\n\tds_read_b128 %9, %16 offset:9216\n\tds_read_b128 %10, %16 offset:10240\n\tds_read_b128 %11, %16 offset:11264\n\t" \
    "ds_read_b128 %12, %16 offset:12288\n\tds_read_b128 %13, %16 offset:13312\n\tds_read_b128 %14, %16 offset:14336\n\tds_read_b128 %15, %16 offset:15360" WAITSTR \
    : "=&v"(f[0]), "=&v"(f[1]), "=&v"(f[2]), "=&v"(f[3]), "=&v"(f[4]), "=&v"(f[5]), "=&v"(f[6]), "=&v"(f[7]), \
      "=&v"(f[8]), "=&v"(f[9]), "=&v"(f[10]), "=&v"(f[11]), "=&v"(f[12]), "=&v"(f[13]), "=&v"(f[14]), "=&v"(f[15]) : "v"(addr) : "memory")
constexpr int GB_NS = 4, GB_FLAGS = LDS_MISC + 512, GB_SPIN_CAP = 1 << 22;
DI void gd_b_step(Ctx& F, f32x4 (&S)[8], size_t cid, int dv0, int lane, int ln, int g, float egl, unsigned stage_base, int n) {
    const unsigned base = stage_base + (unsigned)lane * 16u;
    bf16* VNT = (bf16*)(F.ws + WS_GDVN); bf16* SPT = (bf16*)(F.ws + WS_GDSP);
    bf16x8 wf[16], kef[16]; u32x2 ui[4];
    asm volatile("ds_read_b64 %0, %4 offset:32768\n\tds_read_b64 %1, %4 offset:33280\n\tds_read_b64 %2, %4 offset:33792\n\tds_read_b64 %3, %4 offset:34304"
                 : "=&v"(ui[0]), "=&v"(ui[1]), "=&v"(ui[2]), "=&v"(ui[3]) : "v"(stage_base + (unsigned)lane * 8u) : "memory");
    GB_RD16(wf, base, "\n\ts_waitcnt lgkmcnt(0)");
    asm volatile("" : "+v"(ui[0]), "+v"(ui[1]), "+v"(ui[2]), "+v"(ui[3]));
    GB_RD16(kef, base + 16384u, "");
    f32x4 vacc[4]; bf16x8 sbn[4];
#pragma unroll
    for (int kk = 0; kk < 4; ++kk) sbn[kk] = pack_frag(S[2 * kk], S[2 * kk + 1]);
#pragma unroll
    for (int j = 0; j < 8; ++j) *(u32x2*)(SPT + cid * 16384 + ((dv0 >> 4) * 4 + (j >> 1)) * 512 + ((2 * (j & 1) + (g >> 1)) * 16 + ln) * 8 + (g & 1) * 4) = pack4(S[j]);
#pragma unroll
    for (int mt = 0; mt < 4; ++mt) vacc[mt] = unpack4(ui[mt]);
#pragma unroll
    for (int kk = 0; kk < 4; ++kk)
#pragma unroll
        for (int mt = 0; mt < 4; ++mt) vacc[mt] = MFMA16(wf[mt * 4 + kk], sbn[kk], vacc[mt]);
#pragma unroll
    for (int mt = 0; mt < 4; ++mt) *(u32x2*)(VNT + cid * 8192 + ((dv0 >> 4) * 2 + (mt >> 1)) * 512 + ((2 * (mt & 1) + (g >> 1)) * 16 + ln) * 8 + (g & 1) * 4) = pack4(vacc[mt]);
    bf16x8 vb[2]; vb[0] = pack_frag(vacc[0], vacc[1]); vb[1] = pack_frag(vacc[2], vacc[3]);
    asm volatile("s_waitcnt lgkmcnt(0)" : "+v"(kef[0]), "+v"(kef[1]), "+v"(kef[2]), "+v"(kef[3]), "+v"(kef[4]), "+v"(kef[5]), "+v"(kef[6]), "+v"(kef[7]),
                 "+v"(kef[8]), "+v"(kef[9]), "+v"(kef[10]), "+v"(kef[11]), "+v"(kef[12]), "+v"(kef[13]), "+v"(kef[14]), "+v"(kef[15]) :: "memory");
    if (lane == 0) ((volatile LAS unsigned*)(F.lds + GB_FLAGS))[4] = (unsigned)(n + 1);
#pragma unroll
    for (int j = 0; j < 8; ++j) S[j] *= egl;
#pragma unroll
    for (int k2 = 0; k2 < 2; ++k2)
#pragma unroll
        for (int j = 0; j < 8; ++j) S[j] = MFMA16(kef[j * 2 + k2], vb[k2], S[j]);
}
DI void gd_b_task(Ctx& F, int task) {
    const int bh = task >> 3, dv0 = 16 * (task & 7), lane = F.lane, g = lane >> 4, ln = lane & 15;
    const float* GL = (const float*)(F.ws + WS_GDGL);
    volatile LAS unsigned* fl = (volatile LAS unsigned*)(F.lds + GB_FLAGS);
    f32x4 S[8];
#pragma unroll
    for (int j = 0; j < 8; ++j) S[j] = (f32x4){0.f, 0.f, 0.f, 0.f};
    const size_t c0 = (size_t)bh * 64;
    const float eglv = ldf(GL + c0 + lane);
    asm volatile("s_waitcnt vmcnt(0)" ::: "memory");
    const unsigned L0 = lds_addr(F.lds);
#pragma unroll 1
    for (int n = 0; n < 64; ++n) {
        unsigned spins = 0;
        unsigned long long tp0_ = 0; if (((PROF_MASK) >> 22) & 1) tp0_ = __builtin_amdgcn_s_memrealtime();
        while (fl[n & 3] < (unsigned)(n + 1)) { __builtin_amdgcn_s_sleep(1); if (++spins > (unsigned)GB_SPIN_CAP) { fl[5] = 1u; break; } }
        if (((PROF_MASK) >> 22) & 1) { if (blockIdx.x == 0 && lane == 0) { volatile LAS unsigned long long* pw = (volatile LAS unsigned long long*)(F.lds + LDS_MISC + 128); pw[1] += __builtin_amdgcn_s_memrealtime() - tp0_; } }
        gd_b_step(F, S, c0 + n, dv0, lane, ln, g, __builtin_amdgcn_readlane(eglv, n), L0 + (unsigned)(n & 3) * GB_STAGE, n);
    }
}
DI void gd_b_loader(Ctx& F, int task, int li) {
    const int bh = task >> 3, dv0 = 16 * (task & 7), lane = F.lane, g = lane >> 4, ln = lane & 15;
    const bf16* UT = (const bf16*)(F.ws + WS_GDUT); const bf16* W = (const bf16*)(F.ws + WS_GDW); const bf16* KET = (const bf16*)(F.ws + WS_GDKE);
    volatile LAS unsigned* fl = (volatile LAS unsigned*)(F.lds + GB_FLAGS);
    const size_t c0 = (size_t)bh * 64;
    int prev = -1;
#pragma unroll 1
    for (int n = li; n < 64; n += 2) {
        if (n >= GB_NS) { unsigned spins = 0; while (fl[4] < (unsigned)(n - GB_NS + 1)) { __builtin_amdgcn_s_sleep(1); if (++spins > (unsigned)GB_SPIN_CAP) { fl[5] = 1u; break; } } }
        gd_b_issue(W, KET, UT, c0 + n, dv0, ln, g, F.lds + (n & 3) * GB_STAGE);
        if (prev >= 0) { asm volatile("s_waitcnt vmcnt(34)" ::: "memory"); if (lane == 0) fl[prev & 3] = (unsigned)(prev + 1); }
        prev = n;
    }
    asm volatile("s_waitcnt vmcnt(0)" ::: "memory"); if (lane == 0) fl[prev & 3] = (unsigned)(prev + 1);
}
DI void gd_c_unit(Ctx& F, const Args& a, int l, int cid, int par) {
    const int b = cid >> 8, h = (cid >> 6) & 3, n = cid & 63, t0 = b * SEQ + n * CH, lane = F.lane, g = lane >> 4, ln = lane & 15, w = F.wave, tt = w & 3, dh = w >> 2, tl = 16 * tt + ln;
    const bf16* PROJ = (const bf16*)(F.ws + WS_PROJ);
    const bf16* SPT = (const bf16*)(F.ws + WS_GDSP) + (size_t)cid * 16384; const bf16* QG = (const bf16*)(F.ws + WS_GDQG) + (size_t)cid * 8192;
    const bf16* VNT = (const bf16*)(F.ws + WS_GDVN) + (size_t)cid * 8192; const bf16* QKD = (const bf16*)(F.ws + WS_GDQK) + (size_t)cid * 4096;
    LAS float* ss = (LAS float*)(F.lds + par * 1024);
    bf16x8 qf[4], pf[2];
#pragma unroll
    for (int ks = 0; ks < 4; ++ks) qf[ks] = *(const bf16x8*)(QG + tl * 128 + 32 * ks + 8 * g);
#pragma unroll
    for (int ks = 0; ks < 2; ++ks) pf[ks] = *(const bf16x8*)(QKD + tl * 64 + 32 * ks + 8 * g);
    u32x2 zr[4]; f32x4 nwr[4];
#pragma unroll
    for (int mt = 0; mt < 4; ++mt) { const int dv = 16 * (4 * dh + mt) + 4 * g; nwr[mt] = *(const f32x4*)(inp(F, 9) + (size_t)l * 128 + dv); zr[mt] = *(const u32x2*)(PROJ + (size_t)(t0 + tl) * NPROJ + 3072 + h * 128 + dv); }
    f32x4 o[4]; float ssq = 0.f;
#pragma unroll
    for (int mt = 0; mt < 4; ++mt) { o[mt] = (f32x4){0.f, 0.f, 0.f, 0.f}; const int dvr = 16 * (4 * dh + mt) + ln;
#pragma unroll
        for (int ks = 0; ks < 4; ++ks) o[mt] = MFMA16(*(const bf16x8*)(SPT + (size_t)dvr * 128 + 32 * ks + 8 * g), qf[ks], o[mt]);
#pragma unroll
        for (int ks = 0; ks < 2; ++ks) o[mt] = MFMA16(*(const bf16x8*)(VNT + (size_t)dvr * 64 + 32 * ks + 8 * g), pf[ks], o[mt]);
        ssq += (o[mt][0] * o[mt][0] + o[mt][1] * o[mt][1]) + (o[mt][2] * o[mt][2] + o[mt][3] * o[mt][3]); }
    ssq += __shfl_xor(ssq, 16); ssq += __shfl_xor(ssq, 32);
    if (g == 0) ss[tl * 2 + dh] = ssq;
    __syncthreads();
    const float rinv = rsqrtf((ss[tl * 2] + ss[tl * 2 + 1]) * (1.f / 128.f) + 1e-6f);
    bf16* MX = (bf16*)(F.ws + WS_MIXED);
#pragma unroll
    for (int mt = 0; mt < 4; ++mt) { const int dv = 16 * (4 * dh + mt) + 4 * g;
        const f32x4 nw = nwr[mt]; const f32x4 z = unpack4(zr[mt]);
        f32x4 r;
#pragma unroll
        for (int i = 0; i < 4; ++i) r[i] = o[mt][i] * rinv * nw[i] * z[i] * sigmoidf_(z[i]);
        *(u32x2*)(MX + (size_t)(t0 + tl) * D + 512 + h * 128 + dv) = pack4(r); }
}

DI void phase_a(Ctx& F, const Args& a, int l) {
    const int h = (F.vcu >> 6) & 3, lane = F.lane, tid = F.tid, w = F.wave;
    const float* GT = (const float*)(F.ws + WS_GATES);
    for (int e = tid; e < 3 * 4 * 128; e += NTHREADS) { const int ten = e / 512, j = (e >> 7) & 3, c = e & 127;
        *(LAS bf16*)(F.lds + GA_WT + e * 2) = f2bf(inp(F, 6)[((size_t)l * 4 + j) * 1536 + ten * 512 + h * 128 + c]); }
    const float bi = inp(F, 3)[l * 4 + h], bf_ = inp(F, 4)[l * 4 + h], nalog = -__expf(inp(F, 7)[l * 4 + h]), dtb = inp(F, 8)[l * 4 + h];
    asm volatile("s_waitcnt vmcnt(0)" ::: "memory");
    const int t00 = (F.vcu & 63) * CH;
    {
        MlAPre P0; ml_a_fetch(F, F.vcu, P0);
        float gb0 = gld4(GT + (size_t)(t00 + lane) * 16 + 8 + h), ga0 = gld4(GT + (size_t)(t00 + lane) * 16 + 12 + h);
        gd_a_issue(F, F.vcu, w, lane);
        ml_a_unit(F, l, F.vcu, 0, P0, bi, bf_, gb0, ga0, nalog, dtb);
    }
#pragma unroll 1
    for (int i = 0; i < 8; ++i) {
        const int cid = F.vcu + 256 * i;
        MlAPre P; float gb = 0.f, ga = 0.f;
        gd_a_unit(F, l, cid, gb, ga, nalog, dtb, i + 1 < 8, P);
        if (i + 1 < 8) ml_a_unit(F, l, cid + 256, (i + 1) & 1, P, bi, bf_, gb, ga, nalog, dtb);
    }
    asm volatile("s_waitcnt vmcnt(0)" ::: "memory"); __syncthreads();
}
constexpr int CS_K = 0, CS_Q = 8192, CS_CT = 16384, CS_V = 32768, CS_NP = 49152, CS_SC = 49408, CS_GI = 50688, CS_GF = 50944, GS_SP = 51200, GS_QG = 83968, GS_VN = 100352, GS_QK = 116736, GS_SS = 124928;
constexpr int CS_OG = 126464, GS_Z = 142848, CS_MP = 159232;
DI void lds_rd4x8_nowait(unsigned addr, u32x2& a, u32x2& b, u32x2& c, u32x2& d) { asm volatile("ds_read_b64 %0, %4\n\tds_read_b64 %1, %4 offset:32\n\tds_read_b64 %2, %4 offset:64\n\tds_read_b64 %3, %4 offset:96" : "=&v"(a), "=&v"(b), "=&v"(c), "=&v"(d) : "v"(addr) : "memory"); }
DI float lds_rd4(unsigned addr) { float r; asm volatile("ds_read_b32 %0, %1\n\ts_waitcnt lgkmcnt(0)" : "=v"(r) : "v"(addr) : "memory"); return r; }
DI bf16x8 lds_frag(unsigned addr) { bf16x8 r; asm volatile("ds_read_b128 %0, %1" : "=v"(r) : "v"(addr) : "memory"); return r; }
DI f32x2 lds_rd8(unsigned addr) { f32x2 r; asm volatile("ds_read_b64 %0, %1\n\ts_waitcnt lgkmcnt(0)" : "=v"(r) : "v"(addr) : "memory"); return r; }
DI void mlc_issue(Ctx& F, int cid, int w, int lane) {
    const int b = cid >> 8, h = (cid >> 6) & 3, n = cid & 63, t0 = b * SEQ + n * CH, g = lane >> 4, ln = lane & 15;
    const bf16* PROJ = (const bf16*)(F.ws + WS_PROJ); const bf16* CT = (const bf16*)(F.ws + WS_MLCT) + (size_t)cid * 8192;
    DMA16(PROJ + (size_t)(t0 + 16 * (w >> 1) + ln) * NPROJ + 256 + h * 64 + 32 * (w & 1) + 8 * g, F.lds + CS_K + w * 1024);
    DMA16(PROJ + (size_t)(t0 + 16 * (w >> 1) + ln) * NPROJ + h * 64 + 32 * (w & 1) + 8 * g, F.lds + CS_Q + w * 1024);
#pragma unroll
    for (int ks = 0; ks < 2; ++ks) DMA16(CT + (2 * w + ks) * 512 + lane * 8, F.lds + CS_CT + (2 * w + ks) * 1024);
#pragma unroll
    for (int q = 0; q < 2; ++q) { const int j = 2 * w + q; DMA16(PROJ + (size_t)(t0 + 4 * j + g) * NPROJ + 512 + h * 128 + 8 * ln, F.lds + CS_V + j * 1024); }
    __builtin_amdgcn_global_load_lds((const unsigned*)((const float*)(F.ws + WS_MLNP) + (size_t)cid * 64 + lane), (LAS unsigned*)(F.lds + CS_NP), 4, 0, 0);
#pragma unroll
    for (int q = 0; q < 2; ++q) { const int j = 2 * w + q; DMA16(PROJ + (size_t)(t0 + 4 * j + g) * NPROJ + 1024 + h * 128 + 8 * ln, F.lds + CS_OG + j * 1024); }
    const float* GT = (const float*)(F.ws + WS_GATES);
    __builtin_amdgcn_global_load_lds((const unsigned*)(GT + (size_t)(t0 + lane) * 16 + h), (LAS unsigned*)(F.lds + CS_GI), 4, 0, 0);
    __builtin_amdgcn_global_load_lds((const unsigned*)(GT + (size_t)(t0 + lane) * 16 + 4 + h), (LAS unsigned*)(F.lds + CS_GF), 4, 0, 0);
    __builtin_amdgcn_global_load_lds((const unsigned*)((const float*)(F.ws + WS_MLMP) + cid), (LAS unsigned*)(F.lds + CS_MP), 4, 0, 0);
}
DI void gdc_issue(Ctx& F, int cid, int w, int lane) {
    const int g = lane >> 4, ln = lane & 15;
    const bf16* SPT = (const bf16*)(F.ws + WS_GDSP) + (size_t)cid * 16384; const bf16* QG = (const bf16*)(F.ws + WS_GDQG) + (size_t)cid * 8192;
    const bf16* VNT = (const bf16*)(F.ws + WS_GDVN) + (size_t)cid * 8192; const bf16* QKD = (const bf16*)(F.ws + WS_GDQK) + (size_t)cid * 4096;
#pragma unroll
    for (int ks = 0; ks < 4; ++ks) DMA16(SPT + (4 * w + ks) * 512 + lane * 8, F.lds + GS_SP + (4 * w + ks) * 1024);
#pragma unroll
    for (int q = 0; q < 2; ++q) { const int bq = 2 * w + q; DMA16(QG + (size_t)(16 * (bq >> 2) + ln) * 128 + 32 * (bq & 3) + 8 * g, F.lds + GS_QG + bq * 1024); }
#pragma unroll
    for (int ks = 0; ks < 2; ++ks) DMA16(VNT + (2 * w + ks) * 512 + lane * 8, F.lds + GS_VN + (2 * w + ks) * 1024);
    DMA16(QKD + w * 512 + lane * 8, F.lds + GS_QK + w * 1024);
    { const int b = cid >> 8, h = (cid >> 6) & 3, n = cid & 63, t0 = b * SEQ + n * CH; const bf16* PROJ = (const bf16*)(F.ws + WS_PROJ);
#pragma unroll
      for (int q = 0; q < 2; ++q) { const int j = 2 * w + q; DMA16(PROJ + (size_t)(t0 + 4 * j + g) * NPROJ + 3072 + h * 128 + 8 * ln, F.lds + GS_Z + j * 1024); } }
}
constexpr int GS_NW = 125440;
DI void phase_c(Ctx& F, const Args& a, int l) {
    const int lane = F.lane, g = lane >> 4, ln = lane & 15, w = F.wave, tt = w & 3, dh = w >> 2, tl = 16 * tt + ln;
    const int h = (F.vcu >> 6) & 3, n = F.vcu & 63;
    const bf16* PROJ = (const bf16*)(F.ws + WS_PROJ); const float* GT = (const float*)(F.ws + WS_GATES); bf16* MX = (bf16*)(F.ws + WS_MIXED);
    const unsigned L0 = lds_addr(F.lds);
    LAS float* ib = (LAS float*)(F.lds + CS_SC); LAS float* Mt = ib + 64; LAS float* bcs = ib + 128;
    if (F.tid < 256) ((LAS float*)(F.lds + GS_NW))[F.tid] = (F.tid < 128) ? inp(F, 5)[(size_t)l * 512 + h * 128 + F.tid] : inp(F, 9)[(size_t)l * 128 + F.tid - 128];
    const float bi = inp(F, 3)[l * 4 + h], bf_ = inp(F, 4)[l * 4 + h];
    asm volatile("s_waitcnt vmcnt(0)" ::: "memory");
    __syncthreads();
    mlc_issue(F, F.vcu, w, lane);
    gdc_issue(F, F.vcu, w, lane);
#pragma unroll 1
    for (int i = 0; i < 8; ++i) {
        const int cid = F.vcu + 256 * i, t0 = i * SEQ + n * CH;
        asm volatile("s_waitcnt vmcnt(11)" ::: "memory");
        const float mpv = lds_rd4(L0 + CS_MP + lane * 4);
        if (w == 7) { const float gi = lds_rd4(L0 + CS_GI + lane * 4), gf = lds_rd4(L0 + CS_GF + lane * 4); const float ip = softcap15(gi + bi), fp = softcap15(gf + bf_);
            const float bc = wave_incl_sum(log_sigmoid(fp), lane), ibs = ip - bc, pm = wave_incl_max(ibs, lane);
            ib[lane] = ibs; Mt[lane] = fmaxf(mpv, pm); bcs[lane] = bc; }
        asm volatile("s_waitcnt lgkmcnt(0)" ::: "memory"); __builtin_amdgcn_s_barrier(); asm volatile("" ::: "memory");
        const float mprev = mpv;
        const float Mtt = lds_rd8(L0 + CS_SC + 256 + (tl & ~1) * 4)[tl & 1], bct = lds_rd8(L0 + CS_SC + 512 + (tl & ~1) * 4)[tl & 1];
        bf16x8 qf[2], kf[4][2];
#pragma unroll
        for (int ks = 0; ks < 2; ++ks) { qf[ks] = lds_frag(L0 + CS_Q + (tt * 2 + ks) * 1024 + lane * 16);
#pragma unroll
            for (int ms = 0; ms < 4; ++ms) kf[ms][ks] = lds_frag(L0 + CS_K + (ms * 2 + ks) * 1024 + lane * 16); }
        f32x4 ibv[4], dum_;
#pragma unroll
        for (int ms = 0; ms < 4; ++ms) g8::lds_rd2x16(L0 + CS_SC + (16 * ms + 4 * g) * 4, ibv[ms], dum_);
        asm volatile("" : "+v"(qf[0]), "+v"(qf[1]), "+v"(kf[0][0]), "+v"(kf[0][1]), "+v"(kf[1][0]), "+v"(kf[1][1]), "+v"(kf[2][0]), "+v"(kf[2][1]), "+v"(kf[3][0]), "+v"(kf[3][1]));
        f32x4 sacc[4];
#pragma unroll
        for (int ms = 0; ms < 4; ++ms) { sacc[ms] = (f32x4){0.f, 0.f, 0.f, 0.f};
#pragma unroll
            for (int ks = 0; ks < 2; ++ks) sacc[ms] = MFMA16(kf[ms][ks], qf[ks], sacc[ms]); }
#pragma unroll
        for (int ms = 0; ms < 4; ++ms)
#pragma unroll
            for (int q = 0; q < 4; ++q) { const int s_ = 16 * ms + 4 * g + q; sacc[ms][q] = (s_ <= tl) ? sacc[ms][q] * 0.125f * __expf(ibv[ms][q] - Mtt) : 0.f; }
        bf16x8 sb[2]; sb[0] = pack_frag(sacc[0], sacc[1]); sb[1] = pack_frag(sacc[2], sacc[3]);
        bf16x8 ctf[5][2]; f32x4 npa[2], npb[2];
#pragma unroll
        for (int ks = 0; ks < 2; ++ks)
#pragma unroll
            for (int mt = 0; mt < 4; ++mt) ctf[mt][ks] = lds_frag(L0 + CS_CT + ((4 * dh + mt) * 2 + ks) * 1024 + lane * 16);
        g8::lds_rd2x16(L0 + CS_NP + (8 * g) * 4, npa[0], npa[1]); g8::lds_rd2x16(L0 + CS_NP + (32 + 8 * g) * 4, npb[0], npb[1]);
        asm volatile("" : "+v"(ctf[0][0]), "+v"(ctf[0][1]), "+v"(ctf[1][0]), "+v"(ctf[1][1]), "+v"(ctf[2][0]), "+v"(ctf[2][1]), "+v"(ctf[3][0]), "+v"(ctf[3][1]));
        { float nvv[8];
#pragma unroll
          for (int j = 0; j < 4; ++j) { nvv[j] = (ln == 0) ? npa[0][j] : 0.f; nvv[4 + j] = (ln == 0) ? npa[1][j] : 0.f; }
          ctf[4][0] = __builtin_bit_cast(bf16x8, pack8(nvv));
#pragma unroll
          for (int j = 0; j < 4; ++j) { nvv[j] = (ln == 0) ? npb[0][j] : 0.f; nvv[4 + j] = (ln == 0) ? npb[1][j] : 0.f; }
          ctf[4][1] = __builtin_bit_cast(bf16x8, pack8(nvv)); }
        f32x4 xacc[5];
#pragma unroll
        for (int mt = 0; mt < 5; ++mt) { xacc[mt] = (f32x4){0.f, 0.f, 0.f, 0.f};
#pragma unroll
            for (int ks = 0; ks < 2; ++ks) xacc[mt] = MFMA16(ctf[mt][ks], qf[ks], xacc[mt]); }
        const float wint = 0.125f * __expf(mprev - Mtt);
#pragma unroll
        for (int mt = 0; mt < 5; ++mt) xacc[mt] *= wint;
        const bf16x8 ones = (ln == 0) ? (bf16x8){0x3f80, 0x3f80, 0x3f80, 0x3f80, 0x3f80, 0x3f80, 0x3f80, 0x3f80} : (bf16x8){0, 0, 0, 0, 0, 0, 0, 0};
#pragma unroll
        for (int kk = 0; kk < 2; ++kk) {
#pragma unroll
            for (int mt = 0; mt < 4; ++mt) { const bf16x8 vf = tr_frag8(L0 + CS_V, 256, 32 * kk + 4 * g, 32 * kk + 16 + 4 * g, 16 * (4 * dh + mt), lane); xacc[mt] = MFMA16(vf, sb[kk], xacc[mt]); }
            xacc[4] = MFMA16(ones, sb[kk], xacc[4]); }
        const float den = __shfl(xacc[4][0], ln), dinv = __builtin_amdgcn_rcpf(fmaxf(fabsf(den), __expf(-(bct + Mtt))));
        float ssq = 0.f;
#pragma unroll
        for (int mt = 0; mt < 4; ++mt) { xacc[mt] *= dinv; ssq += (xacc[mt][0] * xacc[mt][0] + xacc[mt][1] * xacc[mt][1]) + (xacc[mt][2] * xacc[mt][2] + xacc[mt][3] * xacc[mt][3]); }
        ssq += __shfl_xor(ssq, 16); ssq += __shfl_xor(ssq, 32);
        if (g == 0) *(LAS float*)(F.lds + CS_SC + 768 + (tl * 2 + dh) * 4) = ssq;
        u32x2 og0, og1, og2, og3; lds_rd4x8_nowait(L0 + CS_OG + tl * 256 + (16 * 4 * dh + 4 * g) * 2, og0, og1, og2, og3);
        asm volatile("s_waitcnt lgkmcnt(0)" : "+v"(og0), "+v"(og1), "+v"(og2), "+v"(og3) :: "memory"); __builtin_amdgcn_s_barrier(); asm volatile("" ::: "memory");
        if (i + 1 < 8) mlc_issue(F, cid + 256, w, lane);
        { const f32x2 s2 = lds_rd8(L0 + CS_SC + 768 + tl * 8); const float rinv = rsqrtf((s2[0] + s2[1]) * (1.f / 128.f) + 1e-6f);
#pragma unroll
          for (int mt = 0; mt < 4; ++mt) { const int dv = 16 * (4 * dh + mt) + 4 * g; const f32x4 og = unpack4(mt == 0 ? og0 : (mt == 1 ? og1 : (mt == 2 ? og2 : og3))); f32x4 nw, o; g8::lds_rd2x16(L0 + GS_NW + dv * 4, nw, dum_);
#pragma unroll
              for (int q = 0; q < 4; ++q) o[q] = xacc[mt][q] * rinv * nw[q] * sigmoidf_(og[q]);
              *(u32x2*)(MX + (size_t)(t0 + tl) * D + h * 128 + dv) = pack4(o); } }
        if (i + 1 < 8) asm volatile("s_waitcnt vmcnt(12)" ::: "memory");
        else asm volatile("s_waitcnt vmcnt(0)" ::: "memory");
        __builtin_amdgcn_s_barrier(); asm volatile("" ::: "memory");
        bf16x8 gq[4], gp[2];
#pragma unroll
        for (int ks = 0; ks < 4; ++ks) gq[ks] = lds_frag(L0 + GS_QG + (tt * 4 + ks) * 1024 + lane * 16);
#pragma unroll
        for (int ks = 0; ks < 2; ++ks) gp[ks] = lds_frag(L0 + GS_QK + (tt * 2 + ks) * 1024 + lane * 16);
        f32x4 o[4]; float sq2 = 0.f;
#pragma unroll
        for (int mt = 0; mt < 4; ++mt) { bf16x8 gs[4], gv[2];
#pragma unroll
            for (int ks = 0; ks < 4; ++ks) gs[ks] = lds_frag(L0 + GS_SP + ((4 * dh + mt) * 4 + ks) * 1024 + lane * 16);
#pragma unroll
            for (int ks = 0; ks < 2; ++ks) gv[ks] = lds_frag(L0 + GS_VN + ((4 * dh + mt) * 2 + ks) * 1024 + lane * 16);
            asm volatile("s_waitcnt lgkmcnt(0)" : "+v"(gs[0]), "+v"(gs[1]), "+v"(gs[2]), "+v"(gs[3]), "+v"(gv[0]), "+v"(gv[1]), "+v"(gq[0]), "+v"(gq[1]), "+v"(gq[2]), "+v"(gq[3]), "+v"(gp[0]), "+v"(gp[1]) :: "memory");
            o[mt] = (f32x4){0.f, 0.f, 0.f, 0.f};
#pragma unroll
            for (int ks = 0; ks < 4; ++ks) o[mt] = MFMA16(gs[ks], gq[ks], o[mt]);
#pragma unroll
            for (int ks = 0; ks < 2; ++ks) o[mt] = MFMA16(gv[ks], gp[ks], o[mt]);
            sq2 += (o[mt][0] * o[mt][0] + o[mt][1] * o[mt][1]) + (o[mt][2] * o[mt][2] + o[mt][3] * o[mt][3]); }
        sq2 += __shfl_xor(sq2, 16); sq2 += __shfl_xor(sq2, 32);
        if (g == 0) *(LAS float*)(F.lds + GS_SS + (tl * 2 + dh) * 4) = sq2;
        u32x2 z0, z1, z2, z3; lds_rd4x8_nowait(L0 + GS_Z + tl * 256 + (16 * 4 * dh + 4 * g) * 2, z0, z1, z2, z3);
        asm volatile("s_waitcnt lgkmcnt(0)" : "+v"(z0), "+v"(z1), "+v"(z2), "+v"(z3) :: "memory"); __builtin_amdgcn_s_barrier(); asm volatile("" ::: "memory");
        if (i + 1 < 8) gdc_issue(F, cid + 256, w, lane);
        { const f32x2 s2 = lds_rd8(L0 + GS_SS + tl * 8); const float rinv = rsqrtf((s2[0] + s2[1]) * (1.f / 128.f) + 1e-6f);
#pragma unroll
          for (int mt = 0; mt < 4; ++mt) { const int dv = 16 * (4 * dh + mt) + 4 * g; const f32x4 z = unpack4(mt == 0 ? z0 : (mt == 1 ? z1 : (mt == 2 ? z2 : z3))); f32x4 nw, r; g8::lds_rd2x16(L0 + GS_NW + 512 + dv * 4, nw, dum_);
#pragma unroll
              for (int q = 0; q < 4; ++q) r[q] = o[mt][q] * rinv * nw[q] * z[q] * sigmoidf_(z[q]);
              *(u32x2*)(MX + (size_t)(t0 + tl) * D + 512 + h * 128 + dv) = pack4(r); } }
    }
    asm volatile("s_waitcnt vmcnt(0)" ::: "memory"); __syncthreads();
}
struct P2Order {
    unsigned char* ws; int G, c0;
    DI bool next(int i, g8::Unit& u) const {
        const int L = i * G + c0; if (L >= 1024) return false;
        const int q = L & 511, t4 = q & 3, h = (q >> 2) & 3, b = (q >> 4) & 7, l = q >> 7;
        if (L < 512) { u.a = (const char*)(ws + WS_KV) + ((size_t)(2 * l) * 2048 + b * 256) * 2048 + h * 512; u.b = (const char*)(ws + WS_WQ) + ((size_t)l * 1024 + t4 * 256) * 2048 + h * 512;
            u.c = (char*)(ws + WS_WQK) + ((size_t)(l * 8 + b) * 1024 + h * 256) * 2048 + t4 * 512; u.aux = -1; }
        else { u.a = (const char*)(ws + WS_WO) + ((size_t)l * 1024 + t4 * 256) * 2048 + h * 512; u.b = (const char*)(ws + WS_KV) + ((size_t)(2 * l + 1) * 2048 + b * 256) * 2048 + h * 512;
            u.c = (char*)(ws + WS_WVO) + ((size_t)(l * 8 + b) * 1024 + t4 * 256) * 2048 + h * 512; u.aux = 0; }
        u.pm = 0; u.pn = 0; return true;
    }
};

constexpr int NPH_LAYER = 13, NPH = 3 + NL * NPH_LAYER;
__global__ void __launch_bounds__(NTHREADS, 2) mega(Args a) {
    extern __shared__ __attribute__((aligned(16))) unsigned char lds_raw[];
    Ctx F; F.lds = (LAS unsigned char*)0u; F.ws = a.ws; F.ctl = (unsigned*)(a.ws + WS_CTL);
    F.tid = threadIdx.x; F.lane = F.tid & 63; F.wave = __builtin_amdgcn_readfirstlane(F.tid >> 6); F.G = gridDim.x;
    { const int bx = blockIdx.x; F.vcu = (F.G % 8 == 0) ? (bx % 8) * (F.G / 8) + bx / 8 : bx; }
    volatile LAS unsigned* MISC = (volatile LAS unsigned*)(F.lds + LDS_MISC);
    if (F.tid < 64) MISC[F.tid] = 0u;
    if ((unsigned)(size_t)(LAS unsigned char*)lds_raw != 0u) { if (F.tid == 0) atomicAdd(F.ctl + CW_BAR + XB_TMO, 1u); }
    if (F.tid < 28) { const unsigned long long pv = (unsigned long long)(F.tid < 27 ? (const void*)a.in[F.tid] : (const void*)a.out); ((LAS unsigned long long*)(F.lds + LDS_PTAB))[F.tid] = pv; }
    __syncthreads();
    const bool multi = (a.ph_hi - a.ph_lo) > 1;
    XcdBarrier bar; bar.bar = F.ctl + CW_BAR; bar.x = 0; bar.st = MISC;
    if (multi) bar = xcd_barrier_post(F.ctl + CW_BAR, MISC);
    if (PROF_MASK) { if (blockIdx.x == 0 && threadIdx.x == 0) { volatile LAS unsigned long long* pw = (volatile LAS unsigned long long*)(F.lds + LDS_MISC + 128); const unsigned long long t0_ = __builtin_amdgcn_s_memrealtime(); pw[0] = t0_; pw[1] = 0ull; pw[2] = t0_; } }
#ifndef PMASK
#define PMASK 0xffff
#endif
#define EN(j) (((PMASK) >> (j)) & 1)
#ifndef REPMASK
#define REPMASK 0x0
#endif
#define NREP(j) ((((REPMASK) >> (j)) & 1) ? 2 : 1)
#if REPMASK
#define REPLOOP(j) for (int rep_ = 0; rep_ < NREP(j); ++rep_, __syncthreads())
#else
#define REPLOOP(j)
#endif
#define PH(k) (a.ph_lo <= (k) && (k) < a.ph_hi && (refresh(F, a.ws), true))
#define PROF_TICK(k) do { if (PROF_MASK) { if (blockIdx.x == 0 && threadIdx.x == 0) { volatile LAS unsigned long long* pw = (volatile LAS unsigned long long*)(F.lds + LDS_MISC + 128); \
        const unsigned long long now_ = __builtin_amdgcn_s_memrealtime(); const int j_ = ((k) < 3) ? 13 + (k) : ((k) - 3) % NPH_LAYER; \
        if (((PROF_MASK) >> j_) & 1) pw[1] += now_ - pw[0]; pw[0] = now_; } } } while (0)
#define SEAM(k) do { if (PH(k) && PH((k) + 1)) { xcd_barrier(bar); if (((REPMASK) >> 16) & 1) xcd_barrier(bar); PROF_TICK(k); } } while (0)

    if (EN(13) && PH(0)) REPLOOP(13) { phase_convert(F, a); }
    SEAM(0);
    if (EN(14) && PH(1)) REPLOOP(14) {
        g8::AffineOrder S; S.A = (const char*)(F.ws + WS_MEMB); S.B = (const char*)(F.ws + WS_WKV); S.C = (char*)(F.ws + WS_KV);
        S.aM = 256ull * 2048; S.bB = 0; S.bN = 256ull * 2048; S.cM = 256ull * 2048; S.cS = 2048ull * 2048; S.cN = 512; S.nM = 8; S.nN = 32; S.bdiv = 1 << 30; S.csp = 4; S.G = F.G; S.c0 = F.vcu;
        g8::EpiBf16 E{1024, nullptr, 0, 1.f};
        g8::gemm_phase(F.lds, 2048, 2048, 16, S, E);
        row_pass<0>(F, a, 0);
    }
    SEAM(1);
    if (EN(15) && PH(2)) REPLOOP(15) { P2Order S{F.ws, F.G, F.vcu}; g8::EpiBf16 E{1024, nullptr, 0, 0.0625f}; g8::gemm_phase(F.lds, 2048, 2048, 4, S, E); }
    SEAM(2);
#pragma unroll 1
    for (int l = 0; l < NL; ++l) {
        const int pb = 3 + l * NPH_LAYER;
        if (EN(0) && PH(pb + 0)) REPLOOP(0) {
            g8::AffineOrder S = g8::dense_order(F.ws + WS_XB, F.ws + WS_WIN + (size_t)l * NPROJ * D * 2, F.ws + WS_PROJ, T, NPROJ, D, NPROJ * 2, 2, F.G, F.vcu);
            g8::EpiBf16 E{NPROJ, nullptr, 0, 1.f}; g8::gemm_phase(F.lds, 2048, 2048, 16, S, E);
        }
        SEAM(pb + 0);
        if (EN(1) && PH(pb + 1)) REPLOOP(1) {
            phase_a(F, a, l);
        }
        SEAM(pb + 1);
        if (EN(2) && PH(pb + 2)) REPLOOP(2) {
            if (F.tid < 8) ((volatile LAS unsigned*)(F.lds + GB_FLAGS))[F.tid] = 0u;
            __syncthreads();
            if (F.wave == 0) gd_b_task(F, F.vcu);
            else if (F.wave <= 2) gd_b_loader(F, F.vcu, F.wave - 1);
            else if (F.wave >= 4) ml_b_unit(F, F.vcu);
        }
        SEAM(pb + 2);
        if (EN(3) && PH(pb + 3)) REPLOOP(3) {
            phase_c(F, a, l);
        }
        SEAM(pb + 3);
        if (EN(4) && PH(pb + 4)) REPLOOP(4) {
            g8::AffineOrder S = g8::dense_order(F.ws + WS_MIXED, F.ws + WS_WOUT + (size_t)l * D * D * 2, F.ws + WS_HB, T, D, D, D * 2, 2, F.G, F.vcu);
            g8::EpiBf16 E{D, nullptr, 0, 1.f}; g8::gemm_phase(F.lds, 2048, 2048, 16, S, E);
        }
        SEAM(pb + 4);
        if (EN(5) && PH(pb + 5)) { row_pass<1>(F, a, l); if (NREP(5) == 2) { __syncthreads(); row_pass<1>(F, a, l, true); } }
        SEAM(pb + 5);
        if (EN(6) && PH(pb + 6)) REPLOOP(6) {
            g8::AffineOrder S = g8::dense_order(F.ws + WS_XB, F.ws + WS_WQK + (size_t)l * 8 * D * D * 2, F.ws + WS_PB, T, D, D, D * 2, 2, F.G, F.vcu);
            S.bB = (size_t)D * D * 2; S.bdiv = 16;
            g8::EpiSoftmax E{D}; g8::gemm_phase(F.lds, 2048, 2048, 16, S, E);
        }
        SEAM(pb + 6);
        if (EN(7) && PH(pb + 7)) REPLOOP(7) {
            g8::AffineOrder S = g8::dense_order(F.ws + WS_PB, F.ws + WS_WVO + (size_t)l * 8 * D * D * 2, F.ws + WS_HB, T, D, D, D * 2, 2, F.G, F.vcu);
            S.bB = (size_t)D * D * 2; S.bdiv = 16;
            g8::EpiBf16 E{D, nullptr, 0, 1.f}; g8::gemm_phase(F.lds, 2048, 2048, 16, S, E);
        }
        SEAM(pb + 7);
        if (EN(8) && PH(pb + 8)) { row_pass<2>(F, a, l); if (NREP(8) == 2) { __syncthreads(); row_pass<2>(F, a, l, true); } }
        SEAM(pb + 8);
        if (EN(9) && PH(pb + 9)) phase_scatter(F, l);
        SEAM(pb + 9);
        if (EN(10) && PH(pb + 10)) REPLOOP(10) {
            MoeOrder S; S.gather = 1; S.rev = 0; S.A = (const char*)(F.ws + WS_XB); S.B = (const char*)(F.ws + WS_WGU) + (size_t)l * 32 * 2048 * D * 2; S.C = (char*)(F.ws + WS_ACT); S.tile_e = F.ctl + CW_TILE_E + l * MAXTILES;
            S.NT = __builtin_amdgcn_readfirstlane((int)ldu(F.ctl + CW_NT + l)); S.nN = 8; S.bE = 2048ull * D * 2; S.bN = 256ull * 2048; S.cN = 256; S.G = F.G; S.c0 = F.vcu;
            g8::EpiSwiglu E{inp(F, 22) + (size_t)l * 32 * 2048}; g8::gemm_phase<g8::EpiSwiglu, MoeOrder, true>(F.lds, 2048, 2048, 16, S, E, (const unsigned*)(F.ws + WS_XG));
        }
        SEAM(pb + 10);
        if (EN(11) && PH(pb + 11)) REPLOOP(11) {
            MoeOrder S; S.gather = 0; S.rev = 1; S.A = (const char*)(F.ws + WS_ACT); S.B = (const char*)(F.ws + WS_WDN) + (size_t)l * 32 * D * D * 2; S.C = (char*)(F.ws + WS_Y); S.tile_e = F.ctl + CW_TILE_E + l * MAXTILES;
            S.NT = __builtin_amdgcn_readfirstlane((int)ldu(F.ctl + CW_NT + l)); S.nN = 4; S.bE = (size_t)D * D * 2; S.bN = 256ull * 2048; S.cN = 512; S.G = F.G; S.c0 = F.vcu;
            g8::EpiBf16 E{D, inp(F, 24) + (size_t)l * 32 * D, D, 1.f}; g8::gemm_phase(F.lds, 2048, 2048, 16, S, E);
        }
        SEAM(pb + 11);
        if (EN(12) && PH(pb + 12)) { row_pass<3>(F, a, l); if (NREP(12) == 2 && l < NL - 1) { __syncthreads(); row_pass<3>(F, a, l, true); } }
        SEAM(pb + 12);
    }
    if (PROF_MASK) {
        refresh(F, a.ws);
        xcd_barrier(bar); PROF_TICK(NPH - 1);
        if (blockIdx.x == 0 && threadIdx.x == 0) { volatile LAS unsigned long long* pw = (volatile LAS unsigned long long*)(F.lds + LDS_MISC + 128);
            const float f = (float)(double)pw[1] / (float)(double)(pw[0] - pw[2]); const float q = fminf(1.f, floorf(f * (float)(PROF_SCALE) * 32.f + (float)(PROF_OFS) * 0.5f) * (1.f / 32.f));
            __hip_atomic_store(F.ctl + CW_DBG, __float_as_uint(sqrtf(100.f * q)), __ATOMIC_RELAXED, __HIP_MEMORY_SCOPE_AGENT); }
        xcd_barrier(bar);
        const float c = __uint_as_float(ldu(F.ctl + CW_DBG)); float* o = (float*)inp(F, 27);
        for (size_t i = (size_t)blockIdx.x * NTHREADS + threadIdx.x; i < (size_t)T * D; i += (size_t)gridDim.x * NTHREADS) o[i] = c;
    }
}

#ifndef DBG_STOP
#define DBG_STOP 0
#endif
#ifndef DBG_OFF
#define DBG_OFF WS_XB
#endif
#ifndef DBG_N
#define DBG_N ((size_t)T * D)
#endif
#ifndef DBG_F32
#define DBG_F32 0
#endif
__global__ void dbg_dump(const unsigned char* ws, float* out, size_t off) {
    const bf16* b = (const bf16*)(ws + off); const float* f = (const float*)(ws + off);
    for (size_t i = (size_t)blockIdx.x * blockDim.x + threadIdx.x; i < (size_t)T * D; i += (size_t)gridDim.x * blockDim.x) out[i] = (i < (size_t)(DBG_N)) ? (DBG_F32 ? f[i] : bf2f(b[i])) : 0.f;
}
#ifndef N_LAUNCH_MODE
#define N_LAUNCH_MODE 1
#endif
extern "C" void kernel_launch(void* const* d_in, const int* in_sizes, int n_in, void* d_out, int out_size, void* d_ws, size_t ws_size, hipStream_t stream) {
    static int ready = 0;
    if (ready == 0) {
        if (n_in != 27 || ws_size < WS_END) { fprintf(stderr, "kernel_launch: need 27 inputs and %zu bytes of workspace (got %d, %zu)\n", (size_t)WS_END, n_in, ws_size); ready = -1; return; }
        if (hipFuncSetAttribute((const void*)mega, hipFuncAttributeMaxDynamicSharedMemorySize, LDS_BYTES) != hipSuccess) { fprintf(stderr, "kernel_launch: hipFuncSetAttribute failed\n"); ready = -1; return; }
        int per_cu = 0; (void)hipOccupancyMaxActiveBlocksPerMultiprocessor(&per_cu, (const void*)mega, NTHREADS, LDS_BYTES); (void)hipGetLastError();
        ready = 1;
    }
    if (ready < 0) return;
    (void)hipMemsetAsync((char*)d_ws + WS_CTL, 0, 1 << 20, stream);
    (void)hipMemsetAsync((char*)d_ws + WS_XG, 0, (size_t)CAP * 4, stream);
    Args a{};
    for (int i = 0; i < 27; ++i) a.in[i] = (const float*)d_in[i];
    a.out = (float*)d_out; a.ws = (unsigned char*)d_ws;
#if N_LAUNCH_MODE == 1
    a.ph_lo = 0; a.ph_hi = (DBG_STOP > 0 ? DBG_STOP : NPH);
    hipLaunchKernelGGL(mega, dim3(256), dim3(NTHREADS), LDS_BYTES, stream, a);
    if (DBG_STOP > 0) hipLaunchKernelGGL(dbg_dump, dim3(2048), dim3(256), 0, stream, (const unsigned char*)d_ws, (float*)d_out, (size_t)(DBG_OFF));
#else
    for (int p = 0; p < (DBG_STOP > 0 ? DBG_STOP : NPH); ++p) { a.ph_lo = p; a.ph_hi = p + 1; hipLaunchKernelGGL(mega, dim3(256), dim3(NTHREADS), LDS_BYTES, stream, a); }
    if (DBG_STOP > 0) hipLaunchKernelGGL(dbg_dump, dim3(2048), dim3(256), 0, stream, (const unsigned char*)d_ws, (float*)d_out, (size_t)(DBG_OFF));
#endif
}
```

```cpp
#include <hip/hip_runtime.h>
#include <cstdio>
#include <cstdint>
#define PROF_SCALE 16
#define PROF_OFS 1
#ifndef PROF_MASK
#define PROF_MASK 0x0
#endif

#define LAS __attribute__((address_space(3)))
typedef unsigned short bf16;
typedef short bf16x8 __attribute__((ext_vector_type(8)));
typedef short s16x4 __attribute__((ext_vector_type(4)));
typedef float f32x4 __attribute__((ext_vector_type(4)));
typedef float f32x2 __attribute__((ext_vector_type(2)));
typedef unsigned u32x4 __attribute__((ext_vector_type(4)));
typedef unsigned u32x2 __attribute__((ext_vector_type(2)));
#define DI __device__ __forceinline__
#define GAS __attribute__((address_space(1)))

constexpr int T = 32768, D = 1024, NB = 8, SEQ = 4096, NL = 4, NCH = 64, CH = 64;
constexpr int NPROJ = 3584;
constexpr int NE = 32, TOPK = 4;
constexpr int MAXTILES = 544, CAP = MAXTILES * 256;
constexpr float DN_ALPHA = 1.6817928305074290f;
constexpr int NWAVES = 8, NTHREADS = 512;
constexpr int LDS_RING = 131072, LDS_X = 131072  , LDS_MISC = 163840 - 4096, LDS_BYTES = 163840;

constexpr size_t MiB = 1ull << 20;
constexpr size_t WS_CTL = 0;
constexpr size_t WS_WIN = 1 * MiB;
constexpr size_t WS_WGATE = WS_WIN + 4ull * NPROJ * D * 2;
constexpr size_t WS_WRT = WS_WGATE + 4ull * 2 * 16 * D * 2;
constexpr size_t WS_WOUT = WS_WRT + 4ull * 2 * 32 * D * 2;
constexpr size_t WS_WQ = WS_WOUT + 4ull * D * D * 2;
constexpr size_t WS_WKV = WS_WQ + 4ull * D * D * 2;
constexpr size_t WS_WO = WS_WKV + 8ull * D * D * 2;
constexpr size_t WS_WGU = WS_WO + 4ull * D * D * 2;
constexpr size_t WS_WDN = WS_WGU + 4ull * 32 * 2048 * D * 2;
constexpr size_t WS_MEMB = WS_WDN + 4ull * 32 * D * D * 2;
constexpr size_t WS_KV = WS_MEMB + 2048ull * D * 2;
constexpr size_t WS_WQK = WS_KV + 8ull * 2048 * D * 2;
constexpr size_t WS_WVO = WS_WQK + 32ull * D * D * 2;
constexpr size_t WS_XB = WS_WVO + 32ull * D * D * 2;
constexpr size_t WS_PROJ = WS_XB + (size_t)T * D * 2;
constexpr size_t WS_GATES = WS_PROJ + (size_t)T * NPROJ * 2;
constexpr size_t WS_MIXED = WS_GATES + (size_t)T * 16 * 4;
constexpr size_t WS_HB = WS_MIXED + (size_t)T * D * 2;
constexpr size_t WS_PB = WS_HB + (size_t)T * D * 2;
constexpr size_t WS_TOPE = WS_PB + (size_t)T * D * 2;
constexpr size_t WS_TOPP = WS_TOPE + (size_t)T * 16;
constexpr size_t WS_TOPG = WS_TOPP + (size_t)T * 16;
constexpr size_t WS_SLOT = WS_TOPG + (size_t)T * 16;
constexpr size_t WS_XG = WS_SLOT + (size_t)T * 16;
constexpr size_t WS_ACT = WS_XG + (size_t)CAP * D * 2;
constexpr size_t WS_Y = WS_ACT + (size_t)CAP * D * 2;
constexpr size_t WS_MLU = WS_Y + (size_t)CAP * D * 2;
constexpr size_t WS_MLKN = WS_MLU + 2048ull * 8192 * 4;
constexpr size_t WS_MLSC = WS_MLKN + 2048ull * 64 * 4;
constexpr size_t WS_MLCT = WS_MLSC + 2048ull * 16;
constexpr size_t WS_MLNP = WS_MLCT + 2048ull * 8192 * 2;
constexpr size_t WS_MLMP = WS_MLNP + 2048ull * 64 * 4;
constexpr size_t WS_GDUT = WS_MLMP + 2048ull * 4;
constexpr size_t WS_GDW = WS_GDUT + 2048ull * 8192 * 2;
constexpr size_t WS_GDKE = WS_GDW + 2048ull * 8192 * 2;
constexpr size_t WS_GDQG = WS_GDKE + 2048ull * 8192 * 2;
constexpr size_t WS_GDQK = WS_GDQG + 2048ull * 8192 * 2;
constexpr size_t WS_GDGL = WS_GDQK + 2048ull * 4096 * 2;
constexpr size_t WS_GDVN = WS_GDGL + 2048ull * 4;
constexpr size_t WS_GDSP = WS_GDVN + 2048ull * 8192 * 2;
constexpr size_t WS_END = WS_GDSP + 2048ull * 16384 * 2;
constexpr int CW_BAR = 1024, CW_NT = 8192 + 256, CW_TILE_E = 8192 + 512, CW_DBG = 16384, CW_ECNT = 32768;

typedef __bf16 bf16x2_t __attribute__((ext_vector_type(2)));
DI unsigned cvt_pk_bf16(float lo, float hi) { const f32x2 v = {lo, hi}; const bf16x2_t r = __builtin_convertvector(v, bf16x2_t); return __builtin_bit_cast(unsigned, r); }
DI bf16 f2bf(float f) { return (bf16)(cvt_pk_bf16(f, 0.f) & 0xffffu); }
DI float bf2f(bf16 b) { return __uint_as_float(((unsigned)b) << 16); }
DI float bflo(unsigned w) { return __uint_as_float(w << 16); }
DI float bfhi(unsigned w) { return __uint_as_float(w & 0xffff0000u); }
DI float sigmoidf_(float x) { return __builtin_amdgcn_rcpf(1.f + __expf(-x)); }
DI float wave_sum(float v) {
#pragma unroll
    for (int o = 1; o < 64; o <<= 1) v += __shfl_xor(v, o);
    return v;
}
DI float wave_max(float v) {
#pragma unroll
    for (int o = 1; o < 64; o <<= 1) v = fmaxf(v, __shfl_xor(v, o));
    return v;
}
#define LDS_WAIT() asm volatile("s_waitcnt lgkmcnt(0)" ::: "memory")
#define VM_WAIT() asm volatile("s_waitcnt vmcnt(0)" ::: "memory")
#define MFMA16(a, b, c) __builtin_amdgcn_mfma_f32_16x16x32_bf16((a), (b), (c), 0, 0, 0)

#define XB_TMO      128
#define XB_XCNT(j)  (256  + 64 * (j))
#define XB_XSUB(j)  (1280 + 64 * (j))
#define XB_XGEN(j)  (2304 + 64 * (j))
#define XB_TOP      3328
#define XB_TOPGEN   3392
#define XCD_BAR_WORDS 3456
#define XB_SPIN_CAP (1u << 22)
__device__ __forceinline__ unsigned xb_ld(unsigned* p)              { return __hip_atomic_load(p, __ATOMIC_RELAXED, __HIP_MEMORY_SCOPE_AGENT); }
__device__ __forceinline__ unsigned xb_add(unsigned* p, unsigned v) { return __hip_atomic_fetch_add(p, v, __ATOMIC_RELAXED, __HIP_MEMORY_SCOPE_AGENT); }
__device__ __forceinline__ unsigned xb_xcc_id() { return (unsigned)__builtin_amdgcn_s_getreg((3 << 11) | 20) & 0xFu; }
#define XB_SPIN(cond, bar) do { unsigned _sp = 0; while (cond) { __builtin_amdgcn_s_sleep(1); \
    if ((++_sp & 255u) == 0u) { if (xb_ld(&(bar)[XB_TMO])) break; if (_sp > XB_SPIN_CAP) { atomicAdd(&(bar)[XB_TMO], 1u); break; } } } } while (0)
struct XcdBarrier { unsigned* bar; unsigned x; volatile LAS unsigned* st; };
__device__ __forceinline__ XcdBarrier xcd_barrier_post(unsigned* bar, volatile LAS unsigned* st) {
    XcdBarrier b; b.bar = bar; b.x = xb_xcc_id(); b.st = st;
    if (threadIdx.x == 0) (void)xb_add(&bar[XB_XCNT(b.x)], 1u);
    return b;
}
__device__ __attribute__((noinline)) unsigned long long xcd_barrier_complete(unsigned* bar, unsigned x) {
    const unsigned G = gridDim.x * gridDim.y * gridDim.z;
    unsigned sum, cnt, mine, sp = 0u;
    for (;;) {
        sum = 0u; cnt = 0u; mine = 0u;
#pragma unroll
        for (unsigned j = 0; j < 16; ++j) { const unsigned c = xb_ld(&bar[XB_XCNT(j)]); sum += c; cnt += (c > 0u) ? 1u : 0u; mine = (j == x) ? c : mine; }
        if (sum == G) break;
        __builtin_amdgcn_s_sleep(1);
        if ((++sp & 255u) == 0u) { if (xb_ld(&bar[XB_TMO])) break; if (sp > XB_SPIN_CAP) { atomicAdd(&bar[XB_TMO], 1u); break; } }
    }
    const unsigned nloc = mine > 0u ? mine : 1u, nx = cnt > 0u ? cnt : 1u;
    return ((unsigned long long)nx << 32) | nloc;
}
__device__ __forceinline__ void xcd_barrier(const XcdBarrier& b) {
    asm volatile("s_waitcnt vmcnt(0)" ::: "memory");
    __syncthreads();
    if (threadIdx.x == 0) {
        unsigned* bar = b.bar;
        __builtin_amdgcn_s_waitcnt(0);
        unsigned nloc = b.st[0], nx = b.st[1];
        if (nloc == 0u) { const unsigned long long r = xcd_barrier_complete(bar, b.x); nloc = (unsigned)r; nx = (unsigned)(r >> 32); b.st[0] = nloc; b.st[1] = nx; }
        const unsigned old = xb_add(&bar[XB_XSUB(b.x)], 1u);
        const unsigned gen = old / nloc;
        if (old + 1u == (gen + 1u) * nloc) {
            __builtin_amdgcn_fence(__ATOMIC_RELEASE, "agent");
            asm volatile("s_waitcnt vmcnt(0)" ::: "memory");
            const unsigned og = xb_add(&bar[XB_TOP], 1u);
            const unsigned tg = og / nx;
            if (og + 1u == (tg + 1u) * nx) xb_add(&bar[XB_TOPGEN], 1u);
            else XB_SPIN(xb_ld(&bar[XB_TOPGEN]) == tg, bar);
            __builtin_amdgcn_fence(__ATOMIC_ACQUIRE, "agent");
            xb_add(&bar[XB_XGEN(b.x)], 1u);
            asm volatile("s_waitcnt vmcnt(0)" ::: "memory");
        } else {
            XB_SPIN(xb_ld(&bar[XB_XGEN(b.x)]) == gen, bar);
            __builtin_amdgcn_fence(__ATOMIC_ACQUIRE, "agent");
            asm volatile("s_waitcnt vmcnt(0)" ::: "memory");
        }
    }
    __syncthreads();
}

namespace g8 {
constexpr int BM = 256, BK = 64, HALF = 128, HTB = HALF * BK * 2;
__host__ __device__ __forceinline__ int lds_byte(int r, int c) { const int st = (r >> 4) * 2 + (c >> 5), rr = r & 15, cc = c & 31, ob = rr * 64 + cc * 2; return st * 1024 + (ob ^ (((ob >> 9) & 1) << 5)); }
__host__ __device__ __forceinline__ void stage_rc(int b, int& R, int& C) { const int st = b / 1024, sb = b % 1024, swz = sb ^ (((sb >> 9) & 1) << 5); R = (st >> 1) * 16 + swz / 64; C = (st & 1) * 32 + (swz % 64) / 2; }
__host__ __device__ __forceinline__ int perm32(int rho) { const int n = rho >> 4, i = rho & 15; return 8 * (i >> 2) + 4 * n + (i & 3); }

struct Unit { const char* a; const char* b; char* c; int pm, pn, aux; };
DI void tile_of(int L, int nM, int nN, int& pm, int& pn) {
    const int nig = 8 * nN, gid = L / nig, fm = gid * 8, gsz = (nM - fm) < 8 ? (nM - fm) : 8, w = L % nig;
    pm = fm + (w % gsz); pn = w / gsz;
}
struct AffineOrder {
    const char* A; const char* B; char* C; size_t aM, bB, bN, cM, cS, cN; int nM, nN, bdiv, csp, G, c0;
    DI bool next(int i, Unit& u) const {
        const int L = i * G + c0; if (L >= nM * nN) return false;
        int pm, pn; tile_of(L, nM, nN, pm, pn); u.pm = pm; u.pn = pn; u.aux = 0;
        u.a = A + (size_t)pm * aM; u.b = B + (size_t)(pm / bdiv) * bB + (size_t)pn * bN; u.c = C + (size_t)pm * cM + (size_t)(pn / csp) * cS + (size_t)(pn % csp) * cN; return true;
    }
};
DI AffineOrder dense_order(const void* A, const void* B, void* C, int M, int N, int K, int ldc_bytes, int esz, int G, int c0) {
    AffineOrder o; o.A = (const char*)A; o.B = (const char*)B; o.C = (char*)C; o.aM = 256ull * K * 2; o.bB = 0; o.bN = 256ull * K * 2; o.cM = 256ull * ldc_bytes; o.cS = 0; o.cN = 256ull * esz;
    o.nM = M / 256; o.nN = N / 256; o.bdiv = 1 << 30; o.csp = 1 << 30; o.G = G; o.c0 = c0; return o;
}

DI void lds_rd2x16(unsigned addr, f32x4& a, f32x4& b) { asm volatile("ds_read_b128 %0, %2\n\tds_read_b128 %1, %2 offset:16\n\ts_waitcnt lgkmcnt(0)" : "=&v"(a), "=&v"(b) : "v"(addr) : "memory"); }
struct EpiBf16 {
    static constexpr bool PERM = true;
    int ldc; const float* bias; int bias_stride; float scl;
    DI void issue(const Unit& u, LAS unsigned char* lds, int wid, int lane) const {
        if (bias) __builtin_amdgcn_global_load_lds((const unsigned*)(bias + (size_t)u.aux * bias_stride + u.pn * 256 + (lane >> 5) * HALF + (wid & 3) * 32 + (lane & 31)), (LAS unsigned*)(lds + LDS_X + wid * 256), 4, 0, 0);
    }
    DI void operator()(f32x4 (&acc)[2][2][4][2], const Unit& u, int wr, int wc, int fr, int fq, LAS unsigned char* lds) const {
        const int col0 = wc * 32 + 8 * fq; const float sc = (u.aux < 0) ? scl : 1.f;
        f32x4 bv[2][2];
#pragma unroll
        for (int bj = 0; bj < 2; ++bj) { if (bias) lds_rd2x16((unsigned)(size_t)lds + LDS_X + (wr * 4 + wc) * 256 + bj * 128 + fq * 32, bv[bj][0], bv[bj][1]); else { bv[bj][0] = (f32x4){0.f, 0.f, 0.f, 0.f}; bv[bj][1] = (f32x4){0.f, 0.f, 0.f, 0.f}; } }
#pragma unroll
        for (int ai = 0; ai < 2; ++ai)
#pragma unroll
            for (int m = 0; m < 4; ++m) { bf16* rowp = (bf16*)u.c + (size_t)(ai * HALF + wr * 64 + m * 16 + fr) * ldc + col0;
#pragma unroll
                for (int bj = 0; bj < 2; ++bj) { const f32x4 v0 = acc[ai][bj][m][0] * sc + bv[bj][0], v1 = acc[ai][bj][m][1] * sc + bv[bj][1];
                    u32x4 w; w.x = cvt_pk_bf16(v0[0], v0[1]); w.y = cvt_pk_bf16(v0[2], v0[3]); w.z = cvt_pk_bf16(v1[0], v1[1]); w.w = cvt_pk_bf16(v1[2], v1[3]);
                    *(u32x4*)(rowp + bj * HALF) = w; } }
    }
};
struct EpiSoftmax {
    static constexpr bool PERM = true;
    int ldc;
    DI void issue(const Unit&, LAS unsigned char*, int, int) const {}
    DI void operator()(f32x4 (&acc)[2][2][4][2], const Unit& u, int wr, int wc, int fr, int fq, LAS unsigned char* lds) const {
        LAS f32x2* X = (LAS f32x2*)(lds + LDS_X);
#pragma unroll
        for (int ai = 0; ai < 2; ++ai)
#pragma unroll
            for (int m = 0; m < 4; ++m) {
                float v = -3.0e38f;
#pragma unroll
                for (int bj = 0; bj < 2; ++bj)
#pragma unroll
                    for (int n = 0; n < 2; ++n) { const f32x4 x = acc[ai][bj][m][n]; v = fmaxf(v, fmaxf(fmaxf(x[0], x[1]), fmaxf(x[2], x[3]))); }
                v = fmaxf(v, __shfl_xor(v, 16)); v = fmaxf(v, __shfl_xor(v, 32));
                float s = 0.f;
#pragma unroll
                for (int bj = 0; bj < 2; ++bj)
#pragma unroll
                    for (int n = 0; n < 2; ++n) { f32x4 x = acc[ai][bj][m][n]; x[0] = __expf(x[0] - v); x[1] = __expf(x[1] - v); x[2] = __expf(x[2] - v); x[3] = __expf(x[3] - v); acc[ai][bj][m][n] = x; s += (x[0] + x[1]) + (x[2] + x[3]); }
                s += __shfl_xor(s, 16); s += __shfl_xor(s, 32);
                if (fq == 0) X[(ai * HALF + wr * 64 + m * 16 + fr) * 4 + wc] = (f32x2){v, s};
            }
        LDS_WAIT(); __builtin_amdgcn_s_barrier(); asm volatile("" ::: "memory");
        const int col0 = wc * 32 + 8 * fq;
#pragma unroll
        for (int ai = 0; ai < 2; ++ai)
#pragma unroll
            for (int m = 0; m < 4; ++m) {
                const int r = ai * HALF + wr * 64 + m * 16 + fr;
                const f32x4 p01 = *(const LAS f32x4*)(X + r * 4), p23 = *(const LAS f32x4*)(X + r * 4 + 2);
                const float M = fmaxf(fmaxf(p01[0], p01[2]), fmaxf(p23[0], p23[2]));
                const float S = p01[1] * __expf(p01[0] - M) + p01[3] * __expf(p01[2] - M) + p23[1] * __expf(p23[0] - M) + p23[3] * __expf(p23[2] - M);
                const float f = __expf(X[r * 4 + wc][0] - M) * __builtin_amdgcn_rcpf(S);
                bf16* rowp = (bf16*)u.c + (size_t)r * ldc + col0;
#pragma unroll
                for (int bj = 0; bj < 2; ++bj) { const f32x4 v0 = acc[ai][bj][m][0] * f, v1 = acc[ai][bj][m][1] * f;
                    u32x4 w; w.x = cvt_pk_bf16(v0[0], v0[1]); w.y = cvt_pk_bf16(v0[2], v0[3]); w.z = cvt_pk_bf16(v1[0], v1[1]); w.w = cvt_pk_bf16(v1[2], v1[3]);
                    *(u32x4*)(rowp + bj * HALF) = w; }
                asm volatile("" ::: "memory");
            }
    }
};
struct EpiSwiglu {
    static constexpr bool PERM = true;
    const float* bgu;
    DI void issue(const Unit& u, LAS unsigned char* lds, int wid, int lane) const {
        __builtin_amdgcn_global_load_lds((const unsigned*)(bgu + (size_t)u.aux * 2048 + (lane >> 5) * 1024 + u.pn * 128 + (wid & 3) * 32 + (lane & 31)), (LAS unsigned*)(lds + LDS_X + wid * 256), 4, 0, 0);
    }
    DI void operator()(f32x4 (&acc)[2][2][4][2], const Unit& u, int wr, int wc, int fr, int fq, LAS unsigned char* lds) const {
        f32x4 bg[2], bl[2];
        lds_rd2x16((unsigned)(size_t)lds + LDS_X + (wr * 4 + wc) * 256 + fq * 32, bg[0], bg[1]);
        lds_rd2x16((unsigned)(size_t)lds + LDS_X + (wr * 4 + wc) * 256 + 128 + fq * 32, bl[0], bl[1]);
#pragma unroll
        for (int ai = 0; ai < 2; ++ai)
#pragma unroll
            for (int m = 0; m < 4; ++m) {
                float o[8];
#pragma unroll
                for (int n = 0; n < 2; ++n)
#pragma unroll
                    for (int j = 0; j < 4; ++j) {
                        const float glu = fminf(acc[ai][0][m][n][j] + bg[n][j], 7.0f);
                        const float lin = fminf(fmaxf(acc[ai][1][m][n][j] + bl[n][j], -7.0f), 7.0f);
                        o[4 * n + j] = (lin + 1.0f) * glu * sigmoidf_(1.702f * glu);
                    }
                u32x4 w; w.x = cvt_pk_bf16(o[0], o[1]); w.y = cvt_pk_bf16(o[2], o[3]); w.z = cvt_pk_bf16(o[4], o[5]); w.w = cvt_pk_bf16(o[6], o[7]);
                *(u32x4*)((bf16*)u.c + (size_t)(ai * HALF + wr * 64 + m * 16 + fr) * 1024 + wc * 32 + 8 * fq) = w;
            }
    }
};

template <class Epi, class Sched, bool GATHER = false>
__device__ __forceinline__ void gemm_phase(LAS unsigned char* lds, const int lda, const int ldb, const int nt, const Sched& S, const Epi& E, const unsigned* rowtab = nullptr) {
    int tid = threadIdx.x; asm volatile("" : "+v"(tid));
    const int wid = __builtin_amdgcn_readfirstlane(tid >> 6), lane = tid & 63, wr = wid >> 2, wc = wid & 3, fr = lane & 15, fq = lane >> 4;
    unsigned voffA[2], voffB[2];
#pragma unroll
    for (int i = 0; i < 2; ++i) { int R, C; stage_rc(tid * 16 + i * 8192, R, C); const int Rb = Epi::PERM ? ((R & ~31) + perm32(R & 31)) : R;
        voffA[i] = GATHER ? 0u : (unsigned)(R * lda + C * 2); voffB[i] = (unsigned)(Rb * ldb + C * 2); }
    unsigned gc[2][2] = {{0u, 0u}, {0u, 0u}}, gn[2][2] = {{0u, 0u}, {0u, 0u}};
#define PG8_GLOAD(dst, pm_) do { int _t = tid; asm volatile("" : "+v"(_t)); _Pragma("unroll") for (int _i = 0; _i < 2; ++_i) { int _R, _C; stage_rc(_t * 16 + _i * 8192, _R, _C); \
        _Pragma("unroll") for (int _h = 0; _h < 2; ++_h) dst[_h][_i] = __hip_atomic_load(rowtab + (size_t)(pm_) * 256 + _h * 128 + _R, __ATOMIC_RELAXED, __HIP_MEMORY_SCOPE_AGENT) * (unsigned)lda + (unsigned)(_C * 2); } } while (0)
    const size_t kstep = (size_t)(BK * 2);
    const size_t hstepA = (size_t)HALF * lda, hstepB = (size_t)HALF * ldb;
    const unsigned ldsw = (unsigned)wid * 1024u;
    const int aoff = lds_byte(wr * 64 + fr, fq * 8), boff = lds_byte(wc * 32 + fr, fq * 8);
#define PG8_SA(b, h) (((b) * 2 + (h)) * HTB)
#define PG8_SB(b, h) ((4 + (b) * 2 + (h)) * HTB)
#define PG8_STAGE(bufoff, gbase, voff) do { _Pragma("unroll") for (int _i = 0; _i < 2; ++_i) \
        __builtin_amdgcn_global_load_lds((const unsigned*)((const char*)(gbase) + (voff)[_i]), (LAS unsigned*)(lds + (bufoff) + ldsw + _i * 8192), 16, 0, 0); } while (0)
#define PG8_STAGE_A(bufoff, gbase, hh, nx) do { if (GATHER) { _Pragma("unroll") for (int _i = 0; _i < 2; ++_i) \
        __builtin_amdgcn_global_load_lds((const unsigned*)((const char*)(gbase) + ((nx) ? gn[hh][_i] : gc[hh][_i])), (LAS unsigned*)(lds + (bufoff) + ldsw + _i * 8192), 16, 0, 0); } \
        else PG8_STAGE(bufoff, (gbase) + (hh) * hstepA, voffA); } while (0)
#define PG8_LDA(dst, b, h) do { _Pragma("unroll") for (int m = 0; m < 4; ++m) _Pragma("unroll") for (int k = 0; k < 2; ++k) dst[m][k] = *(const LAS bf16x8*)(lds + PG8_SA(b, h) + aoff + m * 2048 + k * 1024); } while (0)
#define PG8_LDB(dst, b, h) do { _Pragma("unroll") for (int n = 0; n < 2; ++n) _Pragma("unroll") for (int k = 0; k < 2; ++k) dst[n][k] = *(const LAS bf16x8*)(lds + PG8_SB(b, h) + boff + n * 2048 + k * 1024); } while (0)
#define PG8_MMA(ai, bj, At, Bt) do { __builtin_amdgcn_s_setprio(1); _Pragma("unroll") for (int m = 0; m < 4; ++m) _Pragma("unroll") for (int n = 0; n < 2; ++n) _Pragma("unroll") for (int k = 0; k < 2; ++k) \
        acc[ai][bj][m][n] = __builtin_amdgcn_mfma_f32_16x16x32_bf16(Bt[n][k], At[m][k], acc[ai][bj][m][n], 0, 0, 0); __builtin_amdgcn_s_setprio(0); } while (0)
#define PG8_WAIT_V(n) asm volatile("s_waitcnt vmcnt(" #n ")" ::: "memory")
#define PG8_WAIT_L(n) asm volatile("s_waitcnt lgkmcnt(" #n ")" ::: "memory")
#define PG8_BAR __builtin_amdgcn_s_barrier()
#define PG8_SCHED __builtin_amdgcn_sched_barrier(0)
    Unit cur, nxt; int ui = 0;
    if (!S.next(0, cur)) return;
    f32x4 acc[2][2][4][2];
#pragma unroll
    for (int a = 0; a < 2; ++a)
#pragma unroll
        for (int b = 0; b < 2; ++b)
#pragma unroll
            for (int m = 0; m < 4; ++m)
#pragma unroll
                for (int n = 0; n < 2; ++n) acc[a][b][m][n] = (f32x4){0.f, 0.f, 0.f, 0.f};
    bf16x8 At[4][2], B0[2][2], B1[2][2];
    const char* cA = cur.a; const char* cB = cur.b;
    if (GATHER) { PG8_GLOAD(gc, cur.pm); }
    PG8_STAGE(PG8_SB(0, 0), cB, voffB); PG8_STAGE(PG8_SB(0, 1), cB + hstepB, voffB); PG8_STAGE_A(PG8_SA(0, 0), cA, 0, false); PG8_STAGE_A(PG8_SA(0, 1), cA, 1, false);
    if (wr == 1) PG8_BAR;
    PG8_WAIT_V(2); PG8_BAR;
    PG8_STAGE(PG8_SB(1, 0), cB + kstep, voffB); PG8_STAGE_A(PG8_SA(1, 0), cA + kstep, 0, false); PG8_STAGE(PG8_SB(1, 1), cB + hstepB + kstep, voffB);
    PG8_WAIT_V(6); PG8_BAR;
    for (;;) {
        const bool has_next = S.next(ui + 1, nxt);
        const char* nA = has_next ? nxt.a : cA; const char* nB = has_next ? nxt.b : cB;
        if (GATHER) { if (has_next) { PG8_GLOAD(gn, nxt.pm); } else { _Pragma("unroll") for (int _h = 0; _h < 2; ++_h) { gn[_h][0] = gc[_h][0]; gn[_h][1] = gc[_h][1]; } } }
#pragma unroll 1
        for (int t = 0; t < nt; t += 2) {
            const bool last = (t == nt - 2);
            const char* a1 = cA + (size_t)(t + 1) * kstep;
            const char* a2 = last ? nA : cA + (size_t)(t + 2) * kstep; const char* b2 = last ? nB : cB + (size_t)(t + 2) * kstep;
            const char* a3 = a2 + kstep; const char* b3 = b2 + kstep;
            PG8_LDB(B0, 0, 0); PG8_LDB(B1, 0, 1); PG8_SCHED; PG8_LDA(At, 0, 0); PG8_STAGE_A(PG8_SA(1, 1), a1, 1, false);
            if (t == 0) E.issue(cur, lds, wid, lane);
            PG8_WAIT_V(8); PG8_WAIT_L(0); PG8_BAR; PG8_MMA(0, 0, At, B0); PG8_MMA(0, 1, At, B1); PG8_BAR; PG8_SCHED;
            PG8_LDA(At, 0, 1); PG8_STAGE(PG8_SB(0, 0), b2, voffB); PG8_STAGE(PG8_SB(0, 1), b2 + hstepB, voffB); PG8_STAGE_A(PG8_SA(0, 0), a2, 0, last);
            PG8_WAIT_V(8); PG8_WAIT_L(0); PG8_BAR; PG8_MMA(1, 0, At, B0); PG8_MMA(1, 1, At, B1); PG8_BAR; PG8_SCHED;
            PG8_LDB(B0, 1, 0); PG8_LDB(B1, 1, 1); PG8_SCHED; PG8_LDA(At, 1, 0); PG8_STAGE_A(PG8_SA(0, 1), a2, 1, last);
            PG8_WAIT_V(8); PG8_WAIT_L(0); PG8_BAR; PG8_MMA(0, 0, At, B0); PG8_MMA(0, 1, At, B1); PG8_BAR; PG8_SCHED;
            PG8_LDA(At, 1, 1); PG8_STAGE(PG8_SB(1, 0), b3, voffB); PG8_STAGE(PG8_SB(1, 1), b3 + hstepB, voffB); PG8_STAGE_A(PG8_SA(1, 0), a3, 0, last);
            PG8_WAIT_V(8); PG8_WAIT_L(0); PG8_BAR; PG8_MMA(1, 0, At, B0); PG8_MMA(1, 1, At, B1); PG8_BAR; PG8_SCHED;
        }
        if (wr == 0) PG8_BAR;
        { int fr_e = fr, fq_e = fq; asm volatile("" : "+v"(fr_e), "+v"(fq_e)); E(acc, cur, wr, wc, fr_e, fq_e, lds); }
        if (!has_next) break;
#pragma unroll
        for (int a = 0; a < 2; ++a)
#pragma unroll
            for (int b = 0; b < 2; ++b)
#pragma unroll
                for (int m = 0; m < 4; ++m)
#pragma unroll
                    for (int n = 0; n < 2; ++n) acc[a][b][m][n] = (f32x4){0.f, 0.f, 0.f, 0.f};
        cur = nxt; cA = nA; cB = nB; ++ui;
        if (GATHER) { _Pragma("unroll") for (int _h = 0; _h < 2; ++_h) { gc[_h][0] = gn[_h][0]; gc[_h][1] = gn[_h][1]; } }
        if (wr == 1) PG8_BAR;
    }
    PG8_WAIT_V(0);
    PG8_BAR;
#undef PG8_SA
#undef PG8_SB
#undef PG8_STAGE
#undef PG8_LDA
#undef PG8_STAGE_A
#undef PG8_GLOAD
#undef PG8_LDB
#undef PG8_MMA
#undef PG8_WAIT_V
#undef PG8_WAIT_L
#undef PG8_BAR
#undef PG8_SCHED
}
}

struct Args { const float* in[27]; float* out; unsigned char* ws; int ph_lo, ph_hi; };
struct Ctx {
    LAS unsigned char* lds; unsigned char* ws; unsigned* ctl;
    int tid, lane, wave, vcu, G;
};
constexpr int LDS_PTAB = LDS_MISC + 1024;
DI void refresh(Ctx& F, unsigned char* wsb) { int t = threadIdx.x; asm volatile("" : "+v"(t)); F.tid = t; F.lane = t & 63; F.wave = __builtin_amdgcn_readfirstlane(t >> 6);
    unsigned lo = (unsigned)(unsigned long long)wsb, hi = (unsigned)((unsigned long long)wsb >> 32); asm volatile("" : "+v"(lo), "+v"(hi));
    lo = __builtin_amdgcn_readfirstlane(lo); hi = __builtin_amdgcn_readfirstlane(hi); F.ws = (unsigned char*)(GAS unsigned char*)(((unsigned long long)hi << 32) | lo); F.ctl = (unsigned*)F.ws;
    int bx = blockIdx.x; asm volatile("" : "+v"(bx)); bx = __builtin_amdgcn_readfirstlane(bx); F.G = 256; F.vcu = (bx & 7) * 32 + (bx >> 3);
    unsigned zb = 0u; asm volatile("" : "+v"(zb)); F.lds = (LAS unsigned char*)(unsigned)__builtin_amdgcn_readfirstlane(zb); }
DI const float* inp(const Ctx& F, int i) {
    const LAS unsigned* p = (const LAS unsigned*)(F.lds + LDS_PTAB) + 2 * i; const unsigned lo = __builtin_amdgcn_readfirstlane(p[0]), hi = __builtin_amdgcn_readfirstlane(p[1]);
    return (const float*)(GAS const float*)(((unsigned long long)hi << 32) | lo);
}
DI unsigned ldu(const unsigned* p) { return __hip_atomic_load(p, __ATOMIC_RELAXED, __HIP_MEMORY_SCOPE_AGENT); }
DI float ldf(const float* p) { return __uint_as_float(__hip_atomic_load((const unsigned*)p, __ATOMIC_RELAXED, __HIP_MEMORY_SCOPE_AGENT)); }

template <int MAP> DI int map_row(int n) {
    if (MAP == 0) return n;
    if (MAP == 1) return n < 1536 ? n : (n < 1544 ? -1 : (n < 3592 ? n - 8 : -1));
    return 256 * ((n & 1023) >> 7) + 128 * (n >> 10) + (n & 127);
}
template <int MAP> DI void tr_item(const float* W, int K, int N, bf16* WT, LAS float* scr, int item, int lane) {
    const int nblk = (N + 31) / 32, kb = item / nblk, nb = item % nblk, k0 = 64 * kb, n0 = 32 * nb;
    const int c4 = 4 * (lane & 7), nl = n0 + c4;
    f32x4 ld[8];
#pragma unroll
    for (int i = 0; i < 8; ++i) { const int kk = 8 * i + (lane >> 3); ld[i] = nl < N ? __builtin_nontemporal_load((const f32x4*)(W + (size_t)(k0 + kk) * N + nl)) : (f32x4){0.f, 0.f, 0.f, 0.f}; }
#pragma unroll
    for (int i = 0; i < 8; ++i) { const int kk = 8 * i + (lane >> 3); LAS float* d = scr + kk * 33 + c4; d[0] = ld[i][0]; d[1] = ld[i][1]; d[2] = ld[i][2]; d[3] = ld[i][3]; }
    LDS_WAIT(); asm volatile("" ::: "memory");
    const int c = lane & 7;
#pragma unroll
    for (int j = 0; j < 4; ++j) { const int nn = (lane >> 3) + 8 * j; const int n = n0 + nn; const LAS float* s = scr + (8 * c) * 33 + nn;
        const int dr = n < N ? map_row<MAP>(n) : -1;
        u32x4 o; o.x = cvt_pk_bf16(s[0 * 33], s[1 * 33]); o.y = cvt_pk_bf16(s[2 * 33], s[3 * 33]); o.z = cvt_pk_bf16(s[4 * 33], s[5 * 33]); o.w = cvt_pk_bf16(s[6 * 33], s[7 * 33]);
        if (dr >= 0) __builtin_nontemporal_store(o, (u32x4*)(WT + (size_t)dr * K + k0 + 8 * c)); }
    LDS_WAIT(); asm volatile("" ::: "memory");
}
DI void phase_convert(Ctx& F, const Args& a) {
    LAS float* scr = (LAS float*)(F.lds + F.wave * 16384);
    const int gw = F.vcu * NWAVES + F.wave, NGW = F.G * NWAVES;
    constexpr int I_WIN = 16 * 113, I_SQ = 16 * 32, I_GU = 16 * 64;
    constexpr int E0 = 4 * I_WIN, E1 = E0 + 4 * I_SQ, E2 = E1 + 4 * I_SQ, E3 = E2 + 4 * I_SQ, E4 = E3 + 4 * I_SQ, E5 = E4 + 128 * I_GU, E6 = E5 + 128 * I_SQ;
    for (int it = gw; it < E6; it += NGW) {
        if (it < E0) { const int l = it / I_WIN, r = it % I_WIN; tr_item<1>(inp(F, 2) + (size_t)l * D * 3600, D, 3600, (bf16*)(F.ws + WS_WIN) + (size_t)l * NPROJ * D, scr, r, F.lane); }
        else if (it < E1) { const int q = it - E0, l = q / I_SQ, r = q % I_SQ; tr_item<0>(inp(F, 10) + (size_t)l * D * D, D, D, (bf16*)(F.ws + WS_WOUT) + (size_t)l * D * D, scr, r, F.lane); }
        else if (it < E2) { const int q = it - E1, l = q / I_SQ, r = q % I_SQ; tr_item<0>(inp(F, 14) + (size_t)l * D * D, D, D, (bf16*)(F.ws + WS_WKV) + (size_t)(2 * l) * D * D, scr, r, F.lane); }
        else if (it < E3) { const int q = it - E2, l = q / I_SQ, r = q % I_SQ; tr_item<0>(inp(F, 15) + (size_t)l * D * D, D, D, (bf16*)(F.ws + WS_WKV) + (size_t)(2 * l + 1) * D * D, scr, r, F.lane); }
        else if (it < E4) { const int q = it - E3, l = q / I_SQ, r = q % I_SQ; tr_item<0>(inp(F, 16) + (size_t)l * D * D, D, D, (bf16*)(F.ws + WS_WO) + (size_t)l * D * D, scr, r, F.lane); }
        else if (it < E5) { const int q = it - E4, le = q / I_GU, r = q % I_GU; tr_item<2>(inp(F, 21) + (size_t)le * D * 2048, D, 2048, (bf16*)(F.ws + WS_WGU) + (size_t)le * 2048 * D, scr, r, F.lane); }
        else { const int q = it - E5, le = q / I_SQ, r = q % I_SQ; tr_item<0>(inp(F, 23) + (size_t)le * D * D, D, D, (bf16*)(F.ws + WS_WDN) + (size_t)le * D * D, scr, r, F.lane); }
    }
    const size_t gt = (size_t)blockIdx.x * NTHREADS + F.tid, NGT = (size_t)F.G * NTHREADS;
    for (size_t i = gt; i < (4ull * D * D + 2048ull * D) / 8; i += NGT) {
        const bool isq = i < 4ull * D * D / 8; const size_t j = isq ? i : i - 4ull * D * D / 8;
        const float* src = (isq ? inp(F, 13) : inp(F, 1)) + j * 8; bf16* dst = (bf16*)(F.ws + (isq ? WS_WQ : WS_MEMB)) + j * 8;
        const f32x4 v0 = *(const f32x4*)src, v1 = *(const f32x4*)(src + 4);
        u32x4 o; o.x = cvt_pk_bf16(v0[0], v0[1]); o.y = cvt_pk_bf16(v0[2], v0[3]); o.z = cvt_pk_bf16(v1[0], v1[1]); o.w = cvt_pk_bf16(v1[2], v1[3]);
        *(u32x4*)dst = o;
    }
    for (size_t i = gt; i < 4ull * 48 * D; i += NGT) {
        const int l = (int)(i / (48 * D)), r = (int)(i % (48 * D)), j = r / D, k = r % D;
        float w; bf16* dh; bf16* dl;
        if (j < 16) { const int col = j < 8 ? 1536 + j : 3592 + (j - 8); w = inp(F, 2)[((size_t)l * D + k) * 3600 + col];
            dh = (bf16*)(F.ws + WS_WGATE) + ((size_t)(l * 2 + 0) * 16 + j) * D + k; dl = dh + 16 * D; }
        else { const int e = j - 16; w = inp(F, 19)[((size_t)l * D + k) * 32 + e];
            dh = (bf16*)(F.ws + WS_WRT) + ((size_t)(l * 2 + 0) * 32 + e) * D + k; dl = dh + 32 * D; }
        const bf16 h = f2bf(w); *dh = h; *dl = f2bf(w - bf2f(h));
    }
}

DI void unpack8(const u32x4 w, float* v) { v[0] = bflo(w.x); v[1] = bfhi(w.x); v[2] = bflo(w.y); v[3] = bfhi(w.y); v[4] = bflo(w.z); v[5] = bfhi(w.z); v[6] = bflo(w.w); v[7] = bfhi(w.w); }
DI u32x4 pack8(const float* v) { u32x4 o; o.x = cvt_pk_bf16(v[0], v[1]); o.y = cvt_pk_bf16(v[2], v[3]); o.z = cvt_pk_bf16(v[4], v[5]); o.w = cvt_pk_bf16(v[6], v[7]); return o; }
#define PROF_RP(k) do { if (MODE == 2 && ((PROF_MASK) >> 23)) { if (blockIdx.x == 0 && threadIdx.x == 0) { volatile LAS unsigned long long* pw = (volatile LAS unsigned long long*)(F.lds + LDS_MISC + 128); \
        const unsigned long long now_ = __builtin_amdgcn_s_memrealtime(); if ((k) >= 0 && (((PROF_MASK) >> (23 + (k))) & 1)) pw[1] += now_ - pw[3]; pw[3] = now_; } } } while (0)
DI void ld2x16_sc1(const void* p0, const void* p1, u32x4& a, u32x4& b) {
    asm volatile("global_load_dwordx4 %0, %2, off sc0 sc1\n\tglobal_load_dwordx4 %1, %3, off sc0 sc1\n\ts_waitcnt vmcnt(0)" : "=&v"(a), "=&v"(b) : "v"(p0), "v"(p1) : "memory");
}
template <int MODE> DI void row_pass(Ctx& F, const Args& a, int l, const bool dummy = false) {
    const int lane = F.lane, r0 = (F.vcu * NWAVES + F.wave) * 16;
    bf16* XB = (bf16*)(F.ws + WS_XB); bf16* XBo = dummy ? (bf16*)(F.ws + WS_XG + 16 * MiB) : XB; const bf16* HB = (const bf16*)(F.ws + WS_HB); const bf16* Y = (const bf16*)(F.ws + WS_Y);
    const int c0 = 8 * lane, c1 = 512 + 8 * lane;
    LAS unsigned* ecnt = (LAS unsigned*)(F.lds + LDS_MISC + 256);
    if (MODE == 2) { if (F.tid < 64 && !dummy) ecnt[F.tid] = 0u; __syncthreads(); }
    PROF_RP(-1);
    constexpr int N16 = (MODE == 2) ? 2 : 1, NN = 16 * N16, NBLK = 32 * N16 * 2;
    const bool has_tail = !(MODE == 1 || (MODE == 3 && l == NL - 1));
    const bf16* Wb = (MODE == 2) ? (const bf16*)(F.ws + WS_WRT) + (size_t)l * 2 * 32 * D : (const bf16*)(F.ws + WS_WGATE) + (size_t)(MODE == 0 ? 0 : (l + 1 < NL ? l + 1 : 0)) * 2 * 16 * D;
    if (has_tail) {
#pragma unroll
        for (int q = 0; q < NBLK / 8; ++q) { const int blk = F.wave * (NBLK / 8) + q, ks = blk / (2 * N16), n = (blk >> 1) % N16, hl = blk & 1;
            __builtin_amdgcn_global_load_lds((const unsigned*)(Wb + (size_t)(hl * NN + n * 16 + (lane & 15)) * D + 32 * ks + 8 * (lane >> 4)), (LAS unsigned*)(F.lds + blk * 1024), 16, 0, 0); }
    }
    float g[16], bb[16];
    if (MODE >= 1) {
        const float* gp = inp(F, MODE == 1 ? 11 : (MODE == 2 ? 17 : 25)) + (size_t)l * D; const float* bp = inp(F, MODE == 1 ? 12 : (MODE == 2 ? 18 : 26)) + (size_t)l * D;
#pragma unroll
        for (int q = 0; q < 2; ++q) { const int c = q ? c1 : c0;
            const f32x4 g0 = *(const f32x4*)(gp + c), g1 = *(const f32x4*)(gp + c + 4), b0 = *(const f32x4*)(bp + c), b1 = *(const f32x4*)(bp + c + 4);
#pragma unroll
            for (int j = 0; j < 4; ++j) { g[8 * q + j] = g0[j]; g[8 * q + 4 + j] = g1[j]; bb[8 * q + j] = b0[j]; bb[8 * q + 4 + j] = b1[j]; } }
    }
    constexpr int RB = (MODE == 3) ? 2 : 4;
#pragma unroll 1
    for (int i0 = 0; i0 < 16; i0 += RB) {
        float v[RB][16];
        if (MODE == 0) {
            f32x4 xi[RB][4];
#pragma unroll
            for (int q = 0; q < RB; ++q) { const float* xr = inp(F, 0) + (size_t)(r0 + i0 + q) * D;
                xi[q][0] = *(const f32x4*)(xr + c0); xi[q][1] = *(const f32x4*)(xr + c0 + 4); xi[q][2] = *(const f32x4*)(xr + c1); xi[q][3] = *(const f32x4*)(xr + c1 + 4); }
#pragma unroll
            for (int q = 0; q < RB; ++q)
#pragma unroll
                for (int j = 0; j < 4; ++j) { v[q][j] = xi[q][0][j]; v[q][4 + j] = xi[q][1][j]; v[q][8 + j] = xi[q][2][j]; v[q][12 + j] = xi[q][3][j]; }
        } else {
            u32x4 xr[RB][2];
#pragma unroll
            for (int q = 0; q < RB; ++q) { xr[q][0] = *(const u32x4*)(XB + (size_t)(r0 + i0 + q) * D + c0); xr[q][1] = *(const u32x4*)(XB + (size_t)(r0 + i0 + q) * D + c1); }
            if (MODE == 3) {
                int slv = 0; float gkv = 0.f;
                if (lane < 4 * RB) { slv = (int)ldu((const unsigned*)(F.ws + WS_SLOT) + (size_t)(r0 + i0) * 4 + lane); gkv = ldf((const float*)(F.ws + WS_TOPG) + (size_t)(r0 + i0) * 4 + lane); }
                u32x4 yr[RB][4][2]; float gk[RB][4];
#pragma unroll
                for (int q = 0; q < RB; ++q)
#pragma unroll
                    for (int k = 0; k < 4; ++k) { const int sl = __shfl(slv, q * 4 + k); gk[q][k] = __shfl(gkv, q * 4 + k);
                        yr[q][k][0] = __builtin_nontemporal_load((const u32x4*)(Y + (size_t)sl * D + c0)); yr[q][k][1] = __builtin_nontemporal_load((const u32x4*)(Y + (size_t)sl * D + c1)); }
#pragma unroll
                for (int q = 0; q < RB; ++q) { float xv[16]; unpack8(xr[q][0], xv); unpack8(xr[q][1], xv + 8);
#pragma unroll
                    for (int j = 0; j < 16; ++j) v[q][j] = DN_ALPHA * xv[j];
#pragma unroll
                    for (int k = 0; k < 4; ++k) { float yv[16]; unpack8(yr[q][k][0], yv); unpack8(yr[q][k][1], yv + 8);
#pragma unroll
                        for (int j = 0; j < 16; ++j) v[q][j] += gk[q][k] * yv[j]; } }
            } else {
                u32x4 hr[RB][2];
#pragma unroll
                for (int q = 0; q < RB; ++q) { hr[q][0] = __builtin_nontemporal_load((const u32x4*)(HB + (size_t)(r0 + i0 + q) * D + c0)); hr[q][1] = __builtin_nontemporal_load((const u32x4*)(HB + (size_t)(r0 + i0 + q) * D + c1)); }
#pragma unroll
                for (int q = 0; q < RB; ++q) { float xv[16], hv[16]; unpack8(xr[q][0], xv); unpack8(xr[q][1], xv + 8); unpack8(hr[q][0], hv); unpack8(hr[q][1], hv + 8);
#pragma unroll
                    for (int j = 0; j < 16; ++j) v[q][j] = DN_ALPHA * xv[j] + hv[j]; }
            }
            float sm[RB];
#pragma unroll
            for (int q = 0; q < RB; ++q) { float t = 0.f;
#pragma unroll
                for (int j = 0; j < 16; ++j) t += v[q][j];
                sm[q] = t; }
#pragma unroll
            for (int o = 1; o < 64; o <<= 1)
#pragma unroll
                for (int q = 0; q < RB; ++q) sm[q] += __shfl_xor(sm[q], o);
            float sq[RB];
#pragma unroll
            for (int q = 0; q < RB; ++q) { const float mean = sm[q] * (1.f / D); float t = 0.f;
#pragma unroll
                for (int j = 0; j < 16; ++j) { v[q][j] -= mean; t += v[q][j] * v[q][j]; }
                sq[q] = t; }
#pragma unroll
            for (int o = 1; o < 64; o <<= 1)
#pragma unroll
                for (int q = 0; q < RB; ++q) sq[q] += __shfl_xor(sq[q], o);
#pragma unroll
            for (int q = 0; q < RB; ++q) { const float rstd = rsqrtf(sq[q] * (1.f / D) + 1e-5f);
#pragma unroll
                for (int j = 0; j < 16; ++j) v[q][j] = v[q][j] * rstd * g[j] + bb[j]; }
        }
#pragma unroll
        for (int q = 0; q < RB; ++q) { const int r = r0 + i0 + q;
            if (MODE == 3 && l == NL - 1) {
                float* orow = (float*)inp(F, 27) + (size_t)r * D;
                *(f32x4*)(orow + c0) = (f32x4){v[q][0], v[q][1], v[q][2], v[q][3]}; *(f32x4*)(orow + c0 + 4) = (f32x4){v[q][4], v[q][5], v[q][6], v[q][7]};
                *(f32x4*)(orow + c1) = (f32x4){v[q][8], v[q][9], v[q][10], v[q][11]}; *(f32x4*)(orow + c1 + 4) = (f32x4){v[q][12], v[q][13], v[q][14], v[q][15]};
            } else {
                *(u32x4*)(XBo + (size_t)r * D + c0) = pack8(v[q]); *(u32x4*)(XBo + (size_t)r * D + c1) = pack8(v[q] + 8);
            } }
    }
    if (MODE == 1 || (MODE == 3 && l == NL - 1)) return;
#ifdef DBG_NOROUTER
    if (MODE == 2) return;
#endif
    VM_WAIT(); __syncthreads(); PROF_RP(0); asm volatile("" ::: "memory");
    const bf16* arow = XBo + (size_t)(r0 + (lane & 15)) * D + 8 * (lane >> 4);
    f32x4 acc[N16];
#pragma unroll
    for (int n = 0; n < N16; ++n) acc[n] = (f32x4){0.f, 0.f, 0.f, 0.f};
#pragma unroll 8
    for (int ks = 0; ks < 32; ++ks) {
        const bf16x8 af = *(const bf16x8*)(arow + 32 * ks);
#pragma unroll
        for (int n = 0; n < N16; ++n) {
            const bf16x8 bh = *(const LAS bf16x8*)(F.lds + ((ks * N16 + n) * 2 + 0) * 1024 + lane * 16), bl = *(const LAS bf16x8*)(F.lds + ((ks * N16 + n) * 2 + 1) * 1024 + lane * 16);
            acc[n] = MFMA16(af, bh, acc[n]); acc[n] = MFMA16(af, bl, acc[n]);
        }
    }
    if (MODE != 2) {
        float* G = dummy ? (float*)(F.ws + WS_XG + 160 * MiB) : (float*)(F.ws + WS_GATES);
#pragma unroll
        for (int i = 0; i < 4; ++i) G[(size_t)(r0 + 4 * (lane >> 4) + i) * 16 + (lane & 15)] = acc[0][i];
        return;
    }
    if (MODE == 2) {
        if ((PROF_MASK) >> 23) __syncthreads(); PROF_RP(1);
        LAS float* LG = (LAS float*)(F.lds + 131072 + F.wave * 2176);
#pragma unroll
        for (int n = 0; n < N16; ++n)
#pragma unroll
            for (int i = 0; i < 4; ++i) LG[(4 * (lane >> 4) + i) * 33 + n * 16 + (lane & 15)] = acc[n][i];
        LDS_WAIT(); asm volatile("" ::: "memory");
        int te[4] = {0, 0, 0, 0}; float tv[4] = {0.f, 0.f, 0.f, 0.f}; unsigned rk[4] = {0u, 0u, 0u, 0u};
        if (lane < 16) {
            float lg[32]; const float* rb = inp(F, 20) + (size_t)l * 32;
#pragma unroll
            for (int e = 0; e < 32; ++e) lg[e] = LG[lane * 33 + e] + rb[e];
#pragma unroll
            for (int k = 0; k < 4; ++k) {
                float best = -3.0e38f; int bi = 0;
#pragma unroll
                for (int e = 0; e < 32; ++e) { const bool gt = lg[e] > best; best = gt ? lg[e] : best; bi = gt ? e : bi; }
                te[k] = bi; tv[k] = best;
#pragma unroll
                for (int e = 0; e < 32; ++e) lg[e] = (e == bi) ? -3.0e38f : lg[e];
            }
            const float e1 = __expf(tv[1] - tv[0]), e2 = __expf(tv[2] - tv[0]), e3 = __expf(tv[3] - tv[0]); const float inv = 1.f / (1.f + e1 + e2 + e3);
            tv[0] = inv; tv[1] = e1 * inv; tv[2] = e2 * inv; tv[3] = e3 * inv;
#pragma unroll
            for (int k = 0; k < 4; ++k) rk[k] = __hip_atomic_fetch_add(ecnt + (dummy ? 40 : 0) + te[k], 1u, __ATOMIC_RELAXED, __HIP_MEMORY_SCOPE_WORKGROUP);
        }
        __syncthreads(); PROF_RP(2);
        if (F.tid < 32 && !dummy) ecnt[32 + F.tid] = __hip_atomic_fetch_add(F.ctl + CW_ECNT + (l * 32 + F.tid) * 64, ecnt[F.tid], __ATOMIC_RELAXED, __HIP_MEMORY_SCOPE_AGENT);
        __syncthreads();
        if (lane < 16 && !dummy) {
            const int r = r0 + lane; int* pe = (int*)(F.ws + WS_TOPE) + (size_t)r * 4; int* pp = (int*)(F.ws + WS_TOPP) + (size_t)r * 4; float* pg = (float*)(F.ws + WS_TOPG) + (size_t)r * 4;
#pragma unroll
            for (int k = 0; k < 4; ++k) { pe[k] = te[k]; pp[k] = (int)(ecnt[32 + te[k]] + rk[k]); pg[k] = tv[k]; }
        }
        if ((PROF_MASK) >> 23) { VM_WAIT(); __syncthreads(); } PROF_RP(3);
    }
}

DI void phase_scatter(Ctx& F, int l) {
    LAS int* ts = (LAS int*)(F.lds + LDS_MISC + 512);
    if (F.tid < 64) {
        const int lane = F.tid; const int nt_ = (lane < 32) ? (int)((ldu(F.ctl + CW_ECNT + (l * 32 + lane) * 64) + 255u) >> 8) : 0;
        int inc = nt_;
#pragma unroll
        for (int o = 1; o < 32; o <<= 1) { const int t_ = __shfl_up(inc, o); inc += (lane >= o) ? t_ : 0; }
        if (lane < 32) ts[lane] = inc - nt_;
        if (lane == 31) ts[32] = inc; }
    __syncthreads();
    if (blockIdx.x == 0) {
        if (F.tid == 0) __hip_atomic_store(F.ctl + CW_NT + l, (unsigned)ts[32], __ATOMIC_RELAXED, __HIP_MEMORY_SCOPE_AGENT);
        for (int t = F.tid; t < ts[32]; t += NTHREADS) { int e = 0; while (e < 31 && t >= ts[e + 1]) ++e; F.ctl[CW_TILE_E + l * MAXTILES + t] = (unsigned)e; }
    }
    { const int r = F.vcu * 128 + (F.tid >> 2), k = F.tid & 3;
      const int e = ((const int*)(F.ws + WS_TOPE))[(size_t)r * 4 + k], p = ((const int*)(F.ws + WS_TOPP))[(size_t)r * 4 + k];
      const int slot = ts[e] * 256 + p;
      ((int*)(F.ws + WS_SLOT))[(size_t)r * 4 + k] = slot; ((unsigned*)(F.ws + WS_XG))[slot] = (unsigned)r; }
}
struct MoeOrder {
    const char* A; const char* B; char* C; const unsigned* tile_e; int NT, nN; size_t bE, bN, cN; int G, c0, gather, rev;
    DI bool next(int i, g8::Unit& u) const {
        const int L = i * G + c0; if (L >= NT * nN) return false;
        int pm, pn; g8::tile_of(L, NT, nN, pm, pn); if (rev) pm = NT - 1 - pm;
        const int e = __builtin_amdgcn_readfirstlane((int)ldu(tile_e + pm));
        u.pm = pm; u.pn = pn; u.aux = e; u.a = gather ? A : A + (size_t)pm * 256 * 2048; u.b = B + (size_t)e * bE + (size_t)pn * bN; u.c = C + (size_t)pm * 256 * 2048 + (size_t)pn * cN; return true;
    }
};

DI unsigned lds_addr(const LAS void* p) { return (unsigned)(size_t)p; }
DI bf16x8 tr_frag8(unsigned img, int ld_bytes, int row_lo, int row_hi, int m0, int lane) {
    const int i = lane & 15; const unsigned a_lo = img + (unsigned)((row_lo + (i >> 2)) * ld_bytes + (m0 + 4 * (i & 3)) * 2), a_hi = img + (unsigned)((row_hi + (i >> 2)) * ld_bytes + (m0 + 4 * (i & 3)) * 2);
    s16x4 lo, hi;
    asm volatile("ds_read_b64_tr_b16 %0, %2\n\tds_read_b64_tr_b16 %1, %3\n\ts_waitcnt lgkmcnt(0)" : "=&v"(lo), "=&v"(hi) : "v"(a_lo), "v"(a_hi) : "memory");
    return __builtin_shufflevector(lo, hi, 0, 1, 2, 3, 4, 5, 6, 7);
}
DI s16x4 tr_read4(unsigned addr) { s16x4 r; asm volatile("ds_read_b64_tr_b16 %0, %1\n\ts_waitcnt lgkmcnt(0)" : "=&v"(r) : "v"(addr) : "memory"); return r; }
DI bf16x8 pack_frag(const f32x4 a, const f32x4 b) {
    u32x4 p; p.x = cvt_pk_bf16(a[0], a[1]); p.y = cvt_pk_bf16(a[2], a[3]); p.z = cvt_pk_bf16(b[0], b[1]); p.w = cvt_pk_bf16(b[2], b[3]); return __builtin_bit_cast(bf16x8, p);
}
DI u32x2 pack4(const f32x4 a) { u32x2 p; p.x = cvt_pk_bf16(a[0], a[1]); p.y = cvt_pk_bf16(a[2], a[3]); return p; }
DI f32x4 unpack4(const u32x2 w) { return (f32x4){bflo(w.x), bfhi(w.x), bflo(w.y), bfhi(w.y)}; }
DI float softcap15(float x) { const float y = x * (1.f / 15.f); const float e = __expf(2.f * y); return 15.f * (1.f - 2.f * __builtin_amdgcn_rcpf(e + 1.f)); }
DI float log_sigmoid(float x) { return fminf(x, 0.f) - log1pf(__expf(-fabsf(x))); }
DI float softplusf_(float x) { return fmaxf(x, 0.f) + log1pf(__expf(-fabsf(x))); }
DI float wave_incl_sum(float v, int lane) {
#pragma unroll
    for (int o = 1; o < 64; o <<= 1) { const float t = __shfl_up(v, o); v += (lane >= o) ? t : 0.f; }
    return v;
}
DI float wave_incl_max(float v, int lane) {
#pragma unroll
    for (int o = 1; o < 64; o <<= 1) { const float t = __shfl_up(v, o); v = (lane >= o) ? fmaxf(v, t) : v; }
    return v;
}
constexpr int GA_QH = 0, GA_KH = 17408, GA_VB = 34816, GA_KB = 52224, GA_NA = 69632, GA_AD = 78848, GA_TI = 82944, GA_GC = 84992, GA_KEI = 86016;
constexpr int LDI = 136 * 2;
constexpr int LDK = 72 * 2;

#define DMA16(src, dst) __builtin_amdgcn_global_load_lds((const unsigned*)(src), (LAS unsigned*)(dst), 16, 0, 0)
DI u32x2 gld8(const void* p) { u32x2 r; asm volatile("global_load_dwordx2 %0, %1, off" : "=v"(r) : "v"(p) : "memory"); return r; }
DI float gld4(const void* p) { float r; asm volatile("global_load_dword %0, %1, off" : "=v"(r) : "v"(p) : "memory"); return r; }
DI u32x4 gld16(const void* p) { u32x4 r; asm volatile("global_load_dwordx4 %0, %1, off" : "=v"(r) : "v"(p) : "memory"); return r; }
struct MlAPre { u32x4 kraw, vraw[2]; float gi, gf; };
#define PROF_SUB(k) do { if ((PROF_MASK) >> 16) { if (blockIdx.x == 0 && threadIdx.x == 0) { volatile LAS unsigned long long* pw = (volatile LAS unsigned long long*)(F.lds + LDS_MISC + 128); \
        const unsigned long long now_ = __builtin_amdgcn_s_memrealtime(); if (((PROF_MASK) >> (16 + (k))) & 1) pw[1] += now_ - pw[3]; pw[3] = now_; } } } while (0)
DI void ml_a_fetch(Ctx& F, int cid, MlAPre& P) {
    const int b = cid >> 8, h = (cid >> 6) & 3, n = cid & 63, t0 = b * SEQ + n * CH, tid = F.tid, lane = F.lane;
    const bf16* PROJ = (const bf16*)(F.ws + WS_PROJ); const float* GT = (const float*)(F.ws + WS_GATES);
    P.kraw = gld16(PROJ + (size_t)(t0 + (tid >> 3)) * NPROJ + 256 + h * 64 + (tid & 7) * 8);
#pragma unroll
    for (int q = 0; q < 2; ++q) { const int idx = tid + 512 * q; P.vraw[q] = gld16(PROJ + (size_t)(t0 + (idx >> 4)) * NPROJ + 512 + h * 128 + (idx & 15) * 8); }
    P.gi = gld4(GT + (size_t)(t0 + lane) * 16 + h); P.gf = gld4(GT + (size_t)(t0 + lane) * 16 + 4 + h);
}
DI void ml_a_unit(Ctx& F, int l, int cid, int par, MlAPre& P, float bi, float bf_, float& gb, float& ga, float nalog, float dtb) {
    int tid = F.tid; asm volatile("" : "+v"(tid)); const int lane = tid & 63;
    LAS unsigned char* KE = F.lds + par * 45056; LAS unsigned char* VI = KE + 16384; LAS float* es = (LAS float*)(KE + 40960);
    asm volatile("s_waitcnt vmcnt(7)" : "+v"(P.kraw), "+v"(P.vraw[0]), "+v"(P.vraw[1]), "+v"(P.gi), "+v"(P.gf), "+v"(gb), "+v"(ga) :: "memory");
    const int ks_ = tid >> 3, kc8 = (tid & 7) * 8;
    const u32x4 kraw = P.kraw; const u32x4 vraw[2] = {P.vraw[0], P.vraw[1]};
    if (F.wave == 7) {
        const float ip = softcap15(P.gi + bi), fp = softcap15(P.gf + bf_);
        const float bc = wave_incl_sum(log_sigmoid(fp), lane), blast = __shfl(bc, 63), lw = blast - bc + ip, amax = wave_max(lw);
        es[lane] = __expf(lw - amax);
        if (lane == 0) { float* sc = (float*)(F.ws + WS_MLSC) + (size_t)cid * 4; sc[0] = blast; sc[1] = amax; }
    }
    if (F.wave == 6) {
        LAS float* gcs = (LAS float*)(F.lds + GA_GC); LAS float* bts = gcs + 64;
        const float beta = sigmoidf_(gb), gg = nalog * softplusf_(ga + dtb), gc = wave_incl_sum(gg, lane);
        gcs[lane] = gc; bts[lane] = beta;
        if (lane == 63) ((float*)(F.ws + WS_GDGL))[cid] = __expf(gc);
    }
#pragma unroll
    for (int q = 0; q < 2; ++q) { const int idx = tid + 512 * q, s_ = idx >> 4, c8 = (idx & 15) * 8; *(LAS u32x4*)(VI + s_ * LDI + c8 * 2) = vraw[q]; }
    __syncthreads();
    { float v[8]; unpack8(kraw, v); const float e = es[ks_];
#pragma unroll
      for (int j = 0; j < 8; ++j) v[j] *= e;
      *(LAS u32x4*)(KE + ks_ * LDK + kc8 * 2) = pack8(v); }
    __syncthreads();
    { const int g = lane >> 4, w = F.wave, ln = lane & 15; f32x4 acc[4], kacc[4];
#pragma unroll
      for (int nt = 0; nt < 4; ++nt) { acc[nt] = (f32x4){0.f, 0.f, 0.f, 0.f}; kacc[nt] = (f32x4){0.f, 0.f, 0.f, 0.f}; }
      const bf16x8 ones = (ln == 0) ? (bf16x8){0x3f80, 0x3f80, 0x3f80, 0x3f80, 0x3f80, 0x3f80, 0x3f80, 0x3f80} : (bf16x8){0, 0, 0, 0, 0, 0, 0, 0};
#pragma unroll
      for (int ks = 0; ks < 2; ++ks) { const int rb = 32 * ks + 8 * g;
          const bf16x8 af = tr_frag8(lds_addr(VI), LDI, rb, rb + 4, 16 * w, lane);
#pragma unroll
          for (int nt = 0; nt < 4; ++nt) { const bf16x8 bf = tr_frag8(lds_addr(KE), LDK, rb, rb + 4, 16 * nt, lane); acc[nt] = MFMA16(bf, af, acc[nt]);
              if (w == 0) kacc[nt] = MFMA16(ones, bf, kacc[nt]); } }
      bf16* U = (bf16*)(F.ws + WS_MLU) + (size_t)cid * 8192;
#pragma unroll
      for (int nt = 0; nt < 4; ++nt)
          *(u32x2*)(U + (w * 2 + (nt >> 1)) * 512 + ((2 * (nt & 1) + (g >> 1)) * 16 + ln) * 8 + 4 * (g & 1)) = pack4(acc[nt]);
      if (w == 0 && g == 0) {
#pragma unroll
          for (int nt = 0; nt < 4; ++nt) ((float*)(F.ws + WS_MLKN))[(size_t)cid * 64 + 16 * nt + ln] = kacc[nt][0]; }
    }
}
struct MlBBatch { u32x2 ub[8]; float kv[8]; u32x2 sc; };
DI void ml_b_fetch(const bf16* U, const float* SC, const float* KN, size_t cid0, int e0, int t, bool dn, MlBBatch& B) {
#pragma unroll
    for (int q = 0; q < 8; ++q) { const size_t cid = cid0 + q;
        B.ub[q] = gld8(U + cid * 8192 + e0);
        B.kv[q] = 0.f; if (dn) asm volatile("global_load_dword %0, %1, off" : "+v"(B.kv[q]) : "v"(KN + cid * 64 + t) : "memory"); }
    B.sc = gld8(SC + (cid0 + (t & 7)) * 4);
}
DI void ml_b_compute(const MlBBatch& B, bf16* CT, float* NP, float* MP, size_t cid0, int e0, int t, int p, bool dn, f32x4& C, float& nv, float& m) {
#pragma unroll
    for (int q = 0; q < 8; ++q) { const size_t cid = cid0 + q;
        *(u32x2*)(CT + cid * 8192 + e0) = pack4(C);
        if (dn) NP[cid * 64 + t] = nv; if (p == 0 && t == 0) MP[cid] = m;
        const float blq = __uint_as_float(__builtin_amdgcn_readlane(B.sc.x, q)), amq = __uint_as_float(__builtin_amdgcn_readlane(B.sc.y, q));
        const float mn = fmaxf(blq + m, amq), d1 = __expf(blq + m - mn), d2 = __expf(amq - mn);
        const f32x4 uv = unpack4(B.ub[q]);
#pragma unroll
        for (int k = 0; k < 4; ++k) C[k] = d1 * C[k] + d2 * uv[k];
        nv = d1 * nv + d2 * (dn ? B.kv[q] : 0.f); m = mn; }
}
#define MLB_TIE(B) do { _Pragma("unroll") for (int q_ = 0; q_ < 8; ++q_) asm volatile("" : "+v"(B.ub[q_]), "+v"(B.kv[q_])); asm volatile("" : "+v"(B.sc)); } while (0)
DI void ml_b_unit(Ctx& F, int u) {
    const int bh = u >> 3, p = u & 7, t = F.tid - 256, e0 = p * 1024 + 4 * t;
    const bf16* U = (const bf16*)(F.ws + WS_MLU); const float* SC = (const float*)(F.ws + WS_MLSC); const float* KN = (const float*)(F.ws + WS_MLKN);
    bf16* CT = (bf16*)(F.ws + WS_MLCT); float* NP = (float*)(F.ws + WS_MLNP); float* MP = (float*)(F.ws + WS_MLMP);
    f32x4 C = (f32x4){0.f, 0.f, 0.f, 0.f}; float nv = 0.f, m = 0.f; const bool dn = (p == 0 && t < 64);
    const size_t c0 = (size_t)bh * 64;
    MlBBatch A, B;
    ml_b_fetch(U, SC, KN, c0, e0, t, dn, A);
#pragma unroll
    for (int nb = 0; nb < 8; nb += 2) {
        ml_b_fetch(U, SC, KN, c0 + 8 * (nb + 1), e0, t, dn, B); asm volatile("s_waitcnt vmcnt(9)" ::: "memory"); MLB_TIE(A);
        ml_b_compute(A, CT, NP, MP, c0 + 8 * nb, e0, t, p, dn, C, nv, m);
        if (nb + 2 < 8) { ml_b_fetch(U, SC, KN, c0 + 8 * (nb + 2), e0, t, dn, A); asm volatile("s_waitcnt vmcnt(9)" ::: "memory"); } else asm volatile("s_waitcnt vmcnt(0)" ::: "memory");
        MLB_TIE(B);
        ml_b_compute(B, CT, NP, MP, c0 + 8 * (nb + 1), e0, t, p, dn, C, nv, m);
    }
}
DI void ml_c_unit(Ctx& F, const Args& a, int l, int cid, int par) {
    const int b = cid >> 8, h = (cid >> 6) & 3, n = cid & 63, t0 = b * SEQ + n * CH, lane = F.lane, tid = F.tid, g = lane >> 4, ln = lane & 15, w = F.wave, tt = w & 3, dh = w >> 2;
    const bf16* PROJ = (const bf16*)(F.ws + WS_PROJ); const float* GT = (const float*)(F.ws + WS_GATES);
    LAS unsigned char* VI = F.lds + par * 24576; LAS float* ib = (LAS float*)(VI + 20480); LAS float* Mt = ib + 64; LAS float* bcs = ib + 128; LAS float* ss = ib + 192;
    const float mprev = ldf((const float*)(F.ws + WS_MLMP) + cid);
    const bf16* CT = (const bf16*)(F.ws + WS_MLCT) + (size_t)cid * 8192; const float* NPv = (const float*)(F.ws + WS_MLNP) + (size_t)cid * 64;
    const int tl = 16 * tt + ln;
    bf16x8 qf[2], kf[4][2], ctf[5][2]; u32x2 ogr[4]; f32x4 nwr[4]; u32x4 vraw[2];
#pragma unroll
    for (int ks = 0; ks < 2; ++ks) { qf[ks] = *(const bf16x8*)(PROJ + (size_t)(t0 + tl) * NPROJ + h * 64 + 32 * ks + 8 * g);
#pragma unroll
        for (int ms = 0; ms < 4; ++ms) kf[ms][ks] = *(const bf16x8*)(PROJ + (size_t)(t0 + 16 * ms + ln) * NPROJ + 256 + h * 64 + 32 * ks + 8 * g);
#pragma unroll
        for (int mt = 0; mt < 4; ++mt) ctf[mt][ks] = *(const bf16x8*)(CT + (size_t)(16 * (4 * dh + mt) + ln) * 64 + 32 * ks + 8 * g);
        const f32x4 n0 = *(const f32x4*)(NPv + 32 * ks + 8 * g), n1 = *(const f32x4*)(NPv + 32 * ks + 8 * g + 4);
        float nvv[8];
#pragma unroll
        for (int j = 0; j < 4; ++j) { nvv[j] = (ln == 0) ? n0[j] : 0.f; nvv[4 + j] = (ln == 0) ? n1[j] : 0.f; }
        ctf[4][ks] = __builtin_bit_cast(bf16x8, pack8(nvv)); }
#pragma unroll
    for (int mt = 0; mt < 4; ++mt) { const int dv = 16 * (4 * dh + mt) + 4 * g;
        nwr[mt] = *(const f32x4*)(inp(F, 5) + (size_t)l * 512 + h * 128 + dv); ogr[mt] = *(const u32x2*)(PROJ + (size_t)(t0 + tl) * NPROJ + 1024 + h * 128 + dv); }
#pragma unroll
    for (int q = 0; q < 2; ++q) { const int idx = tid + 512 * q, s_ = idx >> 4, c8 = (idx & 15) * 8; vraw[q] = *(const u32x4*)(PROJ + (size_t)(t0 + s_) * NPROJ + 512 + h * 128 + c8); }
    if (w == 7) {
        const float ip = softcap15(GT[(size_t)(t0 + lane) * 16 + h] + inp(F, 3)[l * 4 + h]), fp = softcap15(GT[(size_t)(t0 + lane) * 16 + 4 + h] + inp(F, 4)[l * 4 + h]);
        const float bc = wave_incl_sum(log_sigmoid(fp), lane), ibs = ip - bc, pm = wave_incl_max(ibs, lane);
        ib[lane] = ibs; Mt[lane] = fmaxf(mprev, pm); bcs[lane] = bc;
    }
#pragma unroll
    for (int q = 0; q < 2; ++q) { const int idx = tid + 512 * q, s_ = idx >> 4, c8 = (idx & 15) * 8; *(LAS u32x4*)(VI + s_ * LDI + c8 * 2) = vraw[q]; }
    __syncthreads();
    f32x4 sacc[4];
#pragma unroll
    for (int ms = 0; ms < 4; ++ms) { sacc[ms] = (f32x4){0.f, 0.f, 0.f, 0.f};
#pragma unroll
        for (int ks = 0; ks < 2; ++ks) sacc[ms] = MFMA16(kf[ms][ks], qf[ks], sacc[ms]); }
    const float Mtt = Mt[tl];
#pragma unroll
    for (int ms = 0; ms < 4; ++ms) { const f32x4 ibv = *(const LAS f32x4*)(ib + 16 * ms + 4 * g);
#pragma unroll
        for (int i = 0; i < 4; ++i) { const int s = 16 * ms + 4 * g + i; sacc[ms][i] = (s <= tl) ? sacc[ms][i] * 0.125f * __expf(ibv[i] - Mtt) : 0.f; } }
    bf16x8 sb[2]; sb[0] = pack_frag(sacc[0], sacc[1]); sb[1] = pack_frag(sacc[2], sacc[3]);
    f32x4 xacc[5];
#pragma unroll
    for (int mt = 0; mt < 5; ++mt) { xacc[mt] = (f32x4){0.f, 0.f, 0.f, 0.f};
#pragma unroll
        for (int ks = 0; ks < 2; ++ks) xacc[mt] = MFMA16(ctf[mt][ks], qf[ks], xacc[mt]); }
    const float wint = 0.125f * __expf(mprev - Mtt);
#pragma unroll
    for (int mt = 0; mt < 5; ++mt) xacc[mt] *= wint;
    const bf16x8 ones = (ln == 0) ? (bf16x8){0x3f80, 0x3f80, 0x3f80, 0x3f80, 0x3f80, 0x3f80, 0x3f80, 0x3f80} : (bf16x8){0, 0, 0, 0, 0, 0, 0, 0};
#pragma unroll
    for (int kk = 0; kk < 2; ++kk) {
#pragma unroll
        for (int mt = 0; mt < 4; ++mt) { const bf16x8 vf = tr_frag8(lds_addr(VI), LDI, 32 * kk + 4 * g, 32 * kk + 16 + 4 * g, 16 * (4 * dh + mt), lane); xacc[mt] = MFMA16(vf, sb[kk], xacc[mt]); }
        xacc[4] = MFMA16(ones, sb[kk], xacc[4]);
    }
    const float den = __shfl(xacc[4][0], ln), mt_ = bcs[tl] + Mtt, dinv = __builtin_amdgcn_rcpf(fmaxf(fabsf(den), __expf(-mt_)));
    float ssq = 0.f;
#pragma unroll
    for (int mt = 0; mt < 4; ++mt) { xacc[mt] *= dinv; ssq += (xacc[mt][0] * xacc[mt][0] + xacc[mt][1] * xacc[mt][1]) + (xacc[mt][2] * xacc[mt][2] + xacc[mt][3] * xacc[mt][3]); }
    ssq += __shfl_xor(ssq, 16); ssq += __shfl_xor(ssq, 32);
    if (g == 0) ss[tl * 2 + dh] = ssq;
    __syncthreads();
    const float rinv = rsqrtf((ss[tl * 2] + ss[tl * 2 + 1]) * (1.f / 128.f) + 1e-6f);
    bf16* MX = (bf16*)(F.ws + WS_MIXED);
#pragma unroll
    for (int mt = 0; mt < 4; ++mt) { const int dv = 16 * (4 * dh + mt) + 4 * g;
        const f32x4 nw = nwr[mt]; const f32x4 og = unpack4(ogr[mt]);
        f32x4 o;
#pragma unroll
        for (int i = 0; i < 4; ++i) o[i] = xacc[mt][i] * rinv * nw[i] * sigmoidf_(og[i]);
        *(u32x2*)(MX + (size_t)(t0 + tl) * D + h * 128 + dv) = pack4(o); }
}

constexpr int GA_WT = 155648;
constexpr int GA_ST = 103424;
DI void gd_a_issue(Ctx& F, int cid, int w, int lane) {
    const int b = cid >> 8, h = (cid >> 6) & 3, n = cid & 63, t0 = b * SEQ + n * CH;
    const bf16* PROJ = (const bf16*)(F.ws + WS_PROJ);
#pragma unroll
    for (int q = 0; q < 7; ++q) { const int jj = (w + 8 * q) % 51, ten = jj / 17, grp = jj % 17;
        DMA16(PROJ + ((long)t0 - 3 + 4 * grp + (lane >> 4)) * NPROJ + 1536 + ten * 512 + h * 128 + 8 * (lane & 15), F.lds + GA_ST + ten * 17408 + grp * 1024); }
}
DI void gd_a_unit(Ctx& F, int l, int cid, float& gb, float& ga, float nalog, float dtb, bool has_next, MlAPre& P) {
    int tid = F.tid; asm volatile("" : "+v"(tid));
    const int b = cid >> 8, h = (cid >> 6) & 3, n = cid & 63, t0 = b * SEQ + n * CH, lane = tid & 63, g = lane >> 4, ln = lane & 15, w = F.wave;
    const float* GT = (const float*)(F.ws + WS_GATES);
    LAS unsigned char* L = F.lds; LAS float* gcs = (LAS float*)(L + GA_GC); LAS float* bts = gcs + 64;
    const int ten = tid >> 7, tg = (tid >> 4) & 7, cg = tid & 15;
    asm volatile("s_waitcnt vmcnt(0)" ::: "memory");
    __syncthreads();
    u32x4 raw[11];
    if (ten < 3) { const unsigned sa = lds_addr(L) + GA_ST + ten * 17408 + (8 * tg) * 256 + cg * 16;
        asm volatile("ds_read_b128 %0, %11\n\tds_read_b128 %1, %11 offset:256\n\tds_read_b128 %2, %11 offset:512\n\tds_read_b128 %3, %11 offset:768\n\tds_read_b128 %4, %11 offset:1024\n\tds_read_b128 %5, %11 offset:1280\n\t"
                     "ds_read_b128 %6, %11 offset:1536\n\tds_read_b128 %7, %11 offset:1792\n\tds_read_b128 %8, %11 offset:2048\n\tds_read_b128 %9, %11 offset:2304\n\tds_read_b128 %10, %11 offset:2560\n\ts_waitcnt lgkmcnt(0)"
                     : "=&v"(raw[0]), "=&v"(raw[1]), "=&v"(raw[2]), "=&v"(raw[3]), "=&v"(raw[4]), "=&v"(raw[5]), "=&v"(raw[6]), "=&v"(raw[7]), "=&v"(raw[8]), "=&v"(raw[9]), "=&v"(raw[10]) : "v"(sa) : "memory");
        if (n == 0 && tg == 0) { raw[0] = (u32x4){0u, 0u, 0u, 0u}; raw[1] = raw[0]; raw[2] = raw[0]; }
    }
    float wv[4][8];
#pragma unroll
    for (int j = 0; j < 4; ++j) unpack8(*(const LAS u32x4*)(L + GA_WT + (((ten < 3 ? ten : 0) * 4 + j) * 128 + 8 * cg) * 2), wv[j]);
    const float glast = gcs[63];
    bf16* qgb = (bf16*)(F.ws + WS_GDQG) + (size_t)cid * 8192 + (8 * tg) * 128 + 8 * cg; asm volatile("" : "+v"(qgb));
    if (ten < 3) {
#pragma unroll
        for (int i = 0; i < 8; ++i) { const int t = 8 * tg + i; float y[8];
#pragma unroll
            for (int c = 0; c < 8; ++c) y[c] = 0.f;
#pragma unroll
            for (int j = 0; j < 4; ++j) { float xv[8]; unpack8(raw[i + j], xv);
#pragma unroll
                for (int c = 0; c < 8; ++c) y[c] += wv[j][c] * xv[c]; }
#pragma unroll
            for (int c = 0; c < 8; ++c) y[c] = y[c] * sigmoidf_(y[c]);
            const float gct = gcs[t], bt = bts[t];
            if (ten < 2) { float s2 = 0.f;
#pragma unroll
                for (int c = 0; c < 8; ++c) s2 += y[c] * y[c];
                s2 += __shfl_xor(s2, 1); s2 += __shfl_xor(s2, 2); s2 += __shfl_xor(s2, 4); s2 += __shfl_xor(s2, 8);
                const float rn = rsqrtf(s2 + 1e-6f) * (ten == 0 ? 0.08838834764831845f : 1.f);
#pragma unroll
                for (int c = 0; c < 8; ++c) y[c] *= rn; }
            float z[8];
            if (ten == 0) { *(LAS u32x4*)(L + GA_QH + t * LDI + 16 * cg) = pack8(y); const float e = __expf(gct);
#pragma unroll
                for (int c = 0; c < 8; ++c) z[c] = y[c] * e;
                *(u32x4*)(qgb + i * 128) = pack8(z); }
            else if (ten == 1) { *(LAS u32x4*)(L + GA_KH + t * LDI + 16 * cg) = pack8(y); const float e1 = bt * __expf(gct), e2 = __expf(glast - gct);
#pragma unroll
                for (int c = 0; c < 8; ++c) z[c] = y[c] * e1;
                *(LAS u32x4*)(L + GA_KB + t * LDI + 16 * cg) = pack8(z);
#pragma unroll
                for (int c = 0; c < 8; ++c) z[c] = y[c] * e2;
                *(LAS u32x4*)(L + GA_KEI + t * LDI + 16 * cg) = pack8(z); }
            else {
#pragma unroll
                for (int c = 0; c < 8; ++c) z[c] = y[c] * bt;
                *(LAS u32x4*)(L + GA_VB + t * LDI + 16 * cg) = pack8(z); }
        }
    }
    __syncthreads(); PROF_SUB(1);
    if (has_next) {
        ml_a_fetch(F, cid + 256, P);
        gb = gld4(GT + (size_t)(t0 + SEQ + lane) * 16 + 8 + h); ga = gld4(GT + (size_t)(t0 + SEQ + lane) * 16 + 12 + h);
        gd_a_issue(F, cid + 256, w, lane); }
    { const int ti = w & 3, kind = w >> 2; const int tl = 16 * ti + ln; const float gct = gcs[tl], bt = bts[tl];
      bf16* QKD = (bf16*)(F.ws + WS_GDQK) + (size_t)cid * 4096;
#pragma unroll
      for (int si = 0; si < 4; ++si) {
          if (si <= ti) {
              f32x4 acc = (f32x4){0.f, 0.f, 0.f, 0.f};
#pragma unroll
              for (int ks = 0; ks < 4; ++ks) { const bf16x8 af = *(const LAS bf16x8*)(L + GA_KH + (16 * si + ln) * LDI + (32 * ks + 8 * g) * 2);
                  const bf16x8 bfr = *(const LAS bf16x8*)(L + (kind ? GA_QH : GA_KH) + tl * LDI + (32 * ks + 8 * g) * 2); acc = MFMA16(af, bfr, acc); }
              const f32x4 gs = *(const LAS f32x4*)(gcs + 16 * si + 4 * g);
              f32x4 v;
#pragma unroll
              for (int i = 0; i < 4; ++i) { const int s = 16 * si + 4 * g + i; const float dec = __expf(gct - gs[i]);
                  v[i] = kind ? ((s <= tl) ? acc[i] * dec : 0.f) : ((s < tl) ? bt * acc[i] * dec : 0.f); }
              if (kind) *(u32x2*)(QKD + (ti * 2 + (si >> 1)) * 512 + ((2 * (si & 1) + (g >> 1)) * 16 + ln) * 8 + (g & 1) * 4) = pack4(v);
              else { *(LAS u32x2*)(L + GA_NA + tl * LDK + (16 * si + 4 * g) * 2) = pack4(-v);
                  if (si == ti) { LAS float* AD = (LAS float*)(L + GA_AD) + ti * 256 + ln * 16 + 4 * g; AD[0] = v[0]; AD[1] = v[1]; AD[2] = v[2]; AD[3] = v[3]; } }
          } else if (kind) *(u32x2*)(QKD + (ti * 2 + (si >> 1)) * 512 + ((2 * (si & 1) + (g >> 1)) * 16 + ln) * 8 + (g & 1) * 4) = (u32x2){0u, 0u};
      } }
    __syncthreads(); PROF_SUB(2);
    if (w == 0) {
        const LAS float* AD = (const LAS float*)(L + GA_AD) + g * 256; float a_[16][16], acc[16];
#pragma unroll
        for (int t = 1; t < 16; ++t)
#pragma unroll
            for (int q = 0; q < 4; ++q) { if (4 * q < t) { const f32x4 r = *(const LAS f32x4*)(AD + t * 16 + 4 * q); a_[t][4 * q] = r[0]; a_[t][4 * q + 1] = r[1]; a_[t][4 * q + 2] = r[2]; a_[t][4 * q + 3] = r[3]; } }
#pragma unroll
        for (int t = 0; t < 16; ++t) acc[t] = (t == ln) ? 1.f : 0.f;
#pragma unroll
        for (int s_ = 0; s_ < 16; ++s_) { const float tc = acc[s_]; *(LAS bf16*)(L + GA_TI + (16 * g + s_) * 32 + ln * 2) = f2bf(tc);
#pragma unroll
            for (int t = s_ + 1; t < 16; ++t) acc[t] -= a_[t][s_] * tc; }
    }
    __syncthreads(); PROF_SUB(3);
    { const int src = (w < 4) ? GA_VB : GA_KB, cb = 32 * (w & 3);
      u32x2 Ub[4][2]; bf16* UT = (bf16*)(F.ws + WS_GDUT) + (size_t)cid * 8192;
#pragma unroll
      for (int i = 0; i < 4; ++i) {
          f32x4 acc[2];
#pragma unroll
          for (int nt = 0; nt < 2; ++nt)
#pragma unroll
              for (int r = 0; r < 4; ++r) acc[nt][r] = bf2f(*(const LAS bf16*)(L + src + (16 * i + 4 * g + r) * LDI + (cb + 16 * nt + ln) * 2));
#pragma unroll
          for (int jp = 0; jp < 2; ++jp) { if (2 * jp < i) {
              const u32x2 alo = *(const LAS u32x2*)(L + GA_NA + (16 * i + ln) * LDK + (32 * jp + 4 * g) * 2);
              const u32x2 ahi = (2 * jp + 1 < i) ? *(const LAS u32x2*)(L + GA_NA + (16 * i + ln) * LDK + (32 * jp + 16 + 4 * g) * 2) : (u32x2){0u, 0u};
              const bf16x8 af = __builtin_bit_cast(bf16x8, (u32x4){alo.x, alo.y, ahi.x, ahi.y});
#pragma unroll
              for (int nt = 0; nt < 2; ++nt) { const u32x2 blo = Ub[2 * jp][nt], bhi = (2 * jp + 1 < i) ? Ub[2 * jp + 1][nt] : (u32x2){0u, 0u};
                  acc[nt] = MFMA16(af, __builtin_bit_cast(bf16x8, (u32x4){blo.x, blo.y, bhi.x, bhi.y}), acc[nt]); } } }
          const u32x2 tlo = *(const LAS u32x2*)(L + GA_TI + (16 * i + ln) * 32 + (4 * g) * 2);
          const bf16x8 tf = __builtin_bit_cast(bf16x8, (u32x4){tlo.x, tlo.y, 0u, 0u});
#pragma unroll
          for (int nt = 0; nt < 2; ++nt) { const u32x2 p = pack4(acc[nt]);
              const f32x4 u = MFMA16(tf, __builtin_bit_cast(bf16x8, (u32x4){p.x, p.y, 0u, 0u}), ((f32x4){0.f, 0.f, 0.f, 0.f}));
              Ub[i][nt] = pack4(u);
              if (w < 4) *(u32x2*)(UT + ((cb >> 4) + nt) * 1024 + i * 256 + lane * 4) = Ub[i][nt];
              else {
#pragma unroll
                  for (int r = 0; r < 4; ++r) *(LAS bf16*)(L + GA_QH + (16 * i + 4 * g + r) * LDI + (cb + 16 * nt + ln) * 2) = f2bf(-u[r]); } }
      } }
    __syncthreads(); PROF_SUB(4);
    { bf16* W = (bf16*)(F.ws + WS_GDW) + (size_t)cid * 8192; bf16* KET = (bf16*)(F.ws + WS_GDKE) + (size_t)cid * 8192;
#pragma unroll
      for (int q = 0; q < 2; ++q) { const int item = tid + 512 * q, f = item >> 6, lp = item & 63, t = 16 * (f >> 2) + (lp & 15), kk = f & 3, gp = lp >> 4;
          const u32x2 lo = *(const LAS u32x2*)(L + GA_QH + t * LDI + (32 * kk + 4 * gp) * 2), hi = *(const LAS u32x2*)(L + GA_QH + t * LDI + (32 * kk + 16 + 4 * gp) * 2);
          *(u32x4*)(W + item * 8) = (u32x4){lo.x, lo.y, hi.x, hi.y}; }
#pragma unroll
      for (int q = 0; q < 4; ++q) { const int rg = 4 * q + g, kk = rg >> 3, idx = rg & 7, pos = 32 * kk + ((idx < 4) ? 8 * idx : 8 * (idx - 4) + 4);
          const int trow = 32 * kk + ((idx < 4) ? 4 * idx : 16 + 4 * (idx - 4));
          const s16x4 v = tr_read4(lds_addr(L + GA_KEI) + (unsigned)((trow + (ln >> 2)) * LDI + (16 * w + 4 * (ln & 3)) * 2));
          *(s16x4*)(KET + (w * 2 + kk) * 512 + ((idx & 3) * 16 + ln) * 8 + ((idx < 4) ? 0 : 4)) = v; }
    }
    __syncthreads(); PROF_SUB(5);
}
constexpr int GB_STAGE = 36864;
DI void gd_b_issue(const bf16* W, const bf16* KET, const bf16* UT, size_t cid, int dv0, int ln, int g, LAS unsigned char* buf) {
#pragma unroll
    for (int mt = 0; mt < 4; ++mt)
#pragma unroll
        for (int kk = 0; kk < 4; ++kk) __builtin_amdgcn_global_load_lds((const unsigned*)(W + cid * 8192 + (mt * 4 + kk) * 512 + (16 * g + ln) * 8), (LAS unsigned*)(buf + (mt * 4 + kk) * 1024), 16, 0, 0);
#pragma unroll
    for (int j = 0; j < 8; ++j)
#pragma unroll
        for (int k2 = 0; k2 < 2; ++k2) __builtin_amdgcn_global_load_lds((const unsigned*)(KET + cid * 8192 + (j * 2 + k2) * 512 + (16 * g + ln) * 8), (LAS unsigned*)(buf + (16 + j * 2 + k2) * 1024), 16, 0, 0);
#pragma unroll
    for (int q = 0; q < 2; ++q) __builtin_amdgcn_global_load_lds((const unsigned*)(UT + cid * 8192 + dv0 * 64 + q * 512 + (16 * g + ln) * 8), (LAS unsigned*)(buf + (32 + q) * 1024), 16, 0, 0);
}
#define GB_RD16(f, addr, WAITSTR) asm volatile( \
    "ds_read_b128 %0, %16\n\tds_read_b128 %1, %16 offset:1024\n\tds_read_b128 %2, %16 offset:2048\n\tds_read_b128 %3, %16 offset:3072\n\t" \
    "ds_read_b128 %4, %16 offset:4096\n\tds_read_b128 %5, %16 offset:5120\n\tds_read_b128 %6, %16 offset:6144\n\tds_read_b128 %7, %16 offset:7168\n\t" \
    "ds_read_b128 %8, %16 offset:8192\n\tds_read_b128 %9, %16 offset:9216\n\tds_read_b128 %10, %16 offset:10240\n\tds_read_b128 %11, %16 offset:11264\n\t" \
    "ds_read_b128 %12, %16 offset:12288\n\tds_read_b128 %13, %16 offset:13312\n\tds_read_b128 %14, %16 offset:14336\n\tds_read_b128 %15, %16 offset:15360" WAITSTR \
    : "=&v"(f[0]), "=&v"(f[1]), "=&v"(f[2]), "=&v"(f[3]), "=&v"(f[4]), "=&v"(f[5]), "=&v"(f[6]), "=&v"(f[7]), \
      "=&v"(f[8]), "=&v"(f[9]), "=&v"(f[10]), "=&v"(f[11]), "=&v"(f[12]), "=&v"(f[13]), "=&v"(f[14]), "=&v"(f[15]) : "v"(addr) : "memory")
constexpr int GB_NS = 4, GB_FLAGS = LDS_MISC + 512, GB_SPIN_CAP = 1 << 22;
DI void gd_b_step(Ctx& F, f32x4 (&S)[8], size_t cid, int dv0, int lane, int ln, int g, float egl, unsigned stage_base, int n) {
    const unsigned base = stage_base + (unsigned)lane * 16u;
    bf16* VNT = (bf16*)(F.ws + WS_GDVN); bf16* SPT = (bf16*)(F.ws + WS_GDSP);
    bf16x8 wf[16], kef[16]; u32x2 ui[4];
    asm volatile("ds_read_b64 %0, %4 offset:32768\n\tds_read_b64 %1, %4 offset:33280\n\tds_read_b64 %2, %4 offset:33792\n\tds_read_b64 %3, %4 offset:34304"
                 : "=&v"(ui[0]), "=&v"(ui[1]), "=&v"(ui[2]), "=&v"(ui[3]) : "v"(stage_base + (unsigned)lane * 8u) : "memory");
    GB_RD16(wf, base, "\n\ts_waitcnt lgkmcnt(0)");
    asm volatile("" : "+v"(ui[0]), "+v"(ui[1]), "+v"(ui[2]), "+v"(ui[3]));
    GB_RD16(kef, base + 16384u, "");
    f32x4 vacc[4]; bf16x8 sbn[4];
#pragma unroll
    for (int kk = 0; kk < 4; ++kk) sbn[kk] = pack_frag(S[2 * kk], S[2 * kk + 1]);
#pragma unroll
    for (int j = 0; j < 8; ++j) *(u32x2*)(SPT + cid * 16384 + ((dv0 >> 4) * 4 + (j >> 1)) * 512 + ((2 * (j & 1) + (g >> 1)) * 16 + ln) * 8 + (g & 1) * 4) = pack4(S[j]);
#pragma unroll
    for (int mt = 0; mt < 4; ++mt) vacc[mt] = unpack4(ui[mt]);
#pragma unroll
    for (int kk = 0; kk < 4; ++kk)
#pragma unroll
        for (int mt = 0; mt < 4; ++mt) vacc[mt] = MFMA16(wf[mt * 4 + kk], sbn[kk], vacc[mt]);
#pragma unroll
    for (int mt = 0; mt < 4; ++mt) *(u32x2*)(VNT + cid * 8192 + ((dv0 >> 4) * 2 + (mt >> 1)) * 512 + ((2 * (mt & 1) + (g >> 1)) * 16 + ln) * 8 + (g & 1) * 4) = pack4(vacc[mt]);
    bf16x8 vb[2]; vb[0] = pack_frag(vacc[0], vacc[1]); vb[1] = pack_frag(vacc[2], vacc[3]);
    asm volatile("s_waitcnt lgkmcnt(0)" : "+v"(kef[0]), "+v"(kef[1]), "+v"(kef[2]), "+v"(kef[3]), "+v"(kef[4]), "+v"(kef[5]), "+v"(kef[6]), "+v"(kef[7]),
                 "+v"(kef[8]), "+v"(kef[9]), "+v"(kef[10]), "+v"(kef[11]), "+v"(kef[12]), "+v"(kef[13]), "+v"(kef[14]), "+v"(kef[15]) :: "memory");
    if (lane == 0) ((volatile LAS unsigned*)(F.lds + GB_FLAGS))[4] = (unsigned)(n + 1);
#pragma unroll
    for (int j = 0; j < 8; ++j) S[j] *= egl;
#pragma unroll
    for (int k2 = 0; k2 < 2; ++k2)
#pragma unroll
        for (int j = 0; j < 8; ++j) S[j] = MFMA16(kef[j * 2 + k2], vb[k2], S[j]);
}
DI void gd_b_task(Ctx& F, int task) {
    const int bh = task >> 3, dv0 = 16 * (task & 7), lane = F.lane, g = lane >> 4, ln = lane & 15;
    const float* GL = (const float*)(F.ws + WS_GDGL);
    volatile LAS unsigned* fl = (volatile LAS unsigned*)(F.lds + GB_FLAGS);
    f32x4 S[8];
#pragma unroll
    for (int j = 0; j < 8; ++j) S[j] = (f32x4){0.f, 0.f, 0.f, 0.f};
    const size_t c0 = (size_t)bh * 64;
    const float eglv = ldf(GL + c0 + lane);
    asm volatile("s_waitcnt vmcnt(0)" ::: "memory");
    const unsigned L0 = lds_addr(F.lds);
#pragma unroll 1
    for (int n = 0; n < 64; ++n) {
        unsigned spins = 0;
        unsigned long long tp0_ = 0; if (((PROF_MASK) >> 22) & 1) tp0_ = __builtin_amdgcn_s_memrealtime();
        while (fl[n & 3] < (unsigned)(n + 1)) { __builtin_amdgcn_s_sleep(1); if (++spins > (unsigned)GB_SPIN_CAP) { fl[5] = 1u; break; } }
        if (((PROF_MASK) >> 22) & 1) { if (blockIdx.x == 0 && lane == 0) { volatile LAS unsigned long long* pw = (volatile LAS unsigned long long*)(F.lds + LDS_MISC + 128); pw[1] += __builtin_amdgcn_s_memrealtime() - tp0_; } }
        gd_b_step(F, S, c0 + n, dv0, lane, ln, g, __builtin_amdgcn_readlane(eglv, n), L0 + (unsigned)(n & 3) * GB_STAGE, n);
    }
}
DI void gd_b_loader(Ctx& F, int task, int li) {
    const int bh = task >> 3, dv0 = 16 * (task & 7), lane = F.lane, g = lane >> 4, ln = lane & 15;
    const bf16* UT = (const bf16*)(F.ws + WS_GDUT); const bf16* W = (const bf16*)(F.ws + WS_GDW); const bf16* KET = (const bf16*)(F.ws + WS_GDKE);
    volatile LAS unsigned* fl = (volatile LAS unsigned*)(F.lds + GB_FLAGS);
    const size_t c0 = (size_t)bh * 64;
    int prev = -1;
#pragma unroll 1
    for (int n = li; n < 64; n += 2) {
        if (n >= GB_NS) { unsigned spins = 0; while (fl[4] < (unsigned)(n - GB_NS + 1)) { __builtin_amdgcn_s_sleep(1); if (++spins > (unsigned)GB_SPIN_CAP) { fl[5] = 1u; break; } } }
        gd_b_issue(W, KET, UT, c0 + n, dv0, ln, g, F.lds + (n & 3) * GB_STAGE);
        if (prev >= 0) { asm volatile("s_waitcnt vmcnt(34)" ::: "memory"); if (lane == 0) fl[prev & 3] = (unsigned)(prev + 1); }
        prev = n;
    }
    asm volatile("s_waitcnt vmcnt(0)" ::: "memory"); if (lane == 0) fl[prev & 3] = (unsigned)(prev + 1);
}
DI void gd_c_unit(Ctx& F, const Args& a, int l, int cid, int par) {
    const int b = cid >> 8, h = (cid >> 6) & 3, n = cid & 63, t0 = b * SEQ + n * CH, lane = F.lane, g = lane >> 4, ln = lane & 15, w = F.wave, tt = w & 3, dh = w >> 2, tl = 16 * tt + ln;
    const bf16* PROJ = (const bf16*)(F.ws + WS_PROJ);
    const bf16* SPT = (const bf16*)(F.ws + WS_GDSP) + (size_t)cid * 16384; const bf16* QG = (const bf16*)(F.ws + WS_GDQG) + (size_t)cid * 8192;
    const bf16* VNT = (const bf16*)(F.ws + WS_GDVN) + (size_t)cid * 8192; const bf16* QKD = (const bf16*)(F.ws + WS_GDQK) + (size_t)cid * 4096;
    LAS float* ss = (LAS float*)(F.lds + par * 1024);
    bf16x8 qf[4], pf[2];
#pragma unroll
    for (int ks = 0; ks < 4; ++ks) qf[ks] = *(const bf16x8*)(QG + tl * 128 + 32 * ks + 8 * g);
#pragma unroll
    for (int ks = 0; ks < 2; ++ks) pf[ks] = *(const bf16x8*)(QKD + tl * 64 + 32 * ks + 8 * g);
    u32x2 zr[4]; f32x4 nwr[4];
#pragma unroll
    for (int mt = 0; mt < 4; ++mt) { const int dv = 16 * (4 * dh + mt) + 4 * g; nwr[mt] = *(const f32x4*)(inp(F, 9) + (size_t)l * 128 + dv); zr[mt] = *(const u32x2*)(PROJ + (size_t)(t0 + tl) * NPROJ + 3072 + h * 128 + dv); }
    f32x4 o[4]; float ssq = 0.f;
#pragma unroll
    for (int mt = 0; mt < 4; ++mt) { o[mt] = (f32x4){0.f, 0.f, 0.f, 0.f}; const int dvr = 16 * (4 * dh + mt) + ln;
#pragma unroll
        for (int ks = 0; ks < 4; ++ks) o[mt] = MFMA16(*(const bf16x8*)(SPT + (size_t)dvr * 128 + 32 * ks + 8 * g), qf[ks], o[mt]);
#pragma unroll
        for (int ks = 0; ks < 2; ++ks) o[mt] = MFMA16(*(const bf16x8*)(VNT + (size_t)dvr * 64 + 32 * ks + 8 * g), pf[ks], o[mt]);
        ssq += (o[mt][0] * o[mt][0] + o[mt][1] * o[mt][1]) + (o[mt][2] * o[mt][2] + o[mt][3] * o[mt][3]); }
    ssq += __shfl_xor(ssq, 16); ssq += __shfl_xor(ssq, 32);
    if (g == 0) ss[tl * 2 + dh] = ssq;
    __syncthreads();
    const float rinv = rsqrtf((ss[tl * 2] + ss[tl * 2 + 1]) * (1.f / 128.f) + 1e-6f);
    bf16* MX = (bf16*)(F.ws + WS_MIXED);
#pragma unroll
    for (int mt = 0; mt < 4; ++mt) { const int dv = 16 * (4 * dh + mt) + 4 * g;
        const f32x4 nw = nwr[mt]; const f32x4 z = unpack4(zr[mt]);
        f32x4 r;
#pragma unroll
        for (int i = 0; i < 4; ++i) r[i] = o[mt][i] * rinv * nw[i] * z[i] * sigmoidf_(z[i]);
        *(u32x2*)(MX + (size_t)(t0 + tl) * D + 512 + h * 128 + dv) = pack4(r); }
}

DI void phase_a(Ctx& F, const Args& a, int l) {
    const int h = (F.vcu >> 6) & 3, lane = F.lane, tid = F.tid, w = F.wave;
    const float* GT = (const float*)(F.ws + WS_GATES);
    for (int e = tid; e < 3 * 4 * 128; e += NTHREADS) { const int ten = e / 512, j = (e >> 7) & 3, c = e & 127;
        *(LAS bf16*)(F.lds + GA_WT + e * 2) = f2bf(inp(F, 6)[((size_t)l * 4 + j) * 1536 + ten * 512 + h * 128 + c]); }
    const float bi = inp(F, 3)[l * 4 + h], bf_ = inp(F, 4)[l * 4 + h], nalog = -__expf(inp(F, 7)[l * 4 + h]), dtb = inp(F, 8)[l * 4 + h];
    asm volatile("s_waitcnt vmcnt(0)" ::: "memory");
    const int t00 = (F.vcu & 63) * CH;
    {
        MlAPre P0; ml_a_fetch(F, F.vcu, P0);
        float gb0 = gld4(GT + (size_t)(t00 + lane) * 16 + 8 + h), ga0 = gld4(GT + (size_t)(t00 + lane) * 16 + 12 + h);
        gd_a_issue(F, F.vcu, w, lane);
        ml_a_unit(F, l, F.vcu, 0, P0, bi, bf_, gb0, ga0, nalog, dtb);
    }
#pragma unroll 1
    for (int i = 0; i < 8; ++i) {
        const int cid = F.vcu + 256 * i;
        MlAPre P; float gb = 0.f, ga = 0.f;
        gd_a_unit(F, l, cid, gb, ga, nalog, dtb, i + 1 < 8, P);
        if (i + 1 < 8) ml_a_unit(F, l, cid + 256, (i + 1) & 1, P, bi, bf_, gb, ga, nalog, dtb);
    }
    asm volatile("s_waitcnt vmcnt(0)" ::: "memory"); __syncthreads();
}
constexpr int CS_K = 0, CS_Q = 8192, CS_CT = 16384, CS_V = 32768, CS_NP = 49152, CS_SC = 49408, CS_GI = 50688, CS_GF = 50944, GS_SP = 51200, GS_QG = 83968, GS_VN = 100352, GS_QK = 116736, GS_SS = 124928;
constexpr int CS_OG = 126464, GS_Z = 142848, CS_MP = 159232;
DI void lds_rd4x8_nowait(unsigned addr, u32x2& a, u32x2& b, u32x2& c, u32x2& d) { asm volatile("ds_read_b64 %0, %4\n\tds_read_b64 %1, %4 offset:32\n\tds_read_b64 %2, %4 offset:64\n\tds_read_b64 %3, %4 offset:96" : "=&v"(a), "=&v"(b), "=&v"(c), "=&v"(d) : "v"(addr) : "memory"); }
DI float lds_rd4(unsigned addr) { float r; asm volatile("ds_read_b32 %0, %1\n\ts_waitcnt lgkmcnt(0)" : "=v"(r) : "v"(addr) : "memory"); return r; }
DI bf16x8 lds_frag(unsigned addr) { bf16x8 r; asm volatile("ds_read_b128 %0, %1" : "=v"(r) : "v"(addr) : "memory"); return r; }
DI f32x2 lds_rd8(unsigned addr) { f32x2 r; asm volatile("ds_read_b64 %0, %1\n\ts_waitcnt lgkmcnt(0)" : "=v"(r) : "v"(addr) : "memory"); return r; }
DI void mlc_issue(Ctx& F, int cid, int w, int lane) {
    const int b = cid >> 8, h = (cid >> 6) & 3, n = cid & 63, t0 = b * SEQ + n * CH, g = lane >> 4, ln = lane & 15;
    const bf16* PROJ = (const bf16*)(F.ws + WS_PROJ); const bf16* CT = (const bf16*)(F.ws + WS_MLCT) + (size_t)cid * 8192;
    DMA16(PROJ + (size_t)(t0 + 16 * (w >> 1) + ln) * NPROJ + 256 + h * 64 + 32 * (w & 1) + 8 * g, F.lds + CS_K + w * 1024);
    DMA16(PROJ + (size_t)(t0 + 16 * (w >> 1) + ln) * NPROJ + h * 64 + 32 * (w & 1) + 8 * g, F.lds + CS_Q + w * 1024);
#pragma unroll
    for (int ks = 0; ks < 2; ++ks) DMA16(CT + (2 * w + ks) * 512 + lane * 8, F.lds + CS_CT + (2 * w + ks) * 1024);
#pragma unroll
    for (int q = 0; q < 2; ++q) { const int j = 2 * w + q; DMA16(PROJ + (size_t)(t0 + 4 * j + g) * NPROJ + 512 + h * 128 + 8 * ln, F.lds + CS_V + j * 1024); }
    __builtin_amdgcn_global_load_lds((const unsigned*)((const float*)(F.ws + WS_MLNP) + (size_t)cid * 64 + lane), (LAS unsigned*)(F.lds + CS_NP), 4, 0, 0);
#pragma unroll
    for (int q = 0; q < 2; ++q) { const int j = 2 * w + q; DMA16(PROJ + (size_t)(t0 + 4 * j + g) * NPROJ + 1024 + h * 128 + 8 * ln, F.lds + CS_OG + j * 1024); }
    const float* GT = (const float*)(F.ws + WS_GATES);
    __builtin_amdgcn_global_load_lds((const unsigned*)(GT + (size_t)(t0 + lane) * 16 + h), (LAS unsigned*)(F.lds + CS_GI), 4, 0, 0);
    __builtin_amdgcn_global_load_lds((const unsigned*)(GT + (size_t)(t0 + lane) * 16 + 4 + h), (LAS unsigned*)(F.lds + CS_GF), 4, 0, 0);
    __builtin_amdgcn_global_load_lds((const unsigned*)((const float*)(F.ws + WS_MLMP) + cid), (LAS unsigned*)(F.lds + CS_MP), 4, 0, 0);
}
DI void gdc_issue(Ctx& F, int cid, int w, int lane) {
    const int g = lane >> 4, ln = lane & 15;
    const bf16* SPT = (const bf16*)(F.ws + WS_GDSP) + (size_t)cid * 16384; const bf16* QG = (const bf16*)(F.ws + WS_GDQG) + (size_t)cid * 8192;
    const bf16* VNT = (const bf16*)(F.ws + WS_GDVN) + (size_t)cid * 8192; const bf16* QKD = (const bf16*)(F.ws + WS_GDQK) + (size_t)cid * 4096;
#pragma unroll
    for (int ks = 0; ks < 4; ++ks) DMA16(SPT + (4 * w + ks) * 512 + lane * 8, F.lds + GS_SP + (4 * w + ks) * 1024);
#pragma unroll
    for (int q = 0; q < 2; ++q) { const int bq = 2 * w + q; DMA16(QG + (size_t)(16 * (bq >> 2) + ln) * 128 + 32 * (bq & 3) + 8 * g, F.lds + GS_QG + bq * 1024); }
#pragma unroll
    for (int ks = 0; ks < 2; ++ks) DMA16(VNT + (2 * w + ks) * 512 + lane * 8, F.lds + GS_VN + (2 * w + ks) * 1024);
    DMA16(QKD + w * 512 + lane * 8, F.lds + GS_QK + w * 1024);
    { const int b = cid >> 8, h = (cid >> 6) & 3, n = cid & 63, t0 = b * SEQ + n * CH; const bf16* PROJ = (const bf16*)(F.ws + WS_PROJ);
#pragma unroll
      for (int q = 0; q < 2; ++q) { const int j = 2 * w + q; DMA16(PROJ + (size_t)(t0 + 4 * j + g) * NPROJ + 3072 + h * 128 + 8 * ln, F.lds + GS_Z + j * 1024); } }
}
constexpr int GS_NW = 125440;
DI void phase_c(Ctx& F, const Args& a, int l) {
    const int lane = F.lane, g = lane >> 4, ln = lane & 15, w = F.wave, tt = w & 3, dh = w >> 2, tl = 16 * tt + ln;
    const int h = (F.vcu >> 6) & 3, n = F.vcu & 63;
    const bf16* PROJ = (const bf16*)(F.ws + WS_PROJ); const float* GT = (const float*)(F.ws + WS_GATES); bf16* MX = (bf16*)(F.ws + WS_MIXED);
    const unsigned L0 = lds_addr(F.lds);
    LAS float* ib = (LAS float*)(F.lds + CS_SC); LAS float* Mt = ib + 64; LAS float* bcs = ib + 128;
    if (F.tid < 256) ((LAS float*)(F.lds + GS_NW))[F.tid] = (F.tid < 128) ? inp(F, 5)[(size_t)l * 512 + h * 128 + F.tid] : inp(F, 9)[(size_t)l * 128 + F.tid - 128];
    const float bi = inp(F, 3)[l * 4 + h], bf_ = inp(F, 4)[l * 4 + h];
    asm volatile("s_waitcnt vmcnt(0)" ::: "memory");
    __syncthreads();
    mlc_issue(F, F.vcu, w, lane);
    gdc_issue(F, F.vcu, w, lane);
#pragma unroll 1
    for (int i = 0; i < 8; ++i) {
        const int cid = F.vcu + 256 * i, t0 = i * SEQ + n * CH;
        asm volatile("s_waitcnt vmcnt(11)" ::: "memory");
        const float mpv = lds_rd4(L0 + CS_MP + lane * 4);
        if (w == 7) { const float gi = lds_rd4(L0 + CS_GI + lane * 4), gf = lds_rd4(L0 + CS_GF + lane * 4); const float ip = softcap15(gi + bi), fp = softcap15(gf + bf_);
            const float bc = wave_incl_sum(log_sigmoid(fp), lane), ibs = ip - bc, pm = wave_incl_max(ibs, lane);
            ib[lane] = ibs; Mt[lane] = fmaxf(mpv, pm); bcs[lane] = bc; }
        asm volatile("s_waitcnt lgkmcnt(0)" ::: "memory"); __builtin_amdgcn_s_barrier(); asm volatile("" ::: "memory");
        const float mprev = mpv;
        const float Mtt = lds_rd8(L0 + CS_SC + 256 + (tl & ~1) * 4)[tl & 1], bct = lds_rd8(L0 + CS_SC + 512 + (tl & ~1) * 4)[tl & 1];
        bf16x8 qf[2], kf[4][2];
#pragma unroll
        for (int ks = 0; ks < 2; ++ks) { qf[ks] = lds_frag(L0 + CS_Q + (tt * 2 + ks) * 1024 + lane * 16);
#pragma unroll
            for (int ms = 0; ms < 4; ++ms) kf[ms][ks] = lds_frag(L0 + CS_K + (ms * 2 + ks) * 1024 + lane * 16); }
        f32x4 ibv[4], dum_;
#pragma unroll
        for (int ms = 0; ms < 4; ++ms) g8::lds_rd2x16(L0 + CS_SC + (16 * ms + 4 * g) * 4, ibv[ms], dum_);
        asm volatile("" : "+v"(qf[0]), "+v"(qf[1]), "+v"(kf[0][0]), "+v"(kf[0][1]), "+v"(kf[1][0]), "+v"(kf[1][1]), "+v"(kf[2][0]), "+v"(kf[2][1]), "+v"(kf[3][0]), "+v"(kf[3][1]));
        f32x4 sacc[4];
#pragma unroll
        for (int ms = 0; ms < 4; ++ms) { sacc[ms] = (f32x4){0.f, 0.f, 0.f, 0.f};
#pragma unroll
            for (int ks = 0; ks < 2; ++ks) sacc[ms] = MFMA16(kf[ms][ks], qf[ks], sacc[ms]); }
#pragma unroll
        for (int ms = 0; ms < 4; ++ms)
#pragma unroll
            for (int q = 0; q < 4; ++q) { const int s_ = 16 * ms + 4 * g + q; sacc[ms][q] = (s_ <= tl) ? sacc[ms][q] * 0.125f * __expf(ibv[ms][q] - Mtt) : 0.f; }
        bf16x8 sb[2]; sb[0] = pack_frag(sacc[0], sacc[1]); sb[1] = pack_frag(sacc[2], sacc[3]);
        bf16x8 ctf[5][2]; f32x4 npa[2], npb[2];
#pragma unroll
        for (int ks = 0; ks < 2; ++ks)
#pragma unroll
            for (int mt = 0; mt < 4; ++mt) ctf[mt][ks] = lds_frag(L0 + CS_CT + ((4 * dh + mt) * 2 + ks) * 1024 + lane * 16);
        g8::lds_rd2x16(L0 + CS_NP + (8 * g) * 4, npa[0], npa[1]); g8::lds_rd2x16(L0 + CS_NP + (32 + 8 * g) * 4, npb[0], npb[1]);
        asm volatile("" : "+v"(ctf[0][0]), "+v"(ctf[0][1]), "+v"(ctf[1][0]), "+v"(ctf[1][1]), "+v"(ctf[2][0]), "+v"(ctf[2][1]), "+v"(ctf[3][0]), "+v"(ctf[3][1]));
        { float nvv[8];
#pragma unroll
          for (int j = 0; j < 4; ++j) { nvv[j] = (ln == 0) ? npa[0][j] : 0.f; nvv[4 + j] = (ln == 0) ? npa[1][j] : 0.f; }
          ctf[4][0] = __builtin_bit_cast(bf16x8, pack8(nvv));
#pragma unroll
          for (int j = 0; j < 4; ++j) { nvv[j] = (ln == 0) ? npb[0][j] : 0.f; nvv[4 + j] = (ln == 0) ? npb[1][j] : 0.f; }
          ctf[4][1] = __builtin_bit_cast(bf16x8, pack8(nvv)); }
        f32x4 xacc[5];
#pragma unroll
        for (int mt = 0; mt < 5; ++mt) { xacc[mt] = (f32x4){0.f, 0.f, 0.f, 0.f};
#pragma unroll
            for (int ks = 0; ks < 2; ++ks) xacc[mt] = MFMA16(ctf[mt][ks], qf[ks], xacc[mt]); }
        const float wint = 0.125f * __expf(mprev - Mtt);
#pragma unroll
        for (int mt = 0; mt < 5; ++mt) xacc[mt] *= wint;
        const bf16x8 ones = (ln == 0) ? (bf16x8){0x3f80, 0x3f80, 0x3f80, 0x3f80, 0x3f80, 0x3f80, 0x3f80, 0x3f80} : (bf16x8){0, 0, 0, 0, 0, 0, 0, 0};
#pragma unroll
        for (int kk = 0; kk < 2; ++kk) {
#pragma unroll
            for (int mt = 0; mt < 4; ++mt) { const bf16x8 vf = tr_frag8(L0 + CS_V, 256, 32 * kk + 4 * g, 32 * kk + 16 + 4 * g, 16 * (4 * dh + mt), lane); xacc[mt] = MFMA16(vf, sb[kk], xacc[mt]); }
            xacc[4] = MFMA16(ones, sb[kk], xacc[4]); }
        const float den = __shfl(xacc[4][0], ln), dinv = __builtin_amdgcn_rcpf(fmaxf(fabsf(den), __expf(-(bct + Mtt))));
        float ssq = 0.f;
#pragma unroll
        for (int mt = 0; mt < 4; ++mt) { xacc[mt] *= dinv; ssq += (xacc[mt][0] * xacc[mt][0] + xacc[mt][1] * xacc[mt][1]) + (xacc[mt][2] * xacc[mt][2] + xacc[mt][3] * xacc[mt][3]); }
        ssq += __shfl_xor(ssq, 16); ssq += __shfl_xor(ssq, 32);
        if (g == 0) *(LAS float*)(F.lds + CS_SC + 768 + (tl * 2 + dh) * 4) = ssq;
        u32x2 og0, og1, og2, og3; lds_rd4x8_nowait(L0 + CS_OG + tl * 256 + (16 * 4 * dh + 4 * g) * 2, og0, og1, og2, og3);
        asm volatile("s_waitcnt lgkmcnt(0)" : "+v"(og0), "+v"(og1), "+v"(og2), "+v"(og3) :: "memory"); __builtin_amdgcn_s_barrier(); asm volatile("" ::: "memory");
        if (i + 1 < 8) mlc_issue(F, cid + 256, w, lane);
        { const f32x2 s2 = lds_rd8(L0 + CS_SC + 768 + tl * 8); const float rinv = rsqrtf((s2[0] + s2[1]) * (1.f / 128.f) + 1e-6f);
#pragma unroll
          for (int mt = 0; mt < 4; ++mt) { const int dv = 16 * (4 * dh + mt) + 4 * g; const f32x4 og = unpack4(mt == 0 ? og0 : (mt == 1 ? og1 : (mt == 2 ? og2 : og3))); f32x4 nw, o; g8::lds_rd2x16(L0 + GS_NW + dv * 4, nw, dum_);
#pragma unroll
              for (int q = 0; q < 4; ++q) o[q] = xacc[mt][q] * rinv * nw[q] * sigmoidf_(og[q]);
              *(u32x2*)(MX + (size_t)(t0 + tl) * D + h * 128 + dv) = pack4(o); } }
        if (i + 1 < 8) asm volatile("s_waitcnt vmcnt(12)" ::: "memory");
        else asm volatile("s_waitcnt vmcnt(0)" ::: "memory");
        __builtin_amdgcn_s_barrier(); asm volatile("" ::: "memory");
        bf16x8 gq[4], gp[2];
#pragma unroll
        for (int ks = 0; ks < 4; ++ks) gq[ks] = lds_frag(L0 + GS_QG + (tt * 4 + ks) * 1024 + lane * 16);
#pragma unroll
        for (int ks = 0; ks < 2; ++ks) gp[ks] = lds_frag(L0 + GS_QK + (tt * 2 + ks) * 1024 + lane * 16);
        f32x4 o[4]; float sq2 = 0.f;
#pragma unroll
        for (int mt = 0; mt < 4; ++mt) { bf16x8 gs[4], gv[2];
#pragma unroll
            for (int ks = 0; ks < 4; ++ks) gs[ks] = lds_frag(L0 + GS_SP + ((4 * dh + mt) * 4 + ks) * 1024 + lane * 16);
#pragma unroll
            for (int ks = 0; ks < 2; ++ks) gv[ks] = lds_frag(L0 + GS_VN + ((4 * dh + mt) * 2 + ks) * 1024 + lane * 16);
            asm volatile("s_waitcnt lgkmcnt(0)" : "+v"(gs[0]), "+v"(gs[1]), "+v"(gs[2]), "+v"(gs[3]), "+v"(gv[0]), "+v"(gv[1]), "+v"(gq[0]), "+v"(gq[1]), "+v"(gq[2]), "+v"(gq[3]), "+v"(gp[0]), "+v"(gp[1]) :: "memory");
            o[mt] = (f32x4){0.f, 0.f, 0.f, 0.f};
#pragma unroll
            for (int ks = 0; ks < 4; ++ks) o[mt] = MFMA16(gs[ks], gq[ks], o[mt]);
#pragma unroll
            for (int ks = 0; ks < 2; ++ks) o[mt] = MFMA16(gv[ks], gp[ks], o[mt]);
            sq2 += (o[mt][0] * o[mt][0] + o[mt][1] * o[mt][1]) + (o[mt][2] * o[mt][2] + o[mt][3] * o[mt][3]); }
        sq2 += __shfl_xor(sq2, 16); sq2 += __shfl_xor(sq2, 32);
        if (g == 0) *(LAS float*)(F.lds + GS_SS + (tl * 2 + dh) * 4) = sq2;
        u32x2 z0, z1, z2, z3; lds_rd4x8_nowait(L0 + GS_Z + tl * 256 + (16 * 4 * dh + 4 * g) * 2, z0, z1, z2, z3);
        asm volatile("s_waitcnt lgkmcnt(0)" : "+v"(z0), "+v"(z1), "+v"(z2), "+v"(z3) :: "memory"); __builtin_amdgcn_s_barrier(); asm volatile("" ::: "memory");
        if (i + 1 < 8) gdc_issue(F, cid + 256, w, lane);
        { const f32x2 s2 = lds_rd8(L0 + GS_SS + tl * 8); const float rinv = rsqrtf((s2[0] + s2[1]) * (1.f / 128.f) + 1e-6f);
#pragma unroll
          for (int mt = 0; mt < 4; ++mt) { const int dv = 16 * (4 * dh + mt) + 4 * g; const f32x4 z = unpack4(mt == 0 ? z0 : (mt == 1 ? z1 : (mt == 2 ? z2 : z3))); f32x4 nw, r; g8::lds_rd2x16(L0 + GS_NW + 512 + dv * 4, nw, dum_);
#pragma unroll
              for (int q = 0; q < 4; ++q) r[q] = o[mt][q] * rinv * nw[q] * z[q] * sigmoidf_(z[q]);
              *(u32x2*)(MX + (size_t)(t0 + tl) * D + 512 + h * 128 + dv) = pack4(r); } }
    }
    asm volatile("s_waitcnt vmcnt(0)" ::: "memory"); __syncthreads();
}
struct P2Order {
    unsigned char* ws; int G, c0;
    DI bool next(int i, g8::Unit& u) const {
        const int L = i * G + c0; if (L >= 1024) return false;
        const int q = L & 511, t4 = q & 3, h = (q >> 2) & 3, b = (q >> 4) & 7, l = q >> 7;
        if (L < 512) { u.a = (const char*)(ws + WS_KV) + ((size_t)(2 * l) * 2048 + b * 256) * 2048 + h * 512; u.b = (const char*)(ws + WS_WQ) + ((size_t)l * 1024 + t4 * 256) * 2048 + h * 512;
            u.c = (char*)(ws + WS_WQK) + ((size_t)(l * 8 + b) * 1024 + h * 256) * 2048 + t4 * 512; u.aux = -1; }
        else { u.a = (const char*)(ws + WS_WO) + ((size_t)l * 1024 + t4 * 256) * 2048 + h * 512; u.b = (const char*)(ws + WS_KV) + ((size_t)(2 * l + 1) * 2048 + b * 256) * 2048 + h * 512;
            u.c = (char*)(ws + WS_WVO) + ((size_t)(l * 8 + b) * 1024 + t4 * 256) * 2048 + h * 512; u.aux = 0; }
        u.pm = 0; u.pn = 0; return true;
    }
};

constexpr int NPH_LAYER = 13, NPH = 3 + NL * NPH_LAYER;
__global__ void __launch_bounds__(NTHREADS, 2) mega(Args a) {
    extern __shared__ __attribute__((aligned(16))) unsigned char lds_raw[];
    Ctx F; F.lds = (LAS unsigned char*)0u; F.ws = a.ws; F.ctl = (unsigned*)(a.ws + WS_CTL);
    F.tid = threadIdx.x; F.lane = F.tid & 63; F.wave = __builtin_amdgcn_readfirstlane(F.tid >> 6); F.G = gridDim.x;
    { const int bx = blockIdx.x; F.vcu = (F.G % 8 == 0) ? (bx % 8) * (F.G / 8) + bx / 8 : bx; }
    volatile LAS unsigned* MISC = (volatile LAS unsigned*)(F.lds + LDS_MISC);
    if (F.tid < 64) MISC[F.tid] = 0u;
    if ((unsigned)(size_t)(LAS unsigned char*)lds_raw != 0u) { if (F.tid == 0) atomicAdd(F.ctl + CW_BAR + XB_TMO, 1u); }
    if (F.tid < 28) { const unsigned long long pv = (unsigned long long)(F.tid < 27 ? (const void*)a.in[F.tid] : (const void*)a.out); ((LAS unsigned long long*)(F.lds + LDS_PTAB))[F.tid] = pv; }
    __syncthreads();
    const bool multi = (a.ph_hi - a.ph_lo) > 1;
    XcdBarrier bar; bar.bar = F.ctl + CW_BAR; bar.x = 0; bar.st = MISC;
    if (multi) bar = xcd_barrier_post(F.ctl + CW_BAR, MISC);
    if (PROF_MASK) { if (blockIdx.x == 0 && threadIdx.x == 0) { volatile LAS unsigned long long* pw = (volatile LAS unsigned long long*)(F.lds + LDS_MISC + 128); const unsigned long long t0_ = __builtin_amdgcn_s_memrealtime(); pw[0] = t0_; pw[1] = 0ull; pw[2] = t0_; } }
#ifndef PMASK
#define PMASK 0xffff
#endif
#define EN(j) (((PMASK) >> (j)) & 1)
#ifndef REPMASK
#define REPMASK 0x0
#endif
#define NREP(j) ((((REPMASK) >> (j)) & 1) ? 2 : 1)
#if REPMASK
#define REPLOOP(j) for (int rep_ = 0; rep_ < NREP(j); ++rep_, __syncthreads())
#else
#define REPLOOP(j)
#endif
#define PH(k) (a.ph_lo <= (k) && (k) < a.ph_hi && (refresh(F, a.ws), true))
#define PROF_TICK(k) do { if (PROF_MASK) { if (blockIdx.x == 0 && threadIdx.x == 0) { volatile LAS unsigned long long* pw = (volatile LAS unsigned long long*)(F.lds + LDS_MISC + 128); \
        const unsigned long long now_ = __builtin_amdgcn_s_memrealtime(); const int j_ = ((k) < 3) ? 13 + (k) : ((k) - 3) % NPH_LAYER; \
        if (((PROF_MASK) >> j_) & 1) pw[1] += now_ - pw[0]; pw[0] = now_; } } } while (0)
#define SEAM(k) do { if (PH(k) && PH((k) + 1)) { xcd_barrier(bar); if (((REPMASK) >> 16) & 1) xcd_barrier(bar); PROF_TICK(k); } } while (0)

    if (EN(13) && PH(0)) REPLOOP(13) { phase_convert(F, a); }
    SEAM(0);
    if (EN(14) && PH(1)) REPLOOP(14) {
        g8::AffineOrder S; S.A = (const char*)(F.ws + WS_MEMB); S.B = (const char*)(F.ws + WS_WKV); S.C = (char*)(F.ws + WS_KV);
        S.aM = 256ull * 2048; S.bB = 0; S.bN = 256ull * 2048; S.cM = 256ull * 2048; S.cS = 2048ull * 2048; S.cN = 512; S.nM = 8; S.nN = 32; S.bdiv = 1 << 30; S.csp = 4; S.G = F.G; S.c0 = F.vcu;
        g8::EpiBf16 E{1024, nullptr, 0, 1.f};
        g8::gemm_phase(F.lds, 2048, 2048, 16, S, E);
        row_pass<0>(F, a, 0);
    }
    SEAM(1);
    if (EN(15) && PH(2)) REPLOOP(15) { P2Order S{F.ws, F.G, F.vcu}; g8::EpiBf16 E{1024, nullptr, 0, 0.0625f}; g8::gemm_phase(F.lds, 2048, 2048, 4, S, E); }
    SEAM(2);
#pragma unroll 1
    for (int l = 0; l < NL; ++l) {
        const int pb = 3 + l * NPH_LAYER;
        if (EN(0) && PH(pb + 0)) REPLOOP(0) {
            g8::AffineOrder S = g8::dense_order(F.ws + WS_XB, F.ws + WS_WIN + (size_t)l * NPROJ * D * 2, F.ws + WS_PROJ, T, NPROJ, D, NPROJ * 2, 2, F.G, F.vcu);
            g8::EpiBf16 E{NPROJ, nullptr, 0, 1.f}; g8::gemm_phase(F.lds, 2048, 2048, 16, S, E);
        }
        SEAM(pb + 0);
        if (EN(1) && PH(pb + 1)) REPLOOP(1) {
            phase_a(F, a, l);
        }
        SEAM(pb + 1);
        if (EN(2) && PH(pb + 2)) REPLOOP(2) {
            if (F.tid < 8) ((volatile LAS unsigned*)(F.lds + GB_FLAGS))[F.tid] = 0u;
            __syncthreads();
            if (F.wave == 0) gd_b_task(F, F.vcu);
            else if (F.wave <= 2) gd_b_loader(F, F.vcu, F.wave - 1);
            else if (F.wave >= 4) ml_b_unit(F, F.vcu);
        }
        SEAM(pb + 2);
        if (EN(3) && PH(pb + 3)) REPLOOP(3) {
            phase_c(F, a, l);
        }
        SEAM(pb + 3);
        if (EN(4) && PH(pb + 4)) REPLOOP(4) {
            g8::AffineOrder S = g8::dense_order(F.ws + WS_MIXED, F.ws + WS_WOUT + (size_t)l * D * D * 2, F.ws + WS_HB, T, D, D, D * 2, 2, F.G, F.vcu);
            g8::EpiBf16 E{D, nullptr, 0, 1.f}; g8::gemm_phase(F.lds, 2048, 2048, 16, S, E);
        }
        SEAM(pb + 4);
        if (EN(5) && PH(pb + 5)) { row_pass<1>(F, a, l); if (NREP(5) == 2) { __syncthreads(); row_pass<1>(F, a, l, true); } }
        SEAM(pb + 5);
        if (EN(6) && PH(pb + 6)) REPLOOP(6) {
            g8::AffineOrder S = g8::dense_order(F.ws + WS_XB, F.ws + WS_WQK + (size_t)l * 8 * D * D * 2, F.ws + WS_PB, T, D, D, D * 2, 2, F.G, F.vcu);
            S.bB = (size_t)D * D * 2; S.bdiv = 16;
            g8::EpiSoftmax E{D}; g8::gemm_phase(F.lds, 2048, 2048, 16, S, E);
        }
        SEAM(pb + 6);
        if (EN(7) && PH(pb + 7)) REPLOOP(7) {
            g8::AffineOrder S = g8::dense_order(F.ws + WS_PB, F.ws + WS_WVO + (size_t)l * 8 * D * D * 2, F.ws + WS_HB, T, D, D, D * 2, 2, F.G, F.vcu);
            S.bB = (size_t)D * D * 2; S.bdiv = 16;
            g8::EpiBf16 E{D, nullptr, 0, 1.f}; g8::gemm_phase(F.lds, 2048, 2048, 16, S, E);
        }
        SEAM(pb + 7);
        if (EN(8) && PH(pb + 8)) { row_pass<2>(F, a, l); if (NREP(8) == 2) { __syncthreads(); row_pass<2>(F, a, l, true); } }
        SEAM(pb + 8);
        if (EN(9) && PH(pb + 9)) phase_scatter(F, l);
        SEAM(pb + 9);
        if (EN(10) && PH(pb + 10)) REPLOOP(10) {
            MoeOrder S; S.gather = 1; S.rev = 0; S.A = (const char*)(F.ws + WS_XB); S.B = (const char*)(F.ws + WS_WGU) + (size_t)l * 32 * 2048 * D * 2; S.C = (char*)(F.ws + WS_ACT); S.tile_e = F.ctl + CW_TILE_E + l * MAXTILES;
            S.NT = __builtin_amdgcn_readfirstlane((int)ldu(F.ctl + CW_NT + l)); S.nN = 8; S.bE = 2048ull * D * 2; S.bN = 256ull * 2048; S.cN = 256; S.G = F.G; S.c0 = F.vcu;
            g8::EpiSwiglu E{inp(F, 22) + (size_t)l * 32 * 2048}; g8::gemm_phase<g8::EpiSwiglu, MoeOrder, true>(F.lds, 2048, 2048, 16, S, E, (const unsigned*)(F.ws + WS_XG));
        }
        SEAM(pb + 10);
        if (EN(11) && PH(pb + 11)) REPLOOP(11) {
            MoeOrder S; S.gather = 0; S.rev = 1; S.A = (const char*)(F.ws + WS_ACT); S.B = (const char*)(F.ws + WS_WDN) + (size_t)l * 32 * D * D * 2; S.C = (char*)(F.ws + WS_Y); S.tile_e = F.ctl + CW_TILE_E + l * MAXTILES;
            S.NT = __builtin_amdgcn_readfirstlane((int)ldu(F.ctl + CW_NT + l)); S.nN = 4; S.bE = (size_t)D * D * 2; S.bN = 256ull * 2048; S.cN = 512; S.G = F.G; S.c0 = F.vcu;
            g8::EpiBf16 E{D, inp(F, 24) + (size_t)l * 32 * D, D, 1.f}; g8::gemm_phase(F.lds, 2048, 2048, 16, S, E);
        }
        SEAM(pb + 11);
        if (EN(12) && PH(pb + 12)) { row_pass<3>(F, a, l); if (NREP(12) == 2 && l < NL - 1) { __syncthreads(); row_pass<3>(F, a, l, true); } }
        SEAM(pb + 12);
    }
    if (PROF_MASK) {
        refresh(F, a.ws);
        xcd_barrier(bar); PROF_TICK(NPH - 1);
        if (blockIdx.x == 0 && threadIdx.x == 0) { volatile LAS unsigned long long* pw = (volatile LAS unsigned long long*)(F.lds + LDS_MISC + 128);
            const float f = (float)(double)pw[1] / (float)(double)(pw[0] - pw[2]); const float q = fminf(1.f, floorf(f * (float)(PROF_SCALE) * 32.f + (float)(PROF_OFS) * 0.5f) * (1.f / 32.f));
            __hip_atomic_store(F.ctl + CW_DBG, __float_as_uint(sqrtf(100.f * q)), __ATOMIC_RELAXED, __HIP_MEMORY_SCOPE_AGENT); }
        xcd_barrier(bar);
        const float c = __uint_as_float(ldu(F.ctl + CW_DBG)); float* o = (float*)inp(F, 27);
        for (size_t i = (size_t)blockIdx.x * NTHREADS + threadIdx.x; i < (size_t)T * D; i += (size_t)gridDim.x * NTHREADS) o[i] = c;
    }
}

#ifndef DBG_STOP
#define DBG_STOP 0
#endif
#ifndef DBG_OFF
#define DBG_OFF WS_XB
#endif
#ifndef DBG_N
#define DBG_N ((size_t)T * D)
#endif
#ifndef DBG_F32
#define DBG_F32 0
#endif
__global__ void dbg_dump(const unsigned char* ws, float* out, size_t off) {
    const bf16* b = (const bf16*)(ws + off); const float* f = (const float*)(ws + off);
    for (size_t i = (size_t)blockIdx.x * blockDim.x + threadIdx.x; i < (size_t)T * D; i += (size_t)gridDim.x * blockDim.x) out[i] = (i < (size_t)(DBG_N)) ? (DBG_F32 ? f[i] : bf2f(b[i])) : 0.f;
}
#ifndef N_LAUNCH_MODE
#define N_LAUNCH_MODE 1
#endif
extern "C" void kernel_launch(void* const* d_in, const int* in_sizes, int n_in, void* d_out, int out_size, void* d_ws, size_t ws_size, hipStream_t stream) {
    static int ready = 0;
    if (ready == 0) {
        if (n_in != 27 || ws_size < WS_END) { fprintf(stderr, "kernel_launch: need 27 inputs and %zu bytes of workspace (got %d, %zu)\n", (size_t)WS_END, n_in, ws_size); ready = -1; return; }
        if (hipFuncSetAttribute((const void*)mega, hipFuncAttributeMaxDynamicSharedMemorySize, LDS_BYTES) != hipSuccess) { fprintf(stderr, "kernel_launch: hipFuncSetAttribute failed\n"); ready = -1; return; }
        int per_cu = 0; (void)hipOccupancyMaxActiveBlocksPerMultiprocessor(&per_cu, (const void*)mega, NTHREADS, LDS_BYTES); (void)hipGetLastError();
        ready = 1;
    }
    if (ready < 0) return;
    (void)hipMemsetAsync((char*)d_ws + WS_CTL, 0, 1 << 20, stream);
    (void)hipMemsetAsync((char*)d_ws + WS_XG, 0, (size_t)CAP * 4, stream);
    Args a{};
    for (int i = 0; i < 27; ++i) a.in[i] = (const float*)d_in[i];
    a.out = (float*)d_out; a.ws = (unsigned char*)d_ws;
#if N_LAUNCH_MODE == 1
    a.ph_lo = 0; a.ph_hi = (DBG_STOP > 0 ? DBG_STOP : NPH);
    hipLaunchKernelGGL(mega, dim3(256), dim3(NTHREADS), LDS_BYTES, stream, a);
    if (DBG_STOP > 0) hipLaunchKernelGGL(dbg_dump, dim3(2048), dim3(256), 0, stream, (const unsigned char*)d_ws, (float*)d_out, (size_t)(DBG_OFF));
#else
    for (int p = 0; p < (DBG_STOP > 0 ? DBG_STOP : NPH); ++p) { a.ph_lo = p; a.ph_hi = p + 1; hipLaunchKernelGGL(mega, dim3(256), dim3(NTHREADS), LDS_BYTES, stream, a); }
    if (DBG_STOP > 0) hipLaunchKernelGGL(dbg_dump, dim3(2048), dim3(256), 0, stream, (const unsigned char*)d_ws, (float*)d_out, (size_t)(DBG_OFF));
#endif
}
```

```cpp
#include <hip/hip_runtime.h>
#include <cstdio>
#include <cstdint>
#define PROF_SCALE 16
#define PROF_OFS 1
#ifndef PROF_MASK
#define PROF_MASK 0x0
#endif

#define LAS __attribute__((address_space(3)))
typedef unsigned short bf16;
typedef short bf16x8 __attribute__((ext_vector_type(8)));
typedef short s16x4 __attribute__((ext_vector_type(4)));
typedef float f32x4 __attribute__((ext_vector_type(4)));
typedef float f32x2 __attribute__((ext_vector_type(2)));
typedef unsigned u32x4 __attribute__((ext_vector_type(4)));
typedef unsigned u32x2 __attribute__((ext_vector_type(2)));
#define DI __device__ __forceinline__
#define GAS __attribute__((address_space(1)))

constexpr int T = 32768, D = 1024, NB = 8, SEQ = 4096, NL = 4, NCH = 64, CH = 64;
constexpr int NPROJ = 3584;
constexpr int NE = 32, TOPK = 4;
constexpr int MAXTILES = 544, CAP = MAXTILES * 256;
constexpr float DN_ALPHA = 1.6817928305074290f;
constexpr int NWAVES = 8, NTHREADS = 512;
constexpr int LDS_RING = 131072, LDS_X = 131072  , LDS_MISC = 163840 - 4096, LDS_BYTES = 163840;

constexpr size_t MiB = 1ull << 20;
constexpr size_t WS_CTL = 0;
constexpr size_t WS_WIN = 1 * MiB;
constexpr size_t WS_WGATE = WS_WIN + 4ull * NPROJ * D * 2;
constexpr size_t WS_WRT = WS_WGATE + 4ull * 2 * 16 * D * 2;
constexpr size_t WS_WOUT = WS_WRT + 4ull * 2 * 32 * D * 2;
constexpr size_t WS_WQ = WS_WOUT + 4ull * D * D * 2;
constexpr size_t WS_WKV = WS_WQ + 4ull * D * D * 2;
constexpr size_t WS_WO = WS_WKV + 8ull * D * D * 2;
constexpr size_t WS_WGU = WS_WO + 4ull * D * D * 2;
constexpr size_t WS_WDN = WS_WGU + 4ull * 32 * 2048 * D * 2;
constexpr size_t WS_MEMB = WS_WDN + 4ull * 32 * D * D * 2;
constexpr size_t WS_KV = WS_MEMB + 2048ull * D * 2;
constexpr size_t WS_WQK = WS_KV + 8ull * 2048 * D * 2;
constexpr size_t WS_WVO = WS_WQK + 32ull * D * D * 2;
constexpr size_t WS_XB = WS_WVO + 32ull * D * D * 2;
constexpr size_t WS_PROJ = WS_XB + (size_t)T * D * 2;
constexpr size_t WS_GATES = WS_PROJ + (size_t)T * NPROJ * 2;
constexpr size_t WS_MIXED = WS_GATES + (size_t)T * 16 * 4;
constexpr size_t WS_HB = WS_MIXED + (size_t)T * D * 2;
constexpr size_t WS_PB = WS_HB + (size_t)T * D * 2;
constexpr size_t WS_TOPE = WS_PB + (size_t)T * D * 2;
constexpr size_t WS_TOPP = WS_TOPE + (size_t)T * 16;
constexpr size_t WS_TOPG = WS_TOPP + (size_t)T * 16;
constexpr size_t WS_SLOT = WS_TOPG + (size_t)T * 16;
constexpr size_t WS_XG = WS_SLOT + (size_t)T * 16;
constexpr size_t WS_ACT = WS_XG + (size_t)CAP * D * 2;
constexpr size_t WS_Y = WS_ACT + (size_t)CAP * D * 2;
constexpr size_t WS_MLU = WS_Y + (size_t)CAP * D * 2;
constexpr size_t WS_MLKN = WS_MLU + 2048ull * 8192 * 4;
constexpr size_t WS_MLSC = WS_MLKN + 2048ull * 64 * 4;
constexpr size_t WS_MLCT = WS_MLSC + 2048ull * 16;
constexpr size_t WS_MLNP = WS_MLCT + 2048ull * 8192 * 2;
constexpr size_t WS_MLMP = WS_MLNP + 2048ull * 64 * 4;
constexpr size_t WS_GDUT = WS_MLMP + 2048ull * 4;
constexpr size_t WS_GDW = WS_GDUT + 2048ull * 8192 * 2;
constexpr size_t WS_GDKE = WS_GDW + 2048ull * 8192 * 2;
constexpr size_t WS_GDQG = WS_GDKE + 2048ull * 8192 * 2;
constexpr size_t WS_GDQK = WS_GDQG + 2048ull * 8192 * 2;
constexpr size_t WS_GDGL = WS_GDQK + 2048ull * 4096 * 2;
constexpr size_t WS_GDVN = WS_GDGL + 2048ull * 4;
constexpr size_t WS_GDSP = WS_GDVN + 2048ull * 8192 * 2;
constexpr size_t WS_END = WS_GDSP + 2048ull * 16384 * 2;
constexpr int CW_BAR = 1024, CW_NT = 8192 + 256, CW_TILE_E = 8192 + 512, CW_DBG = 16384, CW_ECNT = 32768;

typedef __bf16 bf16x2_t __attribute__((ext_vector_type(2)));
DI unsigned cvt_pk_bf16(float lo, float hi) { const f32x2 v = {lo, hi}; const bf16x2_t r = __builtin_convertvector(v, bf16x2_t); return __builtin_bit_cast(unsigned, r); }
DI bf16 f2bf(float f) { return (bf16)(cvt_pk_bf16(f, 0.f) & 0xffffu); }
DI float bf2f(bf16 b) { return __uint_as_float(((unsigned)b) << 16); }
DI float bflo(unsigned w) { return __uint_as_float(w << 16); }
DI float bfhi(unsigned w) { return __uint_as_float(w & 0xffff0000u); }
DI float sigmoidf_(float x) { return __builtin_amdgcn_rcpf(1.f + __expf(-x)); }
DI float wave_sum(float v) {
#pragma unroll
    for (int o = 1; o < 64; o <<= 1) v += __shfl_xor(v, o);
    return v;
}
DI float wave_max(float v) {
#pragma unroll
    for (int o = 1; o < 64; o <<= 1) v = fmaxf(v, __shfl_xor(v, o));
    return v;
}
#define LDS_WAIT() asm volatile("s_waitcnt lgkmcnt(0)" ::: "memory")
#define VM_WAIT() asm volatile("s_waitcnt vmcnt(0)" ::: "memory")
#define MFMA16(a, b, c) __builtin_amdgcn_mfma_f32_16x16x32_bf16((a), (b), (c), 0, 0, 0)

#define XB_TMO      128
#define XB_XCNT(j)  (256  + 64 * (j))
#define XB_XSUB(j)  (1280 + 64 * (j))
#define XB_XGEN(j)  (2304 + 64 * (j))
#define XB_TOP      3328
#define XB_TOPGEN   3392
#define XCD_BAR_WORDS 3456
#define XB_SPIN_CAP (1u << 22)
__device__ __forceinline__ unsigned xb_ld(unsigned* p)              { return __hip_atomic_load(p, __ATOMIC_RELAXED, __HIP_MEMORY_SCOPE_AGENT); }
__device__ __forceinline__ unsigned xb_add(unsigned* p, unsigned v) { return __hip_atomic_fetch_add(p, v, __ATOMIC_RELAXED, __HIP_MEMORY_SCOPE_AGENT); }
__device__ __forceinline__ unsigned xb_xcc_id() { return (unsigned)__builtin_amdgcn_s_getreg((3 << 11) | 20) & 0xFu; }
#define XB_SPIN(cond, bar) do { unsigned _sp = 0; while (cond) { __builtin_amdgcn_s_sleep(1); \
    if ((++_sp & 255u) == 0u) { if (xb_ld(&(bar)[XB_TMO])) break; if (_sp > XB_SPIN_CAP) { atomicAdd(&(bar)[XB_TMO], 1u); break; } } } } while (0)
struct XcdBarrier { unsigned* bar; unsigned x; volatile LAS unsigned* st; };
__device__ __forceinline__ XcdBarrier xcd_barrier_post(unsigned* bar, volatile LAS unsigned* st) {
    XcdBarrier b; b.bar = bar; b.x = xb_xcc_id(); b.st = st;
    if (threadIdx.x == 0) (void)xb_add(&bar[XB_XCNT(b.x)], 1u);
    return b;
}
__device__ __attribute__((noinline)) unsigned long long xcd_barrier_complete(unsigned* bar, unsigned x) {
    const unsigned G = gridDim.x * gridDim.y * gridDim.z;
    unsigned sum, cnt, mine, sp = 0u;
    for (;;) {
        sum = 0u; cnt = 0u; mine = 0u;
#pragma unroll
        for (unsigned j = 0; j < 16; ++j) { const unsigned c = xb_ld(&bar[XB_XCNT(j)]); sum += c; cnt += (c > 0u) ? 1u : 0u; mine = (j == x) ? c : mine; }
        if (sum == G) break;
        __builtin_amdgcn_s_sleep(1);
        if ((++sp & 255u) == 0u) { if (xb_ld(&bar[XB_TMO])) break; if (sp > XB_SPIN_CAP) { atomicAdd(&bar[XB_TMO], 1u); break; } }
    }
    const unsigned nloc = mine > 0u ? mine : 1u, nx = cnt > 0u ? cnt : 1u;
    return ((unsigned long long)nx << 32) | nloc;
}
__device__ __forceinline__ void xcd_barrier(const XcdBarrier& b) {
    asm volatile("s_waitcnt vmcnt(0)" ::: "memory");
    __syncthreads();
    if (threadIdx.x == 0) {
        unsigned* bar = b.bar;
        __builtin_amdgcn_s_waitcnt(0);
        unsigned nloc = b.st[0], nx = b.st[1];
        if (nloc == 0u) { const unsigned long long r = xcd_barrier_complete(bar, b.x); nloc = (unsigned)r; nx = (unsigned)(r >> 32); b.st[0] = nloc; b.st[1] = nx; }
        const unsigned old = xb_add(&bar[XB_XSUB(b.x)], 1u);
        const unsigned gen = old / nloc;
        if (old + 1u == (gen + 1u) * nloc) {
            __builtin_amdgcn_fence(__ATOMIC_RELEASE, "agent");
            asm volatile("s_waitcnt vmcnt(0)" ::: "memory");
            const unsigned og = xb_add(&bar[XB_TOP], 1u);
            const unsigned tg = og / nx;
            if (og + 1u == (tg + 1u) * nx) xb_add(&bar[XB_TOPGEN], 1u);
            else XB_SPIN(xb_ld(&bar[XB_TOPGEN]) == tg, bar);
            __builtin_amdgcn_fence(__ATOMIC_ACQUIRE, "agent");
            xb_add(&bar[XB_XGEN(b.x)], 1u);
            asm volatile("s_waitcnt vmcnt(0)" ::: "memory");
        } else {
            XB_SPIN(xb_ld(&bar[XB_XGEN(b.x)]) == gen, bar);
            __builtin_amdgcn_fence(__ATOMIC_ACQUIRE, "agent");
            asm volatile("s_waitcnt vmcnt(0)" ::: "memory");
        }
    }
    __syncthreads();
}

namespace g8 {
constexpr int BM = 256, BK = 64, HALF = 128, HTB = HALF * BK * 2;
__host__ __device__ __forceinline__ int lds_byte(int r, int c) { const int st = (r >> 4) * 2 + (c >> 5), rr = r & 15, cc = c & 31, ob = rr * 64 + cc * 2; return st * 1024 + (ob ^ (((ob >> 9) & 1) << 5)); }
__host__ __device__ __forceinline__ void stage_rc(int b, int& R, int& C) { const int st = b / 1024, sb = b % 1024, swz = sb ^ (((sb >> 9) & 1) << 5); R = (st >> 1) * 16 + swz / 64; C = (st & 1) * 32 + (swz % 64) / 2; }
__host__ __device__ __forceinline__ int perm32(int rho) { const int n = rho >> 4, i = rho & 15; return 8 * (i >> 2) + 4 * n + (i & 3); }

struct Unit { const char* a; const char* b; char* c; int pm, pn, aux; };
DI void tile_of(int L, int nM, int nN, int& pm, int& pn) {
    const int nig = 8 * nN, gid = L / nig, fm = gid * 8, gsz = (nM - fm) < 8 ? (nM - fm) : 8, w = L % nig;
    pm = fm + (w % gsz); pn = w / gsz;
}
struct AffineOrder {
    const char* A; const char* B; char* C; size_t aM, bB, bN, cM, cS, cN; int nM, nN, bdiv, csp, G, c0;
    DI bool next(int i, Unit& u) const {
        const int L = i * G + c0; if (L >= nM * nN) return false;
        int pm, pn; tile_of(L, nM, nN, pm, pn); u.pm = pm; u.pn = pn; u.aux = 0;
        u.a = A + (size_t)pm * aM; u.b = B + (size_t)(pm / bdiv) * bB + (size_t)pn * bN; u.c = C + (size_t)pm * cM + (size_t)(pn / csp) * cS + (size_t)(pn % csp) * cN; return true;
    }
};
DI AffineOrder dense_order(const void* A, const void* B, void* C, int M, int N, int K, int ldc_bytes, int esz, int G, int c0) {
    AffineOrder o; o.A = (const char*)A; o.B = (const char*)B; o.C = (char*)C; o.aM = 256ull * K * 2; o.bB = 0; o.bN = 256ull * K * 2; o.cM = 256ull * ldc_bytes; o.cS = 0; o.cN = 256ull * esz;
    o.nM = M / 256; o.nN = N / 256; o.bdiv = 1 << 30; o.csp = 1 << 30; o.G = G; o.c0 = c0; return o;
}

DI void lds_rd2x16(unsigned addr, f32x4& a, f32x4& b) { asm volatile("ds_read_b128 %0, %2\n\tds_read_b128 %1, %2 offset:16\n\ts_waitcnt lgkmcnt(0)" : "=&v"(a), "=&v"(b) : "v"(addr) : "memory"); }
struct EpiBf16 {
    static constexpr bool PERM = true;
    int ldc; const float* bias; int bias_stride; float scl;
    DI void issue(const Unit& u, LAS unsigned char* lds, int wid, int lane) const {
        if (bias) __builtin_amdgcn_global_load_lds((const unsigned*)(bias + (size_t)u.aux * bias_stride + u.pn * 256 + (lane >> 5) * HALF + (wid & 3) * 32 + (lane & 31)), (LAS unsigned*)(lds + LDS_X + wid * 256), 4, 0, 0);
    }
    DI void operator()(f32x4 (&acc)[2][2][4][2], const Unit& u, int wr, int wc, int fr, int fq, LAS unsigned char* lds) const {
        const int col0 = wc * 32 + 8 * fq; const float sc = (u.aux < 0) ? scl : 1.f;
        f32x4 bv[2][2];
#pragma unroll
        for (int bj = 0; bj < 2; ++bj) { if (bias) lds_rd2x16((unsigned)(size_t)lds + LDS_X + (wr * 4 + wc) * 256 + bj * 128 + fq * 32, bv[bj][0], bv[bj][1]); else { bv[bj][0] = (f32x4){0.f, 0.f, 0.f, 0.f}; bv[bj][1] = (f32x4){0.f, 0.f, 0.f, 0.f}; } }
#pragma unroll
        for (int ai = 0; ai < 2; ++ai)
#pragma unroll
            for (int m = 0; m < 4; ++m) { bf16* rowp = (bf16*)u.c + (size_t)(ai * HALF + wr * 64 + m * 16 + fr) * ldc + col0;
#pragma unroll
                for (int bj = 0; bj < 2; ++bj) { const f32x4 v0 = acc[ai][bj][m][0] * sc + bv[bj][0], v1 = acc[ai][bj][m][1] * sc + bv[bj][1];
                    u32x4 w; w.x = cvt_pk_bf16(v0[0], v0[1]); w.y = cvt_pk_bf16(v0[2], v0[3]); w.z = cvt_pk_bf16(v1[0], v1[1]); w.w = cvt_pk_bf16(v1[2], v1[3]);
                    *(u32x4*)(rowp + bj * HALF) = w; } }
    }
};
struct EpiSoftmax {
    static constexpr bool PERM = true;
    int ldc;
    DI void issue(const Unit&, LAS unsigned char*, int, int) const {}
    DI void operator()(f32x4 (&acc)[2][2][4][2], const Unit& u, int wr, int wc, int fr, int fq, LAS unsigned char* lds) const {
        LAS f32x2* X = (LAS f32x2*)(lds + LDS_X);
#pragma unroll
        for (int ai = 0; ai < 2; ++ai)
#pragma unroll
            for (int m = 0; m < 4; ++m) {
                float v = -3.0e38f;
#pragma unroll
                for (int bj = 0; bj < 2; ++bj)
#pragma unroll
                    for (int n = 0; n < 2; ++n) { const f32x4 x = acc[ai][bj][m][n]; v = fmaxf(v, fmaxf(fmaxf(x[0], x[1]), fmaxf(x[2], x[3]))); }
                v = fmaxf(v, __shfl_xor(v, 16)); v = fmaxf(v, __shfl_xor(v, 32));
                float s = 0.f;
#pragma unroll
                for (int bj = 0; bj < 2; ++bj)
#pragma unroll
                    for (int n = 0; n < 2; ++n) { f32x4 x = acc[ai][bj][m][n]; x[0] = __expf(x[0] - v); x[1] = __expf(x[1] - v); x[2] = __expf(x[2] - v); x[3] = __expf(x[3] - v); acc[ai][bj][m][n] = x; s += (x[0] + x[1]) + (x[2] + x[3]); }
                s += __shfl_xor(s, 16); s += __shfl_xor(s, 32);
                if (fq == 0) X[(ai * HALF + wr * 64 + m * 16 + fr) * 4 + wc] = (f32x2){v, s};
            }
        LDS_WAIT(); __builtin_amdgcn_s_barrier(); asm volatile("" ::: "memory");
        const int col0 = wc * 32 + 8 * fq;
#pragma unroll
        for (int ai = 0; ai < 2; ++ai)
#pragma unroll
            for (int m = 0; m < 4; ++m) {
                const int r = ai * HALF + wr * 64 + m * 16 + fr;
                const f32x4 p01 = *(const LAS f32x4*)(X + r * 4), p23 = *(const LAS f32x4*)(X + r * 4 + 2);
                const float M = fmaxf(fmaxf(p01[0], p01[2]), fmaxf(p23[0], p23[2]));
                const float S = p01[1] * __expf(p01[0] - M) + p01[3] * __expf(p01[2] - M) + p23[1] * __expf(p23[0] - M) + p23[3] * __expf(p23[2] - M);
                const float f = __expf(X[r * 4 + wc][0] - M) * __builtin_amdgcn_rcpf(S);
                bf16* rowp = (bf16*)u.c + (size_t)r * ldc + col0;
#pragma unroll
                for (int bj = 0; bj < 2; ++bj) { const f32x4 v0 = acc[ai][bj][m][0] * f, v1 = acc[ai][bj][m][1] * f;
                    u32x4 w; w.x = cvt_pk_bf16(v0[0], v0[1]); w.y = cvt_pk_bf16(v0[2], v0[3]); w.z = cvt_pk_bf16(v1[0], v1[1]); w.w = cvt_pk_bf16(v1[2], v1[3]);
                    *(u32x4*)(rowp + bj * HALF) = w; }
                asm volatile("" ::: "memory");
            }
    }
};
struct EpiSwiglu {
    static constexpr bool PERM = true;
    const float* bgu;
    DI void issue(const Unit& u, LAS unsigned char* lds, int wid, int lane) const {
        __builtin_amdgcn_global_load_lds((const unsigned*)(bgu + (size_t)u.aux * 2048 + (lane >> 5) * 1024 + u.pn * 128 + (wid & 3) * 32 + (lane & 31)), (LAS unsigned*)(lds + LDS_X + wid * 256), 4, 0, 0);
    }
    DI void operator()(f32x4 (&acc)[2][2][4][2], const Unit& u, int wr, int wc, int fr, int fq, LAS unsigned char* lds) const {
        f32x4 bg[2], bl[2];
        lds_rd2x16((unsigned)(size_t)lds + LDS_X + (wr * 4 + wc) * 256 + fq * 32, bg[0], bg[1]);
        lds_rd2x16((unsigned)(size_t)lds + LDS_X + (wr * 4 + wc) * 256 + 128 + fq * 32, bl[0], bl[1]);
#pragma unroll
        for (int ai = 0; ai < 2; ++ai)
#pragma unroll
            for (int m = 0; m < 4; ++m) {
                float o[8];
#pragma unroll
                for (int n = 0; n < 2; ++n)
#pragma unroll
                    for (int j = 0; j < 4; ++j) {
                        const float glu = fminf(acc[ai][0][m][n][j] + bg[n][j], 7.0f);
                        const float lin = fminf(fmaxf(acc[ai][1][m][n][j] + bl[n][j], -7.0f), 7.0f);
                        o[4 * n + j] = (lin + 1.0f) * glu * sigmoidf_(1.702f * glu);
                    }
                u32x4 w; w.x = cvt_pk_bf16(o[0], o[1]); w.y = cvt_pk_bf16(o[2], o[3]); w.z = cvt_pk_bf16(o[4], o[5]); w.w = cvt_pk_bf16(o[6], o[7]);
                *(u32x4*)((bf16*)u.c + (size_t)(ai * HALF + wr * 64 + m * 16 + fr) * 1024 + wc * 32 + 8 * fq) = w;
            }
    }
};

template <class Epi, class Sched, bool GATHER = false>
__device__ __forceinline__ void gemm_phase(LAS unsigned char* lds, const int lda, const int ldb, const int nt, const Sched& S, const Epi& E, const unsigned* rowtab = nullptr) {
    int tid = threadIdx.x; asm volatile("" : "+v"(tid));
    const int wid = __builtin_amdgcn_readfirstlane(tid >> 6), lane = tid & 63, wr = wid >> 2, wc = wid & 3, fr = lane & 15, fq = lane >> 4;
    unsigned voffA[2], voffB[2];
#pragma unroll
    for (int i = 0; i < 2; ++i) { int R, C; stage_rc(tid * 16 + i * 8192, R, C); const int Rb = Epi::PERM ? ((R & ~31) + perm32(R & 31)) : R;
        voffA[i] = GATHER ? 0u : (unsigned)(R * lda + C * 2); voffB[i] = (unsigned)(Rb * ldb + C * 2); }
    unsigned gc[2][2] = {{0u, 0u}, {0u, 0u}}, gn[2][2] = {{0u, 0u}, {0u, 0u}};
#define PG8_GLOAD(dst, pm_) do { int _t = tid; asm volatile("" : "+v"(_t)); _Pragma("unroll") for (int _i = 0; _i < 2; ++_i) { int _R, _C; stage_rc(_t * 16 + _i * 8192, _R, _C); \
        _Pragma("unroll") for (int _h = 0; _h < 2; ++_h) dst[_h][_i] = __hip_atomic_load(rowtab + (size_t)(pm_) * 256 + _h * 128 + _R, __ATOMIC_RELAXED, __HIP_MEMORY_SCOPE_AGENT) * (unsigned)lda + (unsigned)(_C * 2); } } while (0)
    const size_t kstep = (size_t)(BK * 2);
    const size_t hstepA = (size_t)HALF * lda, hstepB = (size_t)HALF * ldb;
    const unsigned ldsw = (unsigned)wid * 1024u;
    const int aoff = lds_byte(wr * 64 + fr, fq * 8), boff = lds_byte(wc * 32 + fr, fq * 8);
#define PG8_SA(b, h) (((b) * 2 + (h)) * HTB)
#define PG8_SB(b, h) ((4 + (b) * 2 + (h)) * HTB)
#define PG8_STAGE(bufoff, gbase, voff) do { _Pragma("unroll") for (int _i = 0; _i < 2; ++_i) \
        __builtin_amdgcn_global_load_lds((const unsigned*)((const char*)(gbase) + (voff)[_i]), (LAS unsigned*)(lds + (bufoff) + ldsw + _i * 8192), 16, 0, 0); } while (0)
#define PG8_STAGE_A(bufoff, gbase, hh, nx) do { if (GATHER) { _Pragma("unroll") for (int _i = 0; _i < 2; ++_i) \
        __builtin_amdgcn_global_load_lds((const unsigned*)((const char*)(gbase) + ((nx) ? gn[hh][_i] : gc[hh][_i])), (LAS unsigned*)(lds + (bufoff) + ldsw + _i * 8192), 16, 0, 0); } \
        else PG8_STAGE(bufoff, (gbase) + (hh) * hstepA, voffA); } while (0)
#define PG8_LDA(dst, b, h) do { _Pragma("unroll") for (int m = 0; m < 4; ++m) _Pragma("unroll") for (int k = 0; k < 2; ++k) dst[m][k] = *(const LAS bf16x8*)(lds + PG8_SA(b, h) + aoff + m * 2048 + k * 1024); } while (0)
#define PG8_LDB(dst, b, h) do { _Pragma("unroll") for (int n = 0; n < 2; ++n) _Pragma("unroll") for (int k = 0; k < 2; ++k) dst[n][k] = *(const LAS bf16x8*)(lds + PG8_SB(b, h) + boff + n * 2048 + k * 1024); } while (0)
#define PG8_MMA(ai, bj, At, Bt) do { __builtin_amdgcn_s_setprio(1); _Pragma("unroll") for (int m = 0; m < 4; ++m) _Pragma("unroll") for (int n = 0; n < 2; ++n) _Pragma("unroll") for (int k = 0; k < 2; ++k) \
        acc[ai][bj][m][n] = __builtin_amdgcn_mfma_f32_16x16x32_bf16(Bt[n][k], At[m][k], acc[ai][bj][m][n], 0, 0, 0); __builtin_amdgcn_s_setprio(0); } while (0)
#define PG8_WAIT_V(n) asm volatile("s_waitcnt vmcnt(" #n ")" ::: "memory")
#define PG8_WAIT_L(n) asm volatile("s_waitcnt lgkmcnt(" #n ")" ::: "memory")
#define PG8_BAR __builtin_amdgcn_s_barrier()
#define PG8_SCHED __builtin_amdgcn_sched_barrier(0)
    Unit cur, nxt; int ui = 0;
    if (!S.next(0, cur)) return;
    f32x4 acc[2][2][4][2];
#pragma unroll
    for (int a = 0; a < 2; ++a)
#pragma unroll
        for (int b = 0; b < 2; ++b)
#pragma unroll
            for (int m = 0; m < 4; ++m)
#pragma unroll
                for (int n = 0; n < 2; ++n) acc[a][b][m][n] = (f32x4){0.f, 0.f, 0.f, 0.f};
    bf16x8 At[4][2], B0[2][2], B1[2][2];
    const char* cA = cur.a; const char* cB = cur.b;
    if (GATHER) { PG8_GLOAD(gc, cur.pm); }
    PG8_STAGE(PG8_SB(0, 0), cB, voffB); PG8_STAGE(PG8_SB(0, 1), cB + hstepB, voffB); PG8_STAGE_A(PG8_SA(0, 0), cA, 0, false); PG8_STAGE_A(PG8_SA(0, 1), cA, 1, false);
    if (wr == 1) PG8_BAR;
    PG8_WAIT_V(2); PG8_BAR;
    PG8_STAGE(PG8_SB(1, 0), cB + kstep, voffB); PG8_STAGE_A(PG8_SA(1, 0), cA + kstep, 0, false); PG8_STAGE(PG8_SB(1, 1), cB + hstepB + kstep, voffB);
    PG8_WAIT_V(6); PG8_BAR;
    for (;;) {
        const bool has_next = S.next(ui + 1, nxt);
        const char* nA = has_next ? nxt.a : cA; const char* nB = has_next ? nxt.b : cB;
        if (GATHER) { if (has_next) { PG8_GLOAD(gn, nxt.pm); } else { _Pragma("unroll") for (int _h = 0; _h < 2; ++_h) { gn[_h][0] = gc[_h][0]; gn[_h][1] = gc[_h][1]; } } }
#pragma unroll 1
        for (int t = 0; t < nt; t += 2) {
            const bool last = (t == nt - 2);
            const char* a1 = cA + (size_t)(t + 1) * kstep;
            const char* a2 = last ? nA : cA + (size_t)(t + 2) * kstep; const char* b2 = last ? nB : cB + (size_t)(t + 2) * kstep;
            const char* a3 = a2 + kstep; const char* b3 = b2 + kstep;
            PG8_LDB(B0, 0, 0); PG8_LDB(B1, 0, 1); PG8_SCHED; PG8_LDA(At, 0, 0); PG8_STAGE_A(PG8_SA(1, 1), a1, 1, false);
            if (t == 0) E.issue(cur, lds, wid, lane);
            PG8_WAIT_V(8); PG8_WAIT_L(0); PG8_BAR; PG8_MMA(0, 0, At, B0); PG8_MMA(0, 1, At, B1); PG8_BAR; PG8_SCHED;
            PG8_LDA(At, 0, 1); PG8_STAGE(PG8_SB(0, 0), b2, voffB); PG8_STAGE(PG8_SB(0, 1), b2 + hstepB, voffB); PG8_STAGE_A(PG8_SA(0, 0), a2, 0, last);
            PG8_WAIT_V(8); PG8_WAIT_L(0); PG8_BAR; PG8_MMA(1, 0, At, B0); PG8_MMA(1, 1, At, B1); PG8_BAR; PG8_SCHED;
            PG8_LDB(B0, 1, 0); PG8_LDB(B1, 1, 1); PG8_SCHED; PG8_LDA(At, 1, 0); PG8_STAGE_A(PG8_SA(0, 1), a2, 1, last);
            PG8_WAIT_V(8); PG8_WAIT_L(0); PG8_BAR; PG8_MMA(0, 0, At, B0); PG8_MMA(0, 1, At, B1); PG8_BAR; PG8_SCHED;
            PG8_LDA(At, 1, 1); PG8_STAGE(PG8_SB(1, 0), b3, voffB); PG8_STAGE(PG8_SB(1, 1), b3 + hstepB, voffB); PG8_STAGE_A(PG8_SA(1, 0), a3, 0, last);
            PG8_WAIT_V(8); PG8_WAIT_L(0); PG8_BAR; PG8_MMA(1, 0, At, B0); PG8_MMA(1, 1, At, B1); PG8_BAR; PG8_SCHED;
        }
        if (wr == 0) PG8_BAR;
        { int fr_e = fr, fq_e = fq; asm volatile("" : "+v"(fr_e), "+v"(fq_e)); E(acc, cur, wr, wc, fr_e, fq_e, lds); }
        if (!has_next) break;
#pragma unroll
        for (int a = 0; a < 2; ++a)
#pragma unroll
            for (int b = 0; b < 2; ++b)
#pragma unroll
                for (int m = 0; m < 4; ++m)
#pragma unroll
                    for (int n = 0; n < 2; ++n) acc[a][b][m][n] = (f32x4){0.f, 0.f, 0.f, 0.f};
        cur = nxt; cA = nA; cB = nB; ++ui;
        if (GATHER) { _Pragma("unroll") for (int _h = 0; _h < 2; ++_h) { gc[_h][0] = gn[_h][0]; gc[_h][1] = gn[_h][1]; } }
        if (wr == 1) PG8_BAR;
    }
    PG8_WAIT_V(0);
    PG8_BAR;
#undef PG8_SA
#undef PG8_SB
#undef PG8_STAGE
#undef PG8_LDA
#undef PG8_STAGE_A
#undef PG8_GLOAD
#undef PG8_LDB
#undef PG8_MMA
#undef PG8_WAIT_V
#undef PG8_WAIT_L
#undef PG8_BAR
#undef PG8_SCHED
}
}

struct Args { const float* in[27]; float* out; unsigned char* ws; int ph_lo, ph_hi; };
struct Ctx {
    LAS unsigned char* lds; unsigned char* ws; unsigned* ctl;
    int tid, lane, wave, vcu, G;
};
constexpr int LDS_PTAB = LDS_MISC + 1024;
DI void refresh(Ctx& F, unsigned char* wsb) { int t = threadIdx.x; asm volatile("" : "+v"(t)); F.tid = t; F.lane = t & 63; F.wave = __builtin_amdgcn_readfirstlane(t >> 6);
    unsigned lo = (unsigned)(unsigned long long)wsb, hi = (unsigned)((unsigned long long)wsb >> 32); asm volatile("" : "+v"(lo), "+v"(hi));
    lo = __builtin_amdgcn_readfirstlane(lo); hi = __builtin_amdgcn_readfirstlane(hi); F.ws = (unsigned char*)(GAS unsigned char*)(((unsigned long long)hi << 32) | lo); F.ctl = (unsigned*)F.ws;
    int bx = blockIdx.x; asm volatile("" : "+v"(bx)); bx = __builtin_amdgcn_readfirstlane(bx); F.G = 256; F.vcu = (bx & 7) * 32 + (bx >> 3);
    unsigned zb = 0u; asm volatile("" : "+v"(zb)); F.lds = (LAS unsigned char*)(unsigned)__builtin_amdgcn_readfirstlane(zb); }
DI const float* inp(const Ctx& F, int i) {
    const LAS unsigned* p = (const LAS unsigned*)(F.lds + LDS_PTAB) + 2 * i; const unsigned lo = __builtin_amdgcn_readfirstlane(p[0]), hi = __builtin_amdgcn_readfirstlane(p[1]);
    return (const float*)(GAS const float*)(((unsigned long long)hi << 32) | lo);
}
DI unsigned ldu(const unsigned* p) { return __hip_atomic_load(p, __ATOMIC_RELAXED, __HIP_MEMORY_SCOPE_AGENT); }
DI float ldf(const float* p) { return __uint_as_float(__hip_atomic_load((const unsigned*)p, __ATOMIC_RELAXED, __HIP_MEMORY_SCOPE_AGENT)); }

template <int MAP> DI int map_row(int n) {
    if (MAP == 0) return n;
    if (MAP == 1) return n < 1536 ? n : (n < 1544 ? -1 : (n < 3592 ? n - 8 : -1));
    return 256 * ((n & 1023) >> 7) + 128 * (n >> 10) + (n & 127);
}
template <int MAP> DI void tr_item(const float* W, int K, int N, bf16* WT, LAS float* scr, int item, int lane) {
    const int nblk = (N + 31) / 32, kb = item / nblk, nb = item % nblk, k0 = 64 * kb, n0 = 32 * nb;
    const int c4 = 4 * (lane & 7), nl = n0 + c4;
    f32x4 ld[8];
#pragma unroll
    for (int i = 0; i < 8; ++i) { const int kk = 8 * i + (lane >> 3); ld[i] = nl < N ? __builtin_nontemporal_load((const f32x4*)(W + (size_t)(k0 + kk) * N + nl)) : (f32x4){0.f, 0.f, 0.f, 0.f}; }
#pragma unroll
    for (int i = 0; i < 8; ++i) { const int kk = 8 * i + (lane >> 3); LAS float* d = scr + kk * 33 + c4; d[0] = ld[i][0]; d[1] = ld[i][1]; d[2] = ld[i][2]; d[3] = ld[i][3]; }
    LDS_WAIT(); asm volatile("" ::: "memory");
    const int c = lane & 7;
#pragma unroll
    for (int j = 0; j < 4; ++j) { const int nn = (lane >> 3) + 8 * j; const int n = n0 + nn; const LAS float* s = scr + (8 * c) * 33 + nn;
        const int dr = n < N ? map_row<MAP>(n) : -1;
        u32x4 o; o.x = cvt_pk_bf16(s[0 * 33], s[1 * 33]); o.y = cvt_pk_bf16(s[2 * 33], s[3 * 33]); o.z = cvt_pk_bf16(s[4 * 33], s[5 * 33]); o.w = cvt_pk_bf16(s[6 * 33], s[7 * 33]);
        if (dr >= 0) __builtin_nontemporal_store(o, (u32x4*)(WT + (size_t)dr * K + k0 + 8 * c)); }
    LDS_WAIT(); asm volatile("" ::: "memory");
}
DI void phase_convert(Ctx& F, const Args& a) {
    LAS float* scr = (LAS float*)(F.lds + F.wave * 16384);
    const int gw = F.vcu * NWAVES + F.wave, NGW = F.G * NWAVES;
    constexpr int I_WIN = 16 * 113, I_SQ = 16 * 32, I_GU = 16 * 64;
    constexpr int E0 = 4 * I_WIN, E1 = E0 + 4 * I_SQ, E2 = E1 + 4 * I_SQ, E3 = E2 + 4 * I_SQ, E4 = E3 + 4 * I_SQ, E5 = E4 + 128 * I_GU, E6 = E5 + 128 * I_SQ;
    for (int it = gw; it < E6; it += NGW) {
        if (it < E0) { const int l = it / I_WIN, r = it % I_WIN; tr_item<1>(inp(F, 2) + (size_t)l * D * 3600, D, 3600, (bf16*)(F.ws + WS_WIN) + (size_t)l * NPROJ * D, scr, r, F.lane); }
        else if (it < E1) { const int q = it - E0, l = q / I_SQ, r = q % I_SQ; tr_item<0>(inp(F, 10) + (size_t)l * D * D, D, D, (bf16*)(F.ws + WS_WOUT) + (size_t)l * D * D, scr, r, F.lane); }
        else if (it < E2) { const int q = it - E1, l = q / I_SQ, r = q % I_SQ; tr_item<0>(inp(F, 14) + (size_t)l * D * D, D, D, (bf16*)(F.ws + WS_WKV) + (size_t)(2 * l) * D * D, scr, r, F.lane); }
        else if (it < E3) { const int q = it - E2, l = q / I_SQ, r = q % I_SQ; tr_item<0>(inp(F, 15) + (size_t)l * D * D, D, D, (bf16*)(F.ws + WS_WKV) + (size_t)(2 * l + 1) * D * D, scr, r, F.lane); }
        else if (it < E4) { const int q = it - E3, l = q / I_SQ, r = q % I_SQ; tr_item<0>(inp(F, 16) + (size_t)l * D * D, D, D, (bf16*)(F.ws + WS_WO) + (size_t)l * D * D, scr, r, F.lane); }
        else if (it < E5) { const int q = it - E4, le = q / I_GU, r = q % I_GU; tr_item<2>(inp(F, 21) + (size_t)le * D * 2048, D, 2048, (bf16*)(F.ws + WS_WGU) + (size_t)le * 2048 * D, scr, r, F.lane); }
        else { const int q = it - E5, le = q / I_SQ, r = q % I_SQ; tr_item<0>(inp(F, 23) + (size_t)le * D * D, D, D, (bf16*)(F.ws + WS_WDN) + (size_t)le * D * D, scr, r, F.lane); }
    }
    const size_t gt = (size_t)blockIdx.x * NTHREADS + F.tid, NGT = (size_t)F.G * NTHREADS;
    for (size_t i = gt; i < (4ull * D * D + 2048ull * D) / 8; i += NGT) {
        const bool isq = i < 4ull * D * D / 8; const size_t j = isq ? i : i - 4ull * D * D / 8;
        const float* src = (isq ? inp(F, 13) : inp(F, 1)) + j * 8; bf16* dst = (bf16*)(F.ws + (isq ? WS_WQ : WS_MEMB)) + j * 8;
        const f32x4 v0 = *(const f32x4*)src, v1 = *(const f32x4*)(src + 4);
        u32x4 o; o.x = cvt_pk_bf16(v0[0], v0[1]); o.y = cvt_pk_bf16(v0[2], v0[3]); o.z = cvt_pk_bf16(v1[0], v1[1]); o.w = cvt_pk_bf16(v1[2], v1[3]);
        *(u32x4*)dst = o;
    }
    for (size_t i = gt; i < 4ull * 48 * D; i += NGT) {
        const int l = (int)(i / (48 * D)), r = (int)(i % (48 * D)), j = r / D, k = r % D;
        float w; bf16* dh; bf16* dl;
        if (j < 16) { const int col = j < 8 ? 1536 + j : 3592 + (j - 8); w = inp(F, 2)[((size_t)l * D + k) * 3600 + col];
            dh = (bf16*)(F.ws + WS_WGATE) + ((size_t)(l * 2 + 0) * 16 + j) * D + k; dl = dh + 16 * D; }
        else { const int e = j - 16; w = inp(F, 19)[((size_t)l * D + k) * 32 + e];
            dh = (bf16*)(F.ws + WS_WRT) + ((size_t)(l * 2 + 0) * 32 + e) * D + k; dl = dh + 32 * D; }
        const bf16 h = f2bf(w); *dh = h; *dl = f2bf(w - bf2f(h));
    }
}

DI void unpack8(const u32x4 w, float* v) { v[0] = bflo(w.x); v[1] = bfhi(w.x); v[2] = bflo(w.y); v[3] = bfhi(w.y); v[4] = bflo(w.z); v[5] = bfhi(w.z); v[6] = bflo(w.w); v[7] = bfhi(w.w); }
DI u32x4 pack8(const float* v) { u32x4 o; o.x = cvt_pk_bf16(v[0], v[1]); o.y = cvt_pk_bf16(v[2], v[3]); o.z = cvt_pk_bf16(v[4], v[5]); o.w = cvt_pk_bf16(v[6], v[7]); return o; }
#define PROF_RP(k) do { if (MODE == 2 && ((PROF_MASK) >> 23)) { if (blockIdx.x == 0 && threadIdx.x == 0) { volatile LAS unsigned long long* pw = (volatile LAS unsigned long long*)(F.lds + LDS_MISC + 128); \
        const unsigned long long now_ = __builtin_amdgcn_s_memrealtime(); if ((k) >= 0 && (((PROF_MASK) >> (23 + (k))) & 1)) pw[1] += now_ - pw[3]; pw[3] = now_; } } } while (0)
DI void ld2x16_sc1(const void* p0, const void* p1, u32x4& a, u32x4& b) {
    asm volatile("global_load_dwordx4 %0, %2, off sc0 sc1\n\tglobal_load_dwordx4 %1, %3, off sc0 sc1\n\ts_waitcnt vmcnt(0)" : "=&v"(a), "=&v"(b) : "v"(p0), "v"(p1) : "memory");
}
template <int MODE> DI void row_pass(Ctx& F, const Args& a, int l, const bool dummy = false) {
    const int lane = F.lane, r0 = (F.vcu * NWAVES + F.wave) * 16;
    bf16* XB = (bf16*)(F.ws + WS_XB); bf16* XBo = dummy ? (bf16*)(F.ws + WS_XG + 16 * MiB) : XB; const bf16* HB = (const bf16*)(F.ws + WS_HB); const bf16* Y = (const bf16*)(F.ws + WS_Y);
    const int c0 = 8 * lane, c1 = 512 + 8 * lane;
    LAS unsigned* ecnt = (LAS unsigned*)(F.lds + LDS_MISC + 256);
    if (MODE == 2) { if (F.tid < 64 && !dummy) ecnt[F.tid] = 0u; __syncthreads(); }
    PROF_RP(-1);
    constexpr int N16 = (MODE == 2) ? 2 : 1, NN = 16 * N16, NBLK = 32 * N16 * 2;
    const bool has_tail = !(MODE == 1 || (MODE == 3 && l == NL - 1));
    const bf16* Wb = (MODE == 2) ? (const bf16*)(F.ws + WS_WRT) + (size_t)l * 2 * 32 * D : (const bf16*)(F.ws + WS_WGATE) + (size_t)(MODE == 0 ? 0 : (l + 1 < NL ? l + 1 : 0)) * 2 * 16 * D;
    if (has_tail) {
#pragma unroll
        for (int q = 0; q < NBLK / 8; ++q) { const int blk = F.wave * (NBLK / 8) + q, ks = blk / (2 * N16), n = (blk >> 1) % N16, hl = blk & 1;
            __builtin_amdgcn_global_load_lds((const unsigned*)(Wb + (size_t)(hl * NN + n * 16 + (lane & 15)) * D + 32 * ks + 8 * (lane >> 4)), (LAS unsigned*)(F.lds + blk * 1024), 16, 0, 0); }
    }
    float g[16], bb[16];
    if (MODE >= 1) {
        const float* gp = inp(F, MODE == 1 ? 11 : (MODE == 2 ? 17 : 25)) + (size_t)l * D; const float* bp = inp(F, MODE == 1 ? 12 : (MODE == 2 ? 18 : 26)) + (size_t)l * D;
#pragma unroll
        for (int q = 0; q < 2; ++q) { const int c = q ? c1 : c0;
            const f32x4 g0 = *(const f32x4*)(gp + c), g1 = *(const f32x4*)(gp + c + 4), b0 = *(const f32x4*)(bp + c), b1 = *(const f32x4*)(bp + c + 4);
#pragma unroll
            for (int j = 0; j < 4; ++j) { g[8 * q + j] = g0[j]; g[8 * q + 4 + j] = g1[j]; bb[8 * q + j] = b0[j]; bb[8 * q + 4 + j] = b1[j]; } }
    }
    constexpr int RB = (MODE == 3) ? 2 : 4;
#pragma unroll 1
    for (int i0 = 0; i0 < 16; i0 += RB) {
        float v[RB][16];
        if (MODE == 0) {
            f32x4 xi[RB][4];
#pragma unroll
            for (int q = 0; q < RB; ++q) { const float* xr = inp(F, 0) + (size_t)(r0 + i0 + q) * D;
                xi[q][0] = *(const f32x4*)(xr + c0); xi[q][1] = *(const f32x4*)(xr + c0 + 4); xi[q][2] = *(const f32x4*)(xr + c1); xi[q][3] = *(const f32x4*)(xr + c1 + 4); }
#pragma unroll
            for (int q = 0; q < RB; ++q)
#pragma unroll
                for (int j = 0; j < 4; ++j) { v[q][j] = xi[q][0][j]; v[q][4 + j] = xi[q][1][j]; v[q][8 + j] = xi[q][2][j]; v[q][12 + j] = xi[q][3][j]; }
        } else {
            u32x4 xr[RB][2];
#pragma unroll
            for (int q = 0; q < RB; ++q) { xr[q][0] = *(const u32x4*)(XB + (size_t)(r0 + i0 + q) * D + c0); xr[q][1] = *(const u32x4*)(XB + (size_t)(r0 + i0 + q) * D + c1); }
            if (MODE == 3) {
                int slv = 0; float gkv = 0.f;
                if (lane < 4 * RB) { slv = (int)ldu((const unsigned*)(F.ws + WS_SLOT) + (size_t)(r0 + i0) * 4 + lane); gkv = ldf((const float*)(F.ws + WS_TOPG) + (size_t)(r0 + i0) * 4 + lane); }
                u32x4 yr[RB][4][2]; float gk[RB][4];
#pragma unroll
                for (int q = 0; q < RB; ++q)
#pragma unroll
                    for (int k = 0; k < 4; ++k) { const int sl = __shfl(slv, q * 4 + k); gk[q][k] = __shfl(gkv, q * 4 + k);
                        yr[q][k][0] = __builtin_nontemporal_load((const u32x4*)(Y + (size_t)sl * D + c0)); yr[q][k][1] = __builtin_nontemporal_load((const u32x4*)(Y + (size_t)sl * D + c1)); }
#pragma unroll
                for (int q = 0; q < RB; ++q) { float xv[16]; unpack8(xr[q][0], xv); unpack8(xr[q][1], xv + 8);
#pragma unroll
                    for (int j = 0; j < 16; ++j) v[q][j] = DN_ALPHA * xv[j];
#pragma unroll
                    for (int k = 0; k < 4; ++k) { float yv[16]; unpack8(yr[q][k][0], yv); unpack8(yr[q][k][1], yv + 8);
#pragma unroll
                        for (int j = 0; j < 16; ++j) v[q][j] += gk[q][k] * yv[j]; } }
            } else {
                u32x4 hr[RB][2];
#pragma unroll
                for (int q = 0; q < RB; ++q) { hr[q][0] = __builtin_nontemporal_load((const u32x4*)(HB + (size_t)(r0 + i0 + q) * D + c0)); hr[q][1] = __builtin_nontemporal_load((const u32x4*)(HB + (size_t)(r0 + i0 + q) * D + c1)); }
#pragma unroll
                for (int q = 0; q < RB; ++q) { float xv[16], hv[16]; unpack8(xr[q][0], xv); unpack8(xr[q][1], xv + 8); unpack8(hr[q][0], hv); unpack8(hr[q][1], hv + 8);
#pragma unroll
                    for (int j = 0; j < 16; ++j) v[q][j] = DN_ALPHA * xv[j] + hv[j]; }
            }
            float sm[RB];
#pragma unroll
            for (int q = 0; q < RB; ++q) { float t = 0.f;
#pragma unroll
                for (int j = 0; j < 16; ++j) t += v[q][j];
                sm[q] = t; }
#pragma unroll
            for (int o = 1; o < 64; o <<= 1)
#pragma unroll
                for (int q = 0; q < RB; ++q) sm[q] += __shfl_xor(sm[q], o);
            float sq[RB];
#pragma unroll
            for (int q = 0; q < RB; ++q) { const float mean = sm[q] * (1.f / D); float t = 0.f;
#pragma unroll
                for (int j = 0; j < 16; ++j) { v[q][j] -= mean; t += v[q][j] * v[q][j]; }
                sq[q] = t; }
#pragma unroll
            for (int o = 1; o < 64; o <<= 1)
#pragma unroll
                for (int q = 0; q < RB; ++q) sq[q] += __shfl_xor(sq[q], o);
#pragma unroll
            for (int q = 0; q < RB; ++q) { const float rstd = rsqrtf(sq[q] * (1.f / D) + 1e-5f);
#pragma unroll
                for (int j = 0; j < 16; ++j) v[q][j] = v[q][j] * rstd * g[j] + bb[j]; }
        }
#pragma unroll
        for (int q = 0; q < RB; ++q) { const int r = r0 + i0 + q;
            if (MODE == 3 && l == NL - 1) {
                float* orow = (float*)inp(F, 27) + (size_t)r * D;
                *(f32x4*)(orow + c0) = (f32x4){v[q][0], v[q][1], v[q][2], v[q][3]}; *(f32x4*)(orow + c0 + 4) = (f32x4){v[q][4], v[q][5], v[q][6], v[q][7]};
                *(f32x4*)(orow + c1) = (f32x4){v[q][8], v[q][9], v[q][10], v[q][11]}; *(f32x4*)(orow + c1 + 4) = (f32x4){v[q][12], v[q][13], v[q][14], v[q][15]};
            } else {
                *(u32x4*)(XBo + (size_t)r * D + c0) = pack8(v[q]); *(u32x4*)(XBo + (size_t)r * D + c1) = pack8(v[q] + 8);
            } }
    }
    if (MODE == 1 || (MODE == 3 && l == NL - 1)) return;
#ifdef DBG_NOROUTER
    if (MODE == 2) return;
#endif
    VM_WAIT(); __syncthreads(); PROF_RP(0); asm volatile("" ::: "memory");
    const bf16* arow = XBo + (size_t)(r0 + (lane & 15)) * D + 8 * (lane >> 4);
    f32x4 acc[N16];
#pragma unroll
    for (int n = 0; n < N16; ++n) acc[n] = (f32x4){0.f, 0.f, 0.f, 0.f};
#pragma unroll 8
    for (int ks = 0; ks < 32; ++ks) {
        const bf16x8 af = *(const bf16x8*)(arow + 32 * ks);
#pragma unroll
        for (int n = 0; n < N16; ++n) {
            const bf16x8 bh = *(const LAS bf16x8*)(F.lds + ((ks * N16 + n) * 2 + 0) * 1024 + lane * 16), bl = *(const LAS bf16x8*)(F.lds + ((ks * N16 + n) * 2 + 1) * 1024 + lane * 16);
            acc[n] = MFMA16(af, bh, acc[n]); acc[n] = MFMA16(af, bl, acc[n]);
        }
    }
    if (MODE != 2) {
        float* G = dummy ? (float*)(F.ws + WS_XG + 160 * MiB) : (float*)(F.ws + WS_GATES);
#pragma unroll
        for (int i = 0; i < 4; ++i) G[(size_t)(r0 + 4 * (lane >> 4) + i) * 16 + (lane & 15)] = acc[0][i];
        return;
    }
    if (MODE == 2) {
        if ((PROF_MASK) >> 23) __syncthreads(); PROF_RP(1);
        LAS float* LG = (LAS float*)(F.lds + 131072 + F.wave * 2176);
#pragma unroll
        for (int n = 0; n < N16; ++n)
#pragma unroll
            for (int i = 0; i < 4; ++i) LG[(4 * (lane >> 4) + i) * 33 + n * 16 + (lane & 15)] = acc[n][i];
        LDS_WAIT(); asm volatile("" ::: "memory");
        int te[4] = {0, 0, 0, 0}; float tv[4] = {0.f, 0.f, 0.f, 0.f}; unsigned rk[4] = {0u, 0u, 0u, 0u};
        if (lane < 16) {
            float lg[32]; const float* rb = inp(F, 20) + (size_t)l * 32;
#pragma unroll
            for (int e = 0; e < 32; ++e) lg[e] = LG[lane * 33 + e] + rb[e];
#pragma unroll
            for (int k = 0; k < 4; ++k) {
                float best = -3.0e38f; int bi = 0;
#pragma unroll
                for (int e = 0; e < 32; ++e) { const bool gt = lg[e] > best; best = gt ? lg[e] : best; bi = gt ? e : bi; }
                te[k] = bi; tv[k] = best;
#pragma unroll
                for (int e = 0; e < 32; ++e) lg[e] = (e == bi) ? -3.0e38f : lg[e];
            }
            const float e1 = __expf(tv[1] - tv[0]), e2 = __expf(tv[2] - tv[0]), e3 = __expf(tv[3] - tv[0]); const float inv = 1.f / (1.f + e1 + e2 + e3);
            tv[0] = inv; tv[1] = e1 * inv; tv[2] = e2 * inv; tv[3] = e3 * inv;
#pragma unroll
            for (int k = 0; k < 4; ++k) rk[k] = __hip_atomic_fetch_add(ecnt + (dummy ? 40 : 0) + te[k], 1u, __ATOMIC_RELAXED, __HIP_MEMORY_SCOPE_WORKGROUP);
        }
        __syncthreads(); PROF_RP(2);
        if (F.tid < 32 && !dummy) ecnt[32 + F.tid] = __hip_atomic_fetch_add(F.ctl + CW_ECNT + (l * 32 + F.tid) * 64, ecnt[F.tid], __ATOMIC_RELAXED, __HIP_MEMORY_SCOPE_AGENT);
        __syncthreads();
        if (lane < 16 && !dummy) {
            const int r = r0 + lane; int* pe = (int*)(F.ws + WS_TOPE) + (size_t)r * 4; int* pp = (int*)(F.ws + WS_TOPP) + (size_t)r * 4; float* pg = (float*)(F.ws + WS_TOPG) + (size_t)r * 4;
#pragma unroll
            for (int k = 0; k < 4; ++k) { pe[k] = te[k]; pp[k] = (int)(ecnt[32 + te[k]] + rk[k]); pg[k] = tv[k]; }
        }
        if ((PROF_MASK) >> 23) { VM_WAIT(); __syncthreads(); } PROF_RP(3);
    }
}

DI void phase_scatter(Ctx& F, int l) {
    LAS int* ts = (LAS int*)(F.lds + LDS_MISC + 512);
    if (F.tid < 64) {
        const int lane = F.tid; const int nt_ = (lane < 32) ? (int)((ldu(F.ctl + CW_ECNT + (l * 32 + lane) * 64) + 255u) >> 8) : 0;
        int inc = nt_;
#pragma unroll
        for (int o = 1; o < 32; o <<= 1) { const int t_ = __shfl_up(inc, o); inc += (lane >= o) ? t_ : 0; }
        if (lane < 32) ts[lane] = inc - nt_;
        if (lane == 31) ts[32] = inc; }
    __syncthreads();
    if (blockIdx.x == 0) {
        if (F.tid == 0) __hip_atomic_store(F.ctl + CW_NT + l, (unsigned)ts[32], __ATOMIC_RELAXED, __HIP_MEMORY_SCOPE_AGENT);
        for (int t = F.tid; t < ts[32]; t += NTHREADS) { int e = 0; while (e < 31 && t >= ts[e + 1]) ++e; F.ctl[CW_TILE_E + l * MAXTILES + t] = (unsigned)e; }
    }
    { const int r = F.vcu * 128 + (F.tid >> 2), k = F.tid & 3;
      const int e = ((const int*)(F.ws + WS_TOPE))[(size_t)r * 4 + k], p = ((const int*)(F.ws + WS_TOPP))[(size_t)r * 4 + k];
      const int slot = ts[e] * 256 + p;
      ((int*)(F.ws + WS_SLOT))[(size_t)r * 4 + k] = slot; ((unsigned*)(F.ws + WS_XG))[slot] = (unsigned)r; }
}
struct MoeOrder {
    const char* A; const char* B; char* C; const unsigned* tile_e; int NT, nN; size_t bE, bN, cN; int G, c0, gather, rev;
    DI bool next(int i, g8::Unit& u) const {
        const int L = i * G + c0; if (L >= NT * nN) return false;
        int pm, pn; g8::tile_of(L, NT, nN, pm, pn); if (rev) pm = NT - 1 - pm;
        const int e = __builtin_amdgcn_readfirstlane((int)ldu(tile_e + pm));
        u.pm = pm; u.pn = pn; u.aux = e; u.a = gather ? A : A + (size_t)pm * 256 * 2048; u.b = B + (size_t)e * bE + (size_t)pn * bN; u.c = C + (size_t)pm * 256 * 2048 + (size_t)pn * cN; return true;
    }
};

DI unsigned lds_addr(const LAS void* p) { return (unsigned)(size_t)p; }
DI bf16x8 tr_frag8(unsigned img, int ld_bytes, int row_lo, int row_hi, int m0, int lane) {
    const int i = lane & 15; const unsigned a_lo = img + (unsigned)((row_lo + (i >> 2)) * ld_bytes + (m0 + 4 * (i & 3)) * 2), a_hi = img + (unsigned)((row_hi + (i >> 2)) * ld_bytes + (m0 + 4 * (i & 3)) * 2);
    s16x4 lo, hi;
    asm volatile("ds_read_b64_tr_b16 %0, %2\n\tds_read_b64_tr_b16 %1, %3\n\ts_waitcnt lgkmcnt(0)" : "=&v"(lo), "=&v"(hi) : "v"(a_lo), "v"(a_hi) : "memory");
    return __builtin_shufflevector(lo, hi, 0, 1, 2, 3, 4, 5, 6, 7);
}
DI s16x4 tr_read4(unsigned addr) { s16x4 r; asm volatile("ds_read_b64_tr_b16 %0, %1\n\ts_waitcnt lgkmcnt(0)" : "=&v"(r) : "v"(addr) : "memory"); return r; }
DI bf16x8 pack_frag(const f32x4 a, const f32x4 b) {
    u32x4 p; p.x = cvt_pk_bf16(a[0], a[1]); p.y = cvt_pk_bf16(a[2], a[3]); p.z = cvt_pk_bf16(b[0], b[1]); p.w = cvt_pk_bf16(b[2], b[3]); return __builtin_bit_cast(bf16x8, p);
}
DI u32x2 pack4(const f32x4 a) { u32x2 p; p.x = cvt_pk_bf16(a[0], a[1]); p.y = cvt_pk_bf16(a[2], a[3]); return p; }
DI f32x4 unpack4(const u32x2 w) { return (f32x4){bflo(w.x), bfhi(w.x), bflo(w.y), bfhi(w.y)}; }
DI float softcap15(float x) { const float y = x * (1.f / 15.f); const float e = __expf(2.f * y); return 15.f * (1.f - 2.f * __builtin_amdgcn_rcpf(e + 1.f)); }
DI float log_sigmoid(float x) { return fminf(x, 0.f) - log1pf(__expf(-fabsf(x))); }
DI float softplusf_(float x) { return fmaxf(x, 0.f) + log1pf(__expf(-fabsf(x))); }
DI float wave_incl_sum(float v, int lane) {
#pragma unroll
    for (int o = 1; o < 64; o <<= 1) { const float t = __shfl_up(v, o); v += (lane >= o) ? t : 0.f; }
    return v;
}
DI float wave_incl_max(float v, int lane) {
#pragma unroll
    for (int o = 1; o < 64; o <<= 1) { const float t = __shfl_up(v, o); v = (lane >= o) ? fmaxf(v, t) : v; }
    return v;
}
constexpr int GA_QH = 0, GA_KH = 17408, GA_VB = 34816, GA_KB = 52224, GA_NA = 69632, GA_AD = 78848, GA_TI = 82944, GA_GC = 84992, GA_KEI = 86016;
constexpr int LDI = 136 * 2;
constexpr int LDK = 72 * 2;

#define DMA16(src, dst) __builtin_amdgcn_global_load_lds((const unsigned*)(src), (LAS unsigned*)(dst), 16, 0, 0)
#define DMA16NT(src, dst) __builtin_amdgcn_global_load_lds((const unsigned*)(src), (LAS unsigned*)(dst), 16, 0, 2)
DI u32x2 gld8(const void* p) { u32x2 r; asm volatile("global_load_dwordx2 %0, %1, off" : "=v"(r) : "v"(p) : "memory"); return r; }
DI float gld4(const void* p) { float r; asm volatile("global_load_dword %0, %1, off" : "=v"(r) : "v"(p) : "memory"); return r; }
DI u32x4 gld16(const void* p) { u32x4 r; asm volatile("global_load_dwordx4 %0, %1, off nt" : "=v"(r) : "v"(p) : "memory"); return r; }
struct MlAPre { u32x4 kraw, vraw[2]; float gi, gf; };
#define PROF_SUB(k) do { if ((PROF_MASK) >> 16) { if (blockIdx.x == 0 && threadIdx.x == 0) { volatile LAS unsigned long long* pw = (volatile LAS unsigned long long*)(F.lds + LDS_MISC + 128); \
        const unsigned long long now_ = __builtin_amdgcn_s_memrealtime(); if (((PROF_MASK) >> (16 + (k))) & 1) pw[1] += now_ - pw[3]; pw[3] = now_; } } } while (0)
DI void ml_a_fetch(Ctx& F, int cid, MlAPre& P) {
    const int b = cid >> 8, h = (cid >> 6) & 3, n = cid & 63, t0 = b * SEQ + n * CH, tid = F.tid, lane = F.lane;
    const bf16* PROJ = (const bf16*)(F.ws + WS_PROJ); const float* GT = (const float*)(F.ws + WS_GATES);
    P.kraw = gld16(PROJ + (size_t)(t0 + (tid >> 3)) * NPROJ + 256 + h * 64 + (tid & 7) * 8);
#pragma unroll
    for (int q = 0; q < 2; ++q) { const int idx = tid + 512 * q; P.vraw[q] = gld16(PROJ + (size_t)(t0 + (idx >> 4)) * NPROJ + 512 + h * 128 + (idx & 15) * 8); }
    P.gi = gld4(GT + (size_t)(t0 + lane) * 16 + h); P.gf = gld4(GT + (size_t)(t0 + lane) * 16 + 4 + h);
}
DI void ml_a_unit(Ctx& F, int l, int cid, int par, MlAPre& P, float bi, float bf_, float& gb, float& ga, float nalog, float dtb) {
    int tid = F.tid; asm volatile("" : "+v"(tid)); const int lane = tid & 63;
    LAS unsigned char* KE = F.lds + par * 45056; LAS unsigned char* VI = KE + 16384; LAS float* es = (LAS float*)(KE + 40960);
    asm volatile("s_waitcnt vmcnt(7)" : "+v"(P.kraw), "+v"(P.vraw[0]), "+v"(P.vraw[1]), "+v"(P.gi), "+v"(P.gf), "+v"(gb), "+v"(ga) :: "memory");
    const int ks_ = tid >> 3, kc8 = (tid & 7) * 8;
    const u32x4 kraw = P.kraw; const u32x4 vraw[2] = {P.vraw[0], P.vraw[1]};
    if (F.wave == 7) {
        const float ip = softcap15(P.gi + bi), fp = softcap15(P.gf + bf_);
        const float bc = wave_incl_sum(log_sigmoid(fp), lane), blast = __shfl(bc, 63), lw = blast - bc + ip, amax = wave_max(lw);
        es[lane] = __expf(lw - amax);
        if (lane == 0) { float* sc = (float*)(F.ws + WS_MLSC) + (size_t)cid * 4; sc[0] = blast; sc[1] = amax; }
    }
    if (F.wave == 6) {
        LAS float* gcs = (LAS float*)(F.lds + GA_GC); LAS float* bts = gcs + 64;
        const float beta = sigmoidf_(gb), gg = nalog * softplusf_(ga + dtb), gc = wave_incl_sum(gg, lane);
        gcs[lane] = gc; bts[lane] = beta;
        if (lane == 63) ((float*)(F.ws + WS_GDGL))[cid] = __expf(gc);
    }
#pragma unroll
    for (int q = 0; q < 2; ++q) { const int idx = tid + 512 * q, s_ = idx >> 4, c8 = (idx & 15) * 8; *(LAS u32x4*)(VI + s_ * LDI + c8 * 2) = vraw[q]; }
    __syncthreads();
    { float v[8]; unpack8(kraw, v); const float e = es[ks_];
#pragma unroll
      for (int j = 0; j < 8; ++j) v[j] *= e;
      *(LAS u32x4*)(KE + ks_ * LDK + kc8 * 2) = pack8(v); }
    __syncthreads();
    { const int g = lane >> 4, w = F.wave, ln = lane & 15; f32x4 acc[4], kacc[4];
#pragma unroll
      for (int nt = 0; nt < 4; ++nt) { acc[nt] = (f32x4){0.f, 0.f, 0.f, 0.f}; kacc[nt] = (f32x4){0.f, 0.f, 0.f, 0.f}; }
      const bf16x8 ones = (ln == 0) ? (bf16x8){0x3f80, 0x3f80, 0x3f80, 0x3f80, 0x3f80, 0x3f80, 0x3f80, 0x3f80} : (bf16x8){0, 0, 0, 0, 0, 0, 0, 0};
#pragma unroll
      for (int ks = 0; ks < 2; ++ks) { const int rb = 32 * ks + 8 * g;
          const bf16x8 af = tr_frag8(lds_addr(VI), LDI, rb, rb + 4, 16 * w, lane);
#pragma unroll
          for (int nt = 0; nt < 4; ++nt) { const bf16x8 bf = tr_frag8(lds_addr(KE), LDK, rb, rb + 4, 16 * nt, lane); acc[nt] = MFMA16(bf, af, acc[nt]);
              if (w == 0) kacc[nt] = MFMA16(ones, bf, kacc[nt]); } }
      bf16* U = (bf16*)(F.ws + WS_MLU) + (size_t)cid * 8192;
#pragma unroll
      for (int nt = 0; nt < 4; ++nt)
          *(u32x2*)(U + (w * 2 + (nt >> 1)) * 512 + ((2 * (nt & 1) + (g >> 1)) * 16 + ln) * 8 + 4 * (g & 1)) = pack4(acc[nt]);
      if (w == 0 && g == 0) {
#pragma unroll
          for (int nt = 0; nt < 4; ++nt) ((float*)(F.ws + WS_MLKN))[(size_t)cid * 64 + 16 * nt + ln] = kacc[nt][0]; }
    }
}
struct MlBBatch { u32x2 ub[8]; float kv[8]; u32x2 sc; };
DI void ml_b_fetch(const bf16* U, const float* SC, const float* KN, size_t cid0, int e0, int t, bool dn, MlBBatch& B) {
#pragma unroll
    for (int q = 0; q < 8; ++q) { const size_t cid = cid0 + q;
        B.ub[q] = gld8(U + cid * 8192 + e0);
        B.kv[q] = 0.f; if (dn) asm volatile("global_load_dword %0, %1, off" : "+v"(B.kv[q]) : "v"(KN + cid * 64 + t) : "memory"); }
    B.sc = gld8(SC + (cid0 + (t & 7)) * 4);
}
DI void ml_b_compute(const MlBBatch& B, bf16* CT, float* NP, float* MP, size_t cid0, int e0, int t, int p, bool dn, f32x4& C, float& nv, float& m) {
#pragma unroll
    for (int q = 0; q < 8; ++q) { const size_t cid = cid0 + q;
        *(u32x2*)(CT + cid * 8192 + e0) = pack4(C);
        if (dn) NP[cid * 64 + t] = nv; if (p == 0 && t == 0) MP[cid] = m;
        const float blq = __uint_as_float(__builtin_amdgcn_readlane(B.sc.x, q)), amq = __uint_as_float(__builtin_amdgcn_readlane(B.sc.y, q));
        const float mn = fmaxf(blq + m, amq), d1 = __expf(blq + m - mn), d2 = __expf(amq - mn);
        const f32x4 uv = unpack4(B.ub[q]);
#pragma unroll
        for (int k = 0; k < 4; ++k) C[k] = d1 * C[k] + d2 * uv[k];
        nv = d1 * nv + d2 * (dn ? B.kv[q] : 0.f); m = mn; }
}
#define MLB_TIE(B) do { _Pragma("unroll") for (int q_ = 0; q_ < 8; ++q_) asm volatile("" : "+v"(B.ub[q_]), "+v"(B.kv[q_])); asm volatile("" : "+v"(B.sc)); } while (0)
DI void ml_b_unit(Ctx& F, int u) {
    const int bh = u >> 3, p = u & 7, t = F.tid - 256, e0 = p * 1024 + 4 * t;
    const bf16* U = (const bf16*)(F.ws + WS_MLU); const float* SC = (const float*)(F.ws + WS_MLSC); const float* KN = (const float*)(F.ws + WS_MLKN);
    bf16* CT = (bf16*)(F.ws + WS_MLCT); float* NP = (float*)(F.ws + WS_MLNP); float* MP = (float*)(F.ws + WS_MLMP);
    f32x4 C = (f32x4){0.f, 0.f, 0.f, 0.f}; float nv = 0.f, m = 0.f; const bool dn = (p == 0 && t < 64);
    const size_t c0 = (size_t)bh * 64;
    MlBBatch A, B;
    ml_b_fetch(U, SC, KN, c0, e0, t, dn, A);
#pragma unroll
    for (int nb = 0; nb < 8; nb += 2) {
        ml_b_fetch(U, SC, KN, c0 + 8 * (nb + 1), e0, t, dn, B); asm volatile("s_waitcnt vmcnt(9)" ::: "memory"); MLB_TIE(A);
        ml_b_compute(A, CT, NP, MP, c0 + 8 * nb, e0, t, p, dn, C, nv, m);
        if (nb + 2 < 8) { ml_b_fetch(U, SC, KN, c0 + 8 * (nb + 2), e0, t, dn, A); asm volatile("s_waitcnt vmcnt(9)" ::: "memory"); } else asm volatile("s_waitcnt vmcnt(0)" ::: "memory");
        MLB_TIE(B);
        ml_b_compute(B, CT, NP, MP, c0 + 8 * (nb + 1), e0, t, p, dn, C, nv, m);
    }
}
DI void ml_c_unit(Ctx& F, const Args& a, int l, int cid, int par) {
    const int b = cid >> 8, h = (cid >> 6) & 3, n = cid & 63, t0 = b * SEQ + n * CH, lane = F.lane, tid = F.tid, g = lane >> 4, ln = lane & 15, w = F.wave, tt = w & 3, dh = w >> 2;
    const bf16* PROJ = (const bf16*)(F.ws + WS_PROJ); const float* GT = (const float*)(F.ws + WS_GATES);
    LAS unsigned char* VI = F.lds + par * 24576; LAS float* ib = (LAS float*)(VI + 20480); LAS float* Mt = ib + 64; LAS float* bcs = ib + 128; LAS float* ss = ib + 192;
    const float mprev = ldf((const float*)(F.ws + WS_MLMP) + cid);
    const bf16* CT = (const bf16*)(F.ws + WS_MLCT) + (size_t)cid * 8192; const float* NPv = (const float*)(F.ws + WS_MLNP) + (size_t)cid * 64;
    const int tl = 16 * tt + ln;
    bf16x8 qf[2], kf[4][2], ctf[5][2]; u32x2 ogr[4]; f32x4 nwr[4]; u32x4 vraw[2];
#pragma unroll
    for (int ks = 0; ks < 2; ++ks) { qf[ks] = *(const bf16x8*)(PROJ + (size_t)(t0 + tl) * NPROJ + h * 64 + 32 * ks + 8 * g);
#pragma unroll
        for (int ms = 0; ms < 4; ++ms) kf[ms][ks] = *(const bf16x8*)(PROJ + (size_t)(t0 + 16 * ms + ln) * NPROJ + 256 + h * 64 + 32 * ks + 8 * g);
#pragma unroll
        for (int mt = 0; mt < 4; ++mt) ctf[mt][ks] = *(const bf16x8*)(CT + (size_t)(16 * (4 * dh + mt) + ln) * 64 + 32 * ks + 8 * g);
        const f32x4 n0 = *(const f32x4*)(NPv + 32 * ks + 8 * g), n1 = *(const f32x4*)(NPv + 32 * ks + 8 * g + 4);
        float nvv[8];
#pragma unroll
        for (int j = 0; j < 4; ++j) { nvv[j] = (ln == 0) ? n0[j] : 0.f; nvv[4 + j] = (ln == 0) ? n1[j] : 0.f; }
        ctf[4][ks] = __builtin_bit_cast(bf16x8, pack8(nvv)); }
#pragma unroll
    for (int mt = 0; mt < 4; ++mt) { const int dv = 16 * (4 * dh + mt) + 4 * g;
        nwr[mt] = *(const f32x4*)(inp(F, 5) + (size_t)l * 512 + h * 128 + dv); ogr[mt] = *(const u32x2*)(PROJ + (size_t)(t0 + tl) * NPROJ + 1024 + h * 128 + dv); }
#pragma unroll
    for (int q = 0; q < 2; ++q) { const int idx = tid + 512 * q, s_ = idx >> 4, c8 = (idx & 15) * 8; vraw[q] = *(const u32x4*)(PROJ + (size_t)(t0 + s_) * NPROJ + 512 + h * 128 + c8); }
    if (w == 7) {
        const float ip = softcap15(GT[(size_t)(t0 + lane) * 16 + h] + inp(F, 3)[l * 4 + h]), fp = softcap15(GT[(size_t)(t0 + lane) * 16 + 4 + h] + inp(F, 4)[l * 4 + h]);
        const float bc = wave_incl_sum(log_sigmoid(fp), lane), ibs = ip - bc, pm = wave_incl_max(ibs, lane);
        ib[lane] = ibs; Mt[lane] = fmaxf(mprev, pm); bcs[lane] = bc;
    }
#pragma unroll
    for (int q = 0; q < 2; ++q) { const int idx = tid + 512 * q, s_ = idx >> 4, c8 = (idx & 15) * 8; *(LAS u32x4*)(VI + s_ * LDI + c8 * 2) = vraw[q]; }
    __syncthreads();
    f32x4 sacc[4];
#pragma unroll
    for (int ms = 0; ms < 4; ++ms) { sacc[ms] = (f32x4){0.f, 0.f, 0.f, 0.f};
#pragma unroll
        for (int ks = 0; ks < 2; ++ks) sacc[ms] = MFMA16(kf[ms][ks], qf[ks], sacc[ms]); }
    const float Mtt = Mt[tl];
#pragma unroll
    for (int ms = 0; ms < 4; ++ms) { const f32x4 ibv = *(const LAS f32x4*)(ib + 16 * ms + 4 * g);
#pragma unroll
        for (int i = 0; i < 4; ++i) { const int s = 16 * ms + 4 * g + i; sacc[ms][i] = (s <= tl) ? sacc[ms][i] * 0.125f * __expf(ibv[i] - Mtt) : 0.f; } }
    bf16x8 sb[2]; sb[0] = pack_frag(sacc[0], sacc[1]); sb[1] = pack_frag(sacc[2], sacc[3]);
    f32x4 xacc[5];
#pragma unroll
    for (int mt = 0; mt < 5; ++mt) { xacc[mt] = (f32x4){0.f, 0.f, 0.f, 0.f};
#pragma unroll
        for (int ks = 0; ks < 2; ++ks) xacc[mt] = MFMA16(ctf[mt][ks], qf[ks], xacc[mt]); }
    const float wint = 0.125f * __expf(mprev - Mtt);
#pragma unroll
    for (int mt = 0; mt < 5; ++mt) xacc[mt] *= wint;
    const bf16x8 ones = (ln == 0) ? (bf16x8){0x3f80, 0x3f80, 0x3f80, 0x3f80, 0x3f80, 0x3f80, 0x3f80, 0x3f80} : (bf16x8){0, 0, 0, 0, 0, 0, 0, 0};
#pragma unroll
    for (int kk = 0; kk < 2; ++kk) {
#pragma unroll
        for (int mt = 0; mt < 4; ++mt) { const bf16x8 vf = tr_frag8(lds_addr(VI), LDI, 32 * kk + 4 * g, 32 * kk + 16 + 4 * g, 16 * (4 * dh + mt), lane); xacc[mt] = MFMA16(vf, sb[kk], xacc[mt]); }
        xacc[4] = MFMA16(ones, sb[kk], xacc[4]);
    }
    const float den = __shfl(xacc[4][0], ln), mt_ = bcs[tl] + Mtt, dinv = __builtin_amdgcn_rcpf(fmaxf(fabsf(den), __expf(-mt_)));
    float ssq = 0.f;
#pragma unroll
    for (int mt = 0; mt < 4; ++mt) { xacc[mt] *= dinv; ssq += (xacc[mt][0] * xacc[mt][0] + xacc[mt][1] * xacc[mt][1]) + (xacc[mt][2] * xacc[mt][2] + xacc[mt][3] * xacc[mt][3]); }
    ssq += __shfl_xor(ssq, 16); ssq += __shfl_xor(ssq, 32);
    if (g == 0) ss[tl * 2 + dh] = ssq;
    __syncthreads();
    const float rinv = rsqrtf((ss[tl * 2] + ss[tl * 2 + 1]) * (1.f / 128.f) + 1e-6f);
    bf16* MX = (bf16*)(F.ws + WS_MIXED);
#pragma unroll
    for (int mt = 0; mt < 4; ++mt) { const int dv = 16 * (4 * dh + mt) + 4 * g;
        const f32x4 nw = nwr[mt]; const f32x4 og = unpack4(ogr[mt]);
        f32x4 o;
#pragma unroll
        for (int i = 0; i < 4; ++i) o[i] = xacc[mt][i] * rinv * nw[i] * sigmoidf_(og[i]);
        *(u32x2*)(MX + (size_t)(t0 + tl) * D + h * 128 + dv) = pack4(o); }
}

constexpr int GA_WT = 155648;
constexpr int GA_ST = 103424;
DI void gd_a_issue(Ctx& F, int cid, int w, int lane) {
    const int b = cid >> 8, h = (cid >> 6) & 3, n = cid & 63, t0 = b * SEQ + n * CH;
    const bf16* PROJ = (const bf16*)(F.ws + WS_PROJ);
#pragma unroll
    for (int q = 0; q < 7; ++q) { const int jj = (w + 8 * q) % 51, ten = jj / 17, grp = jj % 17;
        DMA16NT(PROJ + ((long)t0 - 3 + 4 * grp + (lane >> 4)) * NPROJ + 1536 + ten * 512 + h * 128 + 8 * (lane & 15), F.lds + GA_ST + ten * 17408 + grp * 1024); }
}
DI void gd_a_unit(Ctx& F, int l, int cid, float& gb, float& ga, float nalog, float dtb, bool has_next, MlAPre& P) {
    int tid = F.tid; asm volatile("" : "+v"(tid));
    const int b = cid >> 8, h = (cid >> 6) & 3, n = cid & 63, t0 = b * SEQ + n * CH, lane = tid & 63, g = lane >> 4, ln = lane & 15, w = F.wave;
    const float* GT = (const float*)(F.ws + WS_GATES);
    LAS unsigned char* L = F.lds; LAS float* gcs = (LAS float*)(L + GA_GC); LAS float* bts = gcs + 64;
    const int ten = tid >> 7, tg = (tid >> 4) & 7, cg = tid & 15;
    asm volatile("s_waitcnt vmcnt(0)" ::: "memory");
    __syncthreads();
    u32x4 raw[11];
    if (ten < 3) { const unsigned sa = lds_addr(L) + GA_ST + ten * 17408 + (8 * tg) * 256 + cg * 16;
        asm volatile("ds_read_b128 %0, %11\n\tds_read_b128 %1, %11 offset:256\n\tds_read_b128 %2, %11 offset:512\n\tds_read_b128 %3, %11 offset:768\n\tds_read_b128 %4, %11 offset:1024\n\tds_read_b128 %5, %11 offset:1280\n\t"
                     "ds_read_b128 %6, %11 offset:1536\n\tds_read_b128 %7, %11 offset:1792\n\tds_read_b128 %8, %11 offset:2048\n\tds_read_b128 %9, %11 offset:2304\n\tds_read_b128 %10, %11 offset:2560\n\ts_waitcnt lgkmcnt(0)"
                     : "=&v"(raw[0]), "=&v"(raw[1]), "=&v"(raw[2]), "=&v"(raw[3]), "=&v"(raw[4]), "=&v"(raw[5]), "=&v"(raw[6]), "=&v"(raw[7]), "=&v"(raw[8]), "=&v"(raw[9]), "=&v"(raw[10]) : "v"(sa) : "memory");
        if (n == 0 && tg == 0) { raw[0] = (u32x4){0u, 0u, 0u, 0u}; raw[1] = raw[0]; raw[2] = raw[0]; }
    }
    float wv[4][8];
#pragma unroll
    for (int j = 0; j < 4; ++j) unpack8(*(const LAS u32x4*)(L + GA_WT + (((ten < 3 ? ten : 0) * 4 + j) * 128 + 8 * cg) * 2), wv[j]);
    const float glast = gcs[63];
    bf16* qgb = (bf16*)(F.ws + WS_GDQG) + (size_t)cid * 8192 + (8 * tg) * 128 + 8 * cg; asm volatile("" : "+v"(qgb));
    if (ten < 3) {
#pragma unroll
        for (int i = 0; i < 8; ++i) { const int t = 8 * tg + i; float y[8];
#pragma unroll
            for (int c = 0; c < 8; ++c) y[c] = 0.f;
#pragma unroll
            for (int j = 0; j < 4; ++j) { float xv[8]; unpack8(raw[i + j], xv);
#pragma unroll
                for (int c = 0; c < 8; ++c) y[c] += wv[j][c] * xv[c]; }
#pragma unroll
            for (int c = 0; c < 8; ++c) y[c] = y[c] * sigmoidf_(y[c]);
            const float gct = gcs[t], bt = bts[t];
            if (ten < 2) { float s2 = 0.f;
#pragma unroll
                for (int c = 0; c < 8; ++c) s2 += y[c] * y[c];
                s2 += __shfl_xor(s2, 1); s2 += __shfl_xor(s2, 2); s2 += __shfl_xor(s2, 4); s2 += __shfl_xor(s2, 8);
                const float rn = rsqrtf(s2 + 1e-6f) * (ten == 0 ? 0.08838834764831845f : 1.f);
#pragma unroll
                for (int c = 0; c < 8; ++c) y[c] *= rn; }
            float z[8];
            if (ten == 0) { *(LAS u32x4*)(L + GA_QH + t * LDI + 16 * cg) = pack8(y); const float e = __expf(gct);
#pragma unroll
                for (int c = 0; c < 8; ++c) z[c] = y[c] * e;
                *(u32x4*)(qgb + i * 128) = pack8(z); }
            else if (ten == 1) { *(LAS u32x4*)(L + GA_KH + t * LDI + 16 * cg) = pack8(y); const float e1 = bt * __expf(gct), e2 = __expf(glast - gct);
#pragma unroll
                for (int c = 0; c < 8; ++c) z[c] = y[c] * e1;
                *(LAS u32x4*)(L + GA_KB + t * LDI + 16 * cg) = pack8(z);
#pragma unroll
                for (int c = 0; c < 8; ++c) z[c] = y[c] * e2;
                *(LAS u32x4*)(L + GA_KEI + t * LDI + 16 * cg) = pack8(z); }
            else {
#pragma unroll
                for (int c = 0; c < 8; ++c) z[c] = y[c] * bt;
                *(LAS u32x4*)(L + GA_VB + t * LDI + 16 * cg) = pack8(z); }
        }
    }
    __syncthreads(); PROF_SUB(1);
    if (has_next) {
        ml_a_fetch(F, cid + 256, P);
        gb = gld4(GT + (size_t)(t0 + SEQ + lane) * 16 + 8 + h); ga = gld4(GT + (size_t)(t0 + SEQ + lane) * 16 + 12 + h);
        gd_a_issue(F, cid + 256, w, lane); }
    { const int ti = w & 3, kind = w >> 2; const int tl = 16 * ti + ln; const float gct = gcs[tl], bt = bts[tl];
      bf16* QKD = (bf16*)(F.ws + WS_GDQK) + (size_t)cid * 4096;
#pragma unroll
      for (int si = 0; si < 4; ++si) {
          if (si <= ti) {
              f32x4 acc = (f32x4){0.f, 0.f, 0.f, 0.f};
#pragma unroll
              for (int ks = 0; ks < 4; ++ks) { const bf16x8 af = *(const LAS bf16x8*)(L + GA_KH + (16 * si + ln) * LDI + (32 * ks + 8 * g) * 2);
                  const bf16x8 bfr = *(const LAS bf16x8*)(L + (kind ? GA_QH : GA_KH) + tl * LDI + (32 * ks + 8 * g) * 2); acc = MFMA16(af, bfr, acc); }
              const f32x4 gs = *(const LAS f32x4*)(gcs + 16 * si + 4 * g);
              f32x4 v;
#pragma unroll
              for (int i = 0; i < 4; ++i) { const int s = 16 * si + 4 * g + i; const float dec = __expf(gct - gs[i]);
                  v[i] = kind ? ((s <= tl) ? acc[i] * dec : 0.f) : ((s < tl) ? bt * acc[i] * dec : 0.f); }
              if (kind) *(u32x2*)(QKD + (ti * 2 + (si >> 1)) * 512 + ((2 * (si & 1) + (g >> 1)) * 16 + ln) * 8 + (g & 1) * 4) = pack4(v);
              else { *(LAS u32x2*)(L + GA_NA + tl * LDK + (16 * si + 4 * g) * 2) = pack4(-v);
                  if (si == ti) { LAS float* AD = (LAS float*)(L + GA_AD) + ti * 256 + ln * 16 + 4 * g; AD[0] = v[0]; AD[1] = v[1]; AD[2] = v[2]; AD[3] = v[3]; } }
          } else if (kind) *(u32x2*)(QKD + (ti * 2 + (si >> 1)) * 512 + ((2 * (si & 1) + (g >> 1)) * 16 + ln) * 8 + (g & 1) * 4) = (u32x2){0u, 0u};
      } }
    __syncthreads(); PROF_SUB(2);
    if (w == 0) {
        const LAS float* AD = (const LAS float*)(L + GA_AD) + g * 256; float a_[16][16], acc[16];
#pragma unroll
        for (int t = 1; t < 16; ++t)
#pragma unroll
            for (int q = 0; q < 4; ++q) { if (4 * q < t) { const f32x4 r = *(const LAS f32x4*)(AD + t * 16 + 4 * q); a_[t][4 * q] = r[0]; a_[t][4 * q + 1] = r[1]; a_[t][4 * q + 2] = r[2]; a_[t][4 * q + 3] = r[3]; } }
#pragma unroll
        for (int t = 0; t < 16; ++t) acc[t] = (t == ln) ? 1.f : 0.f;
#pragma unroll
        for (int s_ = 0; s_ < 16; ++s_) { const float tc = acc[s_]; *(LAS bf16*)(L + GA_TI + (16 * g + s_) * 32 + ln * 2) = f2bf(tc);
#pragma unroll
            for (int t = s_ + 1; t < 16; ++t) acc[t] -= a_[t][s_] * tc; }
    }
    __syncthreads(); PROF_SUB(3);
    { const int src = (w < 4) ? GA_VB : GA_KB, cb = 32 * (w & 3);
      u32x2 Ub[4][2]; bf16* UT = (bf16*)(F.ws + WS_GDUT) + (size_t)cid * 8192;
#pragma unroll
      for (int i = 0; i < 4; ++i) {
          f32x4 acc[2];
#pragma unroll
          for (int nt = 0; nt < 2; ++nt)
#pragma unroll
              for (int r = 0; r < 4; ++r) acc[nt][r] = bf2f(*(const LAS bf16*)(L + src + (16 * i + 4 * g + r) * LDI + (cb + 16 * nt + ln) * 2));
#pragma unroll
          for (int jp = 0; jp < 2; ++jp) { if (2 * jp < i) {
              const u32x2 alo = *(const LAS u32x2*)(L + GA_NA + (16 * i + ln) * LDK + (32 * jp + 4 * g) * 2);
              const u32x2 ahi = (2 * jp + 1 < i) ? *(const LAS u32x2*)(L + GA_NA + (16 * i + ln) * LDK + (32 * jp + 16 + 4 * g) * 2) : (u32x2){0u, 0u};
              const bf16x8 af = __builtin_bit_cast(bf16x8, (u32x4){alo.x, alo.y, ahi.x, ahi.y});
#pragma unroll
              for (int nt = 0; nt < 2; ++nt) { const u32x2 blo = Ub[2 * jp][nt], bhi = (2 * jp + 1 < i) ? Ub[2 * jp + 1][nt] : (u32x2){0u, 0u};
                  acc[nt] = MFMA16(af, __builtin_bit_cast(bf16x8, (u32x4){blo.x, blo.y, bhi.x, bhi.y}), acc[nt]); } } }
          const u32x2 tlo = *(const LAS u32x2*)(L + GA_TI + (16 * i + ln) * 32 + (4 * g) * 2);
          const bf16x8 tf = __builtin_bit_cast(bf16x8, (u32x4){tlo.x, tlo.y, 0u, 0u});
#pragma unroll
          for (int nt = 0; nt < 2; ++nt) { const u32x2 p = pack4(acc[nt]);
              const f32x4 u = MFMA16(tf, __builtin_bit_cast(bf16x8, (u32x4){p.x, p.y, 0u, 0u}), ((f32x4){0.f, 0.f, 0.f, 0.f}));
              Ub[i][nt] = pack4(u);
              if (w < 4) *(u32x2*)(UT + ((cb >> 4) + nt) * 1024 + i * 256 + lane * 4) = Ub[i][nt];
              else {
#pragma unroll
                  for (int r = 0; r < 4; ++r) *(LAS bf16*)(L + GA_QH + (16 * i + 4 * g + r) * LDI + (cb + 16 * nt + ln) * 2) = f2bf(-u[r]); } }
      } }
    __syncthreads(); PROF_SUB(4);
    { bf16* W = (bf16*)(F.ws + WS_GDW) + (size_t)cid * 8192; bf16* KET = (bf16*)(F.ws + WS_GDKE) + (size_t)cid * 8192;
#pragma unroll
      for (int q = 0; q < 2; ++q) { const int item = tid + 512 * q, f = item >> 6, lp = item & 63, t = 16 * (f >> 2) + (lp & 15), kk = f & 3, gp = lp >> 4;
          const u32x2 lo = *(const LAS u32x2*)(L + GA_QH + t * LDI + (32 * kk + 4 * gp) * 2), hi = *(const LAS u32x2*)(L + GA_QH + t * LDI + (32 * kk + 16 + 4 * gp) * 2);
          *(u32x4*)(W + item * 8) = (u32x4){lo.x, lo.y, hi.x, hi.y}; }
#pragma unroll
      for (int q = 0; q < 4; ++q) { const int rg = 4 * q + g, kk = rg >> 3, idx = rg & 7, pos = 32 * kk + ((idx < 4) ? 8 * idx : 8 * (idx - 4) + 4);
          const int trow = 32 * kk + ((idx < 4) ? 4 * idx : 16 + 4 * (idx - 4));
          const s16x4 v = tr_read4(lds_addr(L + GA_KEI) + (unsigned)((trow + (ln >> 2)) * LDI + (16 * w + 4 * (ln & 3)) * 2));
          *(s16x4*)(KET + (w * 2 + kk) * 512 + ((idx & 3) * 16 + ln) * 8 + ((idx < 4) ? 0 : 4)) = v; }
    }
    __syncthreads(); PROF_SUB(5);
}
constexpr int GB_STAGE = 36864;
DI void gd_b_issue(const bf16* W, const bf16* KET, const bf16* UT, size_t cid, int dv0, int ln, int g, LAS unsigned char* buf) {
#pragma unroll
    for (int mt = 0; mt < 4; ++mt)
#pragma unroll
        for (int kk = 0; kk < 4; ++kk) __builtin_amdgcn_global_load_lds((const unsigned*)(W + cid * 8192 + (mt * 4 + kk) * 512 + (16 * g + ln) * 8), (LAS unsigned*)(buf + (mt * 4 + kk) * 1024), 16, 0, 0);
#pragma unroll
    for (int j = 0; j < 8; ++j)
#pragma unroll
        for (int k2 = 0; k2 < 2; ++k2) __builtin_amdgcn_global_load_lds((const unsigned*)(KET + cid * 8192 + (j * 2 + k2) * 512 + (16 * g + ln) * 8), (LAS unsigned*)(buf + (16 + j * 2 + k2) * 1024), 16, 0, 0);
#pragma unroll
    for (int q = 0; q < 2; ++q) __builtin_amdgcn_global_load_lds((const unsigned*)(UT + cid * 8192 + dv0 * 64 + q * 512 + (16 * g + ln) * 8), (LAS unsigned*)(buf + (32 + q) * 1024), 16, 0, 0);
}
#define GB_RD16(f, addr, WAITSTR) asm volatile( \
    "ds_read_b128 %0, %16\n\tds_read_b128 %1, %16 offset:1024\n\tds_read_b128 %2, %16 offset:2048\n\tds_read_b128 %3, %16 offset:3072\n\t" \
    "ds_read_b128 %4, %16 offset:4096\n\tds_read_b128 %5, %16 offset:5120\n\tds_read_b128 %6, %16 offset:6144\n\tds_read_b128 %7, %16 offset:7168\n\t" \
    "ds_read_b128 %8, %16 offset:8192\n\tds_read_b128 %9, %16 offset:9216\n\tds_read_b128 %10, %16 offset:10240\n\tds_read_b128 %11, %16 offset:11264\n\t" \
    "ds_read_b128 %12, %16 offset:12288\n\tds_read_b128 %13, %16 offset:13312\n\tds_read_b128 %14, %16 offset:14336\n\tds_read_b128 %15, %16 offset:15360" WAITSTR \
    : "=&v"(f[0]), "=&v"(f[1]), "=&v"(f[2]), "=&v"(f[3]), "=&v"(f[4]), "=&v"(f[5]), "=&v"(f[6]), "=&v"(f[7]), \
      "=&v"(f[8]), "=&v"(f[9]), "=&v"(f[10]), "=&v"(f[11]), "=&v"(f[12]), "=&v"(f[13]), "=&v"(f[14]), "=&v"(f[15]) : "v"(addr) : "memory")
constexpr int GB_NS = 4, GB_FLAGS = LDS_MISC + 512, GB_SPIN_CAP = 1 << 22;
DI void gd_b_step(Ctx& F, f32x4 (&S)[8], size_t cid, int dv0, int lane, int ln, int g, float egl, unsigned stage_base, int n) {
    const unsigned base = stage_base + (unsigned)lane * 16u;
    bf16* VNT = (bf16*)(F.ws + WS_GDVN); bf16* SPT = (bf16*)(F.ws + WS_GDSP);
    bf16x8 wf[16], kef[16]; u32x2 ui[4];
    asm volatile("ds_read_b64 %0, %4 offset:32768\n\tds_read_b64 %1, %4 offset:33280\n\tds_read_b64 %2, %4 offset:33792\n\tds_read_b64 %3, %4 offset:34304"
                 : "=&v"(ui[0]), "=&v"(ui[1]), "=&v"(ui[2]), "=&v"(ui[3]) : "v"(stage_base + (unsigned)lane * 8u) : "memory");
    GB_RD16(wf, base, "\n\ts_waitcnt lgkmcnt(0)");
    asm volatile("" : "+v"(ui[0]), "+v"(ui[1]), "+v"(ui[2]), "+v"(ui[3]));
    GB_RD16(kef, base + 16384u, "");
    f32x4 vacc[4]; bf16x8 sbn[4];
#pragma unroll
    for (int kk = 0; kk < 4; ++kk) sbn[kk] = pack_frag(S[2 * kk], S[2 * kk + 1]);
#pragma unroll
    for (int j = 0; j < 8; ++j) *(u32x2*)(SPT + cid * 16384 + ((dv0 >> 4) * 4 + (j >> 1)) * 512 + ((2 * (j & 1) + (g >> 1)) * 16 + ln) * 8 + (g & 1) * 4) = pack4(S[j]);
#pragma unroll
    for (int mt = 0; mt < 4; ++mt) vacc[mt] = unpack4(ui[mt]);
#pragma unroll
    for (int kk = 0; kk < 4; ++kk)
#pragma unroll
        for (int mt = 0; mt < 4; ++mt) vacc[mt] = MFMA16(wf[mt * 4 + kk], sbn[kk], vacc[mt]);
#pragma unroll
    for (int mt = 0; mt < 4; ++mt) *(u32x2*)(VNT + cid * 8192 + ((dv0 >> 4) * 2 + (mt >> 1)) * 512 + ((2 * (mt & 1) + (g >> 1)) * 16 + ln) * 8 + (g & 1) * 4) = pack4(vacc[mt]);
    bf16x8 vb[2]; vb[0] = pack_frag(vacc[0], vacc[1]); vb[1] = pack_frag(vacc[2], vacc[3]);
    asm volatile("s_waitcnt lgkmcnt(0)" : "+v"(kef[0]), "+v"(kef[1]), "+v"(kef[2]), "+v"(kef[3]), "+v"(kef[4]), "+v"(kef[5]), "+v"(kef[6]), "+v"(kef[7]),
                 "+v"(kef[8]), "+v"(kef[9]), "+v"(kef[10]), "+v"(kef[11]), "+v"(kef[12]), "+v"(kef[13]), "+v"(kef[14]), "+v"(kef[15]) :: "memory");
    if (lane == 0) ((volatile LAS unsigned*)(F.lds + GB_FLAGS))[4] = (unsigned)(n + 1);
#pragma unroll
    for (int j = 0; j < 8; ++j) S[j] *= egl;
#pragma unroll
    for (int k2 = 0; k2 < 2; ++k2)
#pragma unroll
        for (int j = 0; j < 8; ++j) S[j] = MFMA16(kef[j * 2 + k2], vb[k2], S[j]);
}
DI void gd_b_task(Ctx& F, int task) {
    const int bh = task >> 3, dv0 = 16 * (task & 7), lane = F.lane, g = lane >> 4, ln = lane & 15;
    const float* GL = (const float*)(F.ws + WS_GDGL);
    volatile LAS unsigned* fl = (volatile LAS unsigned*)(F.lds + GB_FLAGS);
    f32x4 S[8];
#pragma unroll
    for (int j = 0; j < 8; ++j) S[j] = (f32x4){0.f, 0.f, 0.f, 0.f};
    const size_t c0 = (size_t)bh * 64;
    const float eglv = ldf(GL + c0 + lane);
    asm volatile("s_waitcnt vmcnt(0)" ::: "memory");
    const unsigned L0 = lds_addr(F.lds);
#pragma unroll 1
    for (int n = 0; n < 64; ++n) {
        unsigned spins = 0;
        unsigned long long tp0_ = 0; if (((PROF_MASK) >> 22) & 1) tp0_ = __builtin_amdgcn_s_memrealtime();
        while (fl[n & 3] < (unsigned)(n + 1)) { __builtin_amdgcn_s_sleep(1); if (++spins > (unsigned)GB_SPIN_CAP) { fl[5] = 1u; break; } }
        if (((PROF_MASK) >> 22) & 1) { if (blockIdx.x == 0 && lane == 0) { volatile LAS unsigned long long* pw = (volatile LAS unsigned long long*)(F.lds + LDS_MISC + 128); pw[1] += __builtin_amdgcn_s_memrealtime() - tp0_; } }
        gd_b_step(F, S, c0 + n, dv0, lane, ln, g, __builtin_amdgcn_readlane(eglv, n), L0 + (unsigned)(n & 3) * GB_STAGE, n);
    }
}
DI void gd_b_loader(Ctx& F, int task, int li) {
    const int bh = task >> 3, dv0 = 16 * (task & 7), lane = F.lane, g = lane >> 4, ln = lane & 15;
    const bf16* UT = (const bf16*)(F.ws + WS_GDUT); const bf16* W = (const bf16*)(F.ws + WS_GDW); const bf16* KET = (const bf16*)(F.ws + WS_GDKE);
    volatile LAS unsigned* fl = (volatile LAS unsigned*)(F.lds + GB_FLAGS);
    const size_t c0 = (size_t)bh * 64;
    int prev = -1;
#pragma unroll 1
    for (int n = li; n < 64; n += 2) {
        if (n >= GB_NS) { unsigned spins = 0; while (fl[4] < (unsigned)(n - GB_NS + 1)) { __builtin_amdgcn_s_sleep(1); if (++spins > (unsigned)GB_SPIN_CAP) { fl[5] = 1u; break; } } }
        gd_b_issue(W, KET, UT, c0 + n, dv0, ln, g, F.lds + (n & 3) * GB_STAGE);
        if (prev >= 0) { asm volatile("s_waitcnt vmcnt(34)" ::: "memory"); if (lane == 0) fl[prev & 3] = (unsigned)(prev + 1); }
        prev = n;
    }
    asm volatile("s_waitcnt vmcnt(0)" ::: "memory"); if (lane == 0) fl[prev & 3] = (unsigned)(prev + 1);
}
DI void gd_c_unit(Ctx& F, const Args& a, int l, int cid, int par) {
    const int b = cid >> 8, h = (cid >> 6) & 3, n = cid & 63, t0 = b * SEQ + n * CH, lane = F.lane, g = lane >> 4, ln = lane & 15, w = F.wave, tt = w & 3, dh = w >> 2, tl = 16 * tt + ln;
    const bf16* PROJ = (const bf16*)(F.ws + WS_PROJ);
    const bf16* SPT = (const bf16*)(F.ws + WS_GDSP) + (size_t)cid * 16384; const bf16* QG = (const bf16*)(F.ws + WS_GDQG) + (size_t)cid * 8192;
    const bf16* VNT = (const bf16*)(F.ws + WS_GDVN) + (size_t)cid * 8192; const bf16* QKD = (const bf16*)(F.ws + WS_GDQK) + (size_t)cid * 4096;
    LAS float* ss = (LAS float*)(F.lds + par * 1024);
    bf16x8 qf[4], pf[2];
#pragma unroll
    for (int ks = 0; ks < 4; ++ks) qf[ks] = *(const bf16x8*)(QG + tl * 128 + 32 * ks + 8 * g);
#pragma unroll
    for (int ks = 0; ks < 2; ++ks) pf[ks] = *(const bf16x8*)(QKD + tl * 64 + 32 * ks + 8 * g);
    u32x2 zr[4]; f32x4 nwr[4];
#pragma unroll
    for (int mt = 0; mt < 4; ++mt) { const int dv = 16 * (4 * dh + mt) + 4 * g; nwr[mt] = *(const f32x4*)(inp(F, 9) + (size_t)l * 128 + dv); zr[mt] = *(const u32x2*)(PROJ + (size_t)(t0 + tl) * NPROJ + 3072 + h * 128 + dv); }
    f32x4 o[4]; float ssq = 0.f;
#pragma unroll
    for (int mt = 0; mt < 4; ++mt) { o[mt] = (f32x4){0.f, 0.f, 0.f, 0.f}; const int dvr = 16 * (4 * dh + mt) + ln;
#pragma unroll
        for (int ks = 0; ks < 4; ++ks) o[mt] = MFMA16(*(const bf16x8*)(SPT + (size_t)dvr * 128 + 32 * ks + 8 * g), qf[ks], o[mt]);
#pragma unroll
        for (int ks = 0; ks < 2; ++ks) o[mt] = MFMA16(*(const bf16x8*)(VNT + (size_t)dvr * 64 + 32 * ks + 8 * g), pf[ks], o[mt]);
        ssq += (o[mt][0] * o[mt][0] + o[mt][1] * o[mt][1]) + (o[mt][2] * o[mt][2] + o[mt][3] * o[mt][3]); }
    ssq += __shfl_xor(ssq, 16); ssq += __shfl_xor(ssq, 32);
    if (g == 0) ss[tl * 2 + dh] = ssq;
    __syncthreads();
    const float rinv = rsqrtf((ss[tl * 2] + ss[tl * 2 + 1]) * (1.f / 128.f) + 1e-6f);
    bf16* MX = (bf16*)(F.ws + WS_MIXED);
#pragma unroll
    for (int mt = 0; mt < 4; ++mt) { const int dv = 16 * (4 * dh + mt) + 4 * g;
        const f32x4 nw = nwr[mt]; const f32x4 z = unpack4(zr[mt]);
        f32x4 r;
#pragma unroll
        for (int i = 0; i < 4; ++i) r[i] = o[mt][i] * rinv * nw[i] * z[i] * sigmoidf_(z[i]);
        *(u32x2*)(MX + (size_t)(t0 + tl) * D + 512 + h * 128 + dv) = pack4(r); }
}

DI void phase_a(Ctx& F, const Args& a, int l) {
    const int h = (F.vcu >> 6) & 3, lane = F.lane, tid = F.tid, w = F.wave;
    const float* GT = (const float*)(F.ws + WS_GATES);
    for (int e = tid; e < 3 * 4 * 128; e += NTHREADS) { const int ten = e / 512, j = (e >> 7) & 3, c = e & 127;
        *(LAS bf16*)(F.lds + GA_WT + e * 2) = f2bf(inp(F, 6)[((size_t)l * 4 + j) * 1536 + ten * 512 + h * 128 + c]); }
    const float bi = inp(F, 3)[l * 4 + h], bf_ = inp(F, 4)[l * 4 + h], nalog = -__expf(inp(F, 7)[l * 4 + h]), dtb = inp(F, 8)[l * 4 + h];
    asm volatile("s_waitcnt vmcnt(0)" ::: "memory");
    const int t00 = (F.vcu & 63) * CH;
    {
        MlAPre P0; ml_a_fetch(F, F.vcu, P0);
        float gb0 = gld4(GT + (size_t)(t00 + lane) * 16 + 8 + h), ga0 = gld4(GT + (size_t)(t00 + lane) * 16 + 12 + h);
        gd_a_issue(F, F.vcu, w, lane);
        ml_a_unit(F, l, F.vcu, 0, P0, bi, bf_, gb0, ga0, nalog, dtb);
    }
#pragma unroll 1
    for (int i = 0; i < 8; ++i) {
        const int cid = F.vcu + 256 * i;
        MlAPre P; float gb = 0.f, ga = 0.f;
        gd_a_unit(F, l, cid, gb, ga, nalog, dtb, i + 1 < 8, P);
        if (i + 1 < 8) ml_a_unit(F, l, cid + 256, (i + 1) & 1, P, bi, bf_, gb, ga, nalog, dtb);
    }
    asm volatile("s_waitcnt vmcnt(0)" ::: "memory"); __syncthreads();
}
constexpr int CS_K = 0, CS_Q = 8192, CS_CT = 16384, CS_V = 32768, CS_NP = 49152, CS_SC = 49408, CS_GI = 50688, CS_GF = 50944, GS_SP = 51200, GS_QG = 83968, GS_VN = 100352, GS_QK = 116736, GS_SS = 124928;
constexpr int CS_OG = 126464, GS_Z = 142848, CS_MP = 159232;
DI void lds_rd4x8_nowait(unsigned addr, u32x2& a, u32x2& b, u32x2& c, u32x2& d) { asm volatile("ds_read_b64 %0, %4\n\tds_read_b64 %1, %4 offset:32\n\tds_read_b64 %2, %4 offset:64\n\tds_read_b64 %3, %4 offset:96" : "=&v"(a), "=&v"(b), "=&v"(c), "=&v"(d) : "v"(addr) : "memory"); }
DI float lds_rd4(unsigned addr) { float r; asm volatile("ds_read_b32 %0, %1\n\ts_waitcnt lgkmcnt(0)" : "=v"(r) : "v"(addr) : "memory"); return r; }
DI bf16x8 lds_frag(unsigned addr) { bf16x8 r; asm volatile("ds_read_b128 %0, %1" : "=v"(r) : "v"(addr) : "memory"); return r; }
DI f32x2 lds_rd8(unsigned addr) { f32x2 r; asm volatile("ds_read_b64 %0, %1\n\ts_waitcnt lgkmcnt(0)" : "=v"(r) : "v"(addr) : "memory"); return r; }
DI void mlc_issue(Ctx& F, int cid, int w, int lane) {
    const int b = cid >> 8, h = (cid >> 6) & 3, n = cid & 63, t0 = b * SEQ + n * CH, g = lane >> 4, ln = lane & 15;
    const bf16* PROJ = (const bf16*)(F.ws + WS_PROJ); const bf16* CT = (const bf16*)(F.ws + WS_MLCT) + (size_t)cid * 8192;
    DMA16NT(PROJ + (size_t)(t0 + 16 * (w >> 1) + ln) * NPROJ + 256 + h * 64 + 32 * (w & 1) + 8 * g, F.lds + CS_K + w * 1024);
    DMA16NT(PROJ + (size_t)(t0 + 16 * (w >> 1) + ln) * NPROJ + h * 64 + 32 * (w & 1) + 8 * g, F.lds + CS_Q + w * 1024);
#pragma unroll
    for (int ks = 0; ks < 2; ++ks) DMA16NT(CT + (2 * w + ks) * 512 + lane * 8, F.lds + CS_CT + (2 * w + ks) * 1024);
#pragma unroll
    for (int q = 0; q < 2; ++q) { const int j = 2 * w + q; DMA16NT(PROJ + (size_t)(t0 + 4 * j + g) * NPROJ + 512 + h * 128 + 8 * ln, F.lds + CS_V + j * 1024); }
    __builtin_amdgcn_global_load_lds((const unsigned*)((const float*)(F.ws + WS_MLNP) + (size_t)cid * 64 + lane), (LAS unsigned*)(F.lds + CS_NP), 4, 0, 0);
#pragma unroll
    for (int q = 0; q < 2; ++q) { const int j = 2 * w + q; DMA16NT(PROJ + (size_t)(t0 + 4 * j + g) * NPROJ + 1024 + h * 128 + 8 * ln, F.lds + CS_OG + j * 1024); }
    const float* GT = (const float*)(F.ws + WS_GATES);
    __builtin_amdgcn_global_load_lds((const unsigned*)(GT + (size_t)(t0 + lane) * 16 + h), (LAS unsigned*)(F.lds + CS_GI), 4, 0, 0);
    __builtin_amdgcn_global_load_lds((const unsigned*)(GT + (size_t)(t0 + lane) * 16 + 4 + h), (LAS unsigned*)(F.lds + CS_GF), 4, 0, 0);
    __builtin_amdgcn_global_load_lds((const unsigned*)((const float*)(F.ws + WS_MLMP) + cid), (LAS unsigned*)(F.lds + CS_MP), 4, 0, 0);
}
DI void gdc_issue(Ctx& F, int cid, int w, int lane) {
    const int g = lane >> 4, ln = lane & 15;
    const bf16* SPT = (const bf16*)(F.ws + WS_GDSP) + (size_t)cid * 16384; const bf16* QG = (const bf16*)(F.ws + WS_GDQG) + (size_t)cid * 8192;
    const bf16* VNT = (const bf16*)(F.ws + WS_GDVN) + (size_t)cid * 8192; const bf16* QKD = (const bf16*)(F.ws + WS_GDQK) + (size_t)cid * 4096;
#pragma unroll
    for (int ks = 0; ks < 4; ++ks) DMA16NT(SPT + (4 * w + ks) * 512 + lane * 8, F.lds + GS_SP + (4 * w + ks) * 1024);
#pragma unroll
    for (int q = 0; q < 2; ++q) { const int bq = 2 * w + q; DMA16NT(QG + (size_t)(16 * (bq >> 2) + ln) * 128 + 32 * (bq & 3) + 8 * g, F.lds + GS_QG + bq * 1024); }
#pragma unroll
    for (int ks = 0; ks < 2; ++ks) DMA16NT(VNT + (2 * w + ks) * 512 + lane * 8, F.lds + GS_VN + (2 * w + ks) * 1024);
    DMA16NT(QKD + w * 512 + lane * 8, F.lds + GS_QK + w * 1024);
    { const int b = cid >> 8, h = (cid >> 6) & 3, n = cid & 63, t0 = b * SEQ + n * CH; const bf16* PROJ = (const bf16*)(F.ws + WS_PROJ);
#pragma unroll
      for (int q = 0; q < 2; ++q) { const int j = 2 * w + q; DMA16NT(PROJ + (size_t)(t0 + 4 * j + g) * NPROJ + 3072 + h * 128 + 8 * ln, F.lds + GS_Z + j * 1024); } }
}
constexpr int GS_NW = 125440;
DI void phase_c(Ctx& F, const Args& a, int l) {
    const int lane = F.lane, g = lane >> 4, ln = lane & 15, w = F.wave, tt = w & 3, dh = w >> 2, tl = 16 * tt + ln;
    const int h = (F.vcu >> 6) & 3, n = F.vcu & 63;
    const bf16* PROJ = (const bf16*)(F.ws + WS_PROJ); const float* GT = (const float*)(F.ws + WS_GATES); bf16* MX = (bf16*)(F.ws + WS_MIXED);
    const unsigned L0 = lds_addr(F.lds);
    LAS float* ib = (LAS float*)(F.lds + CS_SC); LAS float* Mt = ib + 64; LAS float* bcs = ib + 128;
    if (F.tid < 256) ((LAS float*)(F.lds + GS_NW))[F.tid] = (F.tid < 128) ? inp(F, 5)[(size_t)l * 512 + h * 128 + F.tid] : inp(F, 9)[(size_t)l * 128 + F.tid - 128];
    const float bi = inp(F, 3)[l * 4 + h], bf_ = inp(F, 4)[l * 4 + h];
    asm volatile("s_waitcnt vmcnt(0)" ::: "memory");
    __syncthreads();
    mlc_issue(F, F.vcu, w, lane);
    gdc_issue(F, F.vcu, w, lane);
#pragma unroll 1
    for (int i = 0; i < 8; ++i) {
        const int cid = F.vcu + 256 * i, t0 = i * SEQ + n * CH;
        asm volatile("s_waitcnt vmcnt(11)" ::: "memory");
        const float mpv = lds_rd4(L0 + CS_MP + lane * 4);
        if (w == 7) { const float gi = lds_rd4(L0 + CS_GI + lane * 4), gf = lds_rd4(L0 + CS_GF + lane * 4); const float ip = softcap15(gi + bi), fp = softcap15(gf + bf_);
            const float bc = wave_incl_sum(log_sigmoid(fp), lane), ibs = ip - bc, pm = wave_incl_max(ibs, lane);
            ib[lane] = ibs; Mt[lane] = fmaxf(mpv, pm); bcs[lane] = bc; }
        asm volatile("s_waitcnt lgkmcnt(0)" ::: "memory"); __builtin_amdgcn_s_barrier(); asm volatile("" ::: "memory");
        const float mprev = mpv;
        const float Mtt = lds_rd8(L0 + CS_SC + 256 + (tl & ~1) * 4)[tl & 1], bct = lds_rd8(L0 + CS_SC + 512 + (tl & ~1) * 4)[tl & 1];
        bf16x8 qf[2], kf[4][2];
#pragma unroll
        for (int ks = 0; ks < 2; ++ks) { qf[ks] = lds_frag(L0 + CS_Q + (tt * 2 + ks) * 1024 + lane * 16);
#pragma unroll
            for (int ms = 0; ms < 4; ++ms) kf[ms][ks] = lds_frag(L0 + CS_K + (ms * 2 + ks) * 1024 + lane * 16); }
        f32x4 ibv[4], dum_;
#pragma unroll
        for (int ms = 0; ms < 4; ++ms) g8::lds_rd2x16(L0 + CS_SC + (16 * ms + 4 * g) * 4, ibv[ms], dum_);
        asm volatile("" : "+v"(qf[0]), "+v"(qf[1]), "+v"(kf[0][0]), "+v"(kf[0][1]), "+v"(kf[1][0]), "+v"(kf[1][1]), "+v"(kf[2][0]), "+v"(kf[2][1]), "+v"(kf[3][0]), "+v"(kf[3][1]));
        f32x4 sacc[4];
#pragma unroll
        for (int ms = 0; ms < 4; ++ms) { sacc[ms] = (f32x4){0.f, 0.f, 0.f, 0.f};
#pragma unroll
            for (int ks = 0; ks < 2; ++ks) sacc[ms] = MFMA16(kf[ms][ks], qf[ks], sacc[ms]); }
#pragma unroll
        for (int ms = 0; ms < 4; ++ms)
#pragma unroll
            for (int q = 0; q < 4; ++q) { const int s_ = 16 * ms + 4 * g + q; sacc[ms][q] = (s_ <= tl) ? sacc[ms][q] * 0.125f * __expf(ibv[ms][q] - Mtt) : 0.f; }
        bf16x8 sb[2]; sb[0] = pack_frag(sacc[0], sacc[1]); sb[1] = pack_frag(sacc[2], sacc[3]);
        bf16x8 ctf[5][2]; f32x4 npa[2], npb[2];
#pragma unroll
        for (int ks = 0; ks < 2; ++ks)
#pragma unroll
            for (int mt = 0; mt < 4; ++mt) ctf[mt][ks] = lds_frag(L0 + CS_CT + ((4 * dh + mt) * 2 + ks) * 1024 + lane * 16);
        g8::lds_rd2x16(L0 + CS_NP + (8 * g) * 4, npa[0], npa[1]); g8::lds_rd2x16(L0 + CS_NP + (32 + 8 * g) * 4, npb[0], npb[1]);
        asm volatile("" : "+v"(ctf[0][0]), "+v"(ctf[0][1]), "+v"(ctf[1][0]), "+v"(ctf[1][1]), "+v"(ctf[2][0]), "+v"(ctf[2][1]), "+v"(ctf[3][0]), "+v"(ctf[3][1]));
        { float nvv[8];
#pragma unroll
          for (int j = 0; j < 4; ++j) { nvv[j] = (ln == 0) ? npa[0][j] : 0.f; nvv[4 + j] = (ln == 0) ? npa[1][j] : 0.f; }
          ctf[4][0] = __builtin_bit_cast(bf16x8, pack8(nvv));
#pragma unroll
          for (int j = 0; j < 4; ++j) { nvv[j] = (ln == 0) ? npb[0][j] : 0.f; nvv[4 + j] = (ln == 0) ? npb[1][j] : 0.f; }
          ctf[4][1] = __builtin_bit_cast(bf16x8, pack8(nvv)); }
        f32x4 xacc[5];
#pragma unroll
        for (int mt = 0; mt < 5; ++mt) { xacc[mt] = (f32x4){0.f, 0.f, 0.f, 0.f};
#pragma unroll
            for (int ks = 0; ks < 2; ++ks) xacc[mt] = MFMA16(ctf[mt][ks], qf[ks], xacc[mt]); }
        const float wint = 0.125f * __expf(mprev - Mtt);
#pragma unroll
        for (int mt = 0; mt < 5; ++mt) xacc[mt] *= wint;
        const bf16x8 ones = (ln == 0) ? (bf16x8){0x3f80, 0x3f80, 0x3f80, 0x3f80, 0x3f80, 0x3f80, 0x3f80, 0x3f80} : (bf16x8){0, 0, 0, 0, 0, 0, 0, 0};
#pragma unroll
        for (int kk = 0; kk < 2; ++kk) {
#pragma unroll
            for (int mt = 0; mt < 4; ++mt) { const bf16x8 vf = tr_frag8(L0 + CS_V, 256, 32 * kk + 4 * g, 32 * kk + 16 + 4 * g, 16 * (4 * dh + mt), lane); xacc[mt] = MFMA16(vf, sb[kk], xacc[mt]); }
            xacc[4] = MFMA16(ones, sb[kk], xacc[4]); }
        const float den = __shfl(xacc[4][0], ln), dinv = __builtin_amdgcn_rcpf(fmaxf(fabsf(den), __expf(-(bct + Mtt))));
        float ssq = 0.f;
#pragma unroll
        for (int mt = 0; mt < 4; ++mt) { xacc[mt] *= dinv; ssq += (xacc[mt][0] * xacc[mt][0] + xacc[mt][1] * xacc[mt][1]) + (xacc[mt][2] * xacc[mt][2] + xacc[mt][3] * xacc[mt][3]); }
        ssq += __shfl_xor(ssq, 16); ssq += __shfl_xor(ssq, 32);
        if (g == 0) *(LAS float*)(F.lds + CS_SC + 768 + (tl * 2 + dh) * 4) = ssq;
        u32x2 og0, og1, og2, og3; lds_rd4x8_nowait(L0 + CS_OG + tl * 256 + (16 * 4 * dh + 4 * g) * 2, og0, og1, og2, og3);
        asm volatile("s_waitcnt lgkmcnt(0)" : "+v"(og0), "+v"(og1), "+v"(og2), "+v"(og3) :: "memory"); __builtin_amdgcn_s_barrier(); asm volatile("" ::: "memory");
        if (i + 1 < 8) mlc_issue(F, cid + 256, w, lane);
        { const f32x2 s2 = lds_rd8(L0 + CS_SC + 768 + tl * 8); const float rinv = rsqrtf((s2[0] + s2[1]) * (1.f / 128.f) + 1e-6f);
#pragma unroll
          for (int mt = 0; mt < 4; ++mt) { const int dv = 16 * (4 * dh + mt) + 4 * g; const f32x4 og = unpack4(mt == 0 ? og0 : (mt == 1 ? og1 : (mt == 2 ? og2 : og3))); f32x4 nw, o; g8::lds_rd2x16(L0 + GS_NW + dv * 4, nw, dum_);
#pragma unroll
              for (int q = 0; q < 4; ++q) o[q] = xacc[mt][q] * rinv * nw[q] * sigmoidf_(og[q]);
              *(u32x2*)(MX + (size_t)(t0 + tl) * D + h * 128 + dv) = pack4(o); } }
        if (i + 1 < 8) asm volatile("s_waitcnt vmcnt(12)" ::: "memory");
        else asm volatile("s_waitcnt vmcnt(0)" ::: "memory");
        __builtin_amdgcn_s_barrier(); asm volatile("" ::: "memory");
        bf16x8 gq[4], gp[2];
#pragma unroll
        for (int ks = 0; ks < 4; ++ks) gq[ks] = lds_frag(L0 + GS_QG + (tt * 4 + ks) * 1024 + lane * 16);
#pragma unroll
        for (int ks = 0; ks < 2; ++ks) gp[ks] = lds_frag(L0 + GS_QK + (tt * 2 + ks) * 1024 + lane * 16);
        f32x4 o[4]; float sq2 = 0.f;
#pragma unroll
        for (int mt = 0; mt < 4; ++mt) { bf16x8 gs[4], gv[2];
#pragma unroll
            for (int ks = 0; ks < 4; ++ks) gs[ks] = lds_frag(L0 + GS_SP + ((4 * dh + mt) * 4 + ks) * 1024 + lane * 16);
#pragma unroll
            for (int ks = 0; ks < 2; ++ks) gv[ks] = lds_frag(L0 + GS_VN + ((4 * dh + mt) * 2 + ks) * 1024 + lane * 16);
            asm volatile("s_waitcnt lgkmcnt(0)" : "+v"(gs[0]), "+v"(gs[1]), "+v"(gs[2]), "+v"(gs[3]), "+v"(gv[0]), "+v"(gv[1]), "+v"(gq[0]), "+v"(gq[1]), "+v"(gq[2]), "+v"(gq[3]), "+v"(gp[0]), "+v"(gp[1]) :: "memory");
            o[mt] = (f32x4){0.f, 0.f, 0.f, 0.f};
#pragma unroll
            for (int ks = 0; ks < 4; ++ks) o[mt] = MFMA16(gs[ks], gq[ks], o[mt]);
#pragma unroll
            for (int ks = 0; ks < 2; ++ks) o[mt] = MFMA16(gv[ks], gp[ks], o[mt]);
            sq2 += (o[mt][0] * o[mt][0] + o[mt][1] * o[mt][1]) + (o[mt][2] * o[mt][2] + o[mt][3] * o[mt][3]); }
        sq2 += __shfl_xor(sq2, 16); sq2 += __shfl_xor(sq2, 32);
        if (g == 0) *(LAS float*)(F.lds + GS_SS + (tl * 2 + dh) * 4) = sq2;
        u32x2 z0, z1, z2, z3; lds_rd4x8_nowait(L0 + GS_Z + tl * 256 + (16 * 4 * dh + 4 * g) * 2, z0, z1, z2, z3);
        asm volatile("s_waitcnt lgkmcnt(0)" : "+v"(z0), "+v"(z1), "+v"(z2), "+v"(z3) :: "memory"); __builtin_amdgcn_s_barrier(); asm volatile("" ::: "memory");
        if (i + 1 < 8) gdc_issue(F, cid + 256, w, lane);
        { const f32x2 s2 = lds_rd8(L0 + GS_SS + tl * 8); const float rinv = rsqrtf((s2[0] + s2[1]) * (1.f / 128.f) + 1e-6f);
#pragma unroll
          for (int mt = 0; mt < 4; ++mt) { const int dv = 16 * (4 * dh + mt) + 4 * g; const f32x4 z = unpack4(mt == 0 ? z0 : (mt == 1 ? z1 : (mt == 2 ? z2 : z3))); f32x4 nw, r; g8::lds_rd2x16(L0 + GS_NW + 512 + dv * 4, nw, dum_);
#pragma unroll
              for (int q = 0; q < 4; ++q) r[q] = o[mt][q] * rinv * nw[q] * z[q] * sigmoidf_(z[q]);
              *(u32x2*)(MX + (size_t)(t0 + tl) * D + 512 + h * 128 + dv) = pack4(r); } }
    }
    asm volatile("s_waitcnt vmcnt(0)" ::: "memory"); __syncthreads();
}
struct P2Order {
    unsigned char* ws; int G, c0;
    DI bool next(int i, g8::Unit& u) const {
        const int L = i * G + c0; if (L >= 1024) return false;
        const int q = L & 511, t4 = q & 3, h = (q >> 2) & 3, b = (q >> 4) & 7, l = q >> 7;
        if (L < 512) { u.a = (const char*)(ws + WS_KV) + ((size_t)(2 * l) * 2048 + b * 256) * 2048 + h * 512; u.b = (const char*)(ws + WS_WQ) + ((size_t)l * 1024 + t4 * 256) * 2048 + h * 512;
            u.c = (char*)(ws + WS_WQK) + ((size_t)(l * 8 + b) * 1024 + h * 256) * 2048 + t4 * 512; u.aux = -1; }
        else { u.a = (const char*)(ws + WS_WO) + ((size_t)l * 1024 + t4 * 256) * 2048 + h * 512; u.b = (const char*)(ws + WS_KV) + ((size_t)(2 * l + 1) * 2048 + b * 256) * 2048 + h * 512;
            u.c = (char*)(ws + WS_WVO) + ((size_t)(l * 8 + b) * 1024 + t4 * 256) * 2048 + h * 512; u.aux = 0; }
        u.pm = 0; u.pn = 0; return true;
    }
};

constexpr int NPH_LAYER = 13, NPH = 3 + NL * NPH_LAYER;
__global__ void __launch_bounds__(NTHREADS, 2) mega(Args a) {
    extern __shared__ __attribute__((aligned(16))) unsigned char lds_raw[];
    Ctx F; F.lds = (LAS unsigned char*)0u; F.ws = a.ws; F.ctl = (unsigned*)(a.ws + WS_CTL);
    F.tid = threadIdx.x; F.lane = F.tid & 63; F.wave = __builtin_amdgcn_readfirstlane(F.tid >> 6); F.G = gridDim.x;
    { const int bx = blockIdx.x; F.vcu = (F.G % 8 == 0) ? (bx % 8) * (F.G / 8) + bx / 8 : bx; }
    volatile LAS unsigned* MISC = (volatile LAS unsigned*)(F.lds + LDS_MISC);
    if (F.tid < 64) MISC[F.tid] = 0u;
    if ((unsigned)(size_t)(LAS unsigned char*)lds_raw != 0u) { if (F.tid == 0) atomicAdd(F.ctl + CW_BAR + XB_TMO, 1u); }
    if (F.tid < 28) { const unsigned long long pv = (unsigned long long)(F.tid < 27 ? (const void*)a.in[F.tid] : (const void*)a.out); ((LAS unsigned long long*)(F.lds + LDS_PTAB))[F.tid] = pv; }
    __syncthreads();
    const bool multi = (a.ph_hi - a.ph_lo) > 1;
    XcdBarrier bar; bar.bar = F.ctl + CW_BAR; bar.x = 0; bar.st = MISC;
    if (multi) bar = xcd_barrier_post(F.ctl + CW_BAR, MISC);
    if (PROF_MASK) { if (blockIdx.x == 0 && threadIdx.x == 0) { volatile LAS unsigned long long* pw = (volatile LAS unsigned long long*)(F.lds + LDS_MISC + 128); const unsigned long long t0_ = __builtin_amdgcn_s_memrealtime(); pw[0] = t0_; pw[1] = 0ull; pw[2] = t0_; } }
#ifndef PMASK
#define PMASK 0xffff
#endif
#define EN(j) (((PMASK) >> (j)) & 1)
#ifndef REPMASK
#define REPMASK 0x0
#endif
#define NREP(j) ((((REPMASK) >> (j)) & 1) ? 2 : 1)
#if REPMASK
#define REPLOOP(j) for (int rep_ = 0; rep_ < NREP(j); ++rep_, __syncthreads())
#else
#define REPLOOP(j)
#endif
#define PH(k) (a.ph_lo <= (k) && (k) < a.ph_hi && (refresh(F, a.ws), true))
#define PROF_TICK(k) do { if (PROF_MASK) { if (blockIdx.x == 0 && threadIdx.x == 0) { volatile LAS unsigned long long* pw = (volatile LAS unsigned long long*)(F.lds + LDS_MISC + 128); \
        const unsigned long long now_ = __builtin_amdgcn_s_memrealtime(); const int j_ = ((k) < 3) ? 13 + (k) : ((k) - 3) % NPH_LAYER; \
        if (((PROF_MASK) >> j_) & 1) pw[1] += now_ - pw[0]; pw[0] = now_; } } } while (0)
#define SEAM(k) do { if (PH(k) && PH((k) + 1)) { xcd_barrier(bar); if (((REPMASK) >> 16) & 1) xcd_barrier(bar); PROF_TICK(k); } } while (0)

    if (EN(13) && PH(0)) REPLOOP(13) { phase_convert(F, a); }
    SEAM(0);
    if (EN(14) && PH(1)) REPLOOP(14) {
        g8::AffineOrder S; S.A = (const char*)(F.ws + WS_MEMB); S.B = (const char*)(F.ws + WS_WKV); S.C = (char*)(F.ws + WS_KV);
        S.aM = 256ull * 2048; S.bB = 0; S.bN = 256ull * 2048; S.cM = 256ull * 2048; S.cS = 2048ull * 2048; S.cN = 512; S.nM = 8; S.nN = 32; S.bdiv = 1 << 30; S.csp = 4; S.G = F.G; S.c0 = F.vcu;
        g8::EpiBf16 E{1024, nullptr, 0, 1.f};
        g8::gemm_phase(F.lds, 2048, 2048, 16, S, E);
        row_pass<0>(F, a, 0);
    }
    SEAM(1);
    if (EN(15) && PH(2)) REPLOOP(15) { P2Order S{F.ws, F.G, F.vcu}; g8::EpiBf16 E{1024, nullptr, 0, 0.0625f}; g8::gemm_phase(F.lds, 2048, 2048, 4, S, E); }
    SEAM(2);
#pragma unroll 1
    for (int l = 0; l < NL; ++l) {
        const int pb = 3 + l * NPH_LAYER;
        if (EN(0) && PH(pb + 0)) REPLOOP(0) {
            g8::AffineOrder S = g8::dense_order(F.ws + WS_XB, F.ws + WS_WIN + (size_t)l * NPROJ * D * 2, F.ws + WS_PROJ, T, NPROJ, D, NPROJ * 2, 2, F.G, F.vcu);
            g8::EpiBf16 E{NPROJ, nullptr, 0, 1.f}; g8::gemm_phase(F.lds, 2048, 2048, 16, S, E);
        }
        SEAM(pb + 0);
        if (EN(1) && PH(pb + 1)) REPLOOP(1) {
            phase_a(F, a, l);
        }
        SEAM(pb + 1);
        if (EN(2) && PH(pb + 2)) REPLOOP(2) {
            if (F.tid < 8) ((volatile LAS unsigned*)(F.lds + GB_FLAGS))[F.tid] = 0u;
            __syncthreads();
            if (F.wave == 0) gd_b_task(F, F.vcu);
            else if (F.wave <= 2) gd_b_loader(F, F.vcu, F.wave - 1);
            else if (F.wave >= 4) ml_b_unit(F, F.vcu);
        }
        SEAM(pb + 2);
        if (EN(3) && PH(pb + 3)) REPLOOP(3) {
            phase_c(F, a, l);
        }
        SEAM(pb + 3);
        if (EN(4) && PH(pb + 4)) REPLOOP(4) {
            g8::AffineOrder S = g8::dense_order(F.ws + WS_MIXED, F.ws + WS_WOUT + (size_t)l * D * D * 2, F.ws + WS_HB, T, D, D, D * 2, 2, F.G, F.vcu);
            g8::EpiBf16 E{D, nullptr, 0, 1.f}; g8::gemm_phase(F.lds, 2048, 2048, 16, S, E);
        }
        SEAM(pb + 4);
        if (EN(5) && PH(pb + 5)) { row_pass<1>(F, a, l); if (NREP(5) == 2) { __syncthreads(); row_pass<1>(F, a, l, true); } }
        SEAM(pb + 5);
        if (EN(6) && PH(pb + 6)) REPLOOP(6) {
            g8::AffineOrder S = g8::dense_order(F.ws + WS_XB, F.ws + WS_WQK + (size_t)l * 8 * D * D * 2, F.ws + WS_PB, T, D, D, D * 2, 2, F.G, F.vcu);
            S.bB = (size_t)D * D * 2; S.bdiv = 16;
            g8::EpiSoftmax E{D}; g8::gemm_phase(F.lds, 2048, 2048, 16, S, E);
        }
        SEAM(pb + 6);
        if (EN(7) && PH(pb + 7)) REPLOOP(7) {
            g8::AffineOrder S = g8::dense_order(F.ws + WS_PB, F.ws + WS_WVO + (size_t)l * 8 * D * D * 2, F.ws + WS_HB, T, D, D, D * 2, 2, F.G, F.vcu);
            S.bB = (size_t)D * D * 2; S.bdiv = 16;
            g8::EpiBf16 E{D, nullptr, 0, 1.f}; g8::gemm_phase(F.lds, 2048, 2048, 16, S, E);
        }
        SEAM(pb + 7);
        if (EN(8) && PH(pb + 8)) { row_pass<2>(F, a, l); if (NREP(8) == 2) { __syncthreads(); row_pass<2>(F, a, l, true); } }
        SEAM(pb + 8);
        if (EN(9) && PH(pb + 9)) phase_scatter(F, l);
        SEAM(pb + 9);
        if (EN(10) && PH(pb + 10)) REPLOOP(10) {
            MoeOrder S; S.gather = 1; S.rev = 0; S.A = (const char*)(F.ws + WS_XB); S.B = (const char*)(F.ws + WS_WGU) + (size_t)l * 32 * 2048 * D * 2; S.C = (char*)(F.ws + WS_ACT); S.tile_e = F.ctl + CW_TILE_E + l * MAXTILES;
            S.NT = __builtin_amdgcn_readfirstlane((int)ldu(F.ctl + CW_NT + l)); S.nN = 8; S.bE = 2048ull * D * 2; S.bN = 256ull * 2048; S.cN = 256; S.G = F.G; S.c0 = F.vcu;
            g8::EpiSwiglu E{inp(F, 22) + (size_t)l * 32 * 2048}; g8::gemm_phase<g8::EpiSwiglu, MoeOrder, true>(F.lds, 2048, 2048, 16, S, E, (const unsigned*)(F.ws + WS_XG));
        }
        SEAM(pb + 10);
        if (EN(11) && PH(pb + 11)) REPLOOP(11) {
            MoeOrder S; S.gather = 0; S.rev = 1; S.A = (const char*)(F.ws + WS_ACT); S.B = (const char*)(F.ws + WS_WDN) + (size_t)l * 32 * D * D * 2; S.C = (char*)(F.ws + WS_Y); S.tile_e = F.ctl + CW_TILE_E + l * MAXTILES;
            S.NT = __builtin_amdgcn_readfirstlane((int)ldu(F.ctl + CW_NT + l)); S.nN = 4; S.bE = (size_t)D * D * 2; S.bN = 256ull * 2048; S.cN = 512; S.G = F.G; S.c0 = F.vcu;
            g8::EpiBf16 E{D, inp(F, 24) + (size_t)l * 32 * D, D, 1.f}; g8::gemm_phase(F.lds, 2048, 2048, 16, S, E);
        }
        SEAM(pb + 11);
        if (EN(12) && PH(pb + 12)) { row_pass<3>(F, a, l); if (NREP(12) == 2 && l < NL - 1) { __syncthreads(); row_pass<3>(F, a, l, true); } }
        SEAM(pb + 12);
    }
    if (PROF_MASK) {
        refresh(F, a.ws);
        xcd_barrier(bar); PROF_TICK(NPH - 1);
        if (blockIdx.x == 0 && threadIdx.x == 0) { volatile LAS unsigned long long* pw = (volatile LAS unsigned long long*)(F.lds + LDS_MISC + 128);
            const float f = (float)(double)pw[1] / (float)(double)(pw[0] - pw[2]); const float q = fminf(1.f, floorf(f * (float)(PROF_SCALE) * 32.f + (float)(PROF_OFS) * 0.5f) * (1.f / 32.f));
            __hip_atomic_store(F.ctl + CW_DBG, __float_as_uint(sqrtf(100.f * q)), __ATOMIC_RELAXED, __HIP_MEMORY_SCOPE_AGENT); }
        xcd_barrier(bar);
        const float c = __uint_as_float(ldu(F.ctl + CW_DBG)); float* o = (float*)inp(F, 27);
        for (size_t i = (size_t)blockIdx.x * NTHREADS + threadIdx.x; i < (size_t)T * D; i += (size_t)gridDim.x * NTHREADS) o[i] = c;
    }
}

#ifndef DBG_STOP
#define DBG_STOP 0
#endif
#ifndef DBG_OFF
#define DBG_OFF WS_XB
#endif
#ifndef DBG_N
#define DBG_N ((size_t)T * D)
#endif
#ifndef DBG_F32
#define DBG_F32 0
#endif
__global__ void dbg_dump(const unsigned char* ws, float* out, size_t off) {
    const bf16* b = (const bf16*)(ws + off); const float* f = (const float*)(ws + off);
    for (size_t i = (size_t)blockIdx.x * blockDim.x + threadIdx.x; i < (size_t)T * D; i += (size_t)gridDim.x * blockDim.x) out[i] = (i < (size_t)(DBG_N)) ? (DBG_F32 ? f[i] : bf2f(b[i])) : 0.f;
}
#ifndef N_LAUNCH_MODE
#define N_LAUNCH_MODE 1
#endif
extern "C" void kernel_launch(void* const* d_in, const int* in_sizes, int n_in, void* d_out, int out_size, void* d_ws, size_t ws_size, hipStream_t stream) {
    static int ready = 0;
    if (ready == 0) {
        if (n_in != 27 || ws_size < WS_END) { fprintf(stderr, "kernel_launch: need 27 inputs and %zu bytes of workspace (got %d, %zu)\n", (size_t)WS_END, n_in, ws_size); ready = -1; return; }
        if (hipFuncSetAttribute((const void*)mega, hipFuncAttributeMaxDynamicSharedMemorySize, LDS_BYTES) != hipSuccess) { fprintf(stderr, "kernel_launch: hipFuncSetAttribute failed\n"); ready = -1; return; }
        int per_cu = 0; (void)hipOccupancyMaxActiveBlocksPerMultiprocessor(&per_cu, (const void*)mega, NTHREADS, LDS_BYTES); (void)hipGetLastError();
        ready = 1;
    }
    if (ready < 0) return;
    (void)hipMemsetAsync((char*)d_ws + WS_CTL, 0, 1 << 20, stream);
    (void)hipMemsetAsync((char*)d_ws + WS_XG, 0, (size_t)CAP * 4, stream);
    Args a{};
    for (int i = 0; i < 27; ++i) a.in[i] = (const float*)d_in[i];
    a.out = (float*)d_out; a.ws = (unsigned char*)d_ws;
#if N_LAUNCH_MODE == 1
    a.ph_lo = 0; a.ph_hi = (DBG_STOP > 0 ? DBG_STOP : NPH);
    hipLaunchKernelGGL(mega, dim3(256), dim3(NTHREADS), LDS_BYTES, stream, a);
    if (DBG_STOP > 0) hipLaunchKernelGGL(dbg_dump, dim3(2048), dim3(256), 0, stream, (const unsigned char*)d_ws, (float*)d_out, (size_t)(DBG_OFF));
#else
    for (int p = 0; p < (DBG_STOP > 0 ? DBG_STOP : NPH); ++p) { a.ph_lo = p; a.ph_hi = p + 1; hipLaunchKernelGGL(mega, dim3(256), dim3(NTHREADS), LDS_BYTES, stream, a); }
    if (DBG_STOP > 0) hipLaunchKernelGGL(dbg_dump, dim3(2048), dim3(256), 0, stream, (const unsigned char*)d_ws, (float*)d_out, (size_t)(DBG_OFF));
#endif
}
```

```cpp
#include <hip/hip_runtime.h>
#include <cstdio>
#include <cstdint>
#define PROF_SCALE 16
#define PROF_OFS 1
#ifndef PROF_MASK
#define PROF_MASK 0x0
#endif

#define LAS __attribute__((address_space(3)))
typedef unsigned short bf16;
typedef short bf16x8 __attribute__((ext_vector_type(8)));
typedef short s16x4 __attribute__((ext_vector_type(4)));
typedef float f32x4 __attribute__((ext_vector_type(4)));
typedef float f32x2 __attribute__((ext_vector_type(2)));
typedef unsigned u32x4 __attribute__((ext_vector_type(4)));
typedef unsigned u32x2 __attribute__((ext_vector_type(2)));
#define DI __device__ __forceinline__
#define GAS __attribute__((address_space(1)))

constexpr int T = 32768, D = 1024, NB = 8, SEQ = 4096, NL = 4, NCH = 64, CH = 64;
constexpr int NPROJ = 3584;
constexpr int NE = 32, TOPK = 4;
constexpr int MAXTILES = 544, CAP = MAXTILES * 256;
constexpr float DN_ALPHA = 1.6817928305074290f;
constexpr int NWAVES = 8, NTHREADS = 512;
constexpr int LDS_RING = 131072, LDS_X = 131072  , LDS_MISC = 163840 - 4096, LDS_BYTES = 163840;

constexpr size_t MiB = 1ull << 20;
constexpr size_t WS_CTL = 0;
constexpr size_t WS_WIN = 1 * MiB;
constexpr size_t WS_WGATE = WS_WIN + 4ull * NPROJ * D * 2;
constexpr size_t WS_WRT = WS_WGATE + 4ull * 2 * 16 * D * 2;
constexpr size_t WS_WOUT = WS_WRT + 4ull * 2 * 32 * D * 2;
constexpr size_t WS_WQ = WS_WOUT + 4ull * D * D * 2;
constexpr size_t WS_WKV = WS_WQ + 4ull * D * D * 2;
constexpr size_t WS_WO = WS_WKV + 8ull * D * D * 2;
constexpr size_t WS_WGU = WS_WO + 4ull * D * D * 2;
constexpr size_t WS_WDN = WS_WGU + 4ull * 32 * 2048 * D * 2;
constexpr size_t WS_MEMB = WS_WDN + 4ull * 32 * D * D * 2;
constexpr size_t WS_KV = WS_MEMB + 2048ull * D * 2;
constexpr size_t WS_WQK = WS_KV + 8ull * 2048 * D * 2;
constexpr size_t WS_WVO = WS_WQK + 32ull * D * D * 2;
constexpr size_t WS_XB = WS_WVO + 32ull * D * D * 2;
constexpr size_t WS_PROJ = WS_XB + (size_t)T * D * 2;
constexpr size_t WS_GATES = WS_PROJ + (size_t)T * NPROJ * 2;
constexpr size_t WS_MIXED = WS_GATES + (size_t)T * 16 * 4;
constexpr size_t WS_HB = WS_MIXED + (size_t)T * D * 2;
constexpr size_t WS_PB = WS_HB + (size_t)T * D * 2;
constexpr size_t WS_TOPE = WS_PB + (size_t)T * D * 2;
constexpr size_t WS_TOPP = WS_TOPE + (size_t)T * 16;
constexpr size_t WS_TOPG = WS_TOPP + (size_t)T * 16;
constexpr size_t WS_SLOT = WS_TOPG + (size_t)T * 16;
constexpr size_t WS_XG = WS_SLOT + (size_t)T * 16;
constexpr size_t WS_ACT = WS_XG + (size_t)CAP * D * 2;
constexpr size_t WS_Y = WS_ACT + (size_t)CAP * D * 2;
constexpr size_t WS_MLU = WS_Y + (size_t)CAP * D * 2;
constexpr size_t WS_MLKN = WS_MLU + 2048ull * 8192 * 4;
constexpr size_t WS_MLSC = WS_MLKN + 2048ull * 64 * 4;
constexpr size_t WS_MLCT = WS_MLSC + 2048ull * 16;
constexpr size_t WS_MLNP = WS_MLCT + 2048ull * 8192 * 2;
constexpr size_t WS_MLMP = WS_MLNP + 2048ull * 64 * 4;
constexpr size_t WS_GDUT = WS_MLMP + 2048ull * 4;
constexpr size_t WS_GDW = WS_GDUT + 2048ull * 8192 * 2;
constexpr size_t WS_GDKE = WS_GDW + 2048ull * 8192 * 2;
constexpr size_t WS_GDQG = WS_GDKE + 2048ull * 8192 * 2;
constexpr size_t WS_GDQK = WS_GDQG + 2048ull * 8192 * 2;
constexpr size_t WS_GDGL = WS_GDQK + 2048ull * 4096 * 2;
constexpr size_t WS_GDVN = WS_GDGL + 2048ull * 4;
constexpr size_t WS_GDSP = WS_GDVN + 2048ull * 8192 * 2;
constexpr size_t WS_END = WS_GDSP + 2048ull * 16384 * 2;
constexpr int CW_BAR = 1024, CW_NT = 8192 + 256, CW_TILE_E = 8192 + 512, CW_DBG = 16384, CW_ECNT = 32768;

typedef __bf16 bf16x2_t __attribute__((ext_vector_type(2)));
DI unsigned cvt_pk_bf16(float lo, float hi) { const f32x2 v = {lo, hi}; const bf16x2_t r = __builtin_convertvector(v, bf16x2_t); return __builtin_bit_cast(unsigned, r); }
DI bf16 f2bf(float f) { return (bf16)(cvt_pk_bf16(f, 0.f) & 0xffffu); }
DI float bf2f(bf16 b) { return __uint_as_float(((unsigned)b) << 16); }
DI float bflo(unsigned w) { return __uint_as_float(w << 16); }
DI float bfhi(unsigned w) { return __uint_as_float(w & 0xffff0000u); }
DI float sigmoidf_(float x) { return __builtin_amdgcn_rcpf(1.f + __expf(-x)); }
DI float wave_sum(float v) {
#pragma unroll
    for (int o = 1; o < 64; o <<= 1) v += __shfl_xor(v, o);
    return v;
}
DI float wave_max(float v) {
#pragma unroll
    for (int o = 1; o < 64; o <<= 1) v = fmaxf(v, __shfl_xor(v, o));
    return v;
}
#define LDS_WAIT() asm volatile("s_waitcnt lgkmcnt(0)" ::: "memory")
#define VM_WAIT() asm volatile("s_waitcnt vmcnt(0)" ::: "memory")
#define MFMA16(a, b, c) __builtin_amdgcn_mfma_f32_16x16x32_bf16((a), (b), (c), 0, 0, 0)

#define XB_TMO      128
#define XB_XCNT(j)  (256  + 64 * (j))
#define XB_XSUB(j)  (1280 + 64 * (j))
#define XB_XGEN(j)  (2304 + 64 * (j))
#define XB_TOP      3328
#define XB_TOPGEN   3392
#define XCD_BAR_WORDS 3456
#define XB_SPIN_CAP (1u << 22)
__device__ __forceinline__ unsigned xb_ld(unsigned* p)              { return __hip_atomic_load(p, __ATOMIC_RELAXED, __HIP_MEMORY_SCOPE_AGENT); }
__device__ __forceinline__ unsigned xb_add(unsigned* p, unsigned v) { return __hip_atomic_fetch_add(p, v, __ATOMIC_RELAXED, __HIP_MEMORY_SCOPE_AGENT); }
__device__ __forceinline__ unsigned xb_xcc_id() { return (unsigned)__builtin_amdgcn_s_getreg((3 << 11) | 20) & 0xFu; }
#define XB_SPIN(cond, bar) do { unsigned _sp = 0; while (cond) { __builtin_amdgcn_s_sleep(1); \
    if ((++_sp & 255u) == 0u) { if (xb_ld(&(bar)[XB_TMO])) break; if (_sp > XB_SPIN_CAP) { atomicAdd(&(bar)[XB_TMO], 1u); break; } } } } while (0)
struct XcdBarrier { unsigned* bar; unsigned x; volatile LAS unsigned* st; };
__device__ __forceinline__ XcdBarrier xcd_barrier_post(unsigned* bar, volatile LAS unsigned* st) {
    XcdBarrier b; b.bar = bar; b.x = xb_xcc_id(); b.st = st;
    if (threadIdx.x == 0) (void)xb_add(&bar[XB_XCNT(b.x)], 1u);
    return b;
}
__device__ __attribute__((noinline)) unsigned long long xcd_barrier_complete(unsigned* bar, unsigned x) {
    const unsigned G = gridDim.x * gridDim.y * gridDim.z;
    unsigned sum, cnt, mine, sp = 0u;
    for (;;) {
        sum = 0u; cnt = 0u; mine = 0u;
#pragma unroll
        for (unsigned j = 0; j < 16; ++j) { const unsigned c = xb_ld(&bar[XB_XCNT(j)]); sum += c; cnt += (c > 0u) ? 1u : 0u; mine = (j == x) ? c : mine; }
        if (sum == G) break;
        __builtin_amdgcn_s_sleep(1);
        if ((++sp & 255u) == 0u) { if (xb_ld(&bar[XB_TMO])) break; if (sp > XB_SPIN_CAP) { atomicAdd(&bar[XB_TMO], 1u); break; } }
    }
    const unsigned nloc = mine > 0u ? mine : 1u, nx = cnt > 0u ? cnt : 1u;
    return ((unsigned long long)nx << 32) | nloc;
}
__device__ __forceinline__ void xcd_barrier(const XcdBarrier& b) {
    asm volatile("s_waitcnt vmcnt(0)" ::: "memory");
    __syncthreads();
    if (threadIdx.x == 0) {
        unsigned* bar = b.bar;
        __builtin_amdgcn_s_waitcnt(0);
        unsigned nloc = b.st[0], nx = b.st[1];
        if (nloc == 0u) { const unsigned long long r = xcd_barrier_complete(bar, b.x); nloc = (unsigned)r; nx = (unsigned)(r >> 32); b.st[0] = nloc; b.st[1] = nx; }
        const unsigned old = xb_add(&bar[XB_XSUB(b.x)], 1u);
        const unsigned gen = old / nloc;
        if (old + 1u == (gen + 1u) * nloc) {
            __builtin_amdgcn_fence(__ATOMIC_RELEASE, "agent");
            asm volatile("s_waitcnt vmcnt(0)" ::: "memory");
            const unsigned og = xb_add(&bar[XB_TOP], 1u);
            const unsigned tg = og / nx;
            if (og + 1u == (tg + 1u) * nx) xb_add(&bar[XB_TOPGEN], 1u);
            else XB_SPIN(xb_ld(&bar[XB_TOPGEN]) == tg, bar);
            __builtin_amdgcn_fence(__ATOMIC_ACQUIRE, "agent");
            xb_add(&bar[XB_XGEN(b.x)], 1u);
            asm volatile("s_waitcnt vmcnt(0)" ::: "memory");
        } else {
            XB_SPIN(xb_ld(&bar[XB_XGEN(b.x)]) == gen, bar);
            __builtin_amdgcn_fence(__ATOMIC_ACQUIRE, "agent");
            asm volatile("s_waitcnt vmcnt(0)" ::: "memory");
        }
    }
    __syncthreads();
}

namespace g8 {
constexpr int BM = 256, BK = 64, HALF = 128, HTB = HALF * BK * 2;
__host__ __device__ __forceinline__ int lds_byte(int r, int c) { const int st = (r >> 4) * 2 + (c >> 5), rr = r & 15, cc = c & 31, ob = rr * 64 + cc * 2; return st * 1024 + (ob ^ (((ob >> 9) & 1) << 5)); }
__host__ __device__ __forceinline__ void stage_rc(int b, int& R, int& C) { const int st = b / 1024, sb = b % 1024, swz = sb ^ (((sb >> 9) & 1) << 5); R = (st >> 1) * 16 + swz / 64; C = (st & 1) * 32 + (swz % 64) / 2; }
__host__ __device__ __forceinline__ int perm32(int rho) { const int n = rho >> 4, i = rho & 15; return 8 * (i >> 2) + 4 * n + (i & 3); }

struct Unit { const char* a; const char* b; char* c; int pm, pn, aux; };
DI void tile_of(int L, int nM, int nN, int& pm, int& pn) {
    const int nig = 8 * nN, gid = L / nig, fm = gid * 8, gsz = (nM - fm) < 8 ? (nM - fm) : 8, w = L % nig;
    pm = fm + (w % gsz); pn = w / gsz;
}
struct AffineOrder {
    const char* A; const char* B; char* C; size_t aM, bB, bN, cM, cS, cN; int nM, nN, bdiv, csp, G, c0;
    DI bool next(int i, Unit& u) const {
        const int L = i * G + c0; if (L >= nM * nN) return false;
        int pm, pn; tile_of(L, nM, nN, pm, pn); u.pm = pm; u.pn = pn; u.aux = 0;
        u.a = A + (size_t)pm * aM; u.b = B + (size_t)(pm / bdiv) * bB + (size_t)pn * bN; u.c = C + (size_t)pm * cM + (size_t)(pn / csp) * cS + (size_t)(pn % csp) * cN; return true;
    }
};
DI AffineOrder dense_order(const void* A, const void* B, void* C, int M, int N, int K, int ldc_bytes, int esz, int G, int c0) {
    AffineOrder o; o.A = (const char*)A; o.B = (const char*)B; o.C = (char*)C; o.aM = 256ull * K * 2; o.bB = 0; o.bN = 256ull * K * 2; o.cM = 256ull * ldc_bytes; o.cS = 0; o.cN = 256ull * esz;
    o.nM = M / 256; o.nN = N / 256; o.bdiv = 1 << 30; o.csp = 1 << 30; o.G = G; o.c0 = c0; return o;
}

DI void lds_rd2x16(unsigned addr, f32x4& a, f32x4& b) { asm volatile("ds_read_b128 %0, %2\n\tds_read_b128 %1, %2 offset:16\n\ts_waitcnt lgkmcnt(0)" : "=&v"(a), "=&v"(b) : "v"(addr) : "memory"); }
struct EpiBf16 {
    static constexpr bool PERM = true;
    int ldc; const float* bias; int bias_stride; float scl;
    DI void issue(const Unit& u, LAS unsigned char* lds, int wid, int lane) const {
        if (bias) __builtin_amdgcn_global_load_lds((const unsigned*)(bias + (size_t)u.aux * bias_stride + u.pn * 256 + (lane >> 5) * HALF + (wid & 3) * 32 + (lane & 31)), (LAS unsigned*)(lds + LDS_X + wid * 256), 4, 0, 0);
    }
    DI void operator()(f32x4 (&acc)[2][2][4][2], const Unit& u, int wr, int wc, int fr, int fq, LAS unsigned char* lds) const {
        const int col0 = wc * 32 + 8 * fq; const float sc = (u.aux < 0) ? scl : 1.f;
        f32x4 bv[2][2];
#pragma unroll
        for (int bj = 0; bj < 2; ++bj) { if (bias) lds_rd2x16((unsigned)(size_t)lds + LDS_X + (wr * 4 + wc) * 256 + bj * 128 + fq * 32, bv[bj][0], bv[bj][1]); else { bv[bj][0] = (f32x4){0.f, 0.f, 0.f, 0.f}; bv[bj][1] = (f32x4){0.f, 0.f, 0.f, 0.f}; } }
#pragma unroll
        for (int ai = 0; ai < 2; ++ai)
#pragma unroll
            for (int m = 0; m < 4; ++m) { bf16* rowp = (bf16*)u.c + (size_t)(ai * HALF + wr * 64 + m * 16 + fr) * ldc + col0;
#pragma unroll
                for (int bj = 0; bj < 2; ++bj) { const f32x4 v0 = acc[ai][bj][m][0] * sc + bv[bj][0], v1 = acc[ai][bj][m][1] * sc + bv[bj][1];
                    u32x4 w; w.x = cvt_pk_bf16(v0[0], v0[1]); w.y = cvt_pk_bf16(v0[2], v0[3]); w.z = cvt_pk_bf16(v1[0], v1[1]); w.w = cvt_pk_bf16(v1[2], v1[3]);
                    *(u32x4*)(rowp + bj * HALF) = w; } }
    }
};
struct EpiSoftmax {
    static constexpr bool PERM = true;
    int ldc;
    DI void issue(const Unit&, LAS unsigned char*, int, int) const {}
    DI void operator()(f32x4 (&acc)[2][2][4][2], const Unit& u, int wr, int wc, int fr, int fq, LAS unsigned char* lds) const {
        LAS f32x2* X = (LAS f32x2*)(lds + LDS_X);
#pragma unroll
        for (int ai = 0; ai < 2; ++ai)
#pragma unroll
            for (int m = 0; m < 4; ++m) {
                float v = -3.0e38f;
#pragma unroll
                for (int bj = 0; bj < 2; ++bj)
#pragma unroll
                    for (int n = 0; n < 2; ++n) { const f32x4 x = acc[ai][bj][m][n]; v = fmaxf(v, fmaxf(fmaxf(x[0], x[1]), fmaxf(x[2], x[3]))); }
                v = fmaxf(v, __shfl_xor(v, 16)); v = fmaxf(v, __shfl_xor(v, 32));
                float s = 0.f;
#pragma unroll
                for (int bj = 0; bj < 2; ++bj)
#pragma unroll
                    for (int n = 0; n < 2; ++n) { f32x4 x = acc[ai][bj][m][n]; x[0] = __expf(x[0] - v); x[1] = __expf(x[1] - v); x[2] = __expf(x[2] - v); x[3] = __expf(x[3] - v); acc[ai][bj][m][n] = x; s += (x[0] + x[1]) + (x[2] + x[3]); }
                s += __shfl_xor(s, 16); s += __shfl_xor(s, 32);
                if (fq == 0) X[(ai * HALF + wr * 64 + m * 16 + fr) * 4 + wc] = (f32x2){v, s};
            }
        LDS_WAIT(); __builtin_amdgcn_s_barrier(); asm volatile("" ::: "memory");
        const int col0 = wc * 32 + 8 * fq;
#pragma unroll
        for (int ai = 0; ai < 2; ++ai)
#pragma unroll
            for (int m = 0; m < 4; ++m) {
                const int r = ai * HALF + wr * 64 + m * 16 + fr;
                const f32x4 p01 = *(const LAS f32x4*)(X + r * 4), p23 = *(const LAS f32x4*)(X + r * 4 + 2);
                const float M = fmaxf(fmaxf(p01[0], p01[2]), fmaxf(p23[0], p23[2]));
                const float S = p01[1] * __expf(p01[0] - M) + p01[3] * __expf(p01[2] - M) + p23[1] * __expf(p23[0] - M) + p23[3] * __expf(p23[2] - M);
                const float f = __expf(X[r * 4 + wc][0] - M) * __builtin_amdgcn_rcpf(S);
                bf16* rowp = (bf16*)u.c + (size_t)r * ldc + col0;
#pragma unroll
                for (int bj = 0; bj < 2; ++bj) { const f32x4 v0 = acc[ai][bj][m][0] * f, v1 = acc[ai][bj][m][1] * f;
                    u32x4 w; w.x = cvt_pk_bf16(v0[0], v0[1]); w.y = cvt_pk_bf16(v0[2], v0[3]); w.z = cvt_pk_bf16(v1[0], v1[1]); w.w = cvt_pk_bf16(v1[2], v1[3]);
                    *(u32x4*)(rowp + bj * HALF) = w; }
                asm volatile("" ::: "memory");
            }
    }
};
struct EpiSwiglu {
    static constexpr bool PERM = true;
    const float* bgu;
    DI void issue(const Unit& u, LAS unsigned char* lds, int wid, int lane) const {
        __builtin_amdgcn_global_load_lds((const unsigned*)(bgu + (size_t)u.aux * 2048 + (lane >> 5) * 1024 + u.pn * 128 + (wid & 3) * 32 + (lane & 31)), (LAS unsigned*)(lds + LDS_X + wid * 256), 4, 0, 0);
    }
    DI void operator()(f32x4 (&acc)[2][2][4][2], const Unit& u, int wr, int wc, int fr, int fq, LAS unsigned char* lds) const {
        f32x4 bg[2], bl[2];
        lds_rd2x16((unsigned)(size_t)lds + LDS_X + (wr * 4 + wc) * 256 + fq * 32, bg[0], bg[1]);
        lds_rd2x16((unsigned)(size_t)lds + LDS_X + (wr * 4 + wc) * 256 + 128 + fq * 32, bl[0], bl[1]);
#pragma unroll
        for (int ai = 0; ai < 2; ++ai)
#pragma unroll
            for (int m = 0; m < 4; ++m) {
                float o[8];
#pragma unroll
                for (int n = 0; n < 2; ++n)
#pragma unroll
                    for (int j = 0; j < 4; ++j) {
                        const float glu = fminf(acc[ai][0][m][n][j] + bg[n][j], 7.0f);
                        const float lin = fminf(fmaxf(acc[ai][1][m][n][j] + bl[n][j], -7.0f), 7.0f);
                        o[4 * n + j] = (lin + 1.0f) * glu * sigmoidf_(1.702f * glu);
                    }
                u32x4 w; w.x = cvt_pk_bf16(o[0], o[1]); w.y = cvt_pk_bf16(o[2], o[3]); w.z = cvt_pk_bf16(o[4], o[5]); w.w = cvt_pk_bf16(o[6], o[7]);
                *(u32x4*)((bf16*)u.c + (size_t)(ai * HALF + wr * 64 + m * 16 + fr) * 1024 + wc * 32 + 8 * fq) = w;
            }
    }
};

template <class Epi, class Sched, bool GATHER = false>
__device__ __forceinline__ void gemm_phase(LAS unsigned char* lds, const int lda, const int ldb, const int nt, const Sched& S, const Epi& E, const unsigned* rowtab = nullptr) {
    int tid = threadIdx.x; asm volatile("" : "+v"(tid));
    const int wid = __builtin_amdgcn_readfirstlane(tid >> 6), lane = tid & 63, wr = wid >> 2, wc = wid & 3, fr = lane & 15, fq = lane >> 4;
    unsigned voffA[2], voffB[2];
#pragma unroll
    for (int i = 0; i < 2; ++i) { int R, C; stage_rc(tid * 16 + i * 8192, R, C); const int Rb = Epi::PERM ? ((R & ~31) + perm32(R & 31)) : R;
        voffA[i] = GATHER ? 0u : (unsigned)(R * lda + C * 2); voffB[i] = (unsigned)(Rb * ldb + C * 2); }
    unsigned gc[2][2] = {{0u, 0u}, {0u, 0u}}, gn[2][2] = {{0u, 0u}, {0u, 0u}};
#define PG8_GLOAD(dst, pm_) do { int _t = tid; asm volatile("" : "+v"(_t)); _Pragma("unroll") for (int _i = 0; _i < 2; ++_i) { int _R, _C; stage_rc(_t * 16 + _i * 8192, _R, _C); \
        _Pragma("unroll") for (int _h = 0; _h < 2; ++_h) dst[_h][_i] = __hip_atomic_load(rowtab + (size_t)(pm_) * 256 + _h * 128 + _R, __ATOMIC_RELAXED, __HIP_MEMORY_SCOPE_AGENT) * (unsigned)lda + (unsigned)(_C * 2); } } while (0)
    const size_t kstep = (size_t)(BK * 2);
    const size_t hstepA = (size_t)HALF * lda, hstepB = (size_t)HALF * ldb;
    const unsigned ldsw = (unsigned)wid * 1024u;
    const int aoff = lds_byte(wr * 64 + fr, fq * 8), boff = lds_byte(wc * 32 + fr, fq * 8);
#define PG8_SA(b, h) (((b) * 2 + (h)) * HTB)
#define PG8_SB(b, h) ((4 + (b) * 2 + (h)) * HTB)
#define PG8_STAGE(bufoff, gbase, voff) do { _Pragma("unroll") for (int _i = 0; _i < 2; ++_i) \
        __builtin_amdgcn_global_load_lds((const unsigned*)((const char*)(gbase) + (voff)[_i]), (LAS unsigned*)(lds + (bufoff) + ldsw + _i * 8192), 16, 0, 0); } while (0)
#define PG8_STAGE_A(bufoff, gbase, hh, nx) do { if (GATHER) { _Pragma("unroll") for (int _i = 0; _i < 2; ++_i) \
        __builtin_amdgcn_global_load_lds((const unsigned*)((const char*)(gbase) + ((nx) ? gn[hh][_i] : gc[hh][_i])), (LAS unsigned*)(lds + (bufoff) + ldsw + _i * 8192), 16, 0, 0); } \
        else PG8_STAGE(bufoff, (gbase) + (hh) * hstepA, voffA); } while (0)
#define PG8_LDA(dst, b, h) do { _Pragma("unroll") for (int m = 0; m < 4; ++m) _Pragma("unroll") for (int k = 0; k < 2; ++k) dst[m][k] = *(const LAS bf16x8*)(lds + PG8_SA(b, h) + aoff + m * 2048 + k * 1024); } while (0)
#define PG8_LDB(dst, b, h) do { _Pragma("unroll") for (int n = 0; n < 2; ++n) _Pragma("unroll") for (int k = 0; k < 2; ++k) dst[n][k] = *(const LAS bf16x8*)(lds + PG8_SB(b, h) + boff + n * 2048 + k * 1024); } while (0)
#define PG8_MMA(ai, bj, At, Bt) do { __builtin_amdgcn_s_setprio(1); _Pragma("unroll") for (int m = 0; m < 4; ++m) _Pragma("unroll") for (int n = 0; n < 2; ++n) _Pragma("unroll") for (int k = 0; k < 2; ++k) \
        acc[ai][bj][m][n] = __builtin_amdgcn_mfma_f32_16x16x32_bf16(Bt[n][k], At[m][k], acc[ai][bj][m][n], 0, 0, 0); __builtin_amdgcn_s_setprio(0); } while (0)
#define PG8_WAIT_V(n) asm volatile("s_waitcnt vmcnt(" #n ")" ::: "memory")
#define PG8_WAIT_L(n) asm volatile("s_waitcnt lgkmcnt(" #n ")" ::: "memory")
#define PG8_BAR __builtin_amdgcn_s_barrier()
#define PG8_SCHED __builtin_amdgcn_sched_barrier(0)
    Unit cur, nxt; int ui = 0;
    if (!S.next(0, cur)) return;
    f32x4 acc[2][2][4][2];
#pragma unroll
    for (int a = 0; a < 2; ++a)
#pragma unroll
        for (int b = 0; b < 2; ++b)
#pragma unroll
            for (int m = 0; m < 4; ++m)
#pragma unroll
                for (int n = 0; n < 2; ++n) acc[a][b][m][n] = (f32x4){0.f, 0.f, 0.f, 0.f};
    bf16x8 At[4][2], B0[2][2], B1[2][2];
    const char* cA = cur.a; const char* cB = cur.b;
    if (GATHER) { PG8_GLOAD(gc, cur.pm); }
    PG8_STAGE(PG8_SB(0, 0), cB, voffB); PG8_STAGE(PG8_SB(0, 1), cB + hstepB, voffB); PG8_STAGE_A(PG8_SA(0, 0), cA, 0, false); PG8_STAGE_A(PG8_SA(0, 1), cA, 1, false);
    if (wr == 1) PG8_BAR;
    PG8_WAIT_V(2); PG8_BAR;
    PG8_STAGE(PG8_SB(1, 0), cB + kstep, voffB); PG8_STAGE_A(PG8_SA(1, 0), cA + kstep, 0, false); PG8_STAGE(PG8_SB(1, 1), cB + hstepB + kstep, voffB);
    PG8_WAIT_V(6); PG8_BAR;
    for (;;) {
        const bool has_next = S.next(ui + 1, nxt);
        const char* nA = has_next ? nxt.a : cA; const char* nB = has_next ? nxt.b : cB;
        if (GATHER) { if (has_next) { PG8_GLOAD(gn, nxt.pm); } else { _Pragma("unroll") for (int _h = 0; _h < 2; ++_h) { gn[_h][0] = gc[_h][0]; gn[_h][1] = gc[_h][1]; } } }
#pragma unroll 1
        for (int t = 0; t < nt; t += 2) {
            const bool last = (t == nt - 2);
            const char* a1 = cA + (size_t)(t + 1) * kstep;
            const char* a2 = last ? nA : cA + (size_t)(t + 2) * kstep; const char* b2 = last ? nB : cB + (size_t)(t + 2) * kstep;
            const char* a3 = a2 + kstep; const char* b3 = b2 + kstep;
            PG8_LDB(B0, 0, 0); PG8_LDB(B1, 0, 1); PG8_SCHED; PG8_LDA(At, 0, 0); PG8_STAGE_A(PG8_SA(1, 1), a1, 1, false);
            if (t == 0) E.issue(cur, lds, wid, lane);
            PG8_WAIT_V(8); PG8_WAIT_L(0); PG8_BAR; PG8_MMA(0, 0, At, B0); PG8_MMA(0, 1, At, B1); PG8_BAR; PG8_SCHED;
            PG8_LDA(At, 0, 1); PG8_STAGE(PG8_SB(0, 0), b2, voffB); PG8_STAGE(PG8_SB(0, 1), b2 + hstepB, voffB); PG8_STAGE_A(PG8_SA(0, 0), a2, 0, last);
            PG8_WAIT_V(8); PG8_WAIT_L(0); PG8_BAR; PG8_MMA(1, 0, At, B0); PG8_MMA(1, 1, At, B1); PG8_BAR; PG8_SCHED;
            PG8_LDB(B0, 1, 0); PG8_LDB(B1, 1, 1); PG8_SCHED; PG8_LDA(At, 1, 0); PG8_STAGE_A(PG8_SA(0, 1), a2, 1, last);
            PG8_WAIT_V(8); PG8_WAIT_L(0); PG8_BAR; PG8_MMA(0, 0, At, B0); PG8_MMA(0, 1, At, B1); PG8_BAR; PG8_SCHED;
            PG8_LDA(At, 1, 1); PG8_STAGE(PG8_SB(1, 0), b3, voffB); PG8_STAGE(PG8_SB(1, 1), b3 + hstepB, voffB); PG8_STAGE_A(PG8_SA(1, 0), a3, 0, last);
            PG8_WAIT_V(8); PG8_WAIT_L(0); PG8_BAR; PG8_MMA(1, 0, At, B0); PG8_MMA(1, 1, At, B1); PG8_BAR; PG8_SCHED;
        }
        if (wr == 0) PG8_BAR;
        { int fr_e = fr, fq_e = fq; asm volatile("" : "+v"(fr_e), "+v"(fq_e)); E(acc, cur, wr, wc, fr_e, fq_e, lds); }
        if (!has_next) break;
#pragma unroll
        for (int a = 0; a < 2; ++a)
#pragma unroll
            for (int b = 0; b < 2; ++b)
#pragma unroll
                for (int m = 0; m < 4; ++m)
#pragma unroll
                    for (int n = 0; n < 2; ++n) acc[a][b][m][n] = (f32x4){0.f, 0.f, 0.f, 0.f};
        cur = nxt; cA = nA; cB = nB; ++ui;
        if (GATHER) { _Pragma("unroll") for (int _h = 0; _h < 2; ++_h) { gc[_h][0] = gn[_h][0]; gc[_h][1] = gn[_h][1]; } }
        if (wr == 1) PG8_BAR;
    }
    PG8_WAIT_V(0);
    PG8_BAR;
#undef PG8_SA
#undef PG8_SB
#undef PG8_STAGE
#undef PG8_LDA
#undef PG8_STAGE_A
#undef PG8_GLOAD
#undef PG8_LDB
#undef PG8_MMA
#undef PG8_WAIT_V
#undef PG8_WAIT_L
#undef PG8_BAR
#undef PG8_SCHED
}
}

struct Args { const float* in[27]; float* out; unsigned char* ws; int ph_lo, ph_hi; };
struct Ctx {
    LAS unsigned char* lds; unsigned char* ws; unsigned* ctl;
    int tid, lane, wave, vcu, G;
};
constexpr int LDS_PTAB = LDS_MISC + 1024;
DI void refresh(Ctx& F, unsigned char* wsb) { int t = threadIdx.x; asm volatile("" : "+v"(t)); F.tid = t; F.lane = t & 63; F.wave = __builtin_amdgcn_readfirstlane(t >> 6);
    unsigned lo = (unsigned)(unsigned long long)wsb, hi = (unsigned)((unsigned long long)wsb >> 32); asm volatile("" : "+v"(lo), "+v"(hi));
    lo = __builtin_amdgcn_readfirstlane(lo); hi = __builtin_amdgcn_readfirstlane(hi); F.ws = (unsigned char*)(GAS unsigned char*)(((unsigned long long)hi << 32) | lo); F.ctl = (unsigned*)F.ws;
    int bx = blockIdx.x; asm volatile("" : "+v"(bx)); bx = __builtin_amdgcn_readfirstlane(bx); F.G = 256; F.vcu = (bx & 7) * 32 + (bx >> 3);
    unsigned zb = 0u; asm volatile("" : "+v"(zb)); F.lds = (LAS unsigned char*)(unsigned)__builtin_amdgcn_readfirstlane(zb); }
DI const float* inp(const Ctx& F, int i) {
    const LAS unsigned* p = (const LAS unsigned*)(F.lds + LDS_PTAB) + 2 * i; const unsigned lo = __builtin_amdgcn_readfirstlane(p[0]), hi = __builtin_amdgcn_readfirstlane(p[1]);
    return (const float*)(GAS const float*)(((unsigned long long)hi << 32) | lo);
}
DI unsigned ldu(const unsigned* p) { return __hip_atomic_load(p, __ATOMIC_RELAXED, __HIP_MEMORY_SCOPE_AGENT); }
DI float ldf(const float* p) { return __uint_as_float(__hip_atomic_load((const unsigned*)p, __ATOMIC_RELAXED, __HIP_MEMORY_SCOPE_AGENT)); }

template <int MAP> DI int map_row(int n) {
    if (MAP == 0) return n;
    if (MAP == 1) return n < 1536 ? n : (n < 1544 ? -1 : (n < 3592 ? n - 8 : -1));
    return 256 * ((n & 1023) >> 7) + 128 * (n >> 10) + (n & 127);
}
template <int MAP> DI void tr_item(const float* W, int K, int N, bf16* WT, LAS float* scr, int item, int lane) {
    const int nblk = (N + 31) / 32, kb = item / nblk, nb = item % nblk, k0 = 64 * kb, n0 = 32 * nb;
    const int c4 = 4 * (lane & 7), nl = n0 + c4;
    f32x4 ld[8];
#pragma unroll
    for (int i = 0; i < 8; ++i) { const int kk = 8 * i + (lane >> 3); ld[i] = nl < N ? __builtin_nontemporal_load((const f32x4*)(W + (size_t)(k0 + kk) * N + nl)) : (f32x4){0.f, 0.f, 0.f, 0.f}; }
#pragma unroll
    for (int i = 0; i < 8; ++i) { const int kk = 8 * i + (lane >> 3); LAS float* d = scr + kk * 33 + c4; d[0] = ld[i][0]; d[1] = ld[i][1]; d[2] = ld[i][2]; d[3] = ld[i][3]; }
    LDS_WAIT(); asm volatile("" ::: "memory");
    const int c = lane & 7;
#pragma unroll
    for (int j = 0; j < 4; ++j) { const int nn = (lane >> 3) + 8 * j; const int n = n0 + nn; const LAS float* s = scr + (8 * c) * 33 + nn;
        const int dr = n < N ? map_row<MAP>(n) : -1;
        u32x4 o; o.x = cvt_pk_bf16(s[0 * 33], s[1 * 33]); o.y = cvt_pk_bf16(s[2 * 33], s[3 * 33]); o.z = cvt_pk_bf16(s[4 * 33], s[5 * 33]); o.w = cvt_pk_bf16(s[6 * 33], s[7 * 33]);
        if (dr >= 0) __builtin_nontemporal_store(o, (u32x4*)(WT + (size_t)dr * K + k0 + 8 * c)); }
    LDS_WAIT(); asm volatile("" ::: "memory");
}
DI void phase_convert(Ctx& F, const Args& a) {
    LAS float* scr = (LAS float*)(F.lds + F.wave * 16384);
    const int gw = F.vcu * NWAVES + F.wave, NGW = F.G * NWAVES;
    constexpr int I_WIN = 16 * 113, I_SQ = 16 * 32, I_GU = 16 * 64;
    constexpr int E0 = 4 * I_WIN, E1 = E0 + 4 * I_SQ, E2 = E1 + 4 * I_SQ, E3 = E2 + 4 * I_SQ, E4 = E3 + 4 * I_SQ, E5 = E4 + 128 * I_GU, E6 = E5 + 128 * I_SQ;
    for (int it = gw; it < E6; it += NGW) {
        if (it < E0) { const int l = it / I_WIN, r = it % I_WIN; tr_item<1>(inp(F, 2) + (size_t)l * D * 3600, D, 3600, (bf16*)(F.ws + WS_WIN) + (size_t)l * NPROJ * D, scr, r, F.lane); }
        else if (it < E1) { const int q = it - E0, l = q / I_SQ, r = q % I_SQ; tr_item<0>(inp(F, 10) + (size_t)l * D * D, D, D, (bf16*)(F.ws + WS_WOUT) + (size_t)l * D * D, scr, r, F.lane); }
        else if (it < E2) { const int q = it - E1, l = q / I_SQ, r = q % I_SQ; tr_item<0>(inp(F, 14) + (size_t)l * D * D, D, D, (bf16*)(F.ws + WS_WKV) + (size_t)(2 * l) * D * D, scr, r, F.lane); }
        else if (it < E3) { const int q = it - E2, l = q / I_SQ, r = q % I_SQ; tr_item<0>(inp(F, 15) + (size_t)l * D * D, D, D, (bf16*)(F.ws + WS_WKV) + (size_t)(2 * l + 1) * D * D, scr, r, F.lane); }
        else if (it < E4) { const int q = it - E3, l = q / I_SQ, r = q % I_SQ; tr_item<0>(inp(F, 16) + (size_t)l * D * D, D, D, (bf16*)(F.ws + WS_WO) + (size_t)l * D * D, scr, r, F.lane); }
        else if (it < E5) { const int q = it - E4, le = q / I_GU, r = q % I_GU; tr_item<2>(inp(F, 21) + (size_t)le * D * 2048, D, 2048, (bf16*)(F.ws + WS_WGU) + (size_t)le * 2048 * D, scr, r, F.lane); }
        else { const int q = it - E5, le = q / I_SQ, r = q % I_SQ; tr_item<0>(inp(F, 23) + (size_t)le * D * D, D, D, (bf16*)(F.ws + WS_WDN) + (size_t)le * D * D, scr, r, F.lane); }
    }
    const size_t gt = (size_t)blockIdx.x * NTHREADS + F.tid, NGT = (size_t)F.G * NTHREADS;
    for (size_t i = gt; i < (4ull * D * D + 2048ull * D) / 8; i += NGT) {
        const bool isq = i < 4ull * D * D / 8; const size_t j = isq ? i : i - 4ull * D * D / 8;
        const float* src = (isq ? inp(F, 13) : inp(F, 1)) + j * 8; bf16* dst = (bf16*)(F.ws + (isq ? WS_WQ : WS_MEMB)) + j * 8;
        const f32x4 v0 = *(const f32x4*)src, v1 = *(const f32x4*)(src + 4);
        u32x4 o; o.x = cvt_pk_bf16(v0[0], v0[1]); o.y = cvt_pk_bf16(v0[2], v0[3]); o.z = cvt_pk_bf16(v1[0], v1[1]); o.w = cvt_pk_bf16(v1[2], v1[3]);
        *(u32x4*)dst = o;
    }
    for (size_t i = gt; i < 4ull * 48 * D; i += NGT) {
        const int l = (int)(i / (48 * D)), r = (int)(i % (48 * D)), j = r / D, k = r % D;
        float w; bf16* dh; bf16* dl;
        if (j < 16) { const int col = j < 8 ? 1536 + j : 3592 + (j - 8); w = inp(F, 2)[((size_t)l * D + k) * 3600 + col];
            dh = (bf16*)(F.ws + WS_WGATE) + ((size_t)(l * 2 + 0) * 16 + j) * D + k; dl = dh + 16 * D; }
        else { const int e = j - 16; w = inp(F, 19)[((size_t)l * D + k) * 32 + e];
            dh = (bf16*)(F.ws + WS_WRT) + ((size_t)(l * 2 + 0) * 32 + e) * D + k; dl = dh + 32 * D; }
        const bf16 h = f2bf(w); *dh = h; *dl = f2bf(w - bf2f(h));
    }
}

DI void unpack8(const u32x4 w, float* v) { v[0] = bflo(w.x); v[1] = bfhi(w.x); v[2] = bflo(w.y); v[3] = bfhi(w.y); v[4] = bflo(w.z); v[5] = bfhi(w.z); v[6] = bflo(w.w); v[7] = bfhi(w.w); }
DI u32x4 pack8(const float* v) { u32x4 o; o.x = cvt_pk_bf16(v[0], v[1]); o.y = cvt_pk_bf16(v[2], v[3]); o.z = cvt_pk_bf16(v[4], v[5]); o.w = cvt_pk_bf16(v[6], v[7]); return o; }
#define PROF_RP(k) do { if (MODE == 2 && ((PROF_MASK) >> 23)) { if (blockIdx.x == 0 && threadIdx.x == 0) { volatile LAS unsigned long long* pw = (volatile LAS unsigned long long*)(F.lds + LDS_MISC + 128); \
        const unsigned long long now_ = __builtin_amdgcn_s_memrealtime(); if ((k) >= 0 && (((PROF_MASK) >> (23 + (k))) & 1)) pw[1] += now_ - pw[3]; pw[3] = now_; } } } while (0)
DI void ld2x16_sc1(const void* p0, const void* p1, u32x4& a, u32x4& b) {
    asm volatile("global_load_dwordx4 %0, %2, off sc0 sc1\n\tglobal_load_dwordx4 %1, %3, off sc0 sc1\n\ts_waitcnt vmcnt(0)" : "=&v"(a), "=&v"(b) : "v"(p0), "v"(p1) : "memory");
}
template <int MODE> DI void row_pass(Ctx& F, const Args& a, int l, const bool dummy = false) {
    const int lane = F.lane, r0 = (F.vcu * NWAVES + F.wave) * 16;
    bf16* XB = (bf16*)(F.ws + WS_XB); bf16* XBo = dummy ? (bf16*)(F.ws + WS_XG + 16 * MiB) : XB; const bf16* HB = (const bf16*)(F.ws + WS_HB); const bf16* Y = (const bf16*)(F.ws + WS_Y);
    const int c0 = 8 * lane, c1 = 512 + 8 * lane;
    LAS unsigned* ecnt = (LAS unsigned*)(F.lds + LDS_MISC + 256);
    if (MODE == 2) { if (F.tid < 64 && !dummy) ecnt[F.tid] = 0u; __syncthreads(); }
    PROF_RP(-1);
    constexpr int N16 = (MODE == 2) ? 2 : 1, NN = 16 * N16, NBLK = 32 * N16 * 2;
    const bool has_tail = !(MODE == 1 || (MODE == 3 && l == NL - 1));
    const bf16* Wb = (MODE == 2) ? (const bf16*)(F.ws + WS_WRT) + (size_t)l * 2 * 32 * D : (const bf16*)(F.ws + WS_WGATE) + (size_t)(MODE == 0 ? 0 : (l + 1 < NL ? l + 1 : 0)) * 2 * 16 * D;
    if (has_tail) {
#pragma unroll
        for (int q = 0; q < NBLK / 8; ++q) { const int blk = F.wave * (NBLK / 8) + q, ks = blk / (2 * N16), n = (blk >> 1) % N16, hl = blk & 1;
            __builtin_amdgcn_global_load_lds((const unsigned*)(Wb + (size_t)(hl * NN + n * 16 + (lane & 15)) * D + 32 * ks + 8 * (lane >> 4)), (LAS unsigned*)(F.lds + blk * 1024), 16, 0, 0); }
    }
    float g[16], bb[16];
    if (MODE >= 1) {
        const float* gp = inp(F, MODE == 1 ? 11 : (MODE == 2 ? 17 : 25)) + (size_t)l * D; const float* bp = inp(F, MODE == 1 ? 12 : (MODE == 2 ? 18 : 26)) + (size_t)l * D;
#pragma unroll
        for (int q = 0; q < 2; ++q) { const int c = q ? c1 : c0;
            const f32x4 g0 = *(const f32x4*)(gp + c), g1 = *(const f32x4*)(gp + c + 4), b0 = *(const f32x4*)(bp + c), b1 = *(const f32x4*)(bp + c + 4);
#pragma unroll
            for (int j = 0; j < 4; ++j) { g[8 * q + j] = g0[j]; g[8 * q + 4 + j] = g1[j]; bb[8 * q + j] = b0[j]; bb[8 * q + 4 + j] = b1[j]; } }
    }
    constexpr int RB = (MODE == 3) ? 2 : 4;
#pragma unroll 1
    for (int i0 = 0; i0 < 16; i0 += RB) {
        float v[RB][16];
        if (MODE == 0) {
            f32x4 xi[RB][4];
#pragma unroll
            for (int q = 0; q < RB; ++q) { const float* xr = inp(F, 0) + (size_t)(r0 + i0 + q) * D;
                xi[q][0] = *(const f32x4*)(xr + c0); xi[q][1] = *(const f32x4*)(xr + c0 + 4); xi[q][2] = *(const f32x4*)(xr + c1); xi[q][3] = *(const f32x4*)(xr + c1 + 4); }
#pragma unroll
            for (int q = 0; q < RB; ++q)
#pragma unroll
                for (int j = 0; j < 4; ++j) { v[q][j] = xi[q][0][j]; v[q][4 + j] = xi[q][1][j]; v[q][8 + j] = xi[q][2][j]; v[q][12 + j] = xi[q][3][j]; }
        } else {
            u32x4 xr[RB][2];
#pragma unroll
            for (int q = 0; q < RB; ++q) { xr[q][0] = *(const u32x4*)(XB + (size_t)(r0 + i0 + q) * D + c0); xr[q][1] = *(const u32x4*)(XB + (size_t)(r0 + i0 + q) * D + c1); }
            if (MODE == 3) {
                int slv = 0; float gkv = 0.f;
                if (lane < 4 * RB) { slv = (int)ldu((const unsigned*)(F.ws + WS_SLOT) + (size_t)(r0 + i0) * 4 + lane); gkv = ldf((const float*)(F.ws + WS_TOPG) + (size_t)(r0 + i0) * 4 + lane); }
                u32x4 yr[RB][4][2]; float gk[RB][4];
#pragma unroll
                for (int q = 0; q < RB; ++q)
#pragma unroll
                    for (int k = 0; k < 4; ++k) { const int sl = __shfl(slv, q * 4 + k); gk[q][k] = __shfl(gkv, q * 4 + k);
                        yr[q][k][0] = __builtin_nontemporal_load((const u32x4*)(Y + (size_t)sl * D + c0)); yr[q][k][1] = __builtin_nontemporal_load((const u32x4*)(Y + (size_t)sl * D + c1)); }
#pragma unroll
                for (int q = 0; q < RB; ++q) { float xv[16]; unpack8(xr[q][0], xv); unpack8(xr[q][1], xv + 8);
#pragma unroll
                    for (int j = 0; j < 16; ++j) v[q][j] = DN_ALPHA * xv[j];
#pragma unroll
                    for (int k = 0; k < 4; ++k) { float yv[16]; unpack8(yr[q][k][0], yv); unpack8(yr[q][k][1], yv + 8);
#pragma unroll
                        for (int j = 0; j < 16; ++j) v[q][j] += gk[q][k] * yv[j]; } }
            } else {
                u32x4 hr[RB][2];
#pragma unroll
                for (int q = 0; q < RB; ++q) { hr[q][0] = __builtin_nontemporal_load((const u32x4*)(HB + (size_t)(r0 + i0 + q) * D + c0)); hr[q][1] = __builtin_nontemporal_load((const u32x4*)(HB + (size_t)(r0 + i0 + q) * D + c1)); }
#pragma unroll
                for (int q = 0; q < RB; ++q) { float xv[16], hv[16]; unpack8(xr[q][0], xv); unpack8(xr[q][1], xv + 8); unpack8(hr[q][0], hv); unpack8(hr[q][1], hv + 8);
#pragma unroll
                    for (int j = 0; j < 16; ++j) v[q][j] = DN_ALPHA * xv[j] + hv[j]; }
            }
            float sm[RB];
#pragma unroll
            for (int q = 0; q < RB; ++q) { float t = 0.f;
#pragma unroll
                for (int j = 0; j < 16; ++j) t += v[q][j];
                sm[q] = t; }
#pragma unroll
            for (int o = 1; o < 64; o <<= 1)
#pragma unroll
                for (int q = 0; q < RB; ++q) sm[q] += __shfl_xor(sm[q], o);
            float sq[RB];
#pragma unroll
            for (int q = 0; q < RB; ++q) { const float mean = sm[q] * (1.f / D); float t = 0.f;
#pragma unroll
                for (int j = 0; j < 16; ++j) { v[q][j] -= mean; t += v[q][j] * v[q][j]; }
                sq[q] = t; }
#pragma unroll
            for (int o = 1; o < 64; o <<= 1)
#pragma unroll
                for (int q = 0; q < RB; ++q) sq[q] += __shfl_xor(sq[q], o);
#pragma unroll
            for (int q = 0; q < RB; ++q) { const float rstd = rsqrtf(sq[q] * (1.f / D) + 1e-5f);
#pragma unroll
                for (int j = 0; j < 16; ++j) v[q][j] = v[q][j] * rstd * g[j] + bb[j]; }
        }
#pragma unroll
        for (int q = 0; q < RB; ++q) { const int r = r0 + i0 + q;
            if (MODE == 3 && l == NL - 1) {
                float* orow = (float*)inp(F, 27) + (size_t)r * D;
                *(f32x4*)(orow + c0) = (f32x4){v[q][0], v[q][1], v[q][2], v[q][3]}; *(f32x4*)(orow + c0 + 4) = (f32x4){v[q][4], v[q][5], v[q][6], v[q][7]};
                *(f32x4*)(orow + c1) = (f32x4){v[q][8], v[q][9], v[q][10], v[q][11]}; *(f32x4*)(orow + c1 + 4) = (f32x4){v[q][12], v[q][13], v[q][14], v[q][15]};
            } else {
                *(u32x4*)(XBo + (size_t)r * D + c0) = pack8(v[q]); *(u32x4*)(XBo + (size_t)r * D + c1) = pack8(v[q] + 8);
            } }
    }
    if (MODE == 1 || (MODE == 3 && l == NL - 1)) return;
#ifdef DBG_NOROUTER
    if (MODE == 2) return;
#endif
    VM_WAIT(); __syncthreads(); PROF_RP(0); asm volatile("" ::: "memory");
    const bf16* arow = XBo + (size_t)(r0 + (lane & 15)) * D + 8 * (lane >> 4);
    f32x4 acc[N16];
#pragma unroll
    for (int n = 0; n < N16; ++n) acc[n] = (f32x4){0.f, 0.f, 0.f, 0.f};
#pragma unroll 8
    for (int ks = 0; ks < 32; ++ks) {
        const bf16x8 af = *(const bf16x8*)(arow + 32 * ks);
#pragma unroll
        for (int n = 0; n < N16; ++n) {
            const bf16x8 bh = *(const LAS bf16x8*)(F.lds + ((ks * N16 + n) * 2 + 0) * 1024 + lane * 16), bl = *(const LAS bf16x8*)(F.lds + ((ks * N16 + n) * 2 + 1) * 1024 + lane * 16);
            acc[n] = MFMA16(af, bh, acc[n]); acc[n] = MFMA16(af, bl, acc[n]);
        }
    }
    if (MODE != 2) {
        float* G = dummy ? (float*)(F.ws + WS_XG + 160 * MiB) : (float*)(F.ws + WS_GATES);
#pragma unroll
        for (int i = 0; i < 4; ++i) G[(size_t)(r0 + 4 * (lane >> 4) + i) * 16 + (lane & 15)] = acc[0][i];
        return;
    }
    if (MODE == 2) {
        if ((PROF_MASK) >> 23) __syncthreads(); PROF_RP(1);
        LAS float* LG = (LAS float*)(F.lds + 131072 + F.wave * 2176);
#pragma unroll
        for (int n = 0; n < N16; ++n)
#pragma unroll
            for (int i = 0; i < 4; ++i) LG[(4 * (lane >> 4) + i) * 33 + n * 16 + (lane & 15)] = acc[n][i];
        LDS_WAIT(); asm volatile("" ::: "memory");
        int te[4] = {0, 0, 0, 0}; float tv[4] = {0.f, 0.f, 0.f, 0.f}; unsigned rk[4] = {0u, 0u, 0u, 0u};
        if (lane < 16) {
            float lg[32]; const float* rb = inp(F, 20) + (size_t)l * 32;
#pragma unroll
            for (int e = 0; e < 32; ++e) lg[e] = LG[lane * 33 + e] + rb[e];
#pragma unroll
            for (int k = 0; k < 4; ++k) {
                float best = -3.0e38f; int bi = 0;
#pragma unroll
                for (int e = 0; e < 32; ++e) { const bool gt = lg[e] > best; best = gt ? lg[e] : best; bi = gt ? e : bi; }
                te[k] = bi; tv[k] = best;
#pragma unroll
                for (int e = 0; e < 32; ++e) lg[e] = (e == bi) ? -3.0e38f : lg[e];
            }
            const float e1 = __expf(tv[1] - tv[0]), e2 = __expf(tv[2] - tv[0]), e3 = __expf(tv[3] - tv[0]); const float inv = 1.f / (1.f + e1 + e2 + e3);
            tv[0] = inv; tv[1] = e1 * inv; tv[2] = e2 * inv; tv[3] = e3 * inv;
#pragma unroll
            for (int k = 0; k < 4; ++k) rk[k] = __hip_atomic_fetch_add(ecnt + (dummy ? 40 : 0) + te[k], 1u, __ATOMIC_RELAXED, __HIP_MEMORY_SCOPE_WORKGROUP);
        }
        __syncthreads(); PROF_RP(2);
        if (F.tid < 32 && !dummy) ecnt[32 + F.tid] = __hip_atomic_fetch_add(F.ctl + CW_ECNT + (l * 32 + F.tid) * 64, ecnt[F.tid], __ATOMIC_RELAXED, __HIP_MEMORY_SCOPE_AGENT);
        __syncthreads();
        if (lane < 16 && !dummy) {
            const int r = r0 + lane; int* pe = (int*)(F.ws + WS_TOPE) + (size_t)r * 4; int* pp = (int*)(F.ws + WS_TOPP) + (size_t)r * 4; float* pg = (float*)(F.ws + WS_TOPG) + (size_t)r * 4;
#pragma unroll
            for (int k = 0; k < 4; ++k) { pe[k] = te[k]; pp[k] = (int)(ecnt[32 + te[k]] + rk[k]); pg[k] = tv[k]; }
        }
        if ((PROF_MASK) >> 23) { VM_WAIT(); __syncthreads(); } PROF_RP(3);
    }
}

DI void phase_scatter(Ctx& F, int l) {
    LAS int* ts = (LAS int*)(F.lds + LDS_MISC + 512);
    if (F.tid < 64) {
        const int lane = F.tid; const int nt_ = (lane < 32) ? (int)((ldu(F.ctl + CW_ECNT + (l * 32 + lane) * 64) + 255u) >> 8) : 0;
        int inc = nt_;
#pragma unroll
        for (int o = 1; o < 32; o <<= 1) { const int t_ = __shfl_up(inc, o); inc += (lane >= o) ? t_ : 0; }
        if (lane < 32) ts[lane] = inc - nt_;
        if (lane == 31) ts[32] = inc; }
    __syncthreads();
    if (blockIdx.x == 0) {
        if (F.tid == 0) __hip_atomic_store(F.ctl + CW_NT + l, (unsigned)ts[32], __ATOMIC_RELAXED, __HIP_MEMORY_SCOPE_AGENT);
        for (int t = F.tid; t < ts[32]; t += NTHREADS) { int e = 0; while (e < 31 && t >= ts[e + 1]) ++e; F.ctl[CW_TILE_E + l * MAXTILES + t] = (unsigned)e; }
    }
    { const int r = F.vcu * 128 + (F.tid >> 2), k = F.tid & 3;
      const int e = ((const int*)(F.ws + WS_TOPE))[(size_t)r * 4 + k], p = ((const int*)(F.ws + WS_TOPP))[(size_t)r * 4 + k];
      const int slot = ts[e] * 256 + p;
      ((int*)(F.ws + WS_SLOT))[(size_t)r * 4 + k] = slot; ((unsigned*)(F.ws + WS_XG))[slot] = (unsigned)r; }
}
struct MoeOrder {
    const char* A; const char* B; char* C; const unsigned* tile_e; int NT, nN; size_t bE, bN, cN; int G, c0, gather, rev;
    DI bool next(int i, g8::Unit& u) const {
        const int L = i * G + c0; if (L >= NT * nN) return false;
        int pm, pn; g8::tile_of(L, NT, nN, pm, pn); if (rev) pm = NT - 1 - pm;
        const int e = __builtin_amdgcn_readfirstlane((int)ldu(tile_e + pm));
        u.pm = pm; u.pn = pn; u.aux = e; u.a = gather ? A : A + (size_t)pm * 256 * 2048; u.b = B + (size_t)e * bE + (size_t)pn * bN; u.c = C + (size_t)pm * 256 * 2048 + (size_t)pn * cN; return true;
    }
};

DI unsigned lds_addr(const LAS void* p) { return (unsigned)(size_t)p; }
DI bf16x8 tr_frag8(unsigned img, int ld_bytes, int row_lo, int row_hi, int m0, int lane) {
    const int i = lane & 15; const unsigned a_lo = img + (unsigned)((row_lo + (i >> 2)) * ld_bytes + (m0 + 4 * (i & 3)) * 2), a_hi = img + (unsigned)((row_hi + (i >> 2)) * ld_bytes + (m0 + 4 * (i & 3)) * 2);
    s16x4 lo, hi;
    asm volatile("ds_read_b64_tr_b16 %0, %2\n\tds_read_b64_tr_b16 %1, %3\n\ts_waitcnt lgkmcnt(0)" : "=&v"(lo), "=&v"(hi) : "v"(a_lo), "v"(a_hi) : "memory");
    return __builtin_shufflevector(lo, hi, 0, 1, 2, 3, 4, 5, 6, 7);
}
DI s16x4 tr_read4(unsigned addr) { s16x4 r; asm volatile("ds_read_b64_tr_b16 %0, %1\n\ts_waitcnt lgkmcnt(0)" : "=&v"(r) : "v"(addr) : "memory"); return r; }
DI bf16x8 pack_frag(const f32x4 a, const f32x4 b) {
    u32x4 p; p.x = cvt_pk_bf16(a[0], a[1]); p.y = cvt_pk_bf16(a[2], a[3]); p.z = cvt_pk_bf16(b[0], b[1]); p.w = cvt_pk_bf16(b[2], b[3]); return __builtin_bit_cast(bf16x8, p);
}
DI u32x2 pack4(const f32x4 a) { u32x2 p; p.x = cvt_pk_bf16(a[0], a[1]); p.y = cvt_pk_bf16(a[2], a[3]); return p; }
DI f32x4 unpack4(const u32x2 w) { return (f32x4){bflo(w.x), bfhi(w.x), bflo(w.y), bfhi(w.y)}; }
DI float softcap15(float x) { const float y = x * (1.f / 15.f); const float e = __expf(2.f * y); return 15.f * (1.f - 2.f * __builtin_amdgcn_rcpf(e + 1.f)); }
DI float log_sigmoid(float x) { return fminf(x, 0.f) - log1pf(__expf(-fabsf(x))); }
DI float softplusf_(float x) { return fmaxf(x, 0.f) + log1pf(__expf(-fabsf(x))); }
DI float wave_incl_sum(float v, int lane) {
#pragma unroll
    for (int o = 1; o < 64; o <<= 1) { const float t = __shfl_up(v, o); v += (lane >= o) ? t : 0.f; }
    return v;
}
DI float wave_incl_max(float v, int lane) {
#pragma unroll
    for (int o = 1; o < 64; o <<= 1) { const float t = __shfl_up(v, o); v = (lane >= o) ? fmaxf(v, t) : v; }
    return v;
}
constexpr int GA_QH = 0, GA_KH = 17408, GA_VB = 34816, GA_KB = 52224, GA_NA = 69632, GA_AD = 78848, GA_TI = 82944, GA_GC = 84992, GA_KEI = 86016;
constexpr int LDI = 136 * 2;
constexpr int LDK = 72 * 2;

#define DMA16(src, dst) __builtin_amdgcn_global_load_lds((const unsigned*)(src), (LAS unsigned*)(dst), 16, 0, 0)
#define DMA16NT(src, dst) __builtin_amdgcn_global_load_lds((const unsigned*)(src), (LAS unsigned*)(dst), 16, 0, 2)
DI u32x2 gld8(const void* p) { u32x2 r; asm volatile("global_load_dwordx2 %0, %1, off" : "=v"(r) : "v"(p) : "memory"); return r; }
DI float gld4(const void* p) { float r; asm volatile("global_load_dword %0, %1, off" : "=v"(r) : "v"(p) : "memory"); return r; }
DI u32x4 gld16(const void* p) { u32x4 r; asm volatile("global_load_dwordx4 %0, %1, off nt" : "=v"(r) : "v"(p) : "memory"); return r; }
struct MlAPre { u32x4 kraw, vraw[2]; float gi, gf; };
#define PROF_SUB(k) do { if ((PROF_MASK) >> 16) { if (blockIdx.x == 0 && threadIdx.x == 0) { volatile LAS unsigned long long* pw = (volatile LAS unsigned long long*)(F.lds + LDS_MISC + 128); \
        const unsigned long long now_ = __builtin_amdgcn_s_memrealtime(); if (((PROF_MASK) >> (16 + (k))) & 1) pw[1] += now_ - pw[3]; pw[3] = now_; } } } while (0)
DI void ml_a_fetch(Ctx& F, int cid, MlAPre& P) {
    const int b = cid >> 8, h = (cid >> 6) & 3, n = cid & 63, t0 = b * SEQ + n * CH, tid = F.tid, lane = F.lane;
    const bf16* PROJ = (const bf16*)(F.ws + WS_PROJ); const float* GT = (const float*)(F.ws + WS_GATES);
    P.kraw = gld16(PROJ + (size_t)(t0 + (tid >> 3)) * NPROJ + 256 + h * 64 + (tid & 7) * 8);
#pragma unroll
    for (int q = 0; q < 2; ++q) { const int idx = tid + 512 * q; P.vraw[q] = gld16(PROJ + (size_t)(t0 + (idx >> 4)) * NPROJ + 512 + h * 128 + (idx & 15) * 8); }
    P.gi = gld4(GT + (size_t)(t0 + lane) * 16 + h); P.gf = gld4(GT + (size_t)(t0 + lane) * 16 + 4 + h);
}
DI void ml_a_unit(Ctx& F, int l, int cid, int par, MlAPre& P, float bi, float bf_, float& gb, float& ga, float nalog, float dtb) {
    int tid = F.tid; asm volatile("" : "+v"(tid)); const int lane = tid & 63;
    LAS unsigned char* KE = F.lds + par * 45056; LAS unsigned char* VI = KE + 16384; LAS float* es = (LAS float*)(KE + 40960);
    asm volatile("s_waitcnt vmcnt(7)" : "+v"(P.kraw), "+v"(P.vraw[0]), "+v"(P.vraw[1]), "+v"(P.gi), "+v"(P.gf), "+v"(gb), "+v"(ga) :: "memory");
    const int ks_ = tid >> 3, kc8 = (tid & 7) * 8;
    const u32x4 kraw = P.kraw; const u32x4 vraw[2] = {P.vraw[0], P.vraw[1]};
    if (F.wave == 7) {
        const float ip = softcap15(P.gi + bi), fp = softcap15(P.gf + bf_);
        const float bc = wave_incl_sum(log_sigmoid(fp), lane), blast = __shfl(bc, 63), lw = blast - bc + ip, amax = wave_max(lw);
        es[lane] = __expf(lw - amax);
        if (lane == 0) { float* sc = (float*)(F.ws + WS_MLSC) + (size_t)cid * 4; sc[0] = blast; sc[1] = amax; }
    }
    if (F.wave == 6) {
        LAS float* gcs = (LAS float*)(F.lds + GA_GC); LAS float* bts = gcs + 64;
        const float beta = sigmoidf_(gb), gg = nalog * softplusf_(ga + dtb), gc = wave_incl_sum(gg, lane);
        gcs[lane] = gc; bts[lane] = beta;
        if (lane == 63) ((float*)(F.ws + WS_GDGL))[cid] = __expf(gc);
    }
#pragma unroll
    for (int q = 0; q < 2; ++q) { const int idx = tid + 512 * q, s_ = idx >> 4, c8 = (idx & 15) * 8; *(LAS u32x4*)(VI + s_ * LDI + c8 * 2) = vraw[q]; }
    __syncthreads();
    { float v[8]; unpack8(kraw, v); const float e = es[ks_];
#pragma unroll
      for (int j = 0; j < 8; ++j) v[j] *= e;
      *(LAS u32x4*)(KE + ks_ * LDK + kc8 * 2) = pack8(v); }
    __syncthreads();
    { const int g = lane >> 4, w = F.wave, ln = lane & 15; f32x4 acc[4], kacc[4];
#pragma unroll
      for (int nt = 0; nt < 4; ++nt) { acc[nt] = (f32x4){0.f, 0.f, 0.f, 0.f}; kacc[nt] = (f32x4){0.f, 0.f, 0.f, 0.f}; }
      const bf16x8 ones = (ln == 0) ? (bf16x8){0x3f80, 0x3f80, 0x3f80, 0x3f80, 0x3f80, 0x3f80, 0x3f80, 0x3f80} : (bf16x8){0, 0, 0, 0, 0, 0, 0, 0};
#pragma unroll
      for (int ks = 0; ks < 2; ++ks) { const int rb = 32 * ks + 8 * g;
          const bf16x8 af = tr_frag8(lds_addr(VI), LDI, rb, rb + 4, 16 * w, lane);
#pragma unroll
          for (int nt = 0; nt < 4; ++nt) { const bf16x8 bf = tr_frag8(lds_addr(KE), LDK, rb, rb + 4, 16 * nt, lane); acc[nt] = MFMA16(bf, af, acc[nt]);
              if (w == 0) kacc[nt] = MFMA16(ones, bf, kacc[nt]); } }
      bf16* U = (bf16*)(F.ws + WS_MLU) + (size_t)cid * 8192;
#pragma unroll
      for (int nt = 0; nt < 4; ++nt)
          *(u32x2*)(U + (w * 2 + (nt >> 1)) * 512 + ((2 * (nt & 1) + (g >> 1)) * 16 + ln) * 8 + 4 * (g & 1)) = pack4(acc[nt]);
      if (w == 0 && g == 0) {
#pragma unroll
          for (int nt = 0; nt < 4; ++nt) ((float*)(F.ws + WS_MLKN))[(size_t)cid * 64 + 16 * nt + ln] = kacc[nt][0]; }
    }
}
struct MlBBatch { u32x2 ub[8]; float kv[8]; u32x2 sc; };
DI void ml_b_fetch(const bf16* U, const float* SC, const float* KN, size_t cid0, int e0, int t, bool dn, MlBBatch& B) {
#pragma unroll
    for (int q = 0; q < 8; ++q) { const size_t cid = cid0 + q;
        B.ub[q] = gld8(U + cid * 8192 + e0);
        B.kv[q] = 0.f; if (dn) asm volatile("global_load_dword %0, %1, off" : "+v"(B.kv[q]) : "v"(KN + cid * 64 + t) : "memory"); }
    B.sc = gld8(SC + (cid0 + (t & 7)) * 4);
}
DI void ml_b_compute(const MlBBatch& B, bf16* CT, float* NP, float* MP, size_t cid0, int e0, int t, int p, bool dn, f32x4& C, float& nv, float& m) {
#pragma unroll
    for (int q = 0; q < 8; ++q) { const size_t cid = cid0 + q;
        *(u32x2*)(CT + cid * 8192 + e0) = pack4(C);
        if (dn) NP[cid * 64 + t] = nv; if (p == 0 && t == 0) MP[cid] = m;
        const float blq = __uint_as_float(__builtin_amdgcn_readlane(B.sc.x, q)), amq = __uint_as_float(__builtin_amdgcn_readlane(B.sc.y, q));
        const float mn = fmaxf(blq + m, amq), d1 = __expf(blq + m - mn), d2 = __expf(amq - mn);
        const f32x4 uv = unpack4(B.ub[q]);
#pragma unroll
        for (int k = 0; k < 4; ++k) C[k] = d1 * C[k] + d2 * uv[k];
        nv = d1 * nv + d2 * (dn ? B.kv[q] : 0.f); m = mn; }
}
#define MLB_TIE(B) do { _Pragma("unroll") for (int q_ = 0; q_ < 8; ++q_) asm volatile("" : "+v"(B.ub[q_]), "+v"(B.kv[q_])); asm volatile("" : "+v"(B.sc)); } while (0)
DI void ml_b_unit(Ctx& F, int u) {
    const int bh = u >> 3, p = u & 7, t = F.tid - 256, e0 = p * 1024 + 4 * t;
    const bf16* U = (const bf16*)(F.ws + WS_MLU); const float* SC = (const float*)(F.ws + WS_MLSC); const float* KN = (const float*)(F.ws + WS_MLKN);
    bf16* CT = (bf16*)(F.ws + WS_MLCT); float* NP = (float*)(F.ws + WS_MLNP); float* MP = (float*)(F.ws + WS_MLMP);
    f32x4 C = (f32x4){0.f, 0.f, 0.f, 0.f}; float nv = 0.f, m = 0.f; const bool dn = (p == 0 && t < 64);
    const size_t c0 = (size_t)bh * 64;
    MlBBatch A, B;
    ml_b_fetch(U, SC, KN, c0, e0, t, dn, A);
#pragma unroll
    for (int nb = 0; nb < 8; nb += 2) {
        ml_b_fetch(U, SC, KN, c0 + 8 * (nb + 1), e0, t, dn, B); asm volatile("s_waitcnt vmcnt(9)" ::: "memory"); MLB_TIE(A);
        ml_b_compute(A, CT, NP, MP, c0 + 8 * nb, e0, t, p, dn, C, nv, m);
        if (nb + 2 < 8) { ml_b_fetch(U, SC, KN, c0 + 8 * (nb + 2), e0, t, dn, A); asm volatile("s_waitcnt vmcnt(9)" ::: "memory"); } else asm volatile("s_waitcnt vmcnt(0)" ::: "memory");
        MLB_TIE(B);
        ml_b_compute(B, CT, NP, MP, c0 + 8 * (nb + 1), e0, t, p, dn, C, nv, m);
    }
}
DI void ml_c_unit(Ctx& F, const Args& a, int l, int cid, int par) {
    const int b = cid >> 8, h = (cid >> 6) & 3, n = cid & 63, t0 = b * SEQ + n * CH, lane = F.lane, tid = F.tid, g = lane >> 4, ln = lane & 15, w = F.wave, tt = w & 3, dh = w >> 2;
    const bf16* PROJ = (const bf16*)(F.ws + WS_PROJ); const float* GT = (const float*)(F.ws + WS_GATES);
    LAS unsigned char* VI = F.lds + par * 24576; LAS float* ib = (LAS float*)(VI + 20480); LAS float* Mt = ib + 64; LAS float* bcs = ib + 128; LAS float* ss = ib + 192;
    const float mprev = ldf((const float*)(F.ws + WS_MLMP) + cid);
    const bf16* CT = (const bf16*)(F.ws + WS_MLCT) + (size_t)cid * 8192; const float* NPv = (const float*)(F.ws + WS_MLNP) + (size_t)cid * 64;
    const int tl = 16 * tt + ln;
    bf16x8 qf[2], kf[4][2], ctf[5][2]; u32x2 ogr[4]; f32x4 nwr[4]; u32x4 vraw[2];
#pragma unroll
    for (int ks = 0; ks < 2; ++ks) { qf[ks] = *(const bf16x8*)(PROJ + (size_t)(t0 + tl) * NPROJ + h * 64 + 32 * ks + 8 * g);
#pragma unroll
        for (int ms = 0; ms < 4; ++ms) kf[ms][ks] = *(const bf16x8*)(PROJ + (size_t)(t0 + 16 * ms + ln) * NPROJ + 256 + h * 64 + 32 * ks + 8 * g);
#pragma unroll
        for (int mt = 0; mt < 4; ++mt) ctf[mt][ks] = *(const bf16x8*)(CT + (size_t)(16 * (4 * dh + mt) + ln) * 64 + 32 * ks + 8 * g);
        const f32x4 n0 = *(const f32x4*)(NPv + 32 * ks + 8 * g), n1 = *(const f32x4*)(NPv + 32 * ks + 8 * g + 4);
        float nvv[8];
#pragma unroll
        for (int j = 0; j < 4; ++j) { nvv[j] = (ln == 0) ? n0[j] : 0.f; nvv[4 + j] = (ln == 0) ? n1[j] : 0.f; }
        ctf[4][ks] = __builtin_bit_cast(bf16x8, pack8(nvv)); }
#pragma unroll
    for (int mt = 0; mt < 4; ++mt) { const int dv = 16 * (4 * dh + mt) + 4 * g;
        nwr[mt] = *(const f32x4*)(inp(F, 5) + (size_t)l * 512 + h * 128 + dv); ogr[mt] = *(const u32x2*)(PROJ + (size_t)(t0 + tl) * NPROJ + 1024 + h * 128 + dv); }
#pragma unroll
    for (int q = 0; q < 2; ++q) { const int idx = tid + 512 * q, s_ = idx >> 4, c8 = (idx & 15) * 8; vraw[q] = *(const u32x4*)(PROJ + (size_t)(t0 + s_) * NPROJ + 512 + h * 128 + c8); }
    if (w == 7) {
        const float ip = softcap15(GT[(size_t)(t0 + lane) * 16 + h] + inp(F, 3)[l * 4 + h]), fp = softcap15(GT[(size_t)(t0 + lane) * 16 + 4 + h] + inp(F, 4)[l * 4 + h]);
        const float bc = wave_incl_sum(log_sigmoid(fp), lane), ibs = ip - bc, pm = wave_incl_max(ibs, lane);
        ib[lane] = ibs; Mt[lane] = fmaxf(mprev, pm); bcs[lane] = bc;
    }
#pragma unroll
    for (int q = 0; q < 2; ++q) { const int idx = tid + 512 * q, s_ = idx >> 4, c8 = (idx & 15) * 8; *(LAS u32x4*)(VI + s_ * LDI + c8 * 2) = vraw[q]; }
    __syncthreads();
    f32x4 sacc[4];
#pragma unroll
    for (int ms = 0; ms < 4; ++ms) { sacc[ms] = (f32x4){0.f, 0.f, 0.f, 0.f};
#pragma unroll
        for (int ks = 0; ks < 2; ++ks) sacc[ms] = MFMA16(kf[ms][ks], qf[ks], sacc[ms]); }
    const float Mtt = Mt[tl];
#pragma unroll
    for (int ms = 0; ms < 4; ++ms) { const f32x4 ibv = *(const LAS f32x4*)(ib + 16 * ms + 4 * g);
#pragma unroll
        for (int i = 0; i < 4; ++i) { const int s = 16 * ms + 4 * g + i; sacc[ms][i] = (s <= tl) ? sacc[ms][i] * 0.125f * __expf(ibv[i] - Mtt) : 0.f; } }
    bf16x8 sb[2]; sb[0] = pack_frag(sacc[0], sacc[1]); sb[1] = pack_frag(sacc[2], sacc[3]);
    f32x4 xacc[5];
#pragma unroll
    for (int mt = 0; mt < 5; ++mt) { xacc[mt] = (f32x4){0.f, 0.f, 0.f, 0.f};
#pragma unroll
        for (int ks = 0; ks < 2; ++ks) xacc[mt] = MFMA16(ctf[mt][ks], qf[ks], xacc[mt]); }
    const float wint = 0.125f * __expf(mprev - Mtt);
#pragma unroll
    for (int mt = 0; mt < 5; ++mt) xacc[mt] *= wint;
    const bf16x8 ones = (ln == 0) ? (bf16x8){0x3f80, 0x3f80, 0x3f80, 0x3f80, 0x3f80, 0x3f80, 0x3f80, 0x3f80} : (bf16x8){0, 0, 0, 0, 0, 0, 0, 0};
#pragma unroll
    for (int kk = 0; kk < 2; ++kk) {
#pragma unroll
        for (int mt = 0; mt < 4; ++mt) { const bf16x8 vf = tr_frag8(lds_addr(VI), LDI, 32 * kk + 4 * g, 32 * kk + 16 + 4 * g, 16 * (4 * dh + mt), lane); xacc[mt] = MFMA16(vf, sb[kk], xacc[mt]); }
        xacc[4] = MFMA16(ones, sb[kk], xacc[4]);
    }
    const float den = __shfl(xacc[4][0], ln), mt_ = bcs[tl] + Mtt, dinv = __builtin_amdgcn_rcpf(fmaxf(fabsf(den), __expf(-mt_)));
    float ssq = 0.f;
#pragma unroll
    for (int mt = 0; mt < 4; ++mt) { xacc[mt] *= dinv; ssq += (xacc[mt][0] * xacc[mt][0] + xacc[mt][1] * xacc[mt][1]) + (xacc[mt][2] * xacc[mt][2] + xacc[mt][3] * xacc[mt][3]); }
    ssq += __shfl_xor(ssq, 16); ssq += __shfl_xor(ssq, 32);
    if (g == 0) ss[tl * 2 + dh] = ssq;
    __syncthreads();
    const float rinv = rsqrtf((ss[tl * 2] + ss[tl * 2 + 1]) * (1.f / 128.f) + 1e-6f);
    bf16* MX = (bf16*)(F.ws + WS_MIXED);
#pragma unroll
    for (int mt = 0; mt < 4; ++mt) { const int dv = 16 * (4 * dh + mt) + 4 * g;
        const f32x4 nw = nwr[mt]; const f32x4 og = unpack4(ogr[mt]);
        f32x4 o;
#pragma unroll
        for (int i = 0; i < 4; ++i) o[i] = xacc[mt][i] * rinv * nw[i] * sigmoidf_(og[i]);
        *(u32x2*)(MX + (size_t)(t0 + tl) * D + h * 128 + dv) = pack4(o); }
}

constexpr int GA_WT = 155648;
constexpr int GA_ST = 103424;
DI void gd_a_issue(Ctx& F, int cid, int w, int lane) {
    const int b = cid >> 8, h = (cid >> 6) & 3, n = cid & 63, t0 = b * SEQ + n * CH;
    const bf16* PROJ = (const bf16*)(F.ws + WS_PROJ);
#pragma unroll
    for (int q = 0; q < 7; ++q) { const int jj = (w + 8 * q) % 51, ten = jj / 17, grp = jj % 17;
        DMA16NT(PROJ + ((long)t0 - 3 + 4 * grp + (lane >> 4)) * NPROJ + 1536 + ten * 512 + h * 128 + 8 * (lane & 15), F.lds + GA_ST + ten * 17408 + grp * 1024); }
}
DI void gd_a_unit(Ctx& F, int l, int cid, float& gb, float& ga, float nalog, float dtb, bool has_next, MlAPre& P) {
    int tid = F.tid; asm volatile("" : "+v"(tid));
    const int b = cid >> 8, h = (cid >> 6) & 3, n = cid & 63, t0 = b * SEQ + n * CH, lane = tid & 63, g = lane >> 4, ln = lane & 15, w = F.wave;
    const float* GT = (const float*)(F.ws + WS_GATES);
    LAS unsigned char* L = F.lds; LAS float* gcs = (LAS float*)(L + GA_GC); LAS float* bts = gcs + 64;
    const int ten = tid >> 7, tg = (tid >> 4) & 7, cg = tid & 15;
    asm volatile("s_waitcnt vmcnt(0)" ::: "memory");
    __syncthreads();
    u32x4 raw[11];
    if (ten < 3) { const unsigned sa = lds_addr(L) + GA_ST + ten * 17408 + (8 * tg) * 256 + cg * 16;
        asm volatile("ds_read_b128 %0, %11\n\tds_read_b128 %1, %11 offset:256\n\tds_read_b128 %2, %11 offset:512\n\tds_read_b128 %3, %11 offset:768\n\tds_read_b128 %4, %11 offset:1024\n\tds_read_b128 %5, %11 offset:1280\n\t"
                     "ds_read_b128 %6, %11 offset:1536\n\tds_read_b128 %7, %11 offset:1792\n\tds_read_b128 %8, %11 offset:2048\n\tds_read_b128 %9, %11 offset:2304\n\tds_read_b128 %10, %11 offset:2560\n\ts_waitcnt lgkmcnt(0)"
                     : "=&v"(raw[0]), "=&v"(raw[1]), "=&v"(raw[2]), "=&v"(raw[3]), "=&v"(raw[4]), "=&v"(raw[5]), "=&v"(raw[6]), "=&v"(raw[7]), "=&v"(raw[8]), "=&v"(raw[9]), "=&v"(raw[10]) : "v"(sa) : "memory");
        if (n == 0 && tg == 0) { raw[0] = (u32x4){0u, 0u, 0u, 0u}; raw[1] = raw[0]; raw[2] = raw[0]; }
    }
    float wv[4][8];
#pragma unroll
    for (int j = 0; j < 4; ++j) unpack8(*(const LAS u32x4*)(L + GA_WT + (((ten < 3 ? ten : 0) * 4 + j) * 128 + 8 * cg) * 2), wv[j]);
    const float glast = gcs[63];
    bf16* qgb = (bf16*)(F.ws + WS_GDQG) + (size_t)cid * 8192 + (8 * tg) * 128 + 8 * cg; asm volatile("" : "+v"(qgb));
    if (ten < 3) {
#pragma unroll
        for (int i = 0; i < 8; ++i) { const int t = 8 * tg + i; float y[8];
#pragma unroll
            for (int c = 0; c < 8; ++c) y[c] = 0.f;
#pragma unroll
            for (int j = 0; j < 4; ++j) { float xv[8]; unpack8(raw[i + j], xv);
#pragma unroll
                for (int c = 0; c < 8; ++c) y[c] += wv[j][c] * xv[c]; }
#pragma unroll
            for (int c = 0; c < 8; ++c) y[c] = y[c] * sigmoidf_(y[c]);
            const float gct = gcs[t], bt = bts[t];
            if (ten < 2) { float s2 = 0.f;
#pragma unroll
                for (int c = 0; c < 8; ++c) s2 += y[c] * y[c];
                s2 += __shfl_xor(s2, 1); s2 += __shfl_xor(s2, 2); s2 += __shfl_xor(s2, 4); s2 += __shfl_xor(s2, 8);
                const float rn = rsqrtf(s2 + 1e-6f) * (ten == 0 ? 0.08838834764831845f : 1.f);
#pragma unroll
                for (int c = 0; c < 8; ++c) y[c] *= rn; }
            float z[8];
            if (ten == 0) { *(LAS u32x4*)(L + GA_QH + t * LDI + 16 * cg) = pack8(y); const float e = __expf(gct);
#pragma unroll
                for (int c = 0; c < 8; ++c) z[c] = y[c] * e;
                *(u32x4*)(qgb + i * 128) = pack8(z); }
            else if (ten == 1) { *(LAS u32x4*)(L + GA_KH + t * LDI + 16 * cg) = pack8(y); const float e1 = bt * __expf(gct), e2 = __expf(glast - gct);
#pragma unroll
                for (int c = 0; c < 8; ++c) z[c] = y[c] * e1;
                *(LAS u32x4*)(L + GA_KB + t * LDI + 16 * cg) = pack8(z);
#pragma unroll
                for (int c = 0; c < 8; ++c) z[c] = y[c] * e2;
                *(LAS u32x4*)(L + GA_KEI + t * LDI + 16 * cg) = pack8(z); }
            else {
#pragma unroll
                for (int c = 0; c < 8; ++c) z[c] = y[c] * bt;
                *(LAS u32x4*)(L + GA_VB + t * LDI + 16 * cg) = pack8(z); }
        }
    }
    __syncthreads(); PROF_SUB(1);
    if (has_next) {
        ml_a_fetch(F, cid + 256, P);
        gb = gld4(GT + (size_t)(t0 + SEQ + lane) * 16 + 8 + h); ga = gld4(GT + (size_t)(t0 + SEQ + lane) * 16 + 12 + h);
        gd_a_issue(F, cid + 256, w, lane); }
    { const int ti = w & 3, kind = w >> 2; const int tl = 16 * ti + ln; const float gct = gcs[tl], bt = bts[tl];
      bf16* QKD = (bf16*)(F.ws + WS_GDQK) + (size_t)cid * 4096;
#pragma unroll
      for (int si = 0; si < 4; ++si) {
          if (si <= ti) {
              f32x4 acc = (f32x4){0.f, 0.f, 0.f, 0.f};
#pragma unroll
              for (int ks = 0; ks < 4; ++ks) { const bf16x8 af = *(const LAS bf16x8*)(L + GA_KH + (16 * si + ln) * LDI + (32 * ks + 8 * g) * 2);
                  const bf16x8 bfr = *(const LAS bf16x8*)(L + (kind ? GA_QH : GA_KH) + tl * LDI + (32 * ks + 8 * g) * 2); acc = MFMA16(af, bfr, acc); }
              const f32x4 gs = *(const LAS f32x4*)(gcs + 16 * si + 4 * g);
              f32x4 v;
#pragma unroll
              for (int i = 0; i < 4; ++i) { const int s = 16 * si + 4 * g + i; const float dec = __expf(gct - gs[i]);
                  v[i] = kind ? ((s <= tl) ? acc[i] * dec : 0.f) : ((s < tl) ? bt * acc[i] * dec : 0.f); }
              if (kind) *(u32x2*)(QKD + (ti * 2 + (si >> 1)) * 512 + ((2 * (si & 1) + (g >> 1)) * 16 + ln) * 8 + (g & 1) * 4) = pack4(v);
              else { *(LAS u32x2*)(L + GA_NA + tl * LDK + (16 * si + 4 * g) * 2) = pack4(-v);
                  if (si == ti) { LAS float* AD = (LAS float*)(L + GA_AD) + ti * 256 + ln * 16 + 4 * g; AD[0] = v[0]; AD[1] = v[1]; AD[2] = v[2]; AD[3] = v[3]; } }
          } else if (kind) *(u32x2*)(QKD + (ti * 2 + (si >> 1)) * 512 + ((2 * (si & 1) + (g >> 1)) * 16 + ln) * 8 + (g & 1) * 4) = (u32x2){0u, 0u};
      } }
    __syncthreads(); PROF_SUB(2);
    if (w == 0) {
        const LAS float* AD = (const LAS float*)(L + GA_AD) + g * 256; float a_[16][16], acc[16];
#pragma unroll
        for (int t = 1; t < 16; ++t)
#pragma unroll
            for (int q = 0; q < 4; ++q) { if (4 * q < t) { const f32x4 r = *(const LAS f32x4*)(AD + t * 16 + 4 * q); a_[t][4 * q] = r[0]; a_[t][4 * q + 1] = r[1]; a_[t][4 * q + 2] = r[2]; a_[t][4 * q + 3] = r[3]; } }
#pragma unroll
        for (int t = 0; t < 16; ++t) acc[t] = (t == ln) ? 1.f : 0.f;
#pragma unroll
        for (int s_ = 0; s_ < 16; ++s_) { const float tc = acc[s_]; *(LAS bf16*)(L + GA_TI + (16 * g + s_) * 32 + ln * 2) = f2bf(tc);
#pragma unroll
            for (int t = s_ + 1; t < 16; ++t) acc[t] -= a_[t][s_] * tc; }
    }
    __syncthreads(); PROF_SUB(3);
    { const int src = (w < 4) ? GA_VB : GA_KB, cb = 32 * (w & 3);
      u32x2 Ub[4][2]; bf16* UT = (bf16*)(F.ws + WS_GDUT) + (size_t)cid * 8192;
#pragma unroll
      for (int i = 0; i < 4; ++i) {
          f32x4 acc[2];
#pragma unroll
          for (int nt = 0; nt < 2; ++nt)
#pragma unroll
              for (int r = 0; r < 4; ++r) acc[nt][r] = bf2f(*(const LAS bf16*)(L + src + (16 * i + 4 * g + r) * LDI + (cb + 16 * nt + ln) * 2));
#pragma unroll
          for (int jp = 0; jp < 2; ++jp) { if (2 * jp < i) {
              const u32x2 alo = *(const LAS u32x2*)(L + GA_NA + (16 * i + ln) * LDK + (32 * jp + 4 * g) * 2);
              const u32x2 ahi = (2 * jp + 1 < i) ? *(const LAS u32x2*)(L + GA_NA + (16 * i + ln) * LDK + (32 * jp + 16 + 4 * g) * 2) : (u32x2){0u, 0u};
              const bf16x8 af = __builtin_bit_cast(bf16x8, (u32x4){alo.x, alo.y, ahi.x, ahi.y});
#pragma unroll
              for (int nt = 0; nt < 2; ++nt) { const u32x2 blo = Ub[2 * jp][nt], bhi = (2 * jp + 1 < i) ? Ub[2 * jp + 1][nt] : (u32x2){0u, 0u};
                  acc[nt] = MFMA16(af, __builtin_bit_cast(bf16x8, (u32x4){blo.x, blo.y, bhi.x, bhi.y}), acc[nt]); } } }
          const u32x2 tlo = *(const LAS u32x2*)(L + GA_TI + (16 * i + ln) * 32 + (4 * g) * 2);
          const bf16x8 tf = __builtin_bit_cast(bf16x8, (u32x4){tlo.x, tlo.y, 0u, 0u});
#pragma unroll
          for (int nt = 0; nt < 2; ++nt) { const u32x2 p = pack4(acc[nt]);
              const f32x4 u = MFMA16(tf, __builtin_bit_cast(bf16x8, (u32x4){p.x, p.y, 0u, 0u}), ((f32x4){0.f, 0.f, 0.f, 0.f}));
              Ub[i][nt] = pack4(u);
              if (w < 4) *(u32x2*)(UT + ((cb >> 4) + nt) * 1024 + i * 256 + lane * 4) = Ub[i][nt];
              else {
#pragma unroll
                  for (int r = 0; r < 4; ++r) *(LAS bf16*)(L + GA_QH + (16 * i + 4 * g + r) * LDI + (cb + 16 * nt + ln) * 2) = f2bf(-u[r]); } }
      } }
    __syncthreads(); PROF_SUB(4);
    { bf16* W = (bf16*)(F.ws + WS_GDW) + (size_t)cid * 8192; bf16* KET = (bf16*)(F.ws + WS_GDKE) + (size_t)cid * 8192;
#pragma unroll
      for (int q = 0; q < 2; ++q) { const int item = tid + 512 * q, f = item >> 6, lp = item & 63, t = 16 * (f >> 2) + (lp & 15), kk = f & 3, gp = lp >> 4;
          const u32x2 lo = *(const LAS u32x2*)(L + GA_QH + t * LDI + (32 * kk + 4 * gp) * 2), hi = *(const LAS u32x2*)(L + GA_QH + t * LDI + (32 * kk + 16 + 4 * gp) * 2);
          *(u32x4*)(W + item * 8) = (u32x4){lo.x, lo.y, hi.x, hi.y}; }
#pragma unroll
      for (int q = 0; q < 4; ++q) { const int rg = 4 * q + g, kk = rg >> 3, idx = rg & 7, pos = 32 * kk + ((idx < 4) ? 8 * idx : 8 * (idx - 4) + 4);
          const int trow = 32 * kk + ((idx < 4) ? 4 * idx : 16 + 4 * (idx - 4));
          const s16x4 v = tr_read4(lds_addr(L + GA_KEI) + (unsigned)((trow + (ln >> 2)) * LDI + (16 * w + 4 * (ln & 3)) * 2));
          *(s16x4*)(KET + (w * 2 + kk) * 512 + ((idx & 3) * 16 + ln) * 8 + ((idx < 4) ? 0 : 4)) = v; }
    }
    __syncthreads(); PROF_SUB(5);
}
constexpr int GB_STAGE = 36864;
DI void gd_b_issue(const bf16* W, const bf16* KET, const bf16* UT, size_t cid, int dv0, int ln, int g, LAS unsigned char* buf) {
#pragma unroll
    for (int mt = 0; mt < 4; ++mt)
#pragma unroll
        for (int kk = 0; kk < 4; ++kk) __builtin_amdgcn_global_load_lds((const unsigned*)(W + cid * 8192 + (mt * 4 + kk) * 512 + (16 * g + ln) * 8), (LAS unsigned*)(buf + (mt * 4 + kk) * 1024), 16, 0, 2);
#pragma unroll
    for (int j = 0; j < 8; ++j)
#pragma unroll
        for (int k2 = 0; k2 < 2; ++k2) __builtin_amdgcn_global_load_lds((const unsigned*)(KET + cid * 8192 + (j * 2 + k2) * 512 + (16 * g + ln) * 8), (LAS unsigned*)(buf + (16 + j * 2 + k2) * 1024), 16, 0, 2);
#pragma unroll
    for (int q = 0; q < 2; ++q) __builtin_amdgcn_global_load_lds((const unsigned*)(UT + cid * 8192 + dv0 * 64 + q * 512 + (16 * g + ln) * 8), (LAS unsigned*)(buf + (32 + q) * 1024), 16, 0, 2);
}
#define GB_RD16(f, addr, WAITSTR) asm volatile( \
    "ds_read_b128 %0, %16\n\tds_read_b128 %1, %16 offset:1024\n\tds_read_b128 %2, %16 offset:2048\n\tds_read_b128 %3, %16 offset:3072\n\t" \
    "ds_read_b128 %4, %16 offset:4096\n\tds_read_b128 %5, %16 offset:5120\n\tds_read_b128 %6, %16 offset:6144\n\tds_read_b128 %7, %16 offset:7168\n\t" \
    "ds_read_b128 %8, %16 offset:8192\n\tds_read_b128 %9, %16 offset:9216\n\tds_read_b128 %10, %16 offset:10240\n\tds_read_b128 %11, %16 offset:11264\n\t" \
    "ds_read_b128 %12, %16 offset:12288\n\tds_read_b128 %13, %16 offset:13312\n\tds_read_b128 %14, %16 offset:14336\n\tds_read_b128 %15, %16 offset:15360" WAITSTR \
    : "=&v"(f[0]), "=&v"(f[1]), "=&v"(f[2]), "=&v"(f[3]), "=&v"(f[4]), "=&v"(f[5]), "=&v"(f[6]), "=&v"(f[7]), \
      "=&v"(f[8]), "=&v"(f[9]), "=&v"(f[10]), "=&v"(f[11]), "=&v"(f[12]), "=&v"(f[13]), "=&v"(f[14]), "=&v"(f[15]) : "v"(addr) : "memory")
constexpr int GB_NS = 4, GB_FLAGS = LDS_MISC + 512, GB_SPIN_CAP = 1 << 22;
DI void gd_b_step(Ctx& F, f32x4 (&S)[8], size_t cid, int dv0, int lane, int ln, int g, float egl, unsigned stage_base, int n) {
    const unsigned base = stage_base + (unsigned)lane * 16u;
    bf16* VNT = (bf16*)(F.ws + WS_GDVN); bf16* SPT = (bf16*)(F.ws + WS_GDSP);
    bf16x8 wf[16], kef[16]; u32x2 ui[4];
    asm volatile("ds_read_b64 %0, %4 offset:32768\n\tds_read_b64 %1, %4 offset:33280\n\tds_read_b64 %2, %4 offset:33792\n\tds_read_b64 %3, %4 offset:34304"
                 : "=&v"(ui[0]), "=&v"(ui[1]), "=&v"(ui[2]), "=&v"(ui[3]) : "v"(stage_base + (unsigned)lane * 8u) : "memory");
    GB_RD16(wf, base, "\n\ts_waitcnt lgkmcnt(0)");
    asm volatile("" : "+v"(ui[0]), "+v"(ui[1]), "+v"(ui[2]), "+v"(ui[3]));
    GB_RD16(kef, base + 16384u, "");
    f32x4 vacc[4]; bf16x8 sbn[4];
#pragma unroll
    for (int kk = 0; kk < 4; ++kk) sbn[kk] = pack_frag(S[2 * kk], S[2 * kk + 1]);
#pragma unroll
    for (int j = 0; j < 8; ++j) *(u32x2*)(SPT + cid * 16384 + ((dv0 >> 4) * 4 + (j >> 1)) * 512 + ((2 * (j & 1) + (g >> 1)) * 16 + ln) * 8 + (g & 1) * 4) = pack4(S[j]);
#pragma unroll
    for (int mt = 0; mt < 4; ++mt) vacc[mt] = unpack4(ui[mt]);
#pragma unroll
    for (int kk = 0; kk < 4; ++kk)
#pragma unroll
        for (int mt = 0; mt < 4; ++mt) vacc[mt] = MFMA16(wf[mt * 4 + kk], sbn[kk], vacc[mt]);
#pragma unroll
    for (int mt = 0; mt < 4; ++mt) *(u32x2*)(VNT + cid * 8192 + ((dv0 >> 4) * 2 + (mt >> 1)) * 512 + ((2 * (mt & 1) + (g >> 1)) * 16 + ln) * 8 + (g & 1) * 4) = pack4(vacc[mt]);
    bf16x8 vb[2]; vb[0] = pack_frag(vacc[0], vacc[1]); vb[1] = pack_frag(vacc[2], vacc[3]);
    asm volatile("s_waitcnt lgkmcnt(0)" : "+v"(kef[0]), "+v"(kef[1]), "+v"(kef[2]), "+v"(kef[3]), "+v"(kef[4]), "+v"(kef[5]), "+v"(kef[6]), "+v"(kef[7]),
                 "+v"(kef[8]), "+v"(kef[9]), "+v"(kef[10]), "+v"(kef[11]), "+v"(kef[12]), "+v"(kef[13]), "+v"(kef[14]), "+v"(kef[15]) :: "memory");
    if (lane == 0) ((volatile LAS unsigned*)(F.lds + GB_FLAGS))[4] = (unsigned)(n + 1);
#pragma unroll
    for (int j = 0; j < 8; ++j) S[j] *= egl;
#pragma unroll
    for (int k2 = 0; k2 < 2; ++k2)
#pragma unroll
        for (int j = 0; j < 8; ++j) S[j] = MFMA16(kef[j * 2 + k2], vb[k2], S[j]);
}
DI void gd_b_task(Ctx& F, int task) {
    const int bh = task >> 3, dv0 = 16 * (task & 7), lane = F.lane, g = lane >> 4, ln = lane & 15;
    const float* GL = (const float*)(F.ws + WS_GDGL);
    volatile LAS unsigned* fl = (volatile LAS unsigned*)(F.lds + GB_FLAGS);
    f32x4 S[8];
#pragma unroll
    for (int j = 0; j < 8; ++j) S[j] = (f32x4){0.f, 0.f, 0.f, 0.f};
    const size_t c0 = (size_t)bh * 64;
    const float eglv = ldf(GL + c0 + lane);
    asm volatile("s_waitcnt vmcnt(0)" ::: "memory");
    const unsigned L0 = lds_addr(F.lds);
#pragma unroll 1
    for (int n = 0; n < 64; ++n) {
        unsigned spins = 0;
        unsigned long long tp0_ = 0; if (((PROF_MASK) >> 22) & 1) tp0_ = __builtin_amdgcn_s_memrealtime();
        while (fl[n & 3] < (unsigned)(n + 1)) { __builtin_amdgcn_s_sleep(1); if (++spins > (unsigned)GB_SPIN_CAP) { fl[5] = 1u; break; } }
        if (((PROF_MASK) >> 22) & 1) { if (blockIdx.x == 0 && lane == 0) { volatile LAS unsigned long long* pw = (volatile LAS unsigned long long*)(F.lds + LDS_MISC + 128); pw[1] += __builtin_amdgcn_s_memrealtime() - tp0_; } }
        gd_b_step(F, S, c0 + n, dv0, lane, ln, g, __builtin_amdgcn_readlane(eglv, n), L0 + (unsigned)(n & 3) * GB_STAGE, n);
    }
}
DI void gd_b_loader(Ctx& F, int task, int li) {
    const int bh = task >> 3, dv0 = 16 * (task & 7), lane = F.lane, g = lane >> 4, ln = lane & 15;
    const bf16* UT = (const bf16*)(F.ws + WS_GDUT); const bf16* W = (const bf16*)(F.ws + WS_GDW); const bf16* KET = (const bf16*)(F.ws + WS_GDKE);
    volatile LAS unsigned* fl = (volatile LAS unsigned*)(F.lds + GB_FLAGS);
    const size_t c0 = (size_t)bh * 64;
    int prev = -1;
#pragma unroll 1
    for (int n = li; n < 64; n += 2) {
        if (n >= GB_NS) { unsigned spins = 0; while (fl[4] < (unsigned)(n - GB_NS + 1)) { __builtin_amdgcn_s_sleep(1); if (++spins > (unsigned)GB_SPIN_CAP) { fl[5] = 1u; break; } } }
        gd_b_issue(W, KET, UT, c0 + n, dv0, ln, g, F.lds + (n & 3) * GB_STAGE);
        if (prev >= 0) { asm volatile("s_waitcnt vmcnt(34)" ::: "memory"); if (lane == 0) fl[prev & 3] = (unsigned)(prev + 1); }
        prev = n;
    }
    asm volatile("s_waitcnt vmcnt(0)" ::: "memory"); if (lane == 0) fl[prev & 3] = (unsigned)(prev + 1);
}
DI void gd_c_unit(Ctx& F, const Args& a, int l, int cid, int par) {
    const int b = cid >> 8, h = (cid >> 6) & 3, n = cid & 63, t0 = b * SEQ + n * CH, lane = F.lane, g = lane >> 4, ln = lane & 15, w = F.wave, tt = w & 3, dh = w >> 2, tl = 16 * tt + ln;
    const bf16* PROJ = (const bf16*)(F.ws + WS_PROJ);
    const bf16* SPT = (const bf16*)(F.ws + WS_GDSP) + (size_t)cid * 16384; const bf16* QG = (const bf16*)(F.ws + WS_GDQG) + (size_t)cid * 8192;
    const bf16* VNT = (const bf16*)(F.ws + WS_GDVN) + (size_t)cid * 8192; const bf16* QKD = (const bf16*)(F.ws + WS_GDQK) + (size_t)cid * 4096;
    LAS float* ss = (LAS float*)(F.lds + par * 1024);
    bf16x8 qf[4], pf[2];
#pragma unroll
    for (int ks = 0; ks < 4; ++ks) qf[ks] = *(const bf16x8*)(QG + tl * 128 + 32 * ks + 8 * g);
#pragma unroll
    for (int ks = 0; ks < 2; ++ks) pf[ks] = *(const bf16x8*)(QKD + tl * 64 + 32 * ks + 8 * g);
    u32x2 zr[4]; f32x4 nwr[4];
#pragma unroll
    for (int mt = 0; mt < 4; ++mt) { const int dv = 16 * (4 * dh + mt) + 4 * g; nwr[mt] = *(const f32x4*)(inp(F, 9) + (size_t)l * 128 + dv); zr[mt] = *(const u32x2*)(PROJ + (size_t)(t0 + tl) * NPROJ + 3072 + h * 128 + dv); }
    f32x4 o[4]; float ssq = 0.f;
#pragma unroll
    for (int mt = 0; mt < 4; ++mt) { o[mt] = (f32x4){0.f, 0.f, 0.f, 0.f}; const int dvr = 16 * (4 * dh + mt) + ln;
#pragma unroll
        for (int ks = 0; ks < 4; ++ks) o[mt] = MFMA16(*(const bf16x8*)(SPT + (size_t)dvr * 128 + 32 * ks + 8 * g), qf[ks], o[mt]);
#pragma unroll
        for (int ks = 0; ks < 2; ++ks) o[mt] = MFMA16(*(const bf16x8*)(VNT + (size_t)dvr * 64 + 32 * ks + 8 * g), pf[ks], o[mt]);
        ssq += (o[mt][0] * o[mt][0] + o[mt][1] * o[mt][1]) + (o[mt][2] * o[mt][2] + o[mt][3] * o[mt][3]); }
    ssq += __shfl_xor(ssq, 16); ssq += __shfl_xor(ssq, 32);
    if (g == 0) ss[tl * 2 + dh] = ssq;
    __syncthreads();
    const float rinv = rsqrtf((ss[tl * 2] + ss[tl * 2 + 1]) * (1.f / 128.f) + 1e-6f);
    bf16* MX = (bf16*)(F.ws + WS_MIXED);
#pragma unroll
    for (int mt = 0; mt < 4; ++mt) { const int dv = 16 * (4 * dh + mt) + 4 * g;
        const f32x4 nw = nwr[mt]; const f32x4 z = unpack4(zr[mt]);
        f32x4 r;
#pragma unroll
        for (int i = 0; i < 4; ++i) r[i] = o[mt][i] * rinv * nw[i] * z[i] * sigmoidf_(z[i]);
        *(u32x2*)(MX + (size_t)(t0 + tl) * D + 512 + h * 128 + dv) = pack4(r); }
}

DI void phase_a(Ctx& F, const Args& a, int l) {
    const int h = (F.vcu >> 6) & 3, lane = F.lane, tid = F.tid, w = F.wave;
    const float* GT = (const float*)(F.ws + WS_GATES);
    for (int e = tid; e < 3 * 4 * 128; e += NTHREADS) { const int ten = e / 512, j = (e >> 7) & 3, c = e & 127;
        *(LAS bf16*)(F.lds + GA_WT + e * 2) = f2bf(inp(F, 6)[((size_t)l * 4 + j) * 1536 + ten * 512 + h * 128 + c]); }
    const float bi = inp(F, 3)[l * 4 + h], bf_ = inp(F, 4)[l * 4 + h], nalog = -__expf(inp(F, 7)[l * 4 + h]), dtb = inp(F, 8)[l * 4 + h];
    asm volatile("s_waitcnt vmcnt(0)" ::: "memory");
    const int t00 = (F.vcu & 63) * CH;
    {
        MlAPre P0; ml_a_fetch(F, F.vcu, P0);
        float gb0 = gld4(GT + (size_t)(t00 + lane) * 16 + 8 + h), ga0 = gld4(GT + (size_t)(t00 + lane) * 16 + 12 + h);
        gd_a_issue(F, F.vcu, w, lane);
        ml_a_unit(F, l, F.vcu, 0, P0, bi, bf_, gb0, ga0, nalog, dtb);
    }
#pragma unroll 1
    for (int i = 0; i < 8; ++i) {
        const int cid = F.vcu + 256 * i;
        MlAPre P; float gb = 0.f, ga = 0.f;
        gd_a_unit(F, l, cid, gb, ga, nalog, dtb, i + 1 < 8, P);
        if (i + 1 < 8) ml_a_unit(F, l, cid + 256, (i + 1) & 1, P, bi, bf_, gb, ga, nalog, dtb);
    }
    asm volatile("s_waitcnt vmcnt(0)" ::: "memory"); __syncthreads();
}
constexpr int CS_K = 0, CS_Q = 8192, CS_CT = 16384, CS_V = 32768, CS_NP = 49152, CS_SC = 49408, CS_GI = 50688, CS_GF = 50944, GS_SP = 51200, GS_QG = 83968, GS_VN = 100352, GS_QK = 116736, GS_SS = 124928;
constexpr int CS_OG = 126464, GS_Z = 142848, CS_MP = 159232;
DI void lds_rd4x8_nowait(unsigned addr, u32x2& a, u32x2& b, u32x2& c, u32x2& d) { asm volatile("ds_read_b64 %0, %4\n\tds_read_b64 %1, %4 offset:32\n\tds_read_b64 %2, %4 offset:64\n\tds_read_b64 %3, %4 offset:96" : "=&v"(a), "=&v"(b), "=&v"(c), "=&v"(d) : "v"(addr) : "memory"); }
DI float lds_rd4(unsigned addr) { float r; asm volatile("ds_read_b32 %0, %1\n\ts_waitcnt lgkmcnt(0)" : "=v"(r) : "v"(addr) : "memory"); return r; }
DI bf16x8 lds_frag(unsigned addr) { bf16x8 r; asm volatile("ds_read_b128 %0, %1" : "=v"(r) : "v"(addr) : "memory"); return r; }
DI f32x2 lds_rd8(unsigned addr) { f32x2 r; asm volatile("ds_read_b64 %0, %1\n\ts_waitcnt lgkmcnt(0)" : "=v"(r) : "v"(addr) : "memory"); return r; }
DI void mlc_issue(Ctx& F, int cid, int w, int lane) {
    const int b = cid >> 8, h = (cid >> 6) & 3, n = cid & 63, t0 = b * SEQ + n * CH, g = lane >> 4, ln = lane & 15;
    const bf16* PROJ = (const bf16*)(F.ws + WS_PROJ); const bf16* CT = (const bf16*)(F.ws + WS_MLCT) + (size_t)cid * 8192;
    DMA16NT(PROJ + (size_t)(t0 + 16 * (w >> 1) + ln) * NPROJ + 256 + h * 64 + 32 * (w & 1) + 8 * g, F.lds + CS_K + w * 1024);
    DMA16NT(PROJ + (size_t)(t0 + 16 * (w >> 1) + ln) * NPROJ + h * 64 + 32 * (w & 1) + 8 * g, F.lds + CS_Q + w * 1024);
#pragma unroll
    for (int ks = 0; ks < 2; ++ks) DMA16NT(CT + (2 * w + ks) * 512 + lane * 8, F.lds + CS_CT + (2 * w + ks) * 1024);
#pragma unroll
    for (int q = 0; q < 2; ++q) { const int j = 2 * w + q; DMA16NT(PROJ + (size_t)(t0 + 4 * j + g) * NPROJ + 512 + h * 128 + 8 * ln, F.lds + CS_V + j * 1024); }
    __builtin_amdgcn_global_load_lds((const unsigned*)((const float*)(F.ws + WS_MLNP) + (size_t)cid * 64 + lane), (LAS unsigned*)(F.lds + CS_NP), 4, 0, 0);
#pragma unroll
    for (int q = 0; q < 2; ++q) { const int j = 2 * w + q; DMA16NT(PROJ + (size_t)(t0 + 4 * j + g) * NPROJ + 1024 + h * 128 + 8 * ln, F.lds + CS_OG + j * 1024); }
    const float* GT = (const float*)(F.ws + WS_GATES);
    __builtin_amdgcn_global_load_lds((const unsigned*)(GT + (size_t)(t0 + lane) * 16 + h), (LAS unsigned*)(F.lds + CS_GI), 4, 0, 0);
    __builtin_amdgcn_global_load_lds((const unsigned*)(GT + (size_t)(t0 + lane) * 16 + 4 + h), (LAS unsigned*)(F.lds + CS_GF), 4, 0, 0);
    __builtin_amdgcn_global_load_lds((const unsigned*)((const float*)(F.ws + WS_MLMP) + cid), (LAS unsigned*)(F.lds + CS_MP), 4, 0, 0);
}
DI void gdc_issue(Ctx& F, int cid, int w, int lane) {
    const int g = lane >> 4, ln = lane & 15;
    const bf16* SPT = (const bf16*)(F.ws + WS_GDSP) + (size_t)cid * 16384; const bf16* QG = (const bf16*)(F.ws + WS_GDQG) + (size_t)cid * 8192;
    const bf16* VNT = (const bf16*)(F.ws + WS_GDVN) + (size_t)cid * 8192; const bf16* QKD = (const bf16*)(F.ws + WS_GDQK) + (size_t)cid * 4096;
#pragma unroll
    for (int ks = 0; ks < 4; ++ks) DMA16NT(SPT + (4 * w + ks) * 512 + lane * 8, F.lds + GS_SP + (4 * w + ks) * 1024);
#pragma unroll
    for (int q = 0; q < 2; ++q) { const int bq = 2 * w + q; DMA16NT(QG + (size_t)(16 * (bq >> 2) + ln) * 128 + 32 * (bq & 3) + 8 * g, F.lds + GS_QG + bq * 1024); }
#pragma unroll
    for (int ks = 0; ks < 2; ++ks) DMA16NT(VNT + (2 * w + ks) * 512 + lane * 8, F.lds + GS_VN + (2 * w + ks) * 1024);
    DMA16NT(QKD + w * 512 + lane * 8, F.lds + GS_QK + w * 1024);
    { const int b = cid >> 8, h = (cid >> 6) & 3, n = cid & 63, t0 = b * SEQ + n * CH; const bf16* PROJ = (const bf16*)(F.ws + WS_PROJ);
#pragma unroll
      for (int q = 0; q < 2; ++q) { const int j = 2 * w + q; DMA16NT(PROJ + (size_t)(t0 + 4 * j + g) * NPROJ + 3072 + h * 128 + 8 * ln, F.lds + GS_Z + j * 1024); } }
}
constexpr int GS_NW = 125440;
DI void phase_c(Ctx& F, const Args& a, int l) {
    const int lane = F.lane, g = lane >> 4, ln = lane & 15, w = F.wave, tt = w & 3, dh = w >> 2, tl = 16 * tt + ln;
    const int h = (F.vcu >> 6) & 3, n = F.vcu & 63;
    const bf16* PROJ = (const bf16*)(F.ws + WS_PROJ); const float* GT = (const float*)(F.ws + WS_GATES); bf16* MX = (bf16*)(F.ws + WS_MIXED);
    const unsigned L0 = lds_addr(F.lds);
    LAS float* ib = (LAS float*)(F.lds + CS_SC); LAS float* Mt = ib + 64; LAS float* bcs = ib + 128;
    if (F.tid < 256) ((LAS float*)(F.lds + GS_NW))[F.tid] = (F.tid < 128) ? inp(F, 5)[(size_t)l * 512 + h * 128 + F.tid] : inp(F, 9)[(size_t)l * 128 + F.tid - 128];
    const float bi = inp(F, 3)[l * 4 + h], bf_ = inp(F, 4)[l * 4 + h];
    asm volatile("s_waitcnt vmcnt(0)" ::: "memory");
    __syncthreads();
    mlc_issue(F, F.vcu, w, lane);
    gdc_issue(F, F.vcu, w, lane);
#pragma unroll 1
    for (int i = 0; i < 8; ++i) {
        const int cid = F.vcu + 256 * i, t0 = i * SEQ + n * CH;
        asm volatile("s_waitcnt vmcnt(11)" ::: "memory");
        const float mpv = lds_rd4(L0 + CS_MP + lane * 4);
        if (w == 7) { const float gi = lds_rd4(L0 + CS_GI + lane * 4), gf = lds_rd4(L0 + CS_GF + lane * 4); const float ip = softcap15(gi + bi), fp = softcap15(gf + bf_);
            const float bc = wave_incl_sum(log_sigmoid(fp), lane), ibs = ip - bc, pm = wave_incl_max(ibs, lane);
            ib[lane] = ibs; Mt[lane] = fmaxf(mpv, pm); bcs[lane] = bc; }
        asm volatile("s_waitcnt lgkmcnt(0)" ::: "memory"); __builtin_amdgcn_s_barrier(); asm volatile("" ::: "memory");
        const float mprev = mpv;
        const float Mtt = lds_rd8(L0 + CS_SC + 256 + (tl & ~1) * 4)[tl & 1], bct = lds_rd8(L0 + CS_SC + 512 + (tl & ~1) * 4)[tl & 1];
        bf16x8 qf[2], kf[4][2];
#pragma unroll
        for (int ks = 0; ks < 2; ++ks) { qf[ks] = lds_frag(L0 + CS_Q + (tt * 2 + ks) * 1024 + lane * 16);
#pragma unroll
            for (int ms = 0; ms < 4; ++ms) kf[ms][ks] = lds_frag(L0 + CS_K + (ms * 2 + ks) * 1024 + lane * 16); }
        f32x4 ibv[4], dum_;
#pragma unroll
        for (int ms = 0; ms < 4; ++ms) g8::lds_rd2x16(L0 + CS_SC + (16 * ms + 4 * g) * 4, ibv[ms], dum_);
        asm volatile("" : "+v"(qf[0]), "+v"(qf[1]), "+v"(kf[0][0]), "+v"(kf[0][1]), "+v"(kf[1][0]), "+v"(kf[1][1]), "+v"(kf[2][0]), "+v"(kf[2][1]), "+v"(kf[3][0]), "+v"(kf[3][1]));
        f32x4 sacc[4];
#pragma unroll
        for (int ms = 0; ms < 4; ++ms) { sacc[ms] = (f32x4){0.f, 0.f, 0.f, 0.f};
#pragma unroll
            for (int ks = 0; ks < 2; ++ks) sacc[ms] = MFMA16(kf[ms][ks], qf[ks], sacc[ms]); }
#pragma unroll
        for (int ms = 0; ms < 4; ++ms)
#pragma unroll
            for (int q = 0; q < 4; ++q) { const int s_ = 16 * ms + 4 * g + q; sacc[ms][q] = (s_ <= tl) ? sacc[ms][q] * 0.125f * __expf(ibv[ms][q] - Mtt) : 0.f; }
        bf16x8 sb[2]; sb[0] = pack_frag(sacc[0], sacc[1]); sb[1] = pack_frag(sacc[2], sacc[3]);
        bf16x8 ctf[5][2]; f32x4 npa[2], npb[2];
#pragma unroll
        for (int ks = 0; ks < 2; ++ks)
#pragma unroll
            for (int mt = 0; mt < 4; ++mt) ctf[mt][ks] = lds_frag(L0 + CS_CT + ((4 * dh + mt) * 2 + ks) * 1024 + lane * 16);
        g8::lds_rd2x16(L0 + CS_NP + (8 * g) * 4, npa[0], npa[1]); g8::lds_rd2x16(L0 + CS_NP + (32 + 8 * g) * 4, npb[0], npb[1]);
        asm volatile("" : "+v"(ctf[0][0]), "+v"(ctf[0][1]), "+v"(ctf[1][0]), "+v"(ctf[1][1]), "+v"(ctf[2][0]), "+v"(ctf[2][1]), "+v"(ctf[3][0]), "+v"(ctf[3][1]));
        { float nvv[8];
#pragma unroll
          for (int j = 0; j < 4; ++j) { nvv[j] = (ln == 0) ? npa[0][j] : 0.f; nvv[4 + j] = (ln == 0) ? npa[1][j] : 0.f; }
          ctf[4][0] = __builtin_bit_cast(bf16x8, pack8(nvv));
#pragma unroll
          for (int j = 0; j < 4; ++j) { nvv[j] = (ln == 0) ? npb[0][j] : 0.f; nvv[4 + j] = (ln == 0) ? npb[1][j] : 0.f; }
          ctf[4][1] = __builtin_bit_cast(bf16x8, pack8(nvv)); }
        f32x4 xacc[5];
#pragma unroll
        for (int mt = 0; mt < 5; ++mt) { xacc[mt] = (f32x4){0.f, 0.f, 0.f, 0.f};
#pragma unroll
            for (int ks = 0; ks < 2; ++ks) xacc[mt] = MFMA16(ctf[mt][ks], qf[ks], xacc[mt]); }
        const float wint = 0.125f * __expf(mprev - Mtt);
#pragma unroll
        for (int mt = 0; mt < 5; ++mt) xacc[mt] *= wint;
        const bf16x8 ones = (ln == 0) ? (bf16x8){0x3f80, 0x3f80, 0x3f80, 0x3f80, 0x3f80, 0x3f80, 0x3f80, 0x3f80} : (bf16x8){0, 0, 0, 0, 0, 0, 0, 0};
#pragma unroll
        for (int kk = 0; kk < 2; ++kk) {
#pragma unroll
            for (int mt = 0; mt < 4; ++mt) { const bf16x8 vf = tr_frag8(L0 + CS_V, 256, 32 * kk + 4 * g, 32 * kk + 16 + 4 * g, 16 * (4 * dh + mt), lane); xacc[mt] = MFMA16(vf, sb[kk], xacc[mt]); }
            xacc[4] = MFMA16(ones, sb[kk], xacc[4]); }
        const float den = __shfl(xacc[4][0], ln), dinv = __builtin_amdgcn_rcpf(fmaxf(fabsf(den), __expf(-(bct + Mtt))));
        float ssq = 0.f;
#pragma unroll
        for (int mt = 0; mt < 4; ++mt) { xacc[mt] *= dinv; ssq += (xacc[mt][0] * xacc[mt][0] + xacc[mt][1] * xacc[mt][1]) + (xacc[mt][2] * xacc[mt][2] + xacc[mt][3] * xacc[mt][3]); }
        ssq += __shfl_xor(ssq, 16); ssq += __shfl_xor(ssq, 32);
        if (g == 0) *(LAS float*)(F.lds + CS_SC + 768 + (tl * 2 + dh) * 4) = ssq;
        u32x2 og0, og1, og2, og3; lds_rd4x8_nowait(L0 + CS_OG + tl * 256 + (16 * 4 * dh + 4 * g) * 2, og0, og1, og2, og3);
        asm volatile("s_waitcnt lgkmcnt(0)" : "+v"(og0), "+v"(og1), "+v"(og2), "+v"(og3) :: "memory"); __builtin_amdgcn_s_barrier(); asm volatile("" ::: "memory");
        if (i + 1 < 8) mlc_issue(F, cid + 256, w, lane);
        { const f32x2 s2 = lds_rd8(L0 + CS_SC + 768 + tl * 8); const float rinv = rsqrtf((s2[0] + s2[1]) * (1.f / 128.f) + 1e-6f);
#pragma unroll
          for (int mt = 0; mt < 4; ++mt) { const int dv = 16 * (4 * dh + mt) + 4 * g; const f32x4 og = unpack4(mt == 0 ? og0 : (mt == 1 ? og1 : (mt == 2 ? og2 : og3))); f32x4 nw, o; g8::lds_rd2x16(L0 + GS_NW + dv * 4, nw, dum_);
#pragma unroll
              for (int q = 0; q < 4; ++q) o[q] = xacc[mt][q] * rinv * nw[q] * sigmoidf_(og[q]);
              *(u32x2*)(MX + (size_t)(t0 + tl) * D + h * 128 + dv) = pack4(o); } }
        if (i + 1 < 8) asm volatile("s_waitcnt vmcnt(12)" ::: "memory");
        else asm volatile("s_waitcnt vmcnt(0)" ::: "memory");
        __builtin_amdgcn_s_barrier(); asm volatile("" ::: "memory");
        bf16x8 gq[4], gp[2];
#pragma unroll
        for (int ks = 0; ks < 4; ++ks) gq[ks] = lds_frag(L0 + GS_QG + (tt * 4 + ks) * 1024 + lane * 16);
#pragma unroll
        for (int ks = 0; ks < 2; ++ks) gp[ks] = lds_frag(L0 + GS_QK + (tt * 2 + ks) * 1024 + lane * 16);
        f32x4 o[4]; float sq2 = 0.f;
#pragma unroll
        for (int mt = 0; mt < 4; ++mt) { bf16x8 gs[4], gv[2];
#pragma unroll
            for (int ks = 0; ks < 4; ++ks) gs[ks] = lds_frag(L0 + GS_SP + ((4 * dh + mt) * 4 + ks) * 1024 + lane * 16);
#pragma unroll
            for (int ks = 0; ks < 2; ++ks) gv[ks] = lds_frag(L0 + GS_VN + ((4 * dh + mt) * 2 + ks) * 1024 + lane * 16);
            asm volatile("s_waitcnt lgkmcnt(0)" : "+v"(gs[0]), "+v"(gs[1]), "+v"(gs[2]), "+v"(gs[3]), "+v"(gv[0]), "+v"(gv[1]), "+v"(gq[0]), "+v"(gq[1]), "+v"(gq[2]), "+v"(gq[3]), "+v"(gp[0]), "+v"(gp[1]) :: "memory");
            o[mt] = (f32x4){0.f, 0.f, 0.f, 0.f};
#pragma unroll
            for (int ks = 0; ks < 4; ++ks) o[mt] = MFMA16(gs[ks], gq[ks], o[mt]);
#pragma unroll
            for (int ks = 0; ks < 2; ++ks) o[mt] = MFMA16(gv[ks], gp[ks], o[mt]);
            sq2 += (o[mt][0] * o[mt][0] + o[mt][1] * o[mt][1]) + (o[mt][2] * o[mt][2] + o[mt][3] * o[mt][3]); }
        sq2 += __shfl_xor(sq2, 16); sq2 += __shfl_xor(sq2, 32);
        if (g == 0) *(LAS float*)(F.lds + GS_SS + (tl * 2 + dh) * 4) = sq2;
        u32x2 z0, z1, z2, z3; lds_rd4x8_nowait(L0 + GS_Z + tl * 256 + (16 * 4 * dh + 4 * g) * 2, z0, z1, z2, z3);
        asm volatile("s_waitcnt lgkmcnt(0)" : "+v"(z0), "+v"(z1), "+v"(z2), "+v"(z3) :: "memory"); __builtin_amdgcn_s_barrier(); asm volatile("" ::: "memory");
        if (i + 1 < 8) gdc_issue(F, cid + 256, w, lane);
        { const f32x2 s2 = lds_rd8(L0 + GS_SS + tl * 8); const float rinv = rsqrtf((s2[0] + s2[1]) * (1.f / 128.f) + 1e-6f);
#pragma unroll
          for (int mt = 0; mt < 4; ++mt) { const int dv = 16 * (4 * dh + mt) + 4 * g; const f32x4 z = unpack4(mt == 0 ? z0 : (mt == 1 ? z1 : (mt == 2 ? z2 : z3))); f32x4 nw, r; g8::lds_rd2x16(L0 + GS_NW + 512 + dv * 4, nw, dum_);
#pragma unroll
              for (int q = 0; q < 4; ++q) r[q] = o[mt][q] * rinv * nw[q] * z[q] * sigmoidf_(z[q]);
              *(u32x2*)(MX + (size_t)(t0 + tl) * D + 512 + h * 128 + dv) = pack4(r); } }
    }
    asm volatile("s_waitcnt vmcnt(0)" ::: "memory"); __syncthreads();
}
struct P2Order {
    unsigned char* ws; int G, c0;
    DI bool next(int i, g8::Unit& u) const {
        const int L = i * G + c0; if (L >= 1024) return false;
        const int q = L & 511, t4 = q & 3, h = (q >> 2) & 3, b = (q >> 4) & 7, l = q >> 7;
        if (L < 512) { u.a = (const char*)(ws + WS_KV) + ((size_t)(2 * l) * 2048 + b * 256) * 2048 + h * 512; u.b = (const char*)(ws + WS_WQ) + ((size_t)l * 1024 + t4 * 256) * 2048 + h * 512;
            u.c = (char*)(ws + WS_WQK) + ((size_t)(l * 8 + b) * 1024 + h * 256) * 2048 + t4 * 512; u.aux = -1; }
        else { u.a = (const char*)(ws + WS_WO) + ((size_t)l * 1024 + t4 * 256) * 2048 + h * 512; u.b = (const char*)(ws + WS_KV) + ((size_t)(2 * l + 1) * 2048 + b * 256) * 2048 + h * 512;
            u.c = (char*)(ws + WS_WVO) + ((size_t)(l * 8 + b) * 1024 + t4 * 256) * 2048 + h * 512; u.aux = 0; }
        u.pm = 0; u.pn = 0; return true;
    }
};

constexpr int NPH_LAYER = 13, NPH = 3 + NL * NPH_LAYER;
__global__ void __launch_bounds__(NTHREADS, 2) mega(Args a) {
    extern __shared__ __attribute__((aligned(16))) unsigned char lds_raw[];
    Ctx F; F.lds = (LAS unsigned char*)0u; F.ws = a.ws; F.ctl = (unsigned*)(a.ws + WS_CTL);
    F.tid = threadIdx.x; F.lane = F.tid & 63; F.wave = __builtin_amdgcn_readfirstlane(F.tid >> 6); F.G = gridDim.x;
    { const int bx = blockIdx.x; F.vcu = (F.G % 8 == 0) ? (bx % 8) * (F.G / 8) + bx / 8 : bx; }
    volatile LAS unsigned* MISC = (volatile LAS unsigned*)(F.lds + LDS_MISC);
    if (F.tid < 64) MISC[F.tid] = 0u;
    if ((unsigned)(size_t)(LAS unsigned char*)lds_raw != 0u) { if (F.tid == 0) atomicAdd(F.ctl + CW_BAR + XB_TMO, 1u); }
    if (F.tid < 28) { const unsigned long long pv = (unsigned long long)(F.tid < 27 ? (const void*)a.in[F.tid] : (const void*)a.out); ((LAS unsigned long long*)(F.lds + LDS_PTAB))[F.tid] = pv; }
    __syncthreads();
    const bool multi = (a.ph_hi - a.ph_lo) > 1;
    XcdBarrier bar; bar.bar = F.ctl + CW_BAR; bar.x = 0; bar.st = MISC;
    if (multi) bar = xcd_barrier_post(F.ctl + CW_BAR, MISC);
    if (PROF_MASK) { if (blockIdx.x == 0 && threadIdx.x == 0) { volatile LAS unsigned long long* pw = (volatile LAS unsigned long long*)(F.lds + LDS_MISC + 128); const unsigned long long t0_ = __builtin_amdgcn_s_memrealtime(); pw[0] = t0_; pw[1] = 0ull; pw[2] = t0_; } }
#ifndef PMASK
#define PMASK 0xffff
#endif
#define EN(j) (((PMASK) >> (j)) & 1)
#ifndef REPMASK
#define REPMASK 0x0
#endif
#define NREP(j) ((((REPMASK) >> (j)) & 1) ? 2 : 1)
#if REPMASK
#define REPLOOP(j) for (int rep_ = 0; rep_ < NREP(j); ++rep_, __syncthreads())
#else
#define REPLOOP(j)
#endif
#define PH(k) (a.ph_lo <= (k) && (k) < a.ph_hi && (refresh(F, a.ws), true))
#define PROF_TICK(k) do { if (PROF_MASK) { if (blockIdx.x == 0 && threadIdx.x == 0) { volatile LAS unsigned long long* pw = (volatile LAS unsigned long long*)(F.lds + LDS_MISC + 128); \
        const unsigned long long now_ = __builtin_amdgcn_s_memrealtime(); const int j_ = ((k) < 3) ? 13 + (k) : ((k) - 3) % NPH_LAYER; \
        if (((PROF_MASK) >> j_) & 1) pw[1] += now_ - pw[0]; pw[0] = now_; } } } while (0)
#define SEAM(k) do { if (PH(k) && PH((k) + 1)) { xcd_barrier(bar); if (((REPMASK) >> 16) & 1) xcd_barrier(bar); PROF_TICK(k); } } while (0)

    if (EN(13) && PH(0)) REPLOOP(13) { phase_convert(F, a); }
    SEAM(0);
    if (EN(14) && PH(1)) REPLOOP(14) {
        g8::AffineOrder S; S.A = (const char*)(F.ws + WS_MEMB); S.B = (const char*)(F.ws + WS_WKV); S.C = (char*)(F.ws + WS_KV);
        S.aM = 256ull * 2048; S.bB = 0; S.bN = 256ull * 2048; S.cM = 256ull * 2048; S.cS = 2048ull * 2048; S.cN = 512; S.nM = 8; S.nN = 32; S.bdiv = 1 << 30; S.csp = 4; S.G = F.G; S.c0 = F.vcu;
        g8::EpiBf16 E{1024, nullptr, 0, 1.f};
        g8::gemm_phase(F.lds, 2048, 2048, 16, S, E);
        row_pass<0>(F, a, 0);
    }
    SEAM(1);
    if (EN(15) && PH(2)) REPLOOP(15) { P2Order S{F.ws, F.G, F.vcu}; g8::EpiBf16 E{1024, nullptr, 0, 0.0625f}; g8::gemm_phase(F.lds, 2048, 2048, 4, S, E); }
    SEAM(2);
#pragma unroll 1
    for (int l = 0; l < NL; ++l) {
        const int pb = 3 + l * NPH_LAYER;
        if (EN(0) && PH(pb + 0)) REPLOOP(0) {
            g8::AffineOrder S = g8::dense_order(F.ws + WS_XB, F.ws + WS_WIN + (size_t)l * NPROJ * D * 2, F.ws + WS_PROJ, T, NPROJ, D, NPROJ * 2, 2, F.G, F.vcu);
            g8::EpiBf16 E{NPROJ, nullptr, 0, 1.f}; g8::gemm_phase(F.lds, 2048, 2048, 16, S, E);
        }
        SEAM(pb + 0);
        if (EN(1) && PH(pb + 1)) REPLOOP(1) {
            phase_a(F, a, l);
        }
        SEAM(pb + 1);
        if (EN(2) && PH(pb + 2)) REPLOOP(2) {
            if (F.tid < 8) ((volatile LAS unsigned*)(F.lds + GB_FLAGS))[F.tid] = 0u;
            __syncthreads();
            if (F.wave == 0) gd_b_task(F, F.vcu);
            else if (F.wave <= 2) gd_b_loader(F, F.vcu, F.wave - 1);
            else if (F.wave >= 4) ml_b_unit(F, F.vcu);
        }
        SEAM(pb + 2);
        if (EN(3) && PH(pb + 3)) REPLOOP(3) {
            phase_c(F, a, l);
        }
        SEAM(pb + 3);
        if (EN(4) && PH(pb + 4)) REPLOOP(4) {
            g8::AffineOrder S = g8::dense_order(F.ws + WS_MIXED, F.ws + WS_WOUT + (size_t)l * D * D * 2, F.ws + WS_HB, T, D, D, D * 2, 2, F.G, F.vcu);
            g8::EpiBf16 E{D, nullptr, 0, 1.f}; g8::gemm_phase(F.lds, 2048, 2048, 16, S, E);
        }
        SEAM(pb + 4);
        if (EN(5) && PH(pb + 5)) { row_pass<1>(F, a, l); if (NREP(5) == 2) { __syncthreads(); row_pass<1>(F, a, l, true); } }
        SEAM(pb + 5);
        if (EN(6) && PH(pb + 6)) REPLOOP(6) {
            g8::AffineOrder S = g8::dense_order(F.ws + WS_XB, F.ws + WS_WQK + (size_t)l * 8 * D * D * 2, F.ws + WS_PB, T, D, D, D * 2, 2, F.G, F.vcu);
            S.bB = (size_t)D * D * 2; S.bdiv = 16;
            g8::EpiSoftmax E{D}; g8::gemm_phase(F.lds, 2048, 2048, 16, S, E);
        }
        SEAM(pb + 6);
        if (EN(7) && PH(pb + 7)) REPLOOP(7) {
            g8::AffineOrder S = g8::dense_order(F.ws + WS_PB, F.ws + WS_WVO + (size_t)l * 8 * D * D * 2, F.ws + WS_HB, T, D, D, D * 2, 2, F.G, F.vcu);
            S.bB = (size_t)D * D * 2; S.bdiv = 16;
            g8::EpiBf16 E{D, nullptr, 0, 1.f}; g8::gemm_phase(F.lds, 2048, 2048, 16, S, E);
        }
        SEAM(pb + 7);
        if (EN(8) && PH(pb + 8)) { row_pass<2>(F, a, l); if (NREP(8) == 2) { __syncthreads(); row_pass<2>(F, a, l, true); } }
        SEAM(pb + 8);
        if (EN(9) && PH(pb + 9)) phase_scatter(F, l);
        SEAM(pb + 9);
        if (EN(10) && PH(pb + 10)) REPLOOP(10) {
            MoeOrder S; S.gather = 1; S.rev = 0; S.A = (const char*)(F.ws + WS_XB); S.B = (const char*)(F.ws + WS_WGU) + (size_t)l * 32 * 2048 * D * 2; S.C = (char*)(F.ws + WS_ACT); S.tile_e = F.ctl + CW_TILE_E + l * MAXTILES;
            S.NT = __builtin_amdgcn_readfirstlane((int)ldu(F.ctl + CW_NT + l)); S.nN = 8; S.bE = 2048ull * D * 2; S.bN = 256ull * 2048; S.cN = 256; S.G = F.G; S.c0 = F.vcu;
            g8::EpiSwiglu E{inp(F, 22) + (size_t)l * 32 * 2048}; g8::gemm_phase<g8::EpiSwiglu, MoeOrder, true>(F.lds, 2048, 2048, 16, S, E, (const unsigned*)(F.ws + WS_XG));
        }
        SEAM(pb + 10);
        if (EN(11) && PH(pb + 11)) REPLOOP(11) {
            MoeOrder S; S.gather = 0; S.rev = 1; S.A = (const char*)(F.ws + WS_ACT); S.B = (const char*)(F.ws + WS_WDN) + (size_t)l * 32 * D * D * 2; S.C = (char*)(F.ws + WS_Y); S.tile_e = F.ctl + CW_TILE_E + l * MAXTILES;
            S.NT = __builtin_amdgcn_readfirstlane((int)ldu(F.ctl + CW_NT + l)); S.nN = 4; S.bE = (size_t)D * D * 2; S.bN = 256ull * 2048; S.cN = 512; S.G = F.G; S.c0 = F.vcu;
            g8::EpiBf16 E{D, inp(F, 24) + (size_t)l * 32 * D, D, 1.f}; g8::gemm_phase(F.lds, 2048, 2048, 16, S, E);
        }
        SEAM(pb + 11);
        if (EN(12) && PH(pb + 12)) { row_pass<3>(F, a, l); if (NREP(12) == 2 && l < NL - 1) { __syncthreads(); row_pass<3>(F, a, l, true); } }
        SEAM(pb + 12);
    }
    if (PROF_MASK) {
        refresh(F, a.ws);
        xcd_barrier(bar); PROF_TICK(NPH - 1);
        if (blockIdx.x == 0 && threadIdx.x == 0) { volatile LAS unsigned long long* pw = (volatile LAS unsigned long long*)(F.lds + LDS_MISC + 128);
            const float f = (float)(double)pw[1] / (float)(double)(pw[0] - pw[2]); const float q = fminf(1.f, floorf(f * (float)(PROF_SCALE) * 32.f + (float)(PROF_OFS) * 0.5f) * (1.f / 32.f));
            __hip_atomic_store(F.ctl + CW_DBG, __float_as_uint(sqrtf(100.f * q)), __ATOMIC_RELAXED, __HIP_MEMORY_SCOPE_AGENT); }
        xcd_barrier(bar);
        const float c = __uint_as_float(ldu(F.ctl + CW_DBG)); float* o = (float*)inp(F, 27);
        for (size_t i = (size_t)blockIdx.x * NTHREADS + threadIdx.x; i < (size_t)T * D; i += (size_t)gridDim.x * NTHREADS) o[i] = c;
    }
}

#ifndef DBG_STOP
#define DBG_STOP 0
#endif
#ifndef DBG_OFF
#define DBG_OFF WS_XB
#endif
#ifndef DBG_N
#define DBG_N ((size_t)T * D)
#endif
#ifndef DBG_F32
#define DBG_F32 0
#endif
__global__ void dbg_dump(const unsigned char* ws, float* out, size_t off) {
    const bf16* b = (const bf16*)(ws + off); const float* f = (const float*)(ws + off);
    for (size_t i = (size_t)blockIdx.x * blockDim.x + threadIdx.x; i < (size_t)T * D; i += (size_t)gridDim.x * blockDim.x) out[i] = (i < (size_t)(DBG_N)) ? (DBG_F32 ? f[i] : bf2f(b[i])) : 0.f;
}
#ifndef N_LAUNCH_MODE
#define N_LAUNCH_MODE 1
#endif
extern "C" void kernel_launch(void* const* d_in, const int* in_sizes, int n_in, void* d_out, int out_size, void* d_ws, size_t ws_size, hipStream_t stream) {
    static int ready = 0;
    if (ready == 0) {
        if (n_in != 27 || ws_size < WS_END) { fprintf(stderr, "kernel_launch: need 27 inputs and %zu bytes of workspace (got %d, %zu)\n", (size_t)WS_END, n_in, ws_size); ready = -1; return; }
        if (hipFuncSetAttribute((const void*)mega, hipFuncAttributeMaxDynamicSharedMemorySize, LDS_BYTES) != hipSuccess) { fprintf(stderr, "kernel_launch: hipFuncSetAttribute failed\n"); ready = -1; return; }
        int per_cu = 0; (void)hipOccupancyMaxActiveBlocksPerMultiprocessor(&per_cu, (const void*)mega, NTHREADS, LDS_BYTES); (void)hipGetLastError();
        ready = 1;
    }
    if (ready < 0) return;
    (void)hipMemsetAsync((char*)d_ws + WS_CTL, 0, 1 << 20, stream);
    (void)hipMemsetAsync((char*)d_ws + WS_XG, 0, (size_t)CAP * 4, stream);
    Args a{};
    for (int i = 0; i < 27; ++i) a.in[i] = (const float*)d_in[i];
    a.out = (float*)d_out; a.ws = (unsigned char*)d_ws;
#if N_LAUNCH_MODE == 1
    a.ph_lo = 0; a.ph_hi = (DBG_STOP > 0 ? DBG_STOP : NPH);
    hipLaunchKernelGGL(mega, dim3(256), dim3(NTHREADS), LDS_BYTES, stream, a);
    if (DBG_STOP > 0) hipLaunchKernelGGL(dbg_dump, dim3(2048), dim3(256), 0, stream, (const unsigned char*)d_ws, (float*)d_out, (size_t)(DBG_OFF));
#else
    for (int p = 0; p < (DBG_STOP > 0 ? DBG_STOP : NPH); ++p) { a.ph_lo = p; a.ph_hi = p + 1; hipLaunchKernelGGL(mega, dim3(256), dim3(NTHREADS), LDS_BYTES, stream, a); }
    if (DBG_STOP > 0) hipLaunchKernelGGL(dbg_dump, dim3(2048), dim3(256), 0, stream, (const unsigned char*)d_ws, (float*)d_out, (size_t)(DBG_OFF));
#endif
}
```

```cpp
#include <hip/hip_runtime.h>
#include <cstdio>
#include <cstdint>
#define PROF_SCALE 16
#define PROF_OFS 1
#ifndef PROF_MASK
#define PROF_MASK 0x0
#endif

#define LAS __attribute__((address_space(3)))
typedef unsigned short bf16;
typedef short bf16x8 __attribute__((ext_vector_type(8)));
typedef short s16x4 __attribute__((ext_vector_type(4)));
typedef float f32x4 __attribute__((ext_vector_type(4)));
typedef float f32x2 __attribute__((ext_vector_type(2)));
typedef unsigned u32x4 __attribute__((ext_vector_type(4)));
typedef unsigned u32x2 __attribute__((ext_vector_type(2)));
#define DI __device__ __forceinline__
#define GAS __attribute__((address_space(1)))

constexpr int T = 32768, D = 1024, NB = 8, SEQ = 4096, NL = 4, NCH = 64, CH = 64;
constexpr int NPROJ = 3584;
constexpr int NE = 32, TOPK = 4;
constexpr int MAXTILES = 544, CAP = MAXTILES * 256;
constexpr float DN_ALPHA = 1.6817928305074290f;
constexpr int NWAVES = 8, NTHREADS = 512;
constexpr int LDS_RING = 131072, LDS_X = 131072  , LDS_MISC = 163840 - 4096, LDS_BYTES = 163840;

constexpr size_t MiB = 1ull << 20;
constexpr size_t WS_CTL = 0;
constexpr size_t WS_ROWTAB = WS_CTL + 262144;
constexpr size_t WS_WIN = 1 * MiB;
constexpr size_t WS_WGATE = WS_WIN + 4ull * NPROJ * D * 2;
constexpr size_t WS_WRT = WS_WGATE + 4ull * 2 * 16 * D * 2;
constexpr size_t WS_WOUT = WS_WRT + 4ull * 2 * 32 * D * 2;
constexpr size_t WS_WQ = WS_WOUT + 4ull * D * D * 2;
constexpr size_t WS_WKV = WS_WQ + 4ull * D * D * 2;
constexpr size_t WS_WO = WS_WKV + 8ull * D * D * 2;
constexpr size_t WS_WGU = WS_WO + 4ull * D * D * 2;
constexpr size_t WS_WDN = WS_WGU + 4ull * 32 * 2048 * D * 2;
constexpr size_t WS_MEMB = WS_WDN + 4ull * 32 * D * D * 2;
constexpr size_t WS_KV = WS_MEMB + 2048ull * D * 2;
constexpr size_t WS_WQK = WS_KV + 8ull * 2048 * D * 2;
constexpr size_t WS_WVO = WS_WQK + 32ull * D * D * 2;
constexpr size_t WS_XB = WS_WVO + 32ull * D * D * 2;
constexpr size_t WS_PROJ = WS_XB + (size_t)T * D * 2;
constexpr size_t WS_GATES = WS_PROJ + (size_t)T * NPROJ * 2;
constexpr size_t WS_MIXED = WS_GATES + (size_t)T * 16 * 4;
constexpr size_t WS_HB = WS_MIXED + (size_t)T * D * 2;
constexpr size_t WS_PB = WS_HB + (size_t)T * D * 2;
constexpr size_t WS_TOPE = WS_PB + (size_t)T * D * 2;
constexpr size_t WS_TOPP = WS_TOPE + (size_t)T * 16;
constexpr size_t WS_TOPG = WS_TOPP + (size_t)T * 16;
constexpr size_t WS_SLOT = WS_TOPG + (size_t)T * 16;
constexpr size_t WS_XG = WS_SLOT + (size_t)T * 16;
constexpr size_t WS_ACT = WS_XG + (size_t)CAP * D * 2;
constexpr size_t WS_Y = WS_ACT + (size_t)CAP * D * 2;
constexpr size_t WS_MLU = WS_Y + (size_t)CAP * D * 2;
constexpr size_t WS_MLKN = WS_MLU + 2048ull * 8192 * 4;
constexpr size_t WS_MLSC = WS_MLKN + 2048ull * 64 * 4;
constexpr size_t WS_MLCT = WS_MLSC + 2048ull * 16;
constexpr size_t WS_MLNP = WS_MLCT + 2048ull * 8192 * 2;
constexpr size_t WS_MLMP = WS_MLNP + 2048ull * 64 * 4;
constexpr size_t WS_GDUT = WS_MLMP + 2048ull * 4;
constexpr size_t WS_GDW = WS_GDUT + 2048ull * 8192 * 2;
constexpr size_t WS_GDKE = WS_GDW + 2048ull * 8192 * 2;
constexpr size_t WS_GDQG = WS_GDKE + 2048ull * 8192 * 2;
constexpr size_t WS_GDQK = WS_GDQG + 2048ull * 8192 * 2;
constexpr size_t WS_GDGL = WS_GDQK + 2048ull * 4096 * 2;
constexpr size_t WS_GDVN = WS_GDGL + 2048ull * 4;
constexpr size_t WS_GDSP = WS_GDVN + 2048ull * 8192 * 2;
constexpr size_t WS_END = WS_GDSP + 2048ull * 16384 * 2;
constexpr int CW_BAR = 1024, CW_NT = 8192 + 256, CW_TILE_E = 8192 + 512, CW_DBG = 16384, CW_ECNT = 32768;

typedef __bf16 bf16x2_t __attribute__((ext_vector_type(2)));
DI unsigned cvt_pk_bf16(float lo, float hi) { const f32x2 v = {lo, hi}; const bf16x2_t r = __builtin_convertvector(v, bf16x2_t); return __builtin_bit_cast(unsigned, r); }
DI bf16 f2bf(float f) { return (bf16)(cvt_pk_bf16(f, 0.f) & 0xffffu); }
DI float bf2f(bf16 b) { return __uint_as_float(((unsigned)b) << 16); }
DI float bflo(unsigned w) { return __uint_as_float(w << 16); }
DI float bfhi(unsigned w) { return __uint_as_float(w & 0xffff0000u); }
DI float sigmoidf_(float x) { return __builtin_amdgcn_rcpf(1.f + __expf(-x)); }
DI float wave_sum(float v) {
#pragma unroll
    for (int o = 1; o < 64; o <<= 1) v += __shfl_xor(v, o);
    return v;
}
DI float wave_max(float v) {
#pragma unroll
    for (int o = 1; o < 64; o <<= 1) v = fmaxf(v, __shfl_xor(v, o));
    return v;
}
#define LDS_WAIT() asm volatile("s_waitcnt lgkmcnt(0)" ::: "memory")
#define VM_WAIT() asm volatile("s_waitcnt vmcnt(0)" ::: "memory")
#define MFMA16(a, b, c) __builtin_amdgcn_mfma_f32_16x16x32_bf16((a), (b), (c), 0, 0, 0)

#define XB_TMO      128
#define XB_XCNT(j)  (256  + 64 * (j))
#define XB_XSUB(j)  (1280 + 64 * (j))
#define XB_XGEN(j)  (2304 + 64 * (j))
#define XB_TOP      3328
#define XB_TOPGEN   3392
#define XCD_BAR_WORDS 3456
#define XB_SPIN_CAP (1u << 22)
__device__ __forceinline__ unsigned xb_ld(unsigned* p)              { return __hip_atomic_load(p, __ATOMIC_RELAXED, __HIP_MEMORY_SCOPE_AGENT); }
__device__ __forceinline__ unsigned xb_add(unsigned* p, unsigned v) { return __hip_atomic_fetch_add(p, v, __ATOMIC_RELAXED, __HIP_MEMORY_SCOPE_AGENT); }
__device__ __forceinline__ unsigned xb_xcc_id() { return (unsigned)__builtin_amdgcn_s_getreg((3 << 11) | 20) & 0xFu; }
#define XB_SPIN(cond, bar) do { unsigned _sp = 0; while (cond) { __builtin_amdgcn_s_sleep(1); \
    if ((++_sp & 255u) == 0u) { if (xb_ld(&(bar)[XB_TMO])) break; if (_sp > XB_SPIN_CAP) { atomicAdd(&(bar)[XB_TMO], 1u); break; } } } } while (0)
struct XcdBarrier { unsigned* bar; unsigned x; volatile LAS unsigned* st; };
__device__ __forceinline__ XcdBarrier xcd_barrier_post(unsigned* bar, volatile LAS unsigned* st) {
    XcdBarrier b; b.bar = bar; b.x = xb_xcc_id(); b.st = st;
    if (threadIdx.x == 0) (void)xb_add(&bar[XB_XCNT(b.x)], 1u);
    return b;
}
__device__ __attribute__((noinline)) unsigned long long xcd_barrier_complete(unsigned* bar, unsigned x) {
    const unsigned G = gridDim.x * gridDim.y * gridDim.z;
    unsigned sum, cnt, mine, sp = 0u;
    for (;;) {
        sum = 0u; cnt = 0u; mine = 0u;
#pragma unroll
        for (unsigned j = 0; j < 16; ++j) { const unsigned c = xb_ld(&bar[XB_XCNT(j)]); sum += c; cnt += (c > 0u) ? 1u : 0u; mine = (j == x) ? c : mine; }
        if (sum == G) break;
        __builtin_amdgcn_s_sleep(1);
        if ((++sp & 255u) == 0u) { if (xb_ld(&bar[XB_TMO])) break; if (sp > XB_SPIN_CAP) { atomicAdd(&bar[XB_TMO], 1u); break; } }
    }
    const unsigned nloc = mine > 0u ? mine : 1u, nx = cnt > 0u ? cnt : 1u;
    return ((unsigned long long)nx << 32) | nloc;
}
__device__ __forceinline__ void xcd_barrier(const XcdBarrier& b) {
    asm volatile("s_waitcnt vmcnt(0)" ::: "memory");
    __syncthreads();
    if (threadIdx.x == 0) {
        unsigned* bar = b.bar;
        __builtin_amdgcn_s_waitcnt(0);
        unsigned nloc = b.st[0], nx = b.st[1];
        if (nloc == 0u) { const unsigned long long r = xcd_barrier_complete(bar, b.x); nloc = (unsigned)r; nx = (unsigned)(r >> 32); b.st[0] = nloc; b.st[1] = nx; }
        const unsigned old = xb_add(&bar[XB_XSUB(b.x)], 1u);
        const unsigned gen = old / nloc;
        if (old + 1u == (gen + 1u) * nloc) {
            __builtin_amdgcn_fence(__ATOMIC_RELEASE, "agent");
            asm volatile("s_waitcnt vmcnt(0)" ::: "memory");
            const unsigned og = xb_add(&bar[XB_TOP], 1u);
            const unsigned tg = og / nx;
            if (og + 1u == (tg + 1u) * nx) xb_add(&bar[XB_TOPGEN], 1u);
            else XB_SPIN(xb_ld(&bar[XB_TOPGEN]) == tg, bar);
            __builtin_amdgcn_fence(__ATOMIC_ACQUIRE, "agent");
            xb_add(&bar[XB_XGEN(b.x)], 1u);
            asm volatile("s_waitcnt vmcnt(0)" ::: "memory");
        } else {
            XB_SPIN(xb_ld(&bar[XB_XGEN(b.x)]) == gen, bar);
            __builtin_amdgcn_fence(__ATOMIC_ACQUIRE, "agent");
            asm volatile("s_waitcnt vmcnt(0)" ::: "memory");
        }
    }
    __syncthreads();
}

namespace g8 {
constexpr int BM = 256, BK = 64, HALF = 128, HTB = HALF * BK * 2;
__host__ __device__ __forceinline__ int lds_byte(int r, int c) { const int st = (r >> 4) * 2 + (c >> 5), rr = r & 15, cc = c & 31, ob = rr * 64 + cc * 2; return st * 1024 + (ob ^ (((ob >> 9) & 1) << 5)); }
__host__ __device__ __forceinline__ void stage_rc(int b, int& R, int& C) { const int st = b / 1024, sb = b % 1024, swz = sb ^ (((sb >> 9) & 1) << 5); R = (st >> 1) * 16 + swz / 64; C = (st & 1) * 32 + (swz % 64) / 2; }
__host__ __device__ __forceinline__ int perm32(int rho) { const int n = rho >> 4, i = rho & 15; return 8 * (i >> 2) + 4 * n + (i & 3); }

struct Unit { const char* a; const char* b; char* c; int pm, pn, aux; };
DI void tile_of(int L, int nM, int nN, int& pm, int& pn) {
    const int nig = 8 * nN, gid = L / nig, fm = gid * 8, gsz = (nM - fm) < 8 ? (nM - fm) : 8, w = L % nig;
    pm = fm + (w % gsz); pn = w / gsz;
}
struct AffineOrder {
    const char* A; const char* B; char* C; size_t aM, bB, bN, cM, cS, cN; int nM, nN, bdiv, csp, G, c0;
    DI bool next(int i, Unit& u) const {
        const int L = i * G + c0; if (L >= nM * nN) return false;
        int pm, pn; tile_of(L, nM, nN, pm, pn); u.pm = pm; u.pn = pn; u.aux = 0;
        u.a = A + (size_t)pm * aM; u.b = B + (size_t)(pm / bdiv) * bB + (size_t)pn * bN; u.c = C + (size_t)pm * cM + (size_t)(pn / csp) * cS + (size_t)(pn % csp) * cN; return true;
    }
};
DI AffineOrder dense_order(const void* A, const void* B, void* C, int M, int N, int K, int ldc_bytes, int esz, int G, int c0) {
    AffineOrder o; o.A = (const char*)A; o.B = (const char*)B; o.C = (char*)C; o.aM = 256ull * K * 2; o.bB = 0; o.bN = 256ull * K * 2; o.cM = 256ull * ldc_bytes; o.cS = 0; o.cN = 256ull * esz;
    o.nM = M / 256; o.nN = N / 256; o.bdiv = 1 << 30; o.csp = 1 << 30; o.G = G; o.c0 = c0; return o;
}

DI void lds_rd2x16(unsigned addr, f32x4& a, f32x4& b) { asm volatile("ds_read_b128 %0, %2\n\tds_read_b128 %1, %2 offset:16\n\ts_waitcnt lgkmcnt(0)" : "=&v"(a), "=&v"(b) : "v"(addr) : "memory"); }
struct EpiBf16 {
    static constexpr bool PERM = true;
    int ldc; const float* bias; int bias_stride; float scl;
    DI void issue(const Unit& u, LAS unsigned char* lds, int wid, int lane) const {
        if (bias) __builtin_amdgcn_global_load_lds((const unsigned*)(bias + (size_t)u.aux * bias_stride + u.pn * 256 + (lane >> 5) * HALF + (wid & 3) * 32 + (lane & 31)), (LAS unsigned*)(lds + LDS_X + wid * 256), 4, 0, 0);
    }
    DI void operator()(f32x4 (&acc)[2][2][4][2], const Unit& u, int wr, int wc, int fr, int fq, LAS unsigned char* lds) const {
        const int col0 = wc * 32 + 8 * fq; const float sc = (u.aux < 0) ? scl : 1.f;
        f32x4 bv[2][2];
#pragma unroll
        for (int bj = 0; bj < 2; ++bj) { if (bias) lds_rd2x16((unsigned)(size_t)lds + LDS_X + (wr * 4 + wc) * 256 + bj * 128 + fq * 32, bv[bj][0], bv[bj][1]); else { bv[bj][0] = (f32x4){0.f, 0.f, 0.f, 0.f}; bv[bj][1] = (f32x4){0.f, 0.f, 0.f, 0.f}; } }
#pragma unroll
        for (int ai = 0; ai < 2; ++ai)
#pragma unroll
            for (int m = 0; m < 4; ++m) { bf16* rowp = (bf16*)u.c + (size_t)(ai * HALF + wr * 64 + m * 16 + fr) * ldc + col0;
#pragma unroll
                for (int bj = 0; bj < 2; ++bj) { const f32x4 v0 = acc[ai][bj][m][0] * sc + bv[bj][0], v1 = acc[ai][bj][m][1] * sc + bv[bj][1];
                    u32x4 w; w.x = cvt_pk_bf16(v0[0], v0[1]); w.y = cvt_pk_bf16(v0[2], v0[3]); w.z = cvt_pk_bf16(v1[0], v1[1]); w.w = cvt_pk_bf16(v1[2], v1[3]);
                    *(u32x4*)(rowp + bj * HALF) = w; } }
    }
};
struct EpiSoftmax {
    static constexpr bool PERM = true;
    int ldc;
    DI void issue(const Unit&, LAS unsigned char*, int, int) const {}
    DI void operator()(f32x4 (&acc)[2][2][4][2], const Unit& u, int wr, int wc, int fr, int fq, LAS unsigned char* lds) const {
        LAS f32x2* X = (LAS f32x2*)(lds + LDS_X);
#pragma unroll
        for (int ai = 0; ai < 2; ++ai)
#pragma unroll
            for (int m = 0; m < 4; ++m) {
                float v = -3.0e38f;
#pragma unroll
                for (int bj = 0; bj < 2; ++bj)
#pragma unroll
                    for (int n = 0; n < 2; ++n) { const f32x4 x = acc[ai][bj][m][n]; v = fmaxf(v, fmaxf(fmaxf(x[0], x[1]), fmaxf(x[2], x[3]))); }
                v = fmaxf(v, __shfl_xor(v, 16)); v = fmaxf(v, __shfl_xor(v, 32));
                float s = 0.f;
#pragma unroll
                for (int bj = 0; bj < 2; ++bj)
#pragma unroll
                    for (int n = 0; n < 2; ++n) { f32x4 x = acc[ai][bj][m][n]; x[0] = __expf(x[0] - v); x[1] = __expf(x[1] - v); x[2] = __expf(x[2] - v); x[3] = __expf(x[3] - v); acc[ai][bj][m][n] = x; s += (x[0] + x[1]) + (x[2] + x[3]); }
                s += __shfl_xor(s, 16); s += __shfl_xor(s, 32);
                if (fq == 0) X[(ai * HALF + wr * 64 + m * 16 + fr) * 4 + wc] = (f32x2){v, s};
            }
        LDS_WAIT(); __builtin_amdgcn_s_barrier(); asm volatile("" ::: "memory");
        const int col0 = wc * 32 + 8 * fq;
#pragma unroll
        for (int ai = 0; ai < 2; ++ai)
#pragma unroll
            for (int m = 0; m < 4; ++m) {
                const int r = ai * HALF + wr * 64 + m * 16 + fr;
                const f32x4 p01 = *(const LAS f32x4*)(X + r * 4), p23 = *(const LAS f32x4*)(X + r * 4 + 2);
                const float M = fmaxf(fmaxf(p01[0], p01[2]), fmaxf(p23[0], p23[2]));
                const float S = p01[1] * __expf(p01[0] - M) + p01[3] * __expf(p01[2] - M) + p23[1] * __expf(p23[0] - M) + p23[3] * __expf(p23[2] - M);
                const float f = __expf(X[r * 4 + wc][0] - M) * __builtin_amdgcn_rcpf(S);
                bf16* rowp = (bf16*)u.c + (size_t)r * ldc + col0;
#pragma unroll
                for (int bj = 0; bj < 2; ++bj) { const f32x4 v0 = acc[ai][bj][m][0] * f, v1 = acc[ai][bj][m][1] * f;
                    u32x4 w; w.x = cvt_pk_bf16(v0[0], v0[1]); w.y = cvt_pk_bf16(v0[2], v0[3]); w.z = cvt_pk_bf16(v1[0], v1[1]); w.w = cvt_pk_bf16(v1[2], v1[3]);
                    *(u32x4*)(rowp + bj * HALF) = w; }
                asm volatile("" ::: "memory");
            }
    }
};
struct EpiSwiglu {
    static constexpr bool PERM = true;
    const float* bgu;
    DI void issue(const Unit& u, LAS unsigned char* lds, int wid, int lane) const {
        __builtin_amdgcn_global_load_lds((const unsigned*)(bgu + (size_t)u.aux * 2048 + (lane >> 5) * 1024 + u.pn * 128 + (wid & 3) * 32 + (lane & 31)), (LAS unsigned*)(lds + LDS_X + wid * 256), 4, 0, 0);
    }
    DI void operator()(f32x4 (&acc)[2][2][4][2], const Unit& u, int wr, int wc, int fr, int fq, LAS unsigned char* lds) const {
        f32x4 bg[2], bl[2];
        lds_rd2x16((unsigned)(size_t)lds + LDS_X + (wr * 4 + wc) * 256 + fq * 32, bg[0], bg[1]);
        lds_rd2x16((unsigned)(size_t)lds + LDS_X + (wr * 4 + wc) * 256 + 128 + fq * 32, bl[0], bl[1]);
#pragma unroll
        for (int ai = 0; ai < 2; ++ai)
#pragma unroll
            for (int m = 0; m < 4; ++m) {
                float o[8];
#pragma unroll
                for (int n = 0; n < 2; ++n)
#pragma unroll
                    for (int j = 0; j < 4; ++j) {
                        const float glu = fminf(acc[ai][0][m][n][j] + bg[n][j], 7.0f);
                        const float lin = fminf(fmaxf(acc[ai][1][m][n][j] + bl[n][j], -7.0f), 7.0f);
                        o[4 * n + j] = (lin + 1.0f) * glu * sigmoidf_(1.702f * glu);
                    }
                u32x4 w; w.x = cvt_pk_bf16(o[0], o[1]); w.y = cvt_pk_bf16(o[2], o[3]); w.z = cvt_pk_bf16(o[4], o[5]); w.w = cvt_pk_bf16(o[6], o[7]);
                *(u32x4*)((bf16*)u.c + (size_t)(ai * HALF + wr * 64 + m * 16 + fr) * 1024 + wc * 32 + 8 * fq) = w;
            }
    }
};

template <class Epi, class Sched, bool GATHER = false>
__device__ __forceinline__ void gemm_phase(LAS unsigned char* lds, const int lda, const int ldb, const int nt, const Sched& S, const Epi& E, const unsigned* rowtab = nullptr) {
    int tid = threadIdx.x; asm volatile("" : "+v"(tid));
    const int wid = __builtin_amdgcn_readfirstlane(tid >> 6), lane = tid & 63, wr = wid >> 2, wc = wid & 3, fr = lane & 15, fq = lane >> 4;
    unsigned voffA[2], voffB[2];
#pragma unroll
    for (int i = 0; i < 2; ++i) { int R, C; stage_rc(tid * 16 + i * 8192, R, C); const int Rb = Epi::PERM ? ((R & ~31) + perm32(R & 31)) : R;
        voffA[i] = GATHER ? 0u : (unsigned)(R * lda + C * 2); voffB[i] = (unsigned)(Rb * ldb + C * 2); }
    unsigned gc[2][2] = {{0u, 0u}, {0u, 0u}}, gn[2][2] = {{0u, 0u}, {0u, 0u}};
#define PG8_GLOAD(dst, pm_) do { int _t = tid; asm volatile("" : "+v"(_t)); _Pragma("unroll") for (int _i = 0; _i < 2; ++_i) { int _R, _C; stage_rc(_t * 16 + _i * 8192, _R, _C); \
        _Pragma("unroll") for (int _h = 0; _h < 2; ++_h) dst[_h][_i] = __hip_atomic_load(rowtab + (size_t)(pm_) * 256 + _h * 128 + _R, __ATOMIC_RELAXED, __HIP_MEMORY_SCOPE_AGENT) * (unsigned)lda + (unsigned)(_C * 2); } } while (0)
    const size_t kstep = (size_t)(BK * 2);
    const size_t hstepA = (size_t)HALF * lda, hstepB = (size_t)HALF * ldb;
    const unsigned ldsw = (unsigned)wid * 1024u;
    const int aoff = lds_byte(wr * 64 + fr, fq * 8), boff = lds_byte(wc * 32 + fr, fq * 8);
#define PG8_SA(b, h) (((b) * 2 + (h)) * HTB)
#define PG8_SB(b, h) ((4 + (b) * 2 + (h)) * HTB)
#define PG8_STAGE(bufoff, gbase, voff) do { _Pragma("unroll") for (int _i = 0; _i < 2; ++_i) \
        __builtin_amdgcn_global_load_lds((const unsigned*)((const char*)(gbase) + (voff)[_i]), (LAS unsigned*)(lds + (bufoff) + ldsw + _i * 8192), 16, 0, 0); } while (0)
#define PG8_STAGE_A(bufoff, gbase, hh, nx) do { if (GATHER) { _Pragma("unroll") for (int _i = 0; _i < 2; ++_i) \
        __builtin_amdgcn_global_load_lds((const unsigned*)((const char*)(gbase) + ((nx) ? gn[hh][_i] : gc[hh][_i])), (LAS unsigned*)(lds + (bufoff) + ldsw + _i * 8192), 16, 0, 0); } \
        else PG8_STAGE(bufoff, (gbase) + (hh) * hstepA, voffA); } while (0)
#define PG8_LDA(dst, b, h) do { _Pragma("unroll") for (int m = 0; m < 4; ++m) _Pragma("unroll") for (int k = 0; k < 2; ++k) dst[m][k] = *(const LAS bf16x8*)(lds + PG8_SA(b, h) + aoff + m * 2048 + k * 1024); } while (0)
#define PG8_LDB(dst, b, h) do { _Pragma("unroll") for (int n = 0; n < 2; ++n) _Pragma("unroll") for (int k = 0; k < 2; ++k) dst[n][k] = *(const LAS bf16x8*)(lds + PG8_SB(b, h) + boff + n * 2048 + k * 1024); } while (0)
#define PG8_MMA(ai, bj, At, Bt) do { __builtin_amdgcn_s_setprio(1); _Pragma("unroll") for (int m = 0; m < 4; ++m) _Pragma("unroll") for (int n = 0; n < 2; ++n) _Pragma("unroll") for (int k = 0; k < 2; ++k) \
        acc[ai][bj][m][n] = __builtin_amdgcn_mfma_f32_16x16x32_bf16(Bt[n][k], At[m][k], acc[ai][bj][m][n], 0, 0, 0); __builtin_amdgcn_s_setprio(0); } while (0)
#define PG8_WAIT_V(n) asm volatile("s_waitcnt vmcnt(" #n ")" ::: "memory")
#define PG8_WAIT_L(n) asm volatile("s_waitcnt lgkmcnt(" #n ")" ::: "memory")
#define PG8_BAR __builtin_amdgcn_s_barrier()
#define PG8_SCHED __builtin_amdgcn_sched_barrier(0)
    Unit cur, nxt; int ui = 0;
    if (!S.next(0, cur)) return;
    f32x4 acc[2][2][4][2];
#pragma unroll
    for (int a = 0; a < 2; ++a)
#pragma unroll
        for (int b = 0; b < 2; ++b)
#pragma unroll
            for (int m = 0; m < 4; ++m)
#pragma unroll
                for (int n = 0; n < 2; ++n) acc[a][b][m][n] = (f32x4){0.f, 0.f, 0.f, 0.f};
    bf16x8 At[4][2], B0[2][2], B1[2][2];
    const char* cA = cur.a; const char* cB = cur.b;
    if (GATHER) { PG8_GLOAD(gc, cur.pm); }
    PG8_STAGE(PG8_SB(0, 0), cB, voffB); PG8_STAGE(PG8_SB(0, 1), cB + hstepB, voffB); PG8_STAGE_A(PG8_SA(0, 0), cA, 0, false); PG8_STAGE_A(PG8_SA(0, 1), cA, 1, false);
    if (wr == 1) PG8_BAR;
    PG8_WAIT_V(2); PG8_BAR;
    PG8_STAGE(PG8_SB(1, 0), cB + kstep, voffB); PG8_STAGE_A(PG8_SA(1, 0), cA + kstep, 0, false); PG8_STAGE(PG8_SB(1, 1), cB + hstepB + kstep, voffB);
    PG8_WAIT_V(6); PG8_BAR;
    for (;;) {
        const bool has_next = S.next(ui + 1, nxt);
        const char* nA = has_next ? nxt.a : cA; const char* nB = has_next ? nxt.b : cB;
        if (GATHER) { if (has_next) { PG8_GLOAD(gn, nxt.pm); } else { _Pragma("unroll") for (int _h = 0; _h < 2; ++_h) { gn[_h][0] = gc[_h][0]; gn[_h][1] = gc[_h][1]; } } }
#pragma unroll 1
        for (int t = 0; t < nt; t += 2) {
            const bool last = (t == nt - 2);
            const char* a1 = cA + (size_t)(t + 1) * kstep;
            const char* a2 = last ? nA : cA + (size_t)(t + 2) * kstep; const char* b2 = last ? nB : cB + (size_t)(t + 2) * kstep;
            const char* a3 = a2 + kstep; const char* b3 = b2 + kstep;
            PG8_LDB(B0, 0, 0); PG8_LDB(B1, 0, 1); PG8_SCHED; PG8_LDA(At, 0, 0); PG8_STAGE_A(PG8_SA(1, 1), a1, 1, false);
            if (t == 0) E.issue(cur, lds, wid, lane);
            PG8_WAIT_V(8); PG8_WAIT_L(0); PG8_BAR; PG8_MMA(0, 0, At, B0); PG8_MMA(0, 1, At, B1); PG8_BAR; PG8_SCHED;
            PG8_LDA(At, 0, 1); PG8_STAGE(PG8_SB(0, 0), b2, voffB); PG8_STAGE(PG8_SB(0, 1), b2 + hstepB, voffB); PG8_STAGE_A(PG8_SA(0, 0), a2, 0, last);
            PG8_WAIT_V(8); PG8_WAIT_L(0); PG8_BAR; PG8_MMA(1, 0, At, B0); PG8_MMA(1, 1, At, B1); PG8_BAR; PG8_SCHED;
            PG8_LDB(B0, 1, 0); PG8_LDB(B1, 1, 1); PG8_SCHED; PG8_LDA(At, 1, 0); PG8_STAGE_A(PG8_SA(0, 1), a2, 1, last);
            PG8_WAIT_V(8); PG8_WAIT_L(0); PG8_BAR; PG8_MMA(0, 0, At, B0); PG8_MMA(0, 1, At, B1); PG8_BAR; PG8_SCHED;
            PG8_LDA(At, 1, 1); PG8_STAGE(PG8_SB(1, 0), b3, voffB); PG8_STAGE(PG8_SB(1, 1), b3 + hstepB, voffB); PG8_STAGE_A(PG8_SA(1, 0), a3, 0, last);
            PG8_WAIT_V(8); PG8_WAIT_L(0); PG8_BAR; PG8_MMA(1, 0, At, B0); PG8_MMA(1, 1, At, B1); PG8_BAR; PG8_SCHED;
        }
        if (wr == 0) PG8_BAR;
        { int fr_e = fr, fq_e = fq; asm volatile("" : "+v"(fr_e), "+v"(fq_e)); E(acc, cur, wr, wc, fr_e, fq_e, lds); }
        if (!has_next) break;
#pragma unroll
        for (int a = 0; a < 2; ++a)
#pragma unroll
            for (int b = 0; b < 2; ++b)
#pragma unroll
                for (int m = 0; m < 4; ++m)
#pragma unroll
                    for (int n = 0; n < 2; ++n) acc[a][b][m][n] = (f32x4){0.f, 0.f, 0.f, 0.f};
        cur = nxt; cA = nA; cB = nB; ++ui;
        if (GATHER) { _Pragma("unroll") for (int _h = 0; _h < 2; ++_h) { gc[_h][0] = gn[_h][0]; gc[_h][1] = gn[_h][1]; } }
        if (wr == 1) PG8_BAR;
    }
    PG8_WAIT_V(0);
    PG8_BAR;
#undef PG8_SA
#undef PG8_SB
#undef PG8_STAGE
#undef PG8_LDA
#undef PG8_STAGE_A
#undef PG8_GLOAD
#undef PG8_LDB
#undef PG8_MMA
#undef PG8_WAIT_V
#undef PG8_WAIT_L
#undef PG8_BAR
#undef PG8_SCHED
}
}

struct Args { const float* in[27]; float* out; unsigned char* ws; int ph_lo, ph_hi; };
struct Ctx {
    LAS unsigned char* lds; unsigned char* ws; unsigned* ctl;
    int tid, lane, wave, vcu, G;
};
constexpr int LDS_PTAB = LDS_MISC + 1024;
DI void refresh(Ctx& F, unsigned char* wsb) { int t = threadIdx.x; asm volatile("" : "+v"(t)); F.tid = t; F.lane = t & 63; F.wave = __builtin_amdgcn_readfirstlane(t >> 6);
    unsigned lo = (unsigned)(unsigned long long)wsb, hi = (unsigned)((unsigned long long)wsb >> 32); asm volatile("" : "+v"(lo), "+v"(hi));
    lo = __builtin_amdgcn_readfirstlane(lo); hi = __builtin_amdgcn_readfirstlane(hi); F.ws = (unsigned char*)(GAS unsigned char*)(((unsigned long long)hi << 32) | lo); F.ctl = (unsigned*)F.ws;
    int bx = blockIdx.x; asm volatile("" : "+v"(bx)); bx = __builtin_amdgcn_readfirstlane(bx); F.G = 256; F.vcu = (bx & 7) * 32 + (bx >> 3);
    unsigned zb = 0u; asm volatile("" : "+v"(zb)); F.lds = (LAS unsigned char*)(unsigned)__builtin_amdgcn_readfirstlane(zb); }
DI const float* inp(const Ctx& F, int i) {
    const LAS unsigned* p = (const LAS unsigned*)(F.lds + LDS_PTAB) + 2 * i; const unsigned lo = __builtin_amdgcn_readfirstlane(p[0]), hi = __builtin_amdgcn_readfirstlane(p[1]);
    return (const float*)(GAS const float*)(((unsigned long long)hi << 32) | lo);
}
DI unsigned ldu(const unsigned* p) { return __hip_atomic_load(p, __ATOMIC_RELAXED, __HIP_MEMORY_SCOPE_AGENT); }
DI float ldf(const float* p) { return __uint_as_float(__hip_atomic_load((const unsigned*)p, __ATOMIC_RELAXED, __HIP_MEMORY_SCOPE_AGENT)); }

template <int MAP> DI int map_row(int n) {
    if (MAP == 0) return n;
    if (MAP == 1) return n < 1536 ? n : (n < 1544 ? -1 : (n < 3592 ? n - 8 : -1));
    return 256 * ((n & 1023) >> 7) + 128 * (n >> 10) + (n & 127);
}
template <int MAP> DI void tr_item(const float* W, int K, int N, bf16* WT, LAS float* scr, int item, int lane) {
    const int nblk = (N + 31) / 32, kb = item / nblk, nb = item % nblk, k0 = 64 * kb, n0 = 32 * nb;
    const int c4 = 4 * (lane & 7), nl = n0 + c4;
    f32x4 ld[8];
#pragma unroll
    for (int i = 0; i < 8; ++i) { const int kk = 8 * i + (lane >> 3); ld[i] = nl < N ? __builtin_nontemporal_load((const f32x4*)(W + (size_t)(k0 + kk) * N + nl)) : (f32x4){0.f, 0.f, 0.f, 0.f}; }
#pragma unroll
    for (int i = 0; i < 8; ++i) { const int kk = 8 * i + (lane >> 3); LAS float* d = scr + kk * 33 + c4; d[0] = ld[i][0]; d[1] = ld[i][1]; d[2] = ld[i][2]; d[3] = ld[i][3]; }
    LDS_WAIT(); asm volatile("" ::: "memory");
    const int c = lane & 7;
#pragma unroll
    for (int j = 0; j < 4; ++j) { const int nn = (lane >> 3) + 8 * j; const int n = n0 + nn; const LAS float* s = scr + (8 * c) * 33 + nn;
        const int dr = n < N ? map_row<MAP>(n) : -1;
        u32x4 o; o.x = cvt_pk_bf16(s[0 * 33], s[1 * 33]); o.y = cvt_pk_bf16(s[2 * 33], s[3 * 33]); o.z = cvt_pk_bf16(s[4 * 33], s[5 * 33]); o.w = cvt_pk_bf16(s[6 * 33], s[7 * 33]);
        if (dr >= 0) __builtin_nontemporal_store(o, (u32x4*)(WT + (size_t)dr * K + k0 + 8 * c)); }
    LDS_WAIT(); asm volatile("" ::: "memory");
}
DI void phase_convert(Ctx& F, const Args& a) {
    LAS float* scr = (LAS float*)(F.lds + F.wave * 16384);
    const int gw = F.vcu * NWAVES + F.wave, NGW = F.G * NWAVES;
    constexpr int I_WIN = 16 * 113, I_SQ = 16 * 32, I_GU = 16 * 64;
    constexpr int E0 = 4 * I_WIN, E1 = E0 + 4 * I_SQ, E2 = E1 + 4 * I_SQ, E3 = E2 + 4 * I_SQ, E4 = E3 + 4 * I_SQ, E5 = E4 + 128 * I_GU, E6 = E5 + 128 * I_SQ;
    for (int it = gw; it < E6; it += NGW) {
        if (it < E0) { const int l = it / I_WIN, r = it % I_WIN; tr_item<1>(inp(F, 2) + (size_t)l * D * 3600, D, 3600, (bf16*)(F.ws + WS_WIN) + (size_t)l * NPROJ * D, scr, r, F.lane); }
        else if (it < E1) { const int q = it - E0, l = q / I_SQ, r = q % I_SQ; tr_item<0>(inp(F, 10) + (size_t)l * D * D, D, D, (bf16*)(F.ws + WS_WOUT) + (size_t)l * D * D, scr, r, F.lane); }
        else if (it < E2) { const int q = it - E1, l = q / I_SQ, r = q % I_SQ; tr_item<0>(inp(F, 14) + (size_t)l * D * D, D, D, (bf16*)(F.ws + WS_WKV) + (size_t)(2 * l) * D * D, scr, r, F.lane); }
        else if (it < E3) { const int q = it - E2, l = q / I_SQ, r = q % I_SQ; tr_item<0>(inp(F, 15) + (size_t)l * D * D, D, D, (bf16*)(F.ws + WS_WKV) + (size_t)(2 * l + 1) * D * D, scr, r, F.lane); }
        else if (it < E4) { const int q = it - E3, l = q / I_SQ, r = q % I_SQ; tr_item<0>(inp(F, 16) + (size_t)l * D * D, D, D, (bf16*)(F.ws + WS_WO) + (size_t)l * D * D, scr, r, F.lane); }
        else if (it < E5) { const int q = it - E4, le = q / I_GU, r = q % I_GU; tr_item<2>(inp(F, 21) + (size_t)le * D * 2048, D, 2048, (bf16*)(F.ws + WS_WGU) + (size_t)le * 2048 * D, scr, r, F.lane); }
        else { const int q = it - E5, le = q / I_SQ, r = q % I_SQ; tr_item<0>(inp(F, 23) + (size_t)le * D * D, D, D, (bf16*)(F.ws + WS_WDN) + (size_t)le * D * D, scr, r, F.lane); }
    }
    const size_t gt = (size_t)blockIdx.x * NTHREADS + F.tid, NGT = (size_t)F.G * NTHREADS;
    for (size_t i = gt; i < (4ull * D * D + 2048ull * D) / 8; i += NGT) {
        const bool isq = i < 4ull * D * D / 8; const size_t j = isq ? i : i - 4ull * D * D / 8;
        const float* src = (isq ? inp(F, 13) : inp(F, 1)) + j * 8; bf16* dst = (bf16*)(F.ws + (isq ? WS_WQ : WS_MEMB)) + j * 8;
        const f32x4 v0 = *(const f32x4*)src, v1 = *(const f32x4*)(src + 4);
        u32x4 o; o.x = cvt_pk_bf16(v0[0], v0[1]); o.y = cvt_pk_bf16(v0[2], v0[3]); o.z = cvt_pk_bf16(v1[0], v1[1]); o.w = cvt_pk_bf16(v1[2], v1[3]);
        *(u32x4*)dst = o;
    }
    for (size_t i = gt; i < 4ull * 48 * D; i += NGT) {
        const int l = (int)(i / (48 * D)), r = (int)(i % (48 * D)), j = r / D, k = r % D;
        float w; bf16* dh; bf16* dl;
        if (j < 16) { const int col = j < 8 ? 1536 + j : 3592 + (j - 8); w = inp(F, 2)[((size_t)l * D + k) * 3600 + col];
            dh = (bf16*)(F.ws + WS_WGATE) + ((size_t)(l * 2 + 0) * 16 + j) * D + k; dl = dh + 16 * D; }
        else { const int e = j - 16; w = inp(F, 19)[((size_t)l * D + k) * 32 + e];
            dh = (bf16*)(F.ws + WS_WRT) + ((size_t)(l * 2 + 0) * 32 + e) * D + k; dl = dh + 32 * D; }
        const bf16 h = f2bf(w); *dh = h; *dl = f2bf(w - bf2f(h));
    }
}

DI void unpack8(const u32x4 w, float* v) { v[0] = bflo(w.x); v[1] = bfhi(w.x); v[2] = bflo(w.y); v[3] = bfhi(w.y); v[4] = bflo(w.z); v[5] = bfhi(w.z); v[6] = bflo(w.w); v[7] = bfhi(w.w); }
DI u32x4 pack8(const float* v) { u32x4 o; o.x = cvt_pk_bf16(v[0], v[1]); o.y = cvt_pk_bf16(v[2], v[3]); o.z = cvt_pk_bf16(v[4], v[5]); o.w = cvt_pk_bf16(v[6], v[7]); return o; }
#define PROF_RP(k) do { if (MODE == 2 && ((PROF_MASK) >> 23)) { if (blockIdx.x == 0 && threadIdx.x == 0) { volatile LAS unsigned long long* pw = (volatile LAS unsigned long long*)(F.lds + LDS_MISC + 128); \
        const unsigned long long now_ = __builtin_amdgcn_s_memrealtime(); if ((k) >= 0 && (((PROF_MASK) >> (23 + (k))) & 1)) pw[1] += now_ - pw[3]; pw[3] = now_; } } } while (0)
DI void ld2x16_sc1(const void* p0, const void* p1, u32x4& a, u32x4& b) {
    asm volatile("global_load_dwordx4 %0, %2, off sc0 sc1\n\tglobal_load_dwordx4 %1, %3, off sc0 sc1\n\ts_waitcnt vmcnt(0)" : "=&v"(a), "=&v"(b) : "v"(p0), "v"(p1) : "memory");
}
template <int MODE> DI void row_pass(Ctx& F, const Args& a, int l, const bool dummy = false) {
    const int lane = F.lane, r0 = (F.vcu * NWAVES + F.wave) * 16;
    bf16* XB = (bf16*)(F.ws + WS_XB); bf16* XBo = dummy ? (bf16*)(F.ws + WS_XG + 16 * MiB) : XB; const bf16* HB = (const bf16*)(F.ws + WS_HB); const bf16* Y = (const bf16*)(F.ws + WS_Y);
    const int c0 = 8 * lane, c1 = 512 + 8 * lane;
    LAS unsigned* ecnt = (LAS unsigned*)(F.lds + LDS_MISC + 256);
    if (MODE == 2) { if (F.tid < 64 && !dummy) ecnt[F.tid] = 0u; __syncthreads(); }
    PROF_RP(-1);
    constexpr int N16 = (MODE == 2) ? 2 : 1, NN = 16 * N16, NBLK = 32 * N16 * 2;
    const bool has_tail = !(MODE == 1 || (MODE == 3 && l == NL - 1));
    const bf16* Wb = (MODE == 2) ? (const bf16*)(F.ws + WS_WRT) + (size_t)l * 2 * 32 * D : (const bf16*)(F.ws + WS_WGATE) + (size_t)(MODE == 0 ? 0 : (l + 1 < NL ? l + 1 : 0)) * 2 * 16 * D;
    if (has_tail) {
#pragma unroll
        for (int q = 0; q < NBLK / 8; ++q) { const int blk = F.wave * (NBLK / 8) + q, ks = blk / (2 * N16), n = (blk >> 1) % N16, hl = blk & 1;
            __builtin_amdgcn_global_load_lds((const unsigned*)(Wb + (size_t)(hl * NN + n * 16 + (lane & 15)) * D + 32 * ks + 8 * (lane >> 4)), (LAS unsigned*)(F.lds + blk * 1024), 16, 0, 0); }
    }
    float g[16], bb[16];
    if (MODE >= 1) {
        const float* gp = inp(F, MODE == 1 ? 11 : (MODE == 2 ? 17 : 25)) + (size_t)l * D; const float* bp = inp(F, MODE == 1 ? 12 : (MODE == 2 ? 18 : 26)) + (size_t)l * D;
#pragma unroll
        for (int q = 0; q < 2; ++q) { const int c = q ? c1 : c0;
            const f32x4 g0 = *(const f32x4*)(gp + c), g1 = *(const f32x4*)(gp + c + 4), b0 = *(const f32x4*)(bp + c), b1 = *(const f32x4*)(bp + c + 4);
#pragma unroll
            for (int j = 0; j < 4; ++j) { g[8 * q + j] = g0[j]; g[8 * q + 4 + j] = g1[j]; bb[8 * q + j] = b0[j]; bb[8 * q + 4 + j] = b1[j]; } }
    }
    constexpr int RB = (MODE == 3) ? 2 : 4;
#pragma unroll 1
    for (int i0 = 0; i0 < 16; i0 += RB) {
        float v[RB][16];
        if (MODE == 0) {
            f32x4 xi[RB][4];
#pragma unroll
            for (int q = 0; q < RB; ++q) { const float* xr = inp(F, 0) + (size_t)(r0 + i0 + q) * D;
                xi[q][0] = *(const f32x4*)(xr + c0); xi[q][1] = *(const f32x4*)(xr + c0 + 4); xi[q][2] = *(const f32x4*)(xr + c1); xi[q][3] = *(const f32x4*)(xr + c1 + 4); }
#pragma unroll
            for (int q = 0; q < RB; ++q)
#pragma unroll
                for (int j = 0; j < 4; ++j) { v[q][j] = xi[q][0][j]; v[q][4 + j] = xi[q][1][j]; v[q][8 + j] = xi[q][2][j]; v[q][12 + j] = xi[q][3][j]; }
        } else {
            u32x4 xr[RB][2];
#pragma unroll
            for (int q = 0; q < RB; ++q) { xr[q][0] = *(const u32x4*)(XB + (size_t)(r0 + i0 + q) * D + c0); xr[q][1] = *(const u32x4*)(XB + (size_t)(r0 + i0 + q) * D + c1); }
            if (MODE == 3) {
                int slv = 0; float gkv = 0.f;
                if (lane < 4 * RB) { slv = (int)ldu((const unsigned*)(F.ws + WS_SLOT) + (size_t)(r0 + i0) * 4 + lane); gkv = ldf((const float*)(F.ws + WS_TOPG) + (size_t)(r0 + i0) * 4 + lane); }
                u32x4 yr[RB][4][2]; float gk[RB][4];
#pragma unroll
                for (int q = 0; q < RB; ++q)
#pragma unroll
                    for (int k = 0; k < 4; ++k) { const int sl = __shfl(slv, q * 4 + k); gk[q][k] = __shfl(gkv, q * 4 + k);
                        yr[q][k][0] = __builtin_nontemporal_load((const u32x4*)(Y + (size_t)sl * D + c0)); yr[q][k][1] = __builtin_nontemporal_load((const u32x4*)(Y + (size_t)sl * D + c1)); }
#pragma unroll
                for (int q = 0; q < RB; ++q) { float xv[16]; unpack8(xr[q][0], xv); unpack8(xr[q][1], xv + 8);
#pragma unroll
                    for (int j = 0; j < 16; ++j) v[q][j] = DN_ALPHA * xv[j];
#pragma unroll
                    for (int k = 0; k < 4; ++k) { float yv[16]; unpack8(yr[q][k][0], yv); unpack8(yr[q][k][1], yv + 8);
#pragma unroll
                        for (int j = 0; j < 16; ++j) v[q][j] += gk[q][k] * yv[j]; } }
            } else {
                u32x4 hr[RB][2];
#pragma unroll
                for (int q = 0; q < RB; ++q) { hr[q][0] = __builtin_nontemporal_load((const u32x4*)(HB + (size_t)(r0 + i0 + q) * D + c0)); hr[q][1] = __builtin_nontemporal_load((const u32x4*)(HB + (size_t)(r0 + i0 + q) * D + c1)); }
#pragma unroll
                for (int q = 0; q < RB; ++q) { float xv[16], hv[16]; unpack8(xr[q][0], xv); unpack8(xr[q][1], xv + 8); unpack8(hr[q][0], hv); unpack8(hr[q][1], hv + 8);
#pragma unroll
                    for (int j = 0; j < 16; ++j) v[q][j] = DN_ALPHA * xv[j] + hv[j]; }
            }
            float sm[RB];
#pragma unroll
            for (int q = 0; q < RB; ++q) { float t = 0.f;
#pragma unroll
                for (int j = 0; j < 16; ++j) t += v[q][j];
                sm[q] = t; }
#pragma unroll
            for (int o = 1; o < 64; o <<= 1)
#pragma unroll
                for (int q = 0; q < RB; ++q) sm[q] += __shfl_xor(sm[q], o);
            float sq[RB];
#pragma unroll
            for (int q = 0; q < RB; ++q) { const float mean = sm[q] * (1.f / D); float t = 0.f;
#pragma unroll
                for (int j = 0; j < 16; ++j) { v[q][j] -= mean; t += v[q][j] * v[q][j]; }
                sq[q] = t; }
#pragma unroll
            for (int o = 1; o < 64; o <<= 1)
#pragma unroll
                for (int q = 0; q < RB; ++q) sq[q] += __shfl_xor(sq[q], o);
#pragma unroll
            for (int q = 0; q < RB; ++q) { const float rstd = rsqrtf(sq[q] * (1.f / D) + 1e-5f);
#pragma unroll
                for (int j = 0; j < 16; ++j) v[q][j] = v[q][j] * rstd * g[j] + bb[j]; }
        }
#pragma unroll
        for (int q = 0; q < RB; ++q) { const int r = r0 + i0 + q;
            if (MODE == 3 && l == NL - 1) {
                float* orow = (float*)inp(F, 27) + (size_t)r * D;
                *(f32x4*)(orow + c0) = (f32x4){v[q][0], v[q][1], v[q][2], v[q][3]}; *(f32x4*)(orow + c0 + 4) = (f32x4){v[q][4], v[q][5], v[q][6], v[q][7]};
                *(f32x4*)(orow + c1) = (f32x4){v[q][8], v[q][9], v[q][10], v[q][11]}; *(f32x4*)(orow + c1 + 4) = (f32x4){v[q][12], v[q][13], v[q][14], v[q][15]};
            } else {
                *(u32x4*)(XBo + (size_t)r * D + c0) = pack8(v[q]); *(u32x4*)(XBo + (size_t)r * D + c1) = pack8(v[q] + 8);
            } }
    }
    if (MODE == 1 || (MODE == 3 && l == NL - 1)) return;
#ifdef DBG_NOROUTER
    if (MODE == 2) return;
#endif
    VM_WAIT(); __syncthreads(); PROF_RP(0); asm volatile("" ::: "memory");
    const bf16* arow = XBo + (size_t)(r0 + (lane & 15)) * D + 8 * (lane >> 4);
    f32x4 acc[N16];
#pragma unroll
    for (int n = 0; n < N16; ++n) acc[n] = (f32x4){0.f, 0.f, 0.f, 0.f};
#pragma unroll 8
    for (int ks = 0; ks < 32; ++ks) {
        const bf16x8 af = *(const bf16x8*)(arow + 32 * ks);
#pragma unroll
        for (int n = 0; n < N16; ++n) {
            const bf16x8 bh = *(const LAS bf16x8*)(F.lds + ((ks * N16 + n) * 2 + 0) * 1024 + lane * 16), bl = *(const LAS bf16x8*)(F.lds + ((ks * N16 + n) * 2 + 1) * 1024 + lane * 16);
            acc[n] = MFMA16(af, bh, acc[n]); acc[n] = MFMA16(af, bl, acc[n]);
        }
    }
    if (MODE != 2) {
        float* G = dummy ? (float*)(F.ws + WS_XG + 160 * MiB) : (float*)(F.ws + WS_GATES);
#pragma unroll
        for (int i = 0; i < 4; ++i) G[(size_t)(r0 + 4 * (lane >> 4) + i) * 16 + (lane & 15)] = acc[0][i];
        return;
    }
    if (MODE == 2) {
        if ((PROF_MASK) >> 23) __syncthreads(); PROF_RP(1);
        LAS float* LG = (LAS float*)(F.lds + 131072 + F.wave * 2176);
#pragma unroll
        for (int n = 0; n < N16; ++n)
#pragma unroll
            for (int i = 0; i < 4; ++i) LG[(4 * (lane >> 4) + i) * 33 + n * 16 + (lane & 15)] = acc[n][i];
        LDS_WAIT(); asm volatile("" ::: "memory");
        int te[4] = {0, 0, 0, 0}; float tv[4] = {0.f, 0.f, 0.f, 0.f}; unsigned rk[4] = {0u, 0u, 0u, 0u};
        if (lane < 16) {
            float lg[32]; const float* rb = inp(F, 20) + (size_t)l * 32;
#pragma unroll
            for (int e = 0; e < 32; ++e) lg[e] = LG[lane * 33 + e] + rb[e];
#pragma unroll
            for (int k = 0; k < 4; ++k) {
                float best = -3.0e38f; int bi = 0;
#pragma unroll
                for (int e = 0; e < 32; ++e) { const bool gt = lg[e] > best; best = gt ? lg[e] : best; bi = gt ? e : bi; }
                te[k] = bi; tv[k] = best;
#pragma unroll
                for (int e = 0; e < 32; ++e) lg[e] = (e == bi) ? -3.0e38f : lg[e];
            }
            const float e1 = __expf(tv[1] - tv[0]), e2 = __expf(tv[2] - tv[0]), e3 = __expf(tv[3] - tv[0]); const float inv = 1.f / (1.f + e1 + e2 + e3);
            tv[0] = inv; tv[1] = e1 * inv; tv[2] = e2 * inv; tv[3] = e3 * inv;
#pragma unroll
            for (int k = 0; k < 4; ++k) rk[k] = __hip_atomic_fetch_add(ecnt + (dummy ? 40 : 0) + te[k], 1u, __ATOMIC_RELAXED, __HIP_MEMORY_SCOPE_WORKGROUP);
        }
        __syncthreads(); PROF_RP(2);
        if (F.tid < 32 && !dummy) ecnt[32 + F.tid] = __hip_atomic_fetch_add(F.ctl + CW_ECNT + (l * 32 + F.tid) * 64, ecnt[F.tid], __ATOMIC_RELAXED, __HIP_MEMORY_SCOPE_AGENT);
        __syncthreads();
        if (lane < 16 && !dummy) {
            const int r = r0 + lane; int* pe = (int*)(F.ws + WS_TOPE) + (size_t)r * 4; int* pp = (int*)(F.ws + WS_TOPP) + (size_t)r * 4; float* pg = (float*)(F.ws + WS_TOPG) + (size_t)r * 4;
#pragma unroll
            for (int k = 0; k < 4; ++k) { pe[k] = te[k]; pp[k] = (int)(ecnt[32 + te[k]] + rk[k]); pg[k] = tv[k]; }
        }
        if ((PROF_MASK) >> 23) { VM_WAIT(); __syncthreads(); } PROF_RP(3);
    }
}

DI void phase_scatter(Ctx& F, int l) {
    LAS int* ts = (LAS int*)(F.lds + LDS_MISC + 512);
    if (F.tid < 64) {
        const int lane = F.tid; const int nt_ = (lane < 32) ? (int)((ldu(F.ctl + CW_ECNT + (l * 32 + lane) * 64) + 255u) >> 8) : 0;
        int inc = nt_;
#pragma unroll
        for (int o = 1; o < 32; o <<= 1) { const int t_ = __shfl_up(inc, o); inc += (lane >= o) ? t_ : 0; }
        if (lane < 32) ts[lane] = inc - nt_;
        if (lane == 31) ts[32] = inc; }
    __syncthreads();
    if (blockIdx.x == 0) {
        if (F.tid == 0) __hip_atomic_store(F.ctl + CW_NT + l, (unsigned)ts[32], __ATOMIC_RELAXED, __HIP_MEMORY_SCOPE_AGENT);
        for (int t = F.tid; t < ts[32]; t += NTHREADS) { int e = 0; while (e < 31 && t >= ts[e + 1]) ++e; F.ctl[CW_TILE_E + l * MAXTILES + t] = (unsigned)e; }
    }
    { const int r = F.vcu * 128 + (F.tid >> 2), k = F.tid & 3;
      const int e = ((const int*)(F.ws + WS_TOPE))[(size_t)r * 4 + k], p = ((const int*)(F.ws + WS_TOPP))[(size_t)r * 4 + k];
      const int slot = ts[e] * 256 + p;
      ((int*)(F.ws + WS_SLOT))[(size_t)r * 4 + k] = slot; ((unsigned*)(F.ws + WS_ROWTAB))[slot] = (unsigned)r; }
}
struct MoeOrder {
    const char* A; const char* B; char* C; const unsigned* tile_e; int NT, nN; size_t bE, bN, cN; int G, c0, gather, rev;
    DI bool next(int i, g8::Unit& u) const {
        const int L = i * G + c0; if (L >= NT * nN) return false;
        int pm, pn; g8::tile_of(L, NT, nN, pm, pn); if (rev) pm = NT - 1 - pm;
        const int e = __builtin_amdgcn_readfirstlane((int)ldu(tile_e + pm));
        u.pm = pm; u.pn = pn; u.aux = e; u.a = gather ? A : A + (size_t)pm * 256 * 2048; u.b = B + (size_t)e * bE + (size_t)pn * bN; u.c = C + (size_t)pm * 256 * 2048 + (size_t)pn * cN; return true;
    }
};

DI unsigned lds_addr(const LAS void* p) { return (unsigned)(size_t)p; }
DI bf16x8 tr_frag8(unsigned img, int ld_bytes, int row_lo, int row_hi, int m0, int lane) {
    const int i = lane & 15; const unsigned a_lo = img + (unsigned)((row_lo + (i >> 2)) * ld_bytes + (m0 + 4 * (i & 3)) * 2), a_hi = img + (unsigned)((row_hi + (i >> 2)) * ld_bytes + (m0 + 4 * (i & 3)) * 2);
    s16x4 lo, hi;
    asm volatile("ds_read_b64_tr_b16 %0, %2\n\tds_read_b64_tr_b16 %1, %3\n\ts_waitcnt lgkmcnt(0)" : "=&v"(lo), "=&v"(hi) : "v"(a_lo), "v"(a_hi) : "memory");
    return __builtin_shufflevector(lo, hi, 0, 1, 2, 3, 4, 5, 6, 7);
}
DI s16x4 tr_read4(unsigned addr) { s16x4 r; asm volatile("ds_read_b64_tr_b16 %0, %1\n\ts_waitcnt lgkmcnt(0)" : "=&v"(r) : "v"(addr) : "memory"); return r; }
DI bf16x8 pack_frag(const f32x4 a, const f32x4 b) {
    u32x4 p; p.x = cvt_pk_bf16(a[0], a[1]); p.y = cvt_pk_bf16(a[2], a[3]); p.z = cvt_pk_bf16(b[0], b[1]); p.w = cvt_pk_bf16(b[2], b[3]); return __builtin_bit_cast(bf16x8, p);
}
DI u32x2 pack4(const f32x4 a) { u32x2 p; p.x = cvt_pk_bf16(a[0], a[1]); p.y = cvt_pk_bf16(a[2], a[3]); return p; }
DI f32x4 unpack4(const u32x2 w) { return (f32x4){bflo(w.x), bfhi(w.x), bflo(w.y), bfhi(w.y)}; }
DI float softcap15(float x) { const float y = x * (1.f / 15.f); const float e = __expf(2.f * y); return 15.f * (1.f - 2.f * __builtin_amdgcn_rcpf(e + 1.f)); }
DI float log_sigmoid(float x) { return fminf(x, 0.f) - log1pf(__expf(-fabsf(x))); }
DI float softplusf_(float x) { return fmaxf(x, 0.f) + log1pf(__expf(-fabsf(x))); }
DI float wave_incl_sum(float v, int lane) {
#pragma unroll
    for (int o = 1; o < 64; o <<= 1) { const float t = __shfl_up(v, o); v += (lane >= o) ? t : 0.f; }
    return v;
}
DI float wave_incl_max(float v, int lane) {
#pragma unroll
    for (int o = 1; o < 64; o <<= 1) { const float t = __shfl_up(v, o); v = (lane >= o) ? fmaxf(v, t) : v; }
    return v;
}
constexpr int GA_QH = 0, GA_KH = 17408, GA_VB = 34816, GA_KB = 52224, GA_NA = 69632, GA_AD = 78848, GA_TI = 82944, GA_GC = 84992, GA_KEI = 86016;
constexpr int LDI = 136 * 2;
constexpr int LDK = 72 * 2;

#define DMA16(src, dst) __builtin_amdgcn_global_load_lds((const unsigned*)(src), (LAS unsigned*)(dst), 16, 0, 0)
#define DMA16NT(src, dst) __builtin_amdgcn_global_load_lds((const unsigned*)(src), (LAS unsigned*)(dst), 16, 0, 2)
DI u32x2 gld8(const void* p) { u32x2 r; asm volatile("global_load_dwordx2 %0, %1, off" : "=v"(r) : "v"(p) : "memory"); return r; }
DI float gld4(const void* p) { float r; asm volatile("global_load_dword %0, %1, off" : "=v"(r) : "v"(p) : "memory"); return r; }
DI u32x4 gld16(const void* p) { u32x4 r; asm volatile("global_load_dwordx4 %0, %1, off nt" : "=v"(r) : "v"(p) : "memory"); return r; }
struct MlAPre { u32x4 kraw, vraw[2]; float gi, gf; };
#define PROF_SUB(k) do { if ((PROF_MASK) >> 16) { if (blockIdx.x == 0 && threadIdx.x == 0) { volatile LAS unsigned long long* pw = (volatile LAS unsigned long long*)(F.lds + LDS_MISC + 128); \
        const unsigned long long now_ = __builtin_amdgcn_s_memrealtime(); if (((PROF_MASK) >> (16 + (k))) & 1) pw[1] += now_ - pw[3]; pw[3] = now_; } } } while (0)
DI void ml_a_fetch(Ctx& F, int cid, MlAPre& P) {
    const int b = cid >> 8, h = (cid >> 6) & 3, n = cid & 63, t0 = b * SEQ + n * CH, tid = F.tid, lane = F.lane;
    const bf16* PROJ = (const bf16*)(F.ws + WS_PROJ); const float* GT = (const float*)(F.ws + WS_GATES);
    P.kraw = gld16(PROJ + (size_t)(t0 + (tid >> 3)) * NPROJ + 256 + h * 64 + (tid & 7) * 8);
#pragma unroll
    for (int q = 0; q < 2; ++q) { const int idx = tid + 512 * q; P.vraw[q] = gld16(PROJ + (size_t)(t0 + (idx >> 4)) * NPROJ + 512 + h * 128 + (idx & 15) * 8); }
    P.gi = gld4(GT + (size_t)(t0 + lane) * 16 + h); P.gf = gld4(GT + (size_t)(t0 + lane) * 16 + 4 + h);
}
DI void ml_a_unit(Ctx& F, int l, int cid, int par, MlAPre& P, float bi, float bf_, float& gb, float& ga, float nalog, float dtb) {
    int tid = F.tid; asm volatile("" : "+v"(tid)); const int lane = tid & 63;
    LAS unsigned char* KE = F.lds + par * 45056; LAS unsigned char* VI = KE + 16384; LAS float* es = (LAS float*)(KE + 40960);
    asm volatile("s_waitcnt vmcnt(7)" : "+v"(P.kraw), "+v"(P.vraw[0]), "+v"(P.vraw[1]), "+v"(P.gi), "+v"(P.gf), "+v"(gb), "+v"(ga) :: "memory");
    const int ks_ = tid >> 3, kc8 = (tid & 7) * 8;
    const u32x4 kraw = P.kraw; const u32x4 vraw[2] = {P.vraw[0], P.vraw[1]};
    if (F.wave == 7) {
        const float ip = softcap15(P.gi + bi), fp = softcap15(P.gf + bf_);
        const float bc = wave_incl_sum(log_sigmoid(fp), lane), blast = __shfl(bc, 63), lw = blast - bc + ip, amax = wave_max(lw);
        es[lane] = __expf(lw - amax);
        if (lane == 0) { float* sc = (float*)(F.ws + WS_MLSC) + (size_t)cid * 4; sc[0] = blast; sc[1] = amax; }
    }
    if (F.wave == 6) {
        LAS float* gcs = (LAS float*)(F.lds + GA_GC); LAS float* bts = gcs + 64;
        const float beta = sigmoidf_(gb), gg = nalog * softplusf_(ga + dtb), gc = wave_incl_sum(gg, lane);
        gcs[lane] = gc; bts[lane] = beta;
        if (lane == 63) ((float*)(F.ws + WS_GDGL))[cid] = __expf(gc);
    }
#pragma unroll
    for (int q = 0; q < 2; ++q) { const int idx = tid + 512 * q, s_ = idx >> 4, c8 = (idx & 15) * 8; *(LAS u32x4*)(VI + s_ * LDI + c8 * 2) = vraw[q]; }
    __syncthreads();
    { float v[8]; unpack8(kraw, v); const float e = es[ks_];
#pragma unroll
      for (int j = 0; j < 8; ++j) v[j] *= e;
      *(LAS u32x4*)(KE + ks_ * LDK + kc8 * 2) = pack8(v); }
    __syncthreads();
    { const int g = lane >> 4, w = F.wave, ln = lane & 15; f32x4 acc[4], kacc[4];
#pragma unroll
      for (int nt = 0; nt < 4; ++nt) { acc[nt] = (f32x4){0.f, 0.f, 0.f, 0.f}; kacc[nt] = (f32x4){0.f, 0.f, 0.f, 0.f}; }
      const bf16x8 ones = (ln == 0) ? (bf16x8){0x3f80, 0x3f80, 0x3f80, 0x3f80, 0x3f80, 0x3f80, 0x3f80, 0x3f80} : (bf16x8){0, 0, 0, 0, 0, 0, 0, 0};
#pragma unroll
      for (int ks = 0; ks < 2; ++ks) { const int rb = 32 * ks + 8 * g;
          const bf16x8 af = tr_frag8(lds_addr(VI), LDI, rb, rb + 4, 16 * w, lane);
#pragma unroll
          for (int nt = 0; nt < 4; ++nt) { const bf16x8 bf = tr_frag8(lds_addr(KE), LDK, rb, rb + 4, 16 * nt, lane); acc[nt] = MFMA16(bf, af, acc[nt]);
              if (w == 0) kacc[nt] = MFMA16(ones, bf, kacc[nt]); } }
      bf16* U = (bf16*)(F.ws + WS_MLU) + (size_t)cid * 8192;
#pragma unroll
      for (int nt = 0; nt < 4; ++nt)
          *(u32x2*)(U + (w * 2 + (nt >> 1)) * 512 + ((2 * (nt & 1) + (g >> 1)) * 16 + ln) * 8 + 4 * (g & 1)) = pack4(acc[nt]);
      if (w == 0 && g == 0) {
#pragma unroll
          for (int nt = 0; nt < 4; ++nt) ((float*)(F.ws + WS_MLKN))[(size_t)cid * 64 + 16 * nt + ln] = kacc[nt][0]; }
    }
}
struct MlBBatch { u32x2 ub[8]; float kv[8]; u32x2 sc; };
DI void ml_b_fetch(const bf16* U, const float* SC, const float* KN, size_t cid0, int e0, int t, bool dn, MlBBatch& B) {
#pragma unroll
    for (int q = 0; q < 8; ++q) { const size_t cid = cid0 + q;
        B.ub[q] = gld8(U + cid * 8192 + e0);
        B.kv[q] = 0.f; if (dn) asm volatile("global_load_dword %0, %1, off" : "+v"(B.kv[q]) : "v"(KN + cid * 64 + t) : "memory"); }
    B.sc = gld8(SC + (cid0 + (t & 7)) * 4);
}
DI void ml_b_compute(const MlBBatch& B, bf16* CT, float* NP, float* MP, size_t cid0, int e0, int t, int p, bool dn, f32x4& C, float& nv, float& m) {
#pragma unroll
    for (int q = 0; q < 8; ++q) { const size_t cid = cid0 + q;
        *(u32x2*)(CT + cid * 8192 + e0) = pack4(C);
        if (dn) NP[cid * 64 + t] = nv; if (p == 0 && t == 0) MP[cid] = m;
        const float blq = __uint_as_float(__builtin_amdgcn_readlane(B.sc.x, q)), amq = __uint_as_float(__builtin_amdgcn_readlane(B.sc.y, q));
        const float mn = fmaxf(blq + m, amq), d1 = __expf(blq + m - mn), d2 = __expf(amq - mn);
        const f32x4 uv = unpack4(B.ub[q]);
#pragma unroll
        for (int k = 0; k < 4; ++k) C[k] = d1 * C[k] + d2 * uv[k];
        nv = d1 * nv + d2 * (dn ? B.kv[q] : 0.f); m = mn; }
}
#define MLB_TIE(B) do { _Pragma("unroll") for (int q_ = 0; q_ < 8; ++q_) asm volatile("" : "+v"(B.ub[q_]), "+v"(B.kv[q_])); asm volatile("" : "+v"(B.sc)); } while (0)
DI void ml_b_unit(Ctx& F, int u) {
    const int bh = u >> 3, p = u & 7, t = F.tid - 256, e0 = p * 1024 + 4 * t;
    const bf16* U = (const bf16*)(F.ws + WS_MLU); const float* SC = (const float*)(F.ws + WS_MLSC); const float* KN = (const float*)(F.ws + WS_MLKN);
    bf16* CT = (bf16*)(F.ws + WS_MLCT); float* NP = (float*)(F.ws + WS_MLNP); float* MP = (float*)(F.ws + WS_MLMP);
    f32x4 C = (f32x4){0.f, 0.f, 0.f, 0.f}; float nv = 0.f, m = 0.f; const bool dn = (p == 0 && t < 64);
    const size_t c0 = (size_t)bh * 64;
    MlBBatch A, B;
    ml_b_fetch(U, SC, KN, c0, e0, t, dn, A);
#pragma unroll
    for (int nb = 0; nb < 8; nb += 2) {
        ml_b_fetch(U, SC, KN, c0 + 8 * (nb + 1), e0, t, dn, B); asm volatile("s_waitcnt vmcnt(9)" ::: "memory"); MLB_TIE(A);
        ml_b_compute(A, CT, NP, MP, c0 + 8 * nb, e0, t, p, dn, C, nv, m);
        if (nb + 2 < 8) { ml_b_fetch(U, SC, KN, c0 + 8 * (nb + 2), e0, t, dn, A); asm volatile("s_waitcnt vmcnt(9)" ::: "memory"); } else asm volatile("s_waitcnt vmcnt(0)" ::: "memory");
        MLB_TIE(B);
        ml_b_compute(B, CT, NP, MP, c0 + 8 * (nb + 1), e0, t, p, dn, C, nv, m);
    }
}
DI void ml_c_unit(Ctx& F, const Args& a, int l, int cid, int par) {
    const int b = cid >> 8, h = (cid >> 6) & 3, n = cid & 63, t0 = b * SEQ + n * CH, lane = F.lane, tid = F.tid, g = lane >> 4, ln = lane & 15, w = F.wave, tt = w & 3, dh = w >> 2;
    const bf16* PROJ = (const bf16*)(F.ws + WS_PROJ); const float* GT = (const float*)(F.ws + WS_GATES);
    LAS unsigned char* VI = F.lds + par * 24576; LAS float* ib = (LAS float*)(VI + 20480); LAS float* Mt = ib + 64; LAS float* bcs = ib + 128; LAS float* ss = ib + 192;
    const float mprev = ldf((const float*)(F.ws + WS_MLMP) + cid);
    const bf16* CT = (const bf16*)(F.ws + WS_MLCT) + (size_t)cid * 8192; const float* NPv = (const float*)(F.ws + WS_MLNP) + (size_t)cid * 64;
    const int tl = 16 * tt + ln;
    bf16x8 qf[2], kf[4][2], ctf[5][2]; u32x2 ogr[4]; f32x4 nwr[4]; u32x4 vraw[2];
#pragma unroll
    for (int ks = 0; ks < 2; ++ks) { qf[ks] = *(const bf16x8*)(PROJ + (size_t)(t0 + tl) * NPROJ + h * 64 + 32 * ks + 8 * g);
#pragma unroll
        for (int ms = 0; ms < 4; ++ms) kf[ms][ks] = *(const bf16x8*)(PROJ + (size_t)(t0 + 16 * ms + ln) * NPROJ + 256 + h * 64 + 32 * ks + 8 * g);
#pragma unroll
        for (int mt = 0; mt < 4; ++mt) ctf[mt][ks] = *(const bf16x8*)(CT + (size_t)(16 * (4 * dh + mt) + ln) * 64 + 32 * ks + 8 * g);
        const f32x4 n0 = *(const f32x4*)(NPv + 32 * ks + 8 * g), n1 = *(const f32x4*)(NPv + 32 * ks + 8 * g + 4);
        float nvv[8];
#pragma unroll
        for (int j = 0; j < 4; ++j) { nvv[j] = (ln == 0) ? n0[j] : 0.f; nvv[4 + j] = (ln == 0) ? n1[j] : 0.f; }
        ctf[4][ks] = __builtin_bit_cast(bf16x8, pack8(nvv)); }
#pragma unroll
    for (int mt = 0; mt < 4; ++mt) { const int dv = 16 * (4 * dh + mt) + 4 * g;
        nwr[mt] = *(const f32x4*)(inp(F, 5) + (size_t)l * 512 + h * 128 + dv); ogr[mt] = *(const u32x2*)(PROJ + (size_t)(t0 + tl) * NPROJ + 1024 + h * 128 + dv); }
#pragma unroll
    for (int q = 0; q < 2; ++q) { const int idx = tid + 512 * q, s_ = idx >> 4, c8 = (idx & 15) * 8; vraw[q] = *(const u32x4*)(PROJ + (size_t)(t0 + s_) * NPROJ + 512 + h * 128 + c8); }
    if (w == 7) {
        const float ip = softcap15(GT[(size_t)(t0 + lane) * 16 + h] + inp(F, 3)[l * 4 + h]), fp = softcap15(GT[(size_t)(t0 + lane) * 16 + 4 + h] + inp(F, 4)[l * 4 + h]);
        const float bc = wave_incl_sum(log_sigmoid(fp), lane), ibs = ip - bc, pm = wave_incl_max(ibs, lane);
        ib[lane] = ibs; Mt[lane] = fmaxf(mprev, pm); bcs[lane] = bc;
    }
#pragma unroll
    for (int q = 0; q < 2; ++q) { const int idx = tid + 512 * q, s_ = idx >> 4, c8 = (idx & 15) * 8; *(LAS u32x4*)(VI + s_ * LDI + c8 * 2) = vraw[q]; }
    __syncthreads();
    f32x4 sacc[4];
#pragma unroll
    for (int ms = 0; ms < 4; ++ms) { sacc[ms] = (f32x4){0.f, 0.f, 0.f, 0.f};
#pragma unroll
        for (int ks = 0; ks < 2; ++ks) sacc[ms] = MFMA16(kf[ms][ks], qf[ks], sacc[ms]); }
    const float Mtt = Mt[tl];
#pragma unroll
    for (int ms = 0; ms < 4; ++ms) { const f32x4 ibv = *(const LAS f32x4*)(ib + 16 * ms + 4 * g);
#pragma unroll
        for (int i = 0; i < 4; ++i) { const int s = 16 * ms + 4 * g + i; sacc[ms][i] = (s <= tl) ? sacc[ms][i] * 0.125f * __expf(ibv[i] - Mtt) : 0.f; } }
    bf16x8 sb[2]; sb[0] = pack_frag(sacc[0], sacc[1]); sb[1] = pack_frag(sacc[2], sacc[3]);
    f32x4 xacc[5];
#pragma unroll
    for (int mt = 0; mt < 5; ++mt) { xacc[mt] = (f32x4){0.f, 0.f, 0.f, 0.f};
#pragma unroll
        for (int ks = 0; ks < 2; ++ks) xacc[mt] = MFMA16(ctf[mt][ks], qf[ks], xacc[mt]); }
    const float wint = 0.125f * __expf(mprev - Mtt);
#pragma unroll
    for (int mt = 0; mt < 5; ++mt) xacc[mt] *= wint;
    const bf16x8 ones = (ln == 0) ? (bf16x8){0x3f80, 0x3f80, 0x3f80, 0x3f80, 0x3f80, 0x3f80, 0x3f80, 0x3f80} : (bf16x8){0, 0, 0, 0, 0, 0, 0, 0};
#pragma unroll
    for (int kk = 0; kk < 2; ++kk) {
#pragma unroll
        for (int mt = 0; mt < 4; ++mt) { const bf16x8 vf = tr_frag8(lds_addr(VI), LDI, 32 * kk + 4 * g, 32 * kk + 16 + 4 * g, 16 * (4 * dh + mt), lane); xacc[mt] = MFMA16(vf, sb[kk], xacc[mt]); }
        xacc[4] = MFMA16(ones, sb[kk], xacc[4]);
    }
    const float den = __shfl(xacc[4][0], ln), mt_ = bcs[tl] + Mtt, dinv = __builtin_amdgcn_rcpf(fmaxf(fabsf(den), __expf(-mt_)));
    float ssq = 0.f;
#pragma unroll
    for (int mt = 0; mt < 4; ++mt) { xacc[mt] *= dinv; ssq += (xacc[mt][0] * xacc[mt][0] + xacc[mt][1] * xacc[mt][1]) + (xacc[mt][2] * xacc[mt][2] + xacc[mt][3] * xacc[mt][3]); }
    ssq += __shfl_xor(ssq, 16); ssq += __shfl_xor(ssq, 32);
    if (g == 0) ss[tl * 2 + dh] = ssq;
    __syncthreads();
    const float rinv = rsqrtf((ss[tl * 2] + ss[tl * 2 + 1]) * (1.f / 128.f) + 1e-6f);
    bf16* MX = (bf16*)(F.ws + WS_MIXED);
#pragma unroll
    for (int mt = 0; mt < 4; ++mt) { const int dv = 16 * (4 * dh + mt) + 4 * g;
        const f32x4 nw = nwr[mt]; const f32x4 og = unpack4(ogr[mt]);
        f32x4 o;
#pragma unroll
        for (int i = 0; i < 4; ++i) o[i] = xacc[mt][i] * rinv * nw[i] * sigmoidf_(og[i]);
        *(u32x2*)(MX + (size_t)(t0 + tl) * D + h * 128 + dv) = pack4(o); }
}

constexpr int GA_WT = 155648;
constexpr int GA_ST = 103424;
DI void gd_a_issue(Ctx& F, int cid, int w, int lane) {
    const int b = cid >> 8, h = (cid >> 6) & 3, n = cid & 63, t0 = b * SEQ + n * CH;
    const bf16* PROJ = (const bf16*)(F.ws + WS_PROJ);
#pragma unroll
    for (int q = 0; q < 7; ++q) { const int jj = (w + 8 * q) % 51, ten = jj / 17, grp = jj % 17;
        DMA16NT(PROJ + ((long)t0 - 3 + 4 * grp + (lane >> 4)) * NPROJ + 1536 + ten * 512 + h * 128 + 8 * (lane & 15), F.lds + GA_ST + ten * 17408 + grp * 1024); }
}
DI void gd_a_unit(Ctx& F, int l, int cid, float& gb, float& ga, float nalog, float dtb, bool has_next, MlAPre& P) {
    int tid = F.tid; asm volatile("" : "+v"(tid));
    const int b = cid >> 8, h = (cid >> 6) & 3, n = cid & 63, t0 = b * SEQ + n * CH, lane = tid & 63, g = lane >> 4, ln = lane & 15, w = F.wave;
    const float* GT = (const float*)(F.ws + WS_GATES);
    LAS unsigned char* L = F.lds; LAS float* gcs = (LAS float*)(L + GA_GC); LAS float* bts = gcs + 64;
    const int ten = tid >> 7, tg = (tid >> 4) & 7, cg = tid & 15;
    asm volatile("s_waitcnt vmcnt(0)" ::: "memory");
    __syncthreads();
    u32x4 raw[11];
    if (ten < 3) { const unsigned sa = lds_addr(L) + GA_ST + ten * 17408 + (8 * tg) * 256 + cg * 16;
        asm volatile("ds_read_b128 %0, %11\n\tds_read_b128 %1, %11 offset:256\n\tds_read_b128 %2, %11 offset:512\n\tds_read_b128 %3, %11 offset:768\n\tds_read_b128 %4, %11 offset:1024\n\tds_read_b128 %5, %11 offset:1280\n\t"
                     "ds_read_b128 %6, %11 offset:1536\n\tds_read_b128 %7, %11 offset:1792\n\tds_read_b128 %8, %11 offset:2048\n\tds_read_b128 %9, %11 offset:2304\n\tds_read_b128 %10, %11 offset:2560\n\ts_waitcnt lgkmcnt(0)"
                     : "=&v"(raw[0]), "=&v"(raw[1]), "=&v"(raw[2]), "=&v"(raw[3]), "=&v"(raw[4]), "=&v"(raw[5]), "=&v"(raw[6]), "=&v"(raw[7]), "=&v"(raw[8]), "=&v"(raw[9]), "=&v"(raw[10]) : "v"(sa) : "memory");
        if (n == 0 && tg == 0) { raw[0] = (u32x4){0u, 0u, 0u, 0u}; raw[1] = raw[0]; raw[2] = raw[0]; }
    }
    float wv[4][8];
#pragma unroll
    for (int j = 0; j < 4; ++j) unpack8(*(const LAS u32x4*)(L + GA_WT + (((ten < 3 ? ten : 0) * 4 + j) * 128 + 8 * cg) * 2), wv[j]);
    const float glast = gcs[63];
    bf16* qgb = (bf16*)(F.ws + WS_GDQG) + (size_t)cid * 8192 + (8 * tg) * 128 + 8 * cg; asm volatile("" : "+v"(qgb));
    if (ten < 3) {
#pragma unroll
        for (int i = 0; i < 8; ++i) { const int t = 8 * tg + i; float y[8];
#pragma unroll
            for (int c = 0; c < 8; ++c) y[c] = 0.f;
#pragma unroll
            for (int j = 0; j < 4; ++j) { float xv[8]; unpack8(raw[i + j], xv);
#pragma unroll
                for (int c = 0; c < 8; ++c) y[c] += wv[j][c] * xv[c]; }
#pragma unroll
            for (int c = 0; c < 8; ++c) y[c] = y[c] * sigmoidf_(y[c]);
            const float gct = gcs[t], bt = bts[t];
            if (ten < 2) { float s2 = 0.f;
#pragma unroll
                for (int c = 0; c < 8; ++c) s2 += y[c] * y[c];
                s2 += __shfl_xor(s2, 1); s2 += __shfl_xor(s2, 2); s2 += __shfl_xor(s2, 4); s2 += __shfl_xor(s2, 8);
                const float rn = rsqrtf(s2 + 1e-6f) * (ten == 0 ? 0.08838834764831845f : 1.f);
#pragma unroll
                for (int c = 0; c < 8; ++c) y[c] *= rn; }
            float z[8];
            if (ten == 0) { *(LAS u32x4*)(L + GA_QH + t * LDI + 16 * cg) = pack8(y); const float e = __expf(gct);
#pragma unroll
                for (int c = 0; c < 8; ++c) z[c] = y[c] * e;
                *(u32x4*)(qgb + i * 128) = pack8(z); }
            else if (ten == 1) { *(LAS u32x4*)(L + GA_KH + t * LDI + 16 * cg) = pack8(y); const float e1 = bt * __expf(gct), e2 = __expf(glast - gct);
#pragma unroll
                for (int c = 0; c < 8; ++c) z[c] = y[c] * e1;
                *(LAS u32x4*)(L + GA_KB + t * LDI + 16 * cg) = pack8(z);
#pragma unroll
                for (int c = 0; c < 8; ++c) z[c] = y[c] * e2;
                *(LAS u32x4*)(L + GA_KEI + t * LDI + 16 * cg) = pack8(z); }
            else {
#pragma unroll
                for (int c = 0; c < 8; ++c) z[c] = y[c] * bt;
                *(LAS u32x4*)(L + GA_VB + t * LDI + 16 * cg) = pack8(z); }
        }
    }
    __syncthreads(); PROF_SUB(1);
    if (has_next) {
        ml_a_fetch(F, cid + 256, P);
        gb = gld4(GT + (size_t)(t0 + SEQ + lane) * 16 + 8 + h); ga = gld4(GT + (size_t)(t0 + SEQ + lane) * 16 + 12 + h);
        gd_a_issue(F, cid + 256, w, lane); }
    { const int ti = w & 3, kind = w >> 2; const int tl = 16 * ti + ln; const float gct = gcs[tl], bt = bts[tl];
      bf16* QKD = (bf16*)(F.ws + WS_GDQK) + (size_t)cid * 4096;
#pragma unroll
      for (int si = 0; si < 4; ++si) {
          if (si <= ti) {
              f32x4 acc = (f32x4){0.f, 0.f, 0.f, 0.f};
#pragma unroll
              for (int ks = 0; ks < 4; ++ks) { const bf16x8 af = *(const LAS bf16x8*)(L + GA_KH + (16 * si + ln) * LDI + (32 * ks + 8 * g) * 2);
                  const bf16x8 bfr = *(const LAS bf16x8*)(L + (kind ? GA_QH : GA_KH) + tl * LDI + (32 * ks + 8 * g) * 2); acc = MFMA16(af, bfr, acc); }
              const f32x4 gs = *(const LAS f32x4*)(gcs + 16 * si + 4 * g);
              f32x4 v;
#pragma unroll
              for (int i = 0; i < 4; ++i) { const int s = 16 * si + 4 * g + i; const float dec = __expf(gct - gs[i]);
                  v[i] = kind ? ((s <= tl) ? acc[i] * dec : 0.f) : ((s < tl) ? bt * acc[i] * dec : 0.f); }
              if (kind) *(u32x2*)(QKD + (ti * 2 + (si >> 1)) * 512 + ((2 * (si & 1) + (g >> 1)) * 16 + ln) * 8 + (g & 1) * 4) = pack4(v);
              else { *(LAS u32x2*)(L + GA_NA + tl * LDK + (16 * si + 4 * g) * 2) = pack4(-v);
                  if (si == ti) { LAS float* AD = (LAS float*)(L + GA_AD) + ti * 256 + ln * 16 + 4 * g; AD[0] = v[0]; AD[1] = v[1]; AD[2] = v[2]; AD[3] = v[3]; } }
          } else if (kind) *(u32x2*)(QKD + (ti * 2 + (si >> 1)) * 512 + ((2 * (si & 1) + (g >> 1)) * 16 + ln) * 8 + (g & 1) * 4) = (u32x2){0u, 0u};
      } }
    __syncthreads(); PROF_SUB(2);
    if (w == 0) {
        const LAS float* AD = (const LAS float*)(L + GA_AD) + g * 256; float a_[16][16], acc[16];
#pragma unroll
        for (int t = 1; t < 16; ++t)
#pragma unroll
            for (int q = 0; q < 4; ++q) { if (4 * q < t) { const f32x4 r = *(const LAS f32x4*)(AD + t * 16 + 4 * q); a_[t][4 * q] = r[0]; a_[t][4 * q + 1] = r[1]; a_[t][4 * q + 2] = r[2]; a_[t][4 * q + 3] = r[3]; } }
#pragma unroll
        for (int t = 0; t < 16; ++t) acc[t] = (t == ln) ? 1.f : 0.f;
#pragma unroll
        for (int s_ = 0; s_ < 16; ++s_) { const float tc = acc[s_]; *(LAS bf16*)(L + GA_TI + (16 * g + s_) * 32 + ln * 2) = f2bf(tc);
#pragma unroll
            for (int t = s_ + 1; t < 16; ++t) acc[t] -= a_[t][s_] * tc; }
    }
    __syncthreads(); PROF_SUB(3);
    { const int src = (w < 4) ? GA_VB : GA_KB, cb = 32 * (w & 3);
      u32x2 Ub[4][2]; bf16* UT = (bf16*)(F.ws + WS_GDUT) + (size_t)cid * 8192;
#pragma unroll
      for (int i = 0; i < 4; ++i) {
          f32x4 acc[2];
#pragma unroll
          for (int nt = 0; nt < 2; ++nt)
#pragma unroll
              for (int r = 0; r < 4; ++r) acc[nt][r] = bf2f(*(const LAS bf16*)(L + src + (16 * i + 4 * g + r) * LDI + (cb + 16 * nt + ln) * 2));
#pragma unroll
          for (int jp = 0; jp < 2; ++jp) { if (2 * jp < i) {
              const u32x2 alo = *(const LAS u32x2*)(L + GA_NA + (16 * i + ln) * LDK + (32 * jp + 4 * g) * 2);
              const u32x2 ahi = (2 * jp + 1 < i) ? *(const LAS u32x2*)(L + GA_NA + (16 * i + ln) * LDK + (32 * jp + 16 + 4 * g) * 2) : (u32x2){0u, 0u};
              const bf16x8 af = __builtin_bit_cast(bf16x8, (u32x4){alo.x, alo.y, ahi.x, ahi.y});
#pragma unroll
              for (int nt = 0; nt < 2; ++nt) { const u32x2 blo = Ub[2 * jp][nt], bhi = (2 * jp + 1 < i) ? Ub[2 * jp + 1][nt] : (u32x2){0u, 0u};
                  acc[nt] = MFMA16(af, __builtin_bit_cast(bf16x8, (u32x4){blo.x, blo.y, bhi.x, bhi.y}), acc[nt]); } } }
          const u32x2 tlo = *(const LAS u32x2*)(L + GA_TI + (16 * i + ln) * 32 + (4 * g) * 2);
          const bf16x8 tf = __builtin_bit_cast(bf16x8, (u32x4){tlo.x, tlo.y, 0u, 0u});
#pragma unroll
          for (int nt = 0; nt < 2; ++nt) { const u32x2 p = pack4(acc[nt]);
              const f32x4 u = MFMA16(tf, __builtin_bit_cast(bf16x8, (u32x4){p.x, p.y, 0u, 0u}), ((f32x4){0.f, 0.f, 0.f, 0.f}));
              Ub[i][nt] = pack4(u);
              if (w < 4) *(u32x2*)(UT + ((cb >> 4) + nt) * 1024 + i * 256 + lane * 4) = Ub[i][nt];
              else {
#pragma unroll
                  for (int r = 0; r < 4; ++r) *(LAS bf16*)(L + GA_QH + (16 * i + 4 * g + r) * LDI + (cb + 16 * nt + ln) * 2) = f2bf(-u[r]); } }
      } }
    __syncthreads(); PROF_SUB(4);
    { bf16* W = (bf16*)(F.ws + WS_GDW) + (size_t)cid * 8192; bf16* KET = (bf16*)(F.ws + WS_GDKE) + (size_t)cid * 8192;
#pragma unroll
      for (int q = 0; q < 2; ++q) { const int item = tid + 512 * q, f = item >> 6, lp = item & 63, t = 16 * (f >> 2) + (lp & 15), kk = f & 3, gp = lp >> 4;
          const u32x2 lo = *(const LAS u32x2*)(L + GA_QH + t * LDI + (32 * kk + 4 * gp) * 2), hi = *(const LAS u32x2*)(L + GA_QH + t * LDI + (32 * kk + 16 + 4 * gp) * 2);
          *(u32x4*)(W + item * 8) = (u32x4){lo.x, lo.y, hi.x, hi.y}; }
#pragma unroll
      for (int q = 0; q < 4; ++q) { const int rg = 4 * q + g, kk = rg >> 3, idx = rg & 7, pos = 32 * kk + ((idx < 4) ? 8 * idx : 8 * (idx - 4) + 4);
          const int trow = 32 * kk + ((idx < 4) ? 4 * idx : 16 + 4 * (idx - 4));
          const s16x4 v = tr_read4(lds_addr(L + GA_KEI) + (unsigned)((trow + (ln >> 2)) * LDI + (16 * w + 4 * (ln & 3)) * 2));
          *(s16x4*)(KET + (w * 2 + kk) * 512 + ((idx & 3) * 16 + ln) * 8 + ((idx < 4) ? 0 : 4)) = v; }
    }
    __syncthreads(); PROF_SUB(5);
}
constexpr int GB_STAGE = 36864;
DI void gd_b_issue(const bf16* W, const bf16* KET, const bf16* UT, size_t cid, int dv0, int ln, int g, LAS unsigned char* buf) {
#pragma unroll
    for (int mt = 0; mt < 4; ++mt)
#pragma unroll
        for (int kk = 0; kk < 4; ++kk) __builtin_amdgcn_global_load_lds((const unsigned*)(W + cid * 8192 + (mt * 4 + kk) * 512 + (16 * g + ln) * 8), (LAS unsigned*)(buf + (mt * 4 + kk) * 1024), 16, 0, 2);
#pragma unroll
    for (int j = 0; j < 8; ++j)
#pragma unroll
        for (int k2 = 0; k2 < 2; ++k2) __builtin_amdgcn_global_load_lds((const unsigned*)(KET + cid * 8192 + (j * 2 + k2) * 512 + (16 * g + ln) * 8), (LAS unsigned*)(buf + (16 + j * 2 + k2) * 1024), 16, 0, 2);
#pragma unroll
    for (int q = 0; q < 2; ++q) __builtin_amdgcn_global_load_lds((const unsigned*)(UT + cid * 8192 + dv0 * 64 + q * 512 + (16 * g + ln) * 8), (LAS unsigned*)(buf + (32 + q) * 1024), 16, 0, 2);
}
#define GB_RD16(f, addr, WAITSTR) asm volatile( \
    "ds_read_b128 %0, %16\n\tds_read_b128 %1, %16 offset:1024\n\tds_read_b128 %2, %16 offset:2048\n\tds_read_b128 %3, %16 offset:3072\n\t" \
    "ds_read_b128 %4, %16 offset:4096\n\tds_read_b128 %5, %16 offset:5120\n\tds_read_b128 %6, %16 offset:6144\n\tds_read_b128 %7, %16 offset:7168\n\t" \
    "ds_read_b128 %8, %16 offset:8192\n\tds_read_b128 %9, %16 offset:9216\n\tds_read_b128 %10, %16 offset:10240\n\tds_read_b128 %11, %16 offset:11264\n\t" \
    "ds_read_b128 %12, %16 offset:12288\n\tds_read_b128 %13, %16 offset:13312\n\tds_read_b128 %14, %16 offset:14336\n\tds_read_b128 %15, %16 offset:15360" WAITSTR \
    : "=&v"(f[0]), "=&v"(f[1]), "=&v"(f[2]), "=&v"(f[3]), "=&v"(f[4]), "=&v"(f[5]), "=&v"(f[6]), "=&v"(f[7]), \
      "=&v"(f[8]), "=&v"(f[9]), "=&v"(f[10]), "=&v"(f[11]), "=&v"(f[12]), "=&v"(f[13]), "=&v"(f[14]), "=&v"(f[15]) : "v"(addr) : "memory")
constexpr int GB_NS = 4, GB_FLAGS = LDS_MISC + 512, GB_SPIN_CAP = 1 << 22;
DI void gd_b_step(Ctx& F, f32x4 (&S)[8], size_t cid, int dv0, int lane, int ln, int g, float egl, unsigned stage_base, int n) {
    const unsigned base = stage_base + (unsigned)lane * 16u;
    bf16* VNT = (bf16*)(F.ws + WS_GDVN); bf16* SPT = (bf16*)(F.ws + WS_GDSP);
    bf16x8 wf[16], kef[16]; u32x2 ui[4];
    asm volatile("ds_read_b64 %0, %4 offset:32768\n\tds_read_b64 %1, %4 offset:33280\n\tds_read_b64 %2, %4 offset:33792\n\tds_read_b64 %3, %4 offset:34304"
                 : "=&v"(ui[0]), "=&v"(ui[1]), "=&v"(ui[2]), "=&v"(ui[3]) : "v"(stage_base + (unsigned)lane * 8u) : "memory");
    GB_RD16(wf, base, "\n\ts_waitcnt lgkmcnt(0)");
    asm volatile("" : "+v"(ui[0]), "+v"(ui[1]), "+v"(ui[2]), "+v"(ui[3]));
    GB_RD16(kef, base + 16384u, "");
    f32x4 vacc[4]; bf16x8 sbn[4];
#pragma unroll
    for (int kk = 0; kk < 4; ++kk) sbn[kk] = pack_frag(S[2 * kk], S[2 * kk + 1]);
#pragma unroll
    for (int j = 0; j < 8; ++j) *(u32x2*)(SPT + cid * 16384 + ((dv0 >> 4) * 4 + (j >> 1)) * 512 + ((2 * (j & 1) + (g >> 1)) * 16 + ln) * 8 + (g & 1) * 4) = pack4(S[j]);
#pragma unroll
    for (int mt = 0; mt < 4; ++mt) vacc[mt] = unpack4(ui[mt]);
#pragma unroll
    for (int kk = 0; kk < 4; ++kk)
#pragma unroll
        for (int mt = 0; mt < 4; ++mt) vacc[mt] = MFMA16(wf[mt * 4 + kk], sbn[kk], vacc[mt]);
#pragma unroll
    for (int mt = 0; mt < 4; ++mt) *(u32x2*)(VNT + cid * 8192 + ((dv0 >> 4) * 2 + (mt >> 1)) * 512 + ((2 * (mt & 1) + (g >> 1)) * 16 + ln) * 8 + (g & 1) * 4) = pack4(vacc[mt]);
    bf16x8 vb[2]; vb[0] = pack_frag(vacc[0], vacc[1]); vb[1] = pack_frag(vacc[2], vacc[3]);
    asm volatile("s_waitcnt lgkmcnt(0)" : "+v"(kef[0]), "+v"(kef[1]), "+v"(kef[2]), "+v"(kef[3]), "+v"(kef[4]), "+v"(kef[5]), "+v"(kef[6]), "+v"(kef[7]),
                 "+v"(kef[8]), "+v"(kef[9]), "+v"(kef[10]), "+v"(kef[11]), "+v"(kef[12]), "+v"(kef[13]), "+v"(kef[14]), "+v"(kef[15]) :: "memory");
    if (lane == 0) ((volatile LAS unsigned*)(F.lds + GB_FLAGS))[4] = (unsigned)(n + 1);
#pragma unroll
    for (int j = 0; j < 8; ++j) S[j] *= egl;
#pragma unroll
    for (int k2 = 0; k2 < 2; ++k2)
#pragma unroll
        for (int j = 0; j < 8; ++j) S[j] = MFMA16(kef[j * 2 + k2], vb[k2], S[j]);
}
DI void gd_b_task(Ctx& F, int task) {
    const int bh = task >> 3, dv0 = 16 * (task & 7), lane = F.lane, g = lane >> 4, ln = lane & 15;
    const float* GL = (const float*)(F.ws + WS_GDGL);
    volatile LAS unsigned* fl = (volatile LAS unsigned*)(F.lds + GB_FLAGS);
    f32x4 S[8];
#pragma unroll
    for (int j = 0; j < 8; ++j) S[j] = (f32x4){0.f, 0.f, 0.f, 0.f};
    const size_t c0 = (size_t)bh * 64;
    const float eglv = ldf(GL + c0 + lane);
    asm volatile("s_waitcnt vmcnt(0)" ::: "memory");
    const unsigned L0 = lds_addr(F.lds);
#pragma unroll 1
    for (int n = 0; n < 64; ++n) {
        unsigned spins = 0;
        unsigned long long tp0_ = 0; if (((PROF_MASK) >> 22) & 1) tp0_ = __builtin_amdgcn_s_memrealtime();
        while (fl[n & 3] < (unsigned)(n + 1)) { __builtin_amdgcn_s_sleep(1); if (++spins > (unsigned)GB_SPIN_CAP) { fl[5] = 1u; break; } }
        if (((PROF_MASK) >> 22) & 1) { if (blockIdx.x == 0 && lane == 0) { volatile LAS unsigned long long* pw = (volatile LAS unsigned long long*)(F.lds + LDS_MISC + 128); pw[1] += __builtin_amdgcn_s_memrealtime() - tp0_; } }
        gd_b_step(F, S, c0 + n, dv0, lane, ln, g, __builtin_amdgcn_readlane(eglv, n), L0 + (unsigned)(n & 3) * GB_STAGE, n);
    }
}
DI void gd_b_loader(Ctx& F, int task, int li) {
    const int bh = task >> 3, dv0 = 16 * (task & 7), lane = F.lane, g = lane >> 4, ln = lane & 15;
    const bf16* UT = (const bf16*)(F.ws + WS_GDUT); const bf16* W = (const bf16*)(F.ws + WS_GDW); const bf16* KET = (const bf16*)(F.ws + WS_GDKE);
    volatile LAS unsigned* fl = (volatile LAS unsigned*)(F.lds + GB_FLAGS);
    const size_t c0 = (size_t)bh * 64;
    int prev = -1;
#pragma unroll 1
    for (int n = li; n < 64; n += 2) {
        if (n >= GB_NS) { unsigned spins = 0; while (fl[4] < (unsigned)(n - GB_NS + 1)) { __builtin_amdgcn_s_sleep(1); if (++spins > (unsigned)GB_SPIN_CAP) { fl[5] = 1u; break; } } }
        gd_b_issue(W, KET, UT, c0 + n, dv0, ln, g, F.lds + (n & 3) * GB_STAGE);
        if (prev >= 0) { asm volatile("s_waitcnt vmcnt(34)" ::: "memory"); if (lane == 0) fl[prev & 3] = (unsigned)(prev + 1); }
        prev = n;
    }
    asm volatile("s_waitcnt vmcnt(0)" ::: "memory"); if (lane == 0) fl[prev & 3] = (unsigned)(prev + 1);
}
DI void gd_c_unit(Ctx& F, const Args& a, int l, int cid, int par) {
    const int b = cid >> 8, h = (cid >> 6) & 3, n = cid & 63, t0 = b * SEQ + n * CH, lane = F.lane, g = lane >> 4, ln = lane & 15, w = F.wave, tt = w & 3, dh = w >> 2, tl = 16 * tt + ln;
    const bf16* PROJ = (const bf16*)(F.ws + WS_PROJ);
    const bf16* SPT = (const bf16*)(F.ws + WS_GDSP) + (size_t)cid * 16384; const bf16* QG = (const bf16*)(F.ws + WS_GDQG) + (size_t)cid * 8192;
    const bf16* VNT = (const bf16*)(F.ws + WS_GDVN) + (size_t)cid * 8192; const bf16* QKD = (const bf16*)(F.ws + WS_GDQK) + (size_t)cid * 4096;
    LAS float* ss = (LAS float*)(F.lds + par * 1024);
    bf16x8 qf[4], pf[2];
#pragma unroll
    for (int ks = 0; ks < 4; ++ks) qf[ks] = *(const bf16x8*)(QG + tl * 128 + 32 * ks + 8 * g);
#pragma unroll
    for (int ks = 0; ks < 2; ++ks) pf[ks] = *(const bf16x8*)(QKD + tl * 64 + 32 * ks + 8 * g);
    u32x2 zr[4]; f32x4 nwr[4];
#pragma unroll
    for (int mt = 0; mt < 4; ++mt) { const int dv = 16 * (4 * dh + mt) + 4 * g; nwr[mt] = *(const f32x4*)(inp(F, 9) + (size_t)l * 128 + dv); zr[mt] = *(const u32x2*)(PROJ + (size_t)(t0 + tl) * NPROJ + 3072 + h * 128 + dv); }
    f32x4 o[4]; float ssq = 0.f;
#pragma unroll
    for (int mt = 0; mt < 4; ++mt) { o[mt] = (f32x4){0.f, 0.f, 0.f, 0.f}; const int dvr = 16 * (4 * dh + mt) + ln;
#pragma unroll
        for (int ks = 0; ks < 4; ++ks) o[mt] = MFMA16(*(const bf16x8*)(SPT + (size_t)dvr * 128 + 32 * ks + 8 * g), qf[ks], o[mt]);
#pragma unroll
        for (int ks = 0; ks < 2; ++ks) o[mt] = MFMA16(*(const bf16x8*)(VNT + (size_t)dvr * 64 + 32 * ks + 8 * g), pf[ks], o[mt]);
        ssq += (o[mt][0] * o[mt][0] + o[mt][1] * o[mt][1]) + (o[mt][2] * o[mt][2] + o[mt][3] * o[mt][3]); }
    ssq += __shfl_xor(ssq, 16); ssq += __shfl_xor(ssq, 32);
    if (g == 0) ss[tl * 2 + dh] = ssq;
    __syncthreads();
    const float rinv = rsqrtf((ss[tl * 2] + ss[tl * 2 + 1]) * (1.f / 128.f) + 1e-6f);
    bf16* MX = (bf16*)(F.ws + WS_MIXED);
#pragma unroll
    for (int mt = 0; mt < 4; ++mt) { const int dv = 16 * (4 * dh + mt) + 4 * g;
        const f32x4 nw = nwr[mt]; const f32x4 z = unpack4(zr[mt]);
        f32x4 r;
#pragma unroll
        for (int i = 0; i < 4; ++i) r[i] = o[mt][i] * rinv * nw[i] * z[i] * sigmoidf_(z[i]);
        *(u32x2*)(MX + (size_t)(t0 + tl) * D + 512 + h * 128 + dv) = pack4(r); }
}

DI void phase_a(Ctx& F, const Args& a, int l) {
    const int h = (F.vcu >> 6) & 3, lane = F.lane, tid = F.tid, w = F.wave;
    const float* GT = (const float*)(F.ws + WS_GATES);
    for (int e = tid; e < 3 * 4 * 128; e += NTHREADS) { const int ten = e / 512, j = (e >> 7) & 3, c = e & 127;
        *(LAS bf16*)(F.lds + GA_WT + e * 2) = f2bf(inp(F, 6)[((size_t)l * 4 + j) * 1536 + ten * 512 + h * 128 + c]); }
    const float bi = inp(F, 3)[l * 4 + h], bf_ = inp(F, 4)[l * 4 + h], nalog = -__expf(inp(F, 7)[l * 4 + h]), dtb = inp(F, 8)[l * 4 + h];
    asm volatile("s_waitcnt vmcnt(0)" ::: "memory");
    const int t00 = (F.vcu & 63) * CH;
    {
        MlAPre P0; ml_a_fetch(F, F.vcu, P0);
        float gb0 = gld4(GT + (size_t)(t00 + lane) * 16 + 8 + h), ga0 = gld4(GT + (size_t)(t00 + lane) * 16 + 12 + h);
        gd_a_issue(F, F.vcu, w, lane);
        ml_a_unit(F, l, F.vcu, 0, P0, bi, bf_, gb0, ga0, nalog, dtb);
    }
#pragma unroll 1
    for (int i = 0; i < 8; ++i) {
        const int cid = F.vcu + 256 * i;
        MlAPre P; float gb = 0.f, ga = 0.f;
        gd_a_unit(F, l, cid, gb, ga, nalog, dtb, i + 1 < 8, P);
        if (i + 1 < 8) ml_a_unit(F, l, cid + 256, (i + 1) & 1, P, bi, bf_, gb, ga, nalog, dtb);
    }
    asm volatile("s_waitcnt vmcnt(0)" ::: "memory"); __syncthreads();
}
constexpr int CS_K = 0, CS_Q = 8192, CS_CT = 16384, CS_V = 32768, CS_NP = 49152, CS_SC = 49408, CS_GI = 50688, CS_GF = 50944, GS_SP = 51200, GS_QG = 83968, GS_VN = 100352, GS_QK = 116736, GS_SS = 124928;
constexpr int CS_OG = 126464, GS_Z = 142848, CS_MP = 159232;
DI void lds_rd4x8_nowait(unsigned addr, u32x2& a, u32x2& b, u32x2& c, u32x2& d) { asm volatile("ds_read_b64 %0, %4\n\tds_read_b64 %1, %4 offset:32\n\tds_read_b64 %2, %4 offset:64\n\tds_read_b64 %3, %4 offset:96" : "=&v"(a), "=&v"(b), "=&v"(c), "=&v"(d) : "v"(addr) : "memory"); }
DI float lds_rd4(unsigned addr) { float r; asm volatile("ds_read_b32 %0, %1\n\ts_waitcnt lgkmcnt(0)" : "=v"(r) : "v"(addr) : "memory"); return r; }
DI bf16x8 lds_frag(unsigned addr) { bf16x8 r; asm volatile("ds_read_b128 %0, %1" : "=v"(r) : "v"(addr) : "memory"); return r; }
DI f32x2 lds_rd8(unsigned addr) { f32x2 r; asm volatile("ds_read_b64 %0, %1\n\ts_waitcnt lgkmcnt(0)" : "=v"(r) : "v"(addr) : "memory"); return r; }
DI void mlc_issue(Ctx& F, int cid, int w, int lane) {
    const int b = cid >> 8, h = (cid >> 6) & 3, n = cid & 63, t0 = b * SEQ + n * CH, g = lane >> 4, ln = lane & 15;
    const bf16* PROJ = (const bf16*)(F.ws + WS_PROJ); const bf16* CT = (const bf16*)(F.ws + WS_MLCT) + (size_t)cid * 8192;
    DMA16NT(PROJ + (size_t)(t0 + 16 * (w >> 1) + ln) * NPROJ + 256 + h * 64 + 32 * (w & 1) + 8 * g, F.lds + CS_K + w * 1024);
    DMA16NT(PROJ + (size_t)(t0 + 16 * (w >> 1) + ln) * NPROJ + h * 64 + 32 * (w & 1) + 8 * g, F.lds + CS_Q + w * 1024);
#pragma unroll
    for (int ks = 0; ks < 2; ++ks) DMA16NT(CT + (2 * w + ks) * 512 + lane * 8, F.lds + CS_CT + (2 * w + ks) * 1024);
#pragma unroll
    for (int q = 0; q < 2; ++q) { const int j = 2 * w + q; DMA16NT(PROJ + (size_t)(t0 + 4 * j + g) * NPROJ + 512 + h * 128 + 8 * ln, F.lds + CS_V + j * 1024); }
    __builtin_amdgcn_global_load_lds((const unsigned*)((const float*)(F.ws + WS_MLNP) + (size_t)cid * 64 + lane), (LAS unsigned*)(F.lds + CS_NP), 4, 0, 0);
#pragma unroll
    for (int q = 0; q < 2; ++q) { const int j = 2 * w + q; DMA16NT(PROJ + (size_t)(t0 + 4 * j + g) * NPROJ + 1024 + h * 128 + 8 * ln, F.lds + CS_OG + j * 1024); }
    const float* GT = (const float*)(F.ws + WS_GATES);
    __builtin_amdgcn_global_load_lds((const unsigned*)(GT + (size_t)(t0 + lane) * 16 + h), (LAS unsigned*)(F.lds + CS_GI), 4, 0, 0);
    __builtin_amdgcn_global_load_lds((const unsigned*)(GT + (size_t)(t0 + lane) * 16 + 4 + h), (LAS unsigned*)(F.lds + CS_GF), 4, 0, 0);
    __builtin_amdgcn_global_load_lds((const unsigned*)((const float*)(F.ws + WS_MLMP) + cid), (LAS unsigned*)(F.lds + CS_MP), 4, 0, 0);
}
DI void gdc_issue(Ctx& F, int cid, int w, int lane) {
    const int g = lane >> 4, ln = lane & 15;
    const bf16* SPT = (const bf16*)(F.ws + WS_GDSP) + (size_t)cid * 16384; const bf16* QG = (const bf16*)(F.ws + WS_GDQG) + (size_t)cid * 8192;
    const bf16* VNT = (const bf16*)(F.ws + WS_GDVN) + (size_t)cid * 8192; const bf16* QKD = (const bf16*)(F.ws + WS_GDQK) + (size_t)cid * 4096;
#pragma unroll
    for (int ks = 0; ks < 4; ++ks) DMA16NT(SPT + (4 * w + ks) * 512 + lane * 8, F.lds + GS_SP + (4 * w + ks) * 1024);
#pragma unroll
    for (int q = 0; q < 2; ++q) { const int bq = 2 * w + q; DMA16NT(QG + (size_t)(16 * (bq >> 2) + ln) * 128 + 32 * (bq & 3) + 8 * g, F.lds + GS_QG + bq * 1024); }
#pragma unroll
    for (int ks = 0; ks < 2; ++ks) DMA16NT(VNT + (2 * w + ks) * 512 + lane * 8, F.lds + GS_VN + (2 * w + ks) * 1024);
    DMA16NT(QKD + w * 512 + lane * 8, F.lds + GS_QK + w * 1024);
    { const int b = cid >> 8, h = (cid >> 6) & 3, n = cid & 63, t0 = b * SEQ + n * CH; const bf16* PROJ = (const bf16*)(F.ws + WS_PROJ);
#pragma unroll
      for (int q = 0; q < 2; ++q) { const int j = 2 * w + q; DMA16NT(PROJ + (size_t)(t0 + 4 * j + g) * NPROJ + 3072 + h * 128 + 8 * ln, F.lds + GS_Z + j * 1024); } }
}
constexpr int GS_NW = 125440;
DI void phase_c(Ctx& F, const Args& a, int l) {
    const int lane = F.lane, g = lane >> 4, ln = lane & 15, w = F.wave, tt = w & 3, dh = w >> 2, tl = 16 * tt + ln;
    const int h = (F.vcu >> 6) & 3, n = F.vcu & 63;
    const bf16* PROJ = (const bf16*)(F.ws + WS_PROJ); const float* GT = (const float*)(F.ws + WS_GATES); bf16* MX = (bf16*)(F.ws + WS_MIXED);
    const unsigned L0 = lds_addr(F.lds);
    LAS float* ib = (LAS float*)(F.lds + CS_SC); LAS float* Mt = ib + 64; LAS float* bcs = ib + 128;
    if (F.tid < 256) ((LAS float*)(F.lds + GS_NW))[F.tid] = (F.tid < 128) ? inp(F, 5)[(size_t)l * 512 + h * 128 + F.tid] : inp(F, 9)[(size_t)l * 128 + F.tid - 128];
    const float bi = inp(F, 3)[l * 4 + h], bf_ = inp(F, 4)[l * 4 + h];
    asm volatile("s_waitcnt vmcnt(0)" ::: "memory");
    __syncthreads();
    mlc_issue(F, F.vcu, w, lane);
    gdc_issue(F, F.vcu, w, lane);
#pragma unroll 1
    for (int i = 0; i < 8; ++i) {
        const int cid = F.vcu + 256 * i, t0 = i * SEQ + n * CH;
        asm volatile("s_waitcnt vmcnt(11)" ::: "memory");
        const float mpv = lds_rd4(L0 + CS_MP + lane * 4);
        if (w == 7) { const float gi = lds_rd4(L0 + CS_GI + lane * 4), gf = lds_rd4(L0 + CS_GF + lane * 4); const float ip = softcap15(gi + bi), fp = softcap15(gf + bf_);
            const float bc = wave_incl_sum(log_sigmoid(fp), lane), ibs = ip - bc, pm = wave_incl_max(ibs, lane);
            ib[lane] = ibs; Mt[lane] = fmaxf(mpv, pm); bcs[lane] = bc; }
        asm volatile("s_waitcnt lgkmcnt(0)" ::: "memory"); __builtin_amdgcn_s_barrier(); asm volatile("" ::: "memory");
        const float mprev = mpv;
        const float Mtt = lds_rd8(L0 + CS_SC + 256 + (tl & ~1) * 4)[tl & 1], bct = lds_rd8(L0 + CS_SC + 512 + (tl & ~1) * 4)[tl & 1];
        bf16x8 qf[2], kf[4][2];
#pragma unroll
        for (int ks = 0; ks < 2; ++ks) { qf[ks] = lds_frag(L0 + CS_Q + (tt * 2 + ks) * 1024 + lane * 16);
#pragma unroll
            for (int ms = 0; ms < 4; ++ms) kf[ms][ks] = lds_frag(L0 + CS_K + (ms * 2 + ks) * 1024 + lane * 16); }
        f32x4 ibv[4], dum_;
#pragma unroll
        for (int ms = 0; ms < 4; ++ms) g8::lds_rd2x16(L0 + CS_SC + (16 * ms + 4 * g) * 4, ibv[ms], dum_);
        asm volatile("" : "+v"(qf[0]), "+v"(qf[1]), "+v"(kf[0][0]), "+v"(kf[0][1]), "+v"(kf[1][0]), "+v"(kf[1][1]), "+v"(kf[2][0]), "+v"(kf[2][1]), "+v"(kf[3][0]), "+v"(kf[3][1]));
        f32x4 sacc[4];
#pragma unroll
        for (int ms = 0; ms < 4; ++ms) { sacc[ms] = (f32x4){0.f, 0.f, 0.f, 0.f};
#pragma unroll
            for (int ks = 0; ks < 2; ++ks) sacc[ms] = MFMA16(kf[ms][ks], qf[ks], sacc[ms]); }
#pragma unroll
        for (int ms = 0; ms < 4; ++ms)
#pragma unroll
            for (int q = 0; q < 4; ++q) { const int s_ = 16 * ms + 4 * g + q; sacc[ms][q] = (s_ <= tl) ? sacc[ms][q] * 0.125f * __expf(ibv[ms][q] - Mtt) : 0.f; }
        bf16x8 sb[2]; sb[0] = pack_frag(sacc[0], sacc[1]); sb[1] = pack_frag(sacc[2], sacc[3]);
        bf16x8 ctf[5][2]; f32x4 npa[2], npb[2];
#pragma unroll
        for (int ks = 0; ks < 2; ++ks)
#pragma unroll
            for (int mt = 0; mt < 4; ++mt) ctf[mt][ks] = lds_frag(L0 + CS_CT + ((4 * dh + mt) * 2 + ks) * 1024 + lane * 16);
        g8::lds_rd2x16(L0 + CS_NP + (8 * g) * 4, npa[0], npa[1]); g8::lds_rd2x16(L0 + CS_NP + (32 + 8 * g) * 4, npb[0], npb[1]);
        asm volatile("" : "+v"(ctf[0][0]), "+v"(ctf[0][1]), "+v"(ctf[1][0]), "+v"(ctf[1][1]), "+v"(ctf[2][0]), "+v"(ctf[2][1]), "+v"(ctf[3][0]), "+v"(ctf[3][1]));
        { float nvv[8];
#pragma unroll
          for (int j = 0; j < 4; ++j) { nvv[j] = (ln == 0) ? npa[0][j] : 0.f; nvv[4 + j] = (ln == 0) ? npa[1][j] : 0.f; }
          ctf[4][0] = __builtin_bit_cast(bf16x8, pack8(nvv));
#pragma unroll
          for (int j = 0; j < 4; ++j) { nvv[j] = (ln == 0) ? npb[0][j] : 0.f; nvv[4 + j] = (ln == 0) ? npb[1][j] : 0.f; }
          ctf[4][1] = __builtin_bit_cast(bf16x8, pack8(nvv)); }
        f32x4 xacc[5];
#pragma unroll
        for (int mt = 0; mt < 5; ++mt) { xacc[mt] = (f32x4){0.f, 0.f, 0.f, 0.f};
#pragma unroll
            for (int ks = 0; ks < 2; ++ks) xacc[mt] = MFMA16(ctf[mt][ks], qf[ks], xacc[mt]); }
        const float wint = 0.125f * __expf(mprev - Mtt);
#pragma unroll
        for (int mt = 0; mt < 5; ++mt) xacc[mt] *= wint;
        const bf16x8 ones = (ln == 0) ? (bf16x8){0x3f80, 0x3f80, 0x3f80, 0x3f80, 0x3f80, 0x3f80, 0x3f80, 0x3f80} : (bf16x8){0, 0, 0, 0, 0, 0, 0, 0};
#pragma unroll
        for (int kk = 0; kk < 2; ++kk) {
#pragma unroll
            for (int mt = 0; mt < 4; ++mt) { const bf16x8 vf = tr_frag8(L0 + CS_V, 256, 32 * kk + 4 * g, 32 * kk + 16 + 4 * g, 16 * (4 * dh + mt), lane); xacc[mt] = MFMA16(vf, sb[kk], xacc[mt]); }
            xacc[4] = MFMA16(ones, sb[kk], xacc[4]); }
        const float den = __shfl(xacc[4][0], ln), dinv = __builtin_amdgcn_rcpf(fmaxf(fabsf(den), __expf(-(bct + Mtt))));
        float ssq = 0.f;
#pragma unroll
        for (int mt = 0; mt < 4; ++mt) { xacc[mt] *= dinv; ssq += (xacc[mt][0] * xacc[mt][0] + xacc[mt][1] * xacc[mt][1]) + (xacc[mt][2] * xacc[mt][2] + xacc[mt][3] * xacc[mt][3]); }
        ssq += __shfl_xor(ssq, 16); ssq += __shfl_xor(ssq, 32);
        if (g == 0) *(LAS float*)(F.lds + CS_SC + 768 + (tl * 2 + dh) * 4) = ssq;
        u32x2 og0, og1, og2, og3; lds_rd4x8_nowait(L0 + CS_OG + tl * 256 + (16 * 4 * dh + 4 * g) * 2, og0, og1, og2, og3);
        asm volatile("s_waitcnt lgkmcnt(0)" : "+v"(og0), "+v"(og1), "+v"(og2), "+v"(og3) :: "memory"); __builtin_amdgcn_s_barrier(); asm volatile("" ::: "memory");
        if (i + 1 < 8) mlc_issue(F, cid + 256, w, lane);
        { const f32x2 s2 = lds_rd8(L0 + CS_SC + 768 + tl * 8); const float rinv = rsqrtf((s2[0] + s2[1]) * (1.f / 128.f) + 1e-6f);
#pragma unroll
          for (int mt = 0; mt < 4; ++mt) { const int dv = 16 * (4 * dh + mt) + 4 * g; const f32x4 og = unpack4(mt == 0 ? og0 : (mt == 1 ? og1 : (mt == 2 ? og2 : og3))); f32x4 nw, o; g8::lds_rd2x16(L0 + GS_NW + dv * 4, nw, dum_);
#pragma unroll
              for (int q = 0; q < 4; ++q) o[q] = xacc[mt][q] * rinv * nw[q] * sigmoidf_(og[q]);
              *(u32x2*)(MX + (size_t)(t0 + tl) * D + h * 128 + dv) = pack4(o); } }
        if (i + 1 < 8) asm volatile("s_waitcnt vmcnt(12)" ::: "memory");
        else asm volatile("s_waitcnt vmcnt(0)" ::: "memory");
        __builtin_amdgcn_s_barrier(); asm volatile("" ::: "memory");
        bf16x8 gq[4], gp[2];
#pragma unroll
        for (int ks = 0; ks < 4; ++ks) gq[ks] = lds_frag(L0 + GS_QG + (tt * 4 + ks) * 1024 + lane * 16);
#pragma unroll
        for (int ks = 0; ks < 2; ++ks) gp[ks] = lds_frag(L0 + GS_QK + (tt * 2 + ks) * 1024 + lane * 16);
        f32x4 o[4]; float sq2 = 0.f;
#pragma unroll
        for (int mt = 0; mt < 4; ++mt) { bf16x8 gs[4], gv[2];
#pragma unroll
            for (int ks = 0; ks < 4; ++ks) gs[ks] = lds_frag(L0 + GS_SP + ((4 * dh + mt) * 4 + ks) * 1024 + lane * 16);
#pragma unroll
            for (int ks = 0; ks < 2; ++ks) gv[ks] = lds_frag(L0 + GS_VN + ((4 * dh + mt) * 2 + ks) * 1024 + lane * 16);
            asm volatile("s_waitcnt lgkmcnt(0)" : "+v"(gs[0]), "+v"(gs[1]), "+v"(gs[2]), "+v"(gs[3]), "+v"(gv[0]), "+v"(gv[1]), "+v"(gq[0]), "+v"(gq[1]), "+v"(gq[2]), "+v"(gq[3]), "+v"(gp[0]), "+v"(gp[1]) :: "memory");
            o[mt] = (f32x4){0.f, 0.f, 0.f, 0.f};
#pragma unroll
            for (int ks = 0; ks < 4; ++ks) o[mt] = MFMA16(gs[ks], gq[ks], o[mt]);
#pragma unroll
            for (int ks = 0; ks < 2; ++ks) o[mt] = MFMA16(gv[ks], gp[ks], o[mt]);
            sq2 += (o[mt][0] * o[mt][0] + o[mt][1] * o[mt][1]) + (o[mt][2] * o[mt][2] + o[mt][3] * o[mt][3]); }
        sq2 += __shfl_xor(sq2, 16); sq2 += __shfl_xor(sq2, 32);
        if (g == 0) *(LAS float*)(F.lds + GS_SS + (tl * 2 + dh) * 4) = sq2;
        u32x2 z0, z1, z2, z3; lds_rd4x8_nowait(L0 + GS_Z + tl * 256 + (16 * 4 * dh + 4 * g) * 2, z0, z1, z2, z3);
        asm volatile("s_waitcnt lgkmcnt(0)" : "+v"(z0), "+v"(z1), "+v"(z2), "+v"(z3) :: "memory"); __builtin_amdgcn_s_barrier(); asm volatile("" ::: "memory");
        if (i + 1 < 8) gdc_issue(F, cid + 256, w, lane);
        { const f32x2 s2 = lds_rd8(L0 + GS_SS + tl * 8); const float rinv = rsqrtf((s2[0] + s2[1]) * (1.f / 128.f) + 1e-6f);
#pragma unroll
          for (int mt = 0; mt < 4; ++mt) { const int dv = 16 * (4 * dh + mt) + 4 * g; const f32x4 z = unpack4(mt == 0 ? z0 : (mt == 1 ? z1 : (mt == 2 ? z2 : z3))); f32x4 nw, r; g8::lds_rd2x16(L0 + GS_NW + 512 + dv * 4, nw, dum_);
#pragma unroll
              for (int q = 0; q < 4; ++q) r[q] = o[mt][q] * rinv * nw[q] * z[q] * sigmoidf_(z[q]);
              *(u32x2*)(MX + (size_t)(t0 + tl) * D + 512 + h * 128 + dv) = pack4(r); } }
    }
    asm volatile("s_waitcnt vmcnt(0)" ::: "memory"); __syncthreads();
}
struct P2Order {
    unsigned char* ws; int G, c0;
    DI bool next(int i, g8::Unit& u) const {
        const int L = i * G + c0; if (L >= 1024) return false;
        const int q = L & 511, t4 = q & 3, h = (q >> 2) & 3, b = (q >> 4) & 7, l = q >> 7;
        if (L < 512) { u.a = (const char*)(ws + WS_KV) + ((size_t)(2 * l) * 2048 + b * 256) * 2048 + h * 512; u.b = (const char*)(ws + WS_WQ) + ((size_t)l * 1024 + t4 * 256) * 2048 + h * 512;
            u.c = (char*)(ws + WS_WQK) + ((size_t)(l * 8 + b) * 1024 + h * 256) * 2048 + t4 * 512; u.aux = -1; }
        else { u.a = (const char*)(ws + WS_WO) + ((size_t)l * 1024 + t4 * 256) * 2048 + h * 512; u.b = (const char*)(ws + WS_KV) + ((size_t)(2 * l + 1) * 2048 + b * 256) * 2048 + h * 512;
            u.c = (char*)(ws + WS_WVO) + ((size_t)(l * 8 + b) * 1024 + t4 * 256) * 2048 + h * 512; u.aux = 0; }
        u.pm = 0; u.pn = 0; return true;
    }
};

constexpr int NPH_LAYER = 13, NPH = 3 + NL * NPH_LAYER;
__global__ void __launch_bounds__(NTHREADS, 2) mega(Args a) {
    extern __shared__ __attribute__((aligned(16))) unsigned char lds_raw[];
    Ctx F; F.lds = (LAS unsigned char*)0u; F.ws = a.ws; F.ctl = (unsigned*)(a.ws + WS_CTL);
    F.tid = threadIdx.x; F.lane = F.tid & 63; F.wave = __builtin_amdgcn_readfirstlane(F.tid >> 6); F.G = gridDim.x;
    { const int bx = blockIdx.x; F.vcu = (F.G % 8 == 0) ? (bx % 8) * (F.G / 8) + bx / 8 : bx; }
    volatile LAS unsigned* MISC = (volatile LAS unsigned*)(F.lds + LDS_MISC);
    if (F.tid < 64) MISC[F.tid] = 0u;
    if ((unsigned)(size_t)(LAS unsigned char*)lds_raw != 0u) { if (F.tid == 0) atomicAdd(F.ctl + CW_BAR + XB_TMO, 1u); }
    if (F.tid < 28) { const unsigned long long pv = (unsigned long long)(F.tid < 27 ? (const void*)a.in[F.tid] : (const void*)a.out); ((LAS unsigned long long*)(F.lds + LDS_PTAB))[F.tid] = pv; }
    __syncthreads();
    const bool multi = (a.ph_hi - a.ph_lo) > 1;
    XcdBarrier bar; bar.bar = F.ctl + CW_BAR; bar.x = 0; bar.st = MISC;
    if (multi) bar = xcd_barrier_post(F.ctl + CW_BAR, MISC);
    if (PROF_MASK) { if (blockIdx.x == 0 && threadIdx.x == 0) { volatile LAS unsigned long long* pw = (volatile LAS unsigned long long*)(F.lds + LDS_MISC + 128); const unsigned long long t0_ = __builtin_amdgcn_s_memrealtime(); pw[0] = t0_; pw[1] = 0ull; pw[2] = t0_; } }
#ifndef PMASK
#define PMASK 0xffff
#endif
#define EN(j) (((PMASK) >> (j)) & 1)
#ifndef REPMASK
#define REPMASK 0x0
#endif
#define NREP(j) ((((REPMASK) >> (j)) & 1) ? 2 : 1)
#if REPMASK
#define REPLOOP(j) for (int rep_ = 0; rep_ < NREP(j); ++rep_, __syncthreads())
#else
#define REPLOOP(j)
#endif
#define PH(k) (a.ph_lo <= (k) && (k) < a.ph_hi && (refresh(F, a.ws), true))
#define PROF_TICK(k) do { if (PROF_MASK) { if (blockIdx.x == 0 && threadIdx.x == 0) { volatile LAS unsigned long long* pw = (volatile LAS unsigned long long*)(F.lds + LDS_MISC + 128); \
        const unsigned long long now_ = __builtin_amdgcn_s_memrealtime(); const int j_ = ((k) < 3) ? 13 + (k) : ((k) - 3) % NPH_LAYER; \
        if (((PROF_MASK) >> j_) & 1) pw[1] += now_ - pw[0]; pw[0] = now_; } } } while (0)
#define SEAM(k) do { if (PH(k) && PH((k) + 1)) { xcd_barrier(bar); if (((REPMASK) >> 16) & 1) xcd_barrier(bar); PROF_TICK(k); } } while (0)

    if (EN(13) && PH(0)) REPLOOP(13) { phase_convert(F, a); }
    SEAM(0);
    if (EN(14) && PH(1)) REPLOOP(14) {
        g8::AffineOrder S; S.A = (const char*)(F.ws + WS_MEMB); S.B = (const char*)(F.ws + WS_WKV); S.C = (char*)(F.ws + WS_KV);
        S.aM = 256ull * 2048; S.bB = 0; S.bN = 256ull * 2048; S.cM = 256ull * 2048; S.cS = 2048ull * 2048; S.cN = 512; S.nM = 8; S.nN = 32; S.bdiv = 1 << 30; S.csp = 4; S.G = F.G; S.c0 = F.vcu;
        g8::EpiBf16 E{1024, nullptr, 0, 1.f};
        g8::gemm_phase(F.lds, 2048, 2048, 16, S, E);
        row_pass<0>(F, a, 0);
    }
    SEAM(1);
    if (EN(15) && PH(2)) REPLOOP(15) { P2Order S{F.ws, F.G, F.vcu}; g8::EpiBf16 E{1024, nullptr, 0, 0.0625f}; g8::gemm_phase(F.lds, 2048, 2048, 4, S, E); }
    SEAM(2);
#pragma unroll 1
    for (int l = 0; l < NL; ++l) {
        const int pb = 3 + l * NPH_LAYER;
        if (EN(0) && PH(pb + 0)) REPLOOP(0) {
            g8::AffineOrder S = g8::dense_order(F.ws + WS_XB, F.ws + WS_WIN + (size_t)l * NPROJ * D * 2, F.ws + WS_PROJ, T, NPROJ, D, NPROJ * 2, 2, F.G, F.vcu);
            g8::EpiBf16 E{NPROJ, nullptr, 0, 1.f}; g8::gemm_phase(F.lds, 2048, 2048, 16, S, E);
        }
        SEAM(pb + 0);
        if (EN(1) && PH(pb + 1)) REPLOOP(1) {
            phase_a(F, a, l);
        }
        SEAM(pb + 1);
        if (EN(2) && PH(pb + 2)) REPLOOP(2) {
            if (F.tid < 8) ((volatile LAS unsigned*)(F.lds + GB_FLAGS))[F.tid] = 0u;
            __syncthreads();
            if (F.wave == 0) gd_b_task(F, F.vcu);
            else if (F.wave <= 2) gd_b_loader(F, F.vcu, F.wave - 1);
            else if (F.wave >= 4) ml_b_unit(F, F.vcu);
        }
        SEAM(pb + 2);
        if (EN(3) && PH(pb + 3)) REPLOOP(3) {
            phase_c(F, a, l);
        }
        SEAM(pb + 3);
        if (EN(4) && PH(pb + 4)) REPLOOP(4) {
            g8::AffineOrder S = g8::dense_order(F.ws + WS_MIXED, F.ws + WS_WOUT + (size_t)l * D * D * 2, F.ws + WS_HB, T, D, D, D * 2, 2, F.G, F.vcu);
            g8::EpiBf16 E{D, nullptr, 0, 1.f}; g8::gemm_phase(F.lds, 2048, 2048, 16, S, E);
        }
        SEAM(pb + 4);
        if (EN(5) && PH(pb + 5)) { row_pass<1>(F, a, l); if (NREP(5) == 2) { __syncthreads(); row_pass<1>(F, a, l, true); } }
        SEAM(pb + 5);
        if (EN(6) && PH(pb + 6)) REPLOOP(6) {
            g8::AffineOrder S = g8::dense_order(F.ws + WS_XB, F.ws + WS_WQK + (size_t)l * 8 * D * D * 2, F.ws + WS_PB, T, D, D, D * 2, 2, F.G, F.vcu);
            S.bB = (size_t)D * D * 2; S.bdiv = 16;
            g8::EpiSoftmax E{D}; g8::gemm_phase(F.lds, 2048, 2048, 16, S, E);
        }
        SEAM(pb + 6);
        if (EN(7) && PH(pb + 7)) REPLOOP(7) {
            g8::AffineOrder S = g8::dense_order(F.ws + WS_PB, F.ws + WS_WVO + (size_t)l * 8 * D * D * 2, F.ws + WS_HB, T, D, D, D * 2, 2, F.G, F.vcu);
            S.bB = (size_t)D * D * 2; S.bdiv = 16;
            g8::EpiBf16 E{D, nullptr, 0, 1.f}; g8::gemm_phase(F.lds, 2048, 2048, 16, S, E);
        }
        SEAM(pb + 7);
        if (EN(8) && PH(pb + 8)) { row_pass<2>(F, a, l); if (NREP(8) == 2) { __syncthreads(); row_pass<2>(F, a, l, true); } }
        SEAM(pb + 8);
        if (EN(9) && PH(pb + 9)) phase_scatter(F, l);
        SEAM(pb + 9);
        if (EN(10) && PH(pb + 10)) REPLOOP(10) {
            MoeOrder S; S.gather = 1; S.rev = 0; S.A = (const char*)(F.ws + WS_XB); S.B = (const char*)(F.ws + WS_WGU) + (size_t)l * 32 * 2048 * D * 2; S.C = (char*)(F.ws + WS_ACT); S.tile_e = F.ctl + CW_TILE_E + l * MAXTILES;
            S.NT = __builtin_amdgcn_readfirstlane((int)ldu(F.ctl + CW_NT + l)); S.nN = 8; S.bE = 2048ull * D * 2; S.bN = 256ull * 2048; S.cN = 256; S.G = F.G; S.c0 = F.vcu;
            g8::EpiSwiglu E{inp(F, 22) + (size_t)l * 32 * 2048}; g8::gemm_phase<g8::EpiSwiglu, MoeOrder, true>(F.lds, 2048, 2048, 16, S, E, (const unsigned*)(F.ws + WS_ROWTAB));
        }
        SEAM(pb + 10);
        if (EN(11) && PH(pb + 11)) REPLOOP(11) {
            MoeOrder S; S.gather = 0; S.rev = 1; S.A = (const char*)(F.ws + WS_ACT); S.B = (const char*)(F.ws + WS_WDN) + (size_t)l * 32 * D * D * 2; S.C = (char*)(F.ws + WS_Y); S.tile_e = F.ctl + CW_TILE_E + l * MAXTILES;
            S.NT = __builtin_amdgcn_readfirstlane((int)ldu(F.ctl + CW_NT + l)); S.nN = 4; S.bE = (size_t)D * D * 2; S.bN = 256ull * 2048; S.cN = 512; S.G = F.G; S.c0 = F.vcu;
            g8::EpiBf16 E{D, inp(F, 24) + (size_t)l * 32 * D, D, 1.f}; g8::gemm_phase(F.lds, 2048, 2048, 16, S, E);
        }
        SEAM(pb + 11);
        if (EN(12) && PH(pb + 12)) { row_pass<3>(F, a, l); if (NREP(12) == 2 && l < NL - 1) { __syncthreads(); row_pass<3>(F, a, l, true); } }
        SEAM(pb + 12);
    }
    if (PROF_MASK) {
        refresh(F, a.ws);
        xcd_barrier(bar); PROF_TICK(NPH - 1);
        if (blockIdx.x == 0 && threadIdx.x == 0) { volatile LAS unsigned long long* pw = (volatile LAS unsigned long long*)(F.lds + LDS_MISC + 128);
            const float f = (float)(double)pw[1] / (float)(double)(pw[0] - pw[2]); const float q = fminf(1.f, floorf(f * (float)(PROF_SCALE) * 32.f + (float)(PROF_OFS) * 0.5f) * (1.f / 32.f));
            __hip_atomic_store(F.ctl + CW_DBG, __float_as_uint(sqrtf(100.f * q)), __ATOMIC_RELAXED, __HIP_MEMORY_SCOPE_AGENT); }
        xcd_barrier(bar);
        const float c = __uint_as_float(ldu(F.ctl + CW_DBG)); float* o = (float*)inp(F, 27);
        for (size_t i = (size_t)blockIdx.x * NTHREADS + threadIdx.x; i < (size_t)T * D; i += (size_t)gridDim.x * NTHREADS) o[i] = c;
    }
}

#ifndef DBG_STOP
#define DBG_STOP 0
#endif
#ifndef DBG_OFF
#define DBG_OFF WS_XB
#endif
#ifndef DBG_N
#define DBG_N ((size_t)T * D)
#endif
#ifndef DBG_F32
#define DBG_F32 0
#endif
__global__ void dbg_dump(const unsigned char* ws, float* out, size_t off) {
    const bf16* b = (const bf16*)(ws + off); const float* f = (const float*)(ws + off);
    for (size_t i = (size_t)blockIdx.x * blockDim.x + threadIdx.x; i < (size_t)T * D; i += (size_t)gridDim.x * blockDim.x) out[i] = (i < (size_t)(DBG_N)) ? (DBG_F32 ? f[i] : bf2f(b[i])) : 0.f;
}
#ifndef N_LAUNCH_MODE
#define N_LAUNCH_MODE 1
#endif
extern "C" void kernel_launch(void* const* d_in, const int* in_sizes, int n_in, void* d_out, int out_size, void* d_ws, size_t ws_size, hipStream_t stream) {
    static int ready = 0;
    if (ready == 0) {
        if (n_in != 27 || ws_size < WS_END) { fprintf(stderr, "kernel_launch: need 27 inputs and %zu bytes of workspace (got %d, %zu)\n", (size_t)WS_END, n_in, ws_size); ready = -1; return; }
        if (hipFuncSetAttribute((const void*)mega, hipFuncAttributeMaxDynamicSharedMemorySize, LDS_BYTES) != hipSuccess) { fprintf(stderr, "kernel_launch: hipFuncSetAttribute failed\n"); ready = -1; return; }
        int per_cu = 0; (void)hipOccupancyMaxActiveBlocksPerMultiprocessor(&per_cu, (const void*)mega, NTHREADS, LDS_BYTES); (void)hipGetLastError();
        ready = 1;
    }
    if (ready < 0) return;
    (void)hipMemsetAsync((char*)d_ws + WS_CTL, 0, 1 << 20, stream);
    Args a{};
    for (int i = 0; i < 27; ++i) a.in[i] = (const float*)d_in[i];
    a.out = (float*)d_out; a.ws = (unsigned char*)d_ws;
#if N_LAUNCH_MODE == 1
    a.ph_lo = 0; a.ph_hi = (DBG_STOP > 0 ? DBG_STOP : NPH);
    hipLaunchKernelGGL(mega, dim3(256), dim3(NTHREADS), LDS_BYTES, stream, a);
    if (DBG_STOP > 0) hipLaunchKernelGGL(dbg_dump, dim3(2048), dim3(256), 0, stream, (const unsigned char*)d_ws, (float*)d_out, (size_t)(DBG_OFF));
#else
    for (int p = 0; p < (DBG_STOP > 0 ? DBG_STOP : NPH); ++p) { a.ph_lo = p; a.ph_hi = p + 1; hipLaunchKernelGGL(mega, dim3(256), dim3(NTHREADS), LDS_BYTES, stream, a); }
    if (DBG_STOP > 0) hipLaunchKernelGGL(dbg_dump, dim3(2048), dim3(256), 0, stream, (const unsigned char*)d_ws, (float*)d_out, (size_t)(DBG_OFF));
#endif
}
```

```cpp
#include <hip/hip_runtime.h>
#include <cstdio>
#include <cstdint>
#define PROF_SCALE 16
#define PROF_OFS 1
#ifndef PROF_MASK
#define PROF_MASK 0x0
#endif

#define LAS __attribute__((address_space(3)))
typedef unsigned short bf16;
typedef short bf16x8 __attribute__((ext_vector_type(8)));
typedef short s16x4 __attribute__((ext_vector_type(4)));
typedef float f32x4 __attribute__((ext_vector_type(4)));
typedef float f32x2 __attribute__((ext_vector_type(2)));
typedef unsigned u32x4 __attribute__((ext_vector_type(4)));
typedef unsigned u32x2 __attribute__((ext_vector_type(2)));
#define DI __device__ __forceinline__
#define GAS __attribute__((address_space(1)))

constexpr int T = 32768, D = 1024, NB = 8, SEQ = 4096, NL = 4, NCH = 64, CH = 64;
constexpr int NPROJ = 3584;
constexpr int NE = 32, TOPK = 4;
constexpr int MAXTILES = 544, CAP = MAXTILES * 256;
constexpr float DN_ALPHA = 1.6817928305074290f;
constexpr int NWAVES = 8, NTHREADS = 512;
constexpr int LDS_RING = 131072, LDS_X = 131072  , LDS_MISC = 163840 - 4096, LDS_BYTES = 163840;

constexpr size_t MiB = 1ull << 20;
constexpr size_t WS_CTL = 0;
constexpr size_t WS_ROWTAB = WS_CTL + 262144;
constexpr size_t WS_WIN = 1 * MiB;
constexpr size_t WS_WGATE = WS_WIN + 4ull * NPROJ * D * 2;
constexpr size_t WS_WRT = WS_WGATE + 4ull * 2 * 16 * D * 2;
constexpr size_t WS_WOUT = WS_WRT + 4ull * 2 * 32 * D * 2;
constexpr size_t WS_WQ = WS_WOUT + 4ull * D * D * 2;
constexpr size_t WS_WKV = WS_WQ + 4ull * D * D * 2;
constexpr size_t WS_WO = WS_WKV + 8ull * D * D * 2;
constexpr size_t WS_WGU = WS_WO + 4ull * D * D * 2;
constexpr size_t WS_WDN = WS_WGU + 4ull * 32 * 2048 * D * 2;
constexpr size_t WS_MEMB = WS_WDN + 4ull * 32 * D * D * 2;
constexpr size_t WS_KV = WS_MEMB + 2048ull * D * 2;
constexpr size_t WS_WQK = WS_KV + 8ull * 2048 * D * 2;
constexpr size_t WS_WVO = WS_WQK + 32ull * D * D * 2;
constexpr size_t WS_XB = WS_WVO + 32ull * D * D * 2;
constexpr size_t WS_PROJ = WS_XB + (size_t)T * D * 2;
constexpr size_t WS_GATES = WS_PROJ + (size_t)T * NPROJ * 2;
constexpr size_t WS_MIXED = WS_GATES + (size_t)T * 16 * 4;
constexpr size_t WS_HB = WS_MIXED + (size_t)T * D * 2;
constexpr size_t WS_PB = WS_HB + (size_t)T * D * 2;
constexpr size_t WS_TOPE = WS_PB + (size_t)T * D * 2;
constexpr size_t WS_TOPP = WS_TOPE + (size_t)T * 16;
constexpr size_t WS_TOPG = WS_TOPP + (size_t)T * 16;
constexpr size_t WS_SLOT = WS_TOPG + (size_t)T * 16;
constexpr size_t WS_XG = WS_SLOT + (size_t)T * 16;
constexpr size_t WS_ACT = WS_XG + (size_t)CAP * D * 2;
constexpr size_t WS_Y = WS_ACT + (size_t)CAP * D * 2;
constexpr size_t WS_MLU = WS_Y + (size_t)CAP * D * 2;
constexpr size_t WS_MLKN = WS_MLU + 2048ull * 8192 * 4;
constexpr size_t WS_MLSC = WS_MLKN + 2048ull * 64 * 4;
constexpr size_t WS_MLCT = WS_MLSC + 2048ull * 16;
constexpr size_t WS_MLNP = WS_MLCT + 2048ull * 8192 * 2;
constexpr size_t WS_MLMP = WS_MLNP + 2048ull * 64 * 4;
constexpr size_t WS_GDUT = WS_MLMP + 2048ull * 4;
constexpr size_t WS_GDW = WS_GDUT + 2048ull * 8192 * 2;
constexpr size_t WS_GDKE = WS_GDW + 2048ull * 8192 * 2;
constexpr size_t WS_GDQG = WS_GDKE + 2048ull * 8192 * 2;
constexpr size_t WS_GDQK = WS_GDQG + 2048ull * 8192 * 2;
constexpr size_t WS_GDGL = WS_GDQK + 2048ull * 4096 * 2;
constexpr size_t WS_GDVN = WS_GDGL + 2048ull * 4;
constexpr size_t WS_GDSP = WS_GDVN + 2048ull * 8192 * 2;
constexpr size_t WS_END = WS_GDSP + 2048ull * 16384 * 2;
constexpr int CW_BAR = 1024, CW_NT = 8192 + 256, CW_TILE_E = 8192 + 512, CW_DBG = 16384, CW_ECNT = 32768;

typedef __bf16 bf16x2_t __attribute__((ext_vector_type(2)));
DI unsigned cvt_pk_bf16(float lo, float hi) { const f32x2 v = {lo, hi}; const bf16x2_t r = __builtin_convertvector(v, bf16x2_t); return __builtin_bit_cast(unsigned, r); }
DI bf16 f2bf(float f) { return (bf16)(cvt_pk_bf16(f, 0.f) & 0xffffu); }
DI float bf2f(bf16 b) { return __uint_as_float(((unsigned)b) << 16); }
DI float bflo(unsigned w) { return __uint_as_float(w << 16); }
DI float bfhi(unsigned w) { return __uint_as_float(w & 0xffff0000u); }
DI float sigmoidf_(float x) { return __builtin_amdgcn_rcpf(1.f + __expf(-x)); }
DI float wave_sum(float v) {
#pragma unroll
    for (int o = 1; o < 64; o <<= 1) v += __shfl_xor(v, o);
    return v;
}
DI float wave_max(float v) {
#pragma unroll
    for (int o = 1; o < 64; o <<= 1) v = fmaxf(v, __shfl_xor(v, o));
    return v;
}
#define LDS_WAIT() asm volatile("s_waitcnt lgkmcnt(0)" ::: "memory")
#define VM_WAIT() asm volatile("s_waitcnt vmcnt(0)" ::: "memory")
#define MFMA16(a, b, c) __builtin_amdgcn_mfma_f32_16x16x32_bf16((a), (b), (c), 0, 0, 0)

#define XB_TMO      128
#define XB_XCNT(j)  (256  + 64 * (j))
#define XB_XSUB(j)  (1280 + 64 * (j))
#define XB_XGEN(j)  (2304 + 64 * (j))
#define XB_TOP      3328
#define XB_TOPGEN   3392
#define XCD_BAR_WORDS 3456
#define XB_SPIN_CAP (1u << 22)
__device__ __forceinline__ unsigned xb_ld(unsigned* p)              { return __hip_atomic_load(p, __ATOMIC_RELAXED, __HIP_MEMORY_SCOPE_AGENT); }
__device__ __forceinline__ unsigned xb_add(unsigned* p, unsigned v) { return __hip_atomic_fetch_add(p, v, __ATOMIC_RELAXED, __HIP_MEMORY_SCOPE_AGENT); }
__device__ __forceinline__ unsigned xb_xcc_id() { return (unsigned)__builtin_amdgcn_s_getreg((3 << 11) | 20) & 0xFu; }
#define XB_SPIN(cond, bar) do { unsigned _sp = 0; while (cond) { __builtin_amdgcn_s_sleep(1); \
    if ((++_sp & 255u) == 0u) { if (xb_ld(&(bar)[XB_TMO])) break; if (_sp > XB_SPIN_CAP) { atomicAdd(&(bar)[XB_TMO], 1u); break; } } } } while (0)
struct XcdBarrier { unsigned* bar; unsigned x; volatile LAS unsigned* st; };
__device__ __forceinline__ XcdBarrier xcd_barrier_post(unsigned* bar, volatile LAS unsigned* st) {
    XcdBarrier b; b.bar = bar; b.x = xb_xcc_id(); b.st = st;
    if (threadIdx.x == 0) (void)xb_add(&bar[XB_XCNT(b.x)], 1u);
    return b;
}
__device__ __attribute__((noinline)) unsigned long long xcd_barrier_complete(unsigned* bar, unsigned x) {
    const unsigned G = gridDim.x * gridDim.y * gridDim.z;
    unsigned sum, cnt, mine, sp = 0u;
    for (;;) {
        sum = 0u; cnt = 0u; mine = 0u;
#pragma unroll
        for (unsigned j = 0; j < 16; ++j) { const unsigned c = xb_ld(&bar[XB_XCNT(j)]); sum += c; cnt += (c > 0u) ? 1u : 0u; mine = (j == x) ? c : mine; }
        if (sum == G) break;
        __builtin_amdgcn_s_sleep(1);
        if ((++sp & 255u) == 0u) { if (xb_ld(&bar[XB_TMO])) break; if (sp > XB_SPIN_CAP) { atomicAdd(&bar[XB_TMO], 1u); break; } }
    }
    const unsigned nloc = mine > 0u ? mine : 1u, nx = cnt > 0u ? cnt : 1u;
    return ((unsigned long long)nx << 32) | nloc;
}
__device__ __forceinline__ void xcd_barrier(const XcdBarrier& b) {
    asm volatile("s_waitcnt vmcnt(0)" ::: "memory");
    __syncthreads();
    if (threadIdx.x == 0) {
        unsigned* bar = b.bar;
        __builtin_amdgcn_s_waitcnt(0);
        unsigned nloc = b.st[0], nx = b.st[1];
        if (nloc == 0u) { const unsigned long long r = xcd_barrier_complete(bar, b.x); nloc = (unsigned)r; nx = (unsigned)(r >> 32); b.st[0] = nloc; b.st[1] = nx; }
        const unsigned old = xb_add(&bar[XB_XSUB(b.x)], 1u);
        const unsigned gen = old / nloc;
        if (old + 1u == (gen + 1u) * nloc) {
            __builtin_amdgcn_fence(__ATOMIC_RELEASE, "agent");
            asm volatile("s_waitcnt vmcnt(0)" ::: "memory");
            const unsigned og = xb_add(&bar[XB_TOP], 1u);
            const unsigned tg = og / nx;
            if (og + 1u == (tg + 1u) * nx) xb_add(&bar[XB_TOPGEN], 1u);
            else XB_SPIN(xb_ld(&bar[XB_TOPGEN]) == tg, bar);
            __builtin_amdgcn_fence(__ATOMIC_ACQUIRE, "agent");
            xb_add(&bar[XB_XGEN(b.x)], 1u);
            asm volatile("s_waitcnt vmcnt(0)" ::: "memory");
        } else {
            XB_SPIN(xb_ld(&bar[XB_XGEN(b.x)]) == gen, bar);
            __builtin_amdgcn_fence(__ATOMIC_ACQUIRE, "agent");
            asm volatile("s_waitcnt vmcnt(0)" ::: "memory");
        }
    }
    __syncthreads();
}

namespace g8 {
constexpr int BM = 256, BK = 64, HALF = 128, HTB = HALF * BK * 2;
__host__ __device__ __forceinline__ int lds_byte(int r, int c) { const int st = (r >> 4) * 2 + (c >> 5), rr = r & 15, cc = c & 31, ob = rr * 64 + cc * 2; return st * 1024 + (ob ^ (((ob >> 9) & 1) << 5)); }
__host__ __device__ __forceinline__ void stage_rc(int b, int& R, int& C) { const int st = b / 1024, sb = b % 1024, swz = sb ^ (((sb >> 9) & 1) << 5); R = (st >> 1) * 16 + swz / 64; C = (st & 1) * 32 + (swz % 64) / 2; }
__host__ __device__ __forceinline__ int perm32(int rho) { const int n = rho >> 4, i = rho & 15; return 8 * (i >> 2) + 4 * n + (i & 3); }

struct Unit { const char* a; const char* b; char* c; int pm, pn, aux; };
DI void tile_of(int L, int nM, int nN, int& pm, int& pn) {
    const int nig = 8 * nN, gid = L / nig, fm = gid * 8, gsz = (nM - fm) < 8 ? (nM - fm) : 8, w = L % nig;
    pm = fm + (w % gsz); pn = w / gsz;
}
struct AffineOrder {
    const char* A; const char* B; char* C; size_t aM, bB, bN, cM, cS, cN; int nM, nN, bdiv, csp, G, c0;
    DI bool next(int i, Unit& u) const {
        const int L = i * G + c0; if (L >= nM * nN) return false;
        int pm, pn; tile_of(L, nM, nN, pm, pn); u.pm = pm; u.pn = pn; u.aux = 0;
        u.a = A + (size_t)pm * aM; u.b = B + (size_t)(pm / bdiv) * bB + (size_t)pn * bN; u.c = C + (size_t)pm * cM + (size_t)(pn / csp) * cS + (size_t)(pn % csp) * cN; return true;
    }
};
DI AffineOrder dense_order(const void* A, const void* B, void* C, int M, int N, int K, int ldc_bytes, int esz, int G, int c0) {
    AffineOrder o; o.A = (const char*)A; o.B = (const char*)B; o.C = (char*)C; o.aM = 256ull * K * 2; o.bB = 0; o.bN = 256ull * K * 2; o.cM = 256ull * ldc_bytes; o.cS = 0; o.cN = 256ull * esz;
    o.nM = M / 256; o.nN = N / 256; o.bdiv = 1 << 30; o.csp = 1 << 30; o.G = G; o.c0 = c0; return o;
}

DI void lds_rd2x16(unsigned addr, f32x4& a, f32x4& b) { asm volatile("ds_read_b128 %0, %2\n\tds_read_b128 %1, %2 offset:16\n\ts_waitcnt lgkmcnt(0)" : "=&v"(a), "=&v"(b) : "v"(addr) : "memory"); }
struct EpiBf16 {
    static constexpr bool PERM = true;
    int ldc; const float* bias; int bias_stride; float scl;
    DI void issue(const Unit& u, LAS unsigned char* lds, int wid, int lane) const {
        if (bias) __builtin_amdgcn_global_load_lds((const unsigned*)(bias + (size_t)u.aux * bias_stride + u.pn * 256 + (lane >> 5) * HALF + (wid & 3) * 32 + (lane & 31)), (LAS unsigned*)(lds + LDS_X + wid * 256), 4, 0, 0);
    }
    DI void operator()(f32x4 (&acc)[2][2][4][2], const Unit& u, int wr, int wc, int fr, int fq, LAS unsigned char* lds) const {
        const int col0 = wc * 32 + 8 * fq; const float sc = (u.aux < 0) ? scl : 1.f;
        f32x4 bv[2][2];
#pragma unroll
        for (int bj = 0; bj < 2; ++bj) { if (bias) lds_rd2x16((unsigned)(size_t)lds + LDS_X + (wr * 4 + wc) * 256 + bj * 128 + fq * 32, bv[bj][0], bv[bj][1]); else { bv[bj][0] = (f32x4){0.f, 0.f, 0.f, 0.f}; bv[bj][1] = (f32x4){0.f, 0.f, 0.f, 0.f}; } }
#pragma unroll
        for (int ai = 0; ai < 2; ++ai)
#pragma unroll
            for (int m = 0; m < 4; ++m) { bf16* rowp = (bf16*)u.c + (size_t)(ai * HALF + wr * 64 + m * 16 + fr) * ldc + col0;
#pragma unroll
                for (int bj = 0; bj < 2; ++bj) { const f32x4 v0 = acc[ai][bj][m][0] * sc + bv[bj][0], v1 = acc[ai][bj][m][1] * sc + bv[bj][1];
                    u32x4 w; w.x = cvt_pk_bf16(v0[0], v0[1]); w.y = cvt_pk_bf16(v0[2], v0[3]); w.z = cvt_pk_bf16(v1[0], v1[1]); w.w = cvt_pk_bf16(v1[2], v1[3]);
                    *(u32x4*)(rowp + bj * HALF) = w; } }
    }
};
struct EpiSoftmax {
    static constexpr bool PERM = true;
    int ldc;
    DI void issue(const Unit&, LAS unsigned char*, int, int) const {}
    DI void operator()(f32x4 (&acc)[2][2][4][2], const Unit& u, int wr, int wc, int fr, int fq, LAS unsigned char* lds) const {
        LAS f32x2* X = (LAS f32x2*)(lds + LDS_X);
#pragma unroll
        for (int ai = 0; ai < 2; ++ai)
#pragma unroll
            for (int m = 0; m < 4; ++m) {
                float v = -3.0e38f;
#pragma unroll
                for (int bj = 0; bj < 2; ++bj)
#pragma unroll
                    for (int n = 0; n < 2; ++n) { const f32x4 x = acc[ai][bj][m][n]; v = fmaxf(v, fmaxf(fmaxf(x[0], x[1]), fmaxf(x[2], x[3]))); }
                v = fmaxf(v, __shfl_xor(v, 16)); v = fmaxf(v, __shfl_xor(v, 32));
                float s = 0.f;
#pragma unroll
                for (int bj = 0; bj < 2; ++bj)
#pragma unroll
                    for (int n = 0; n < 2; ++n) { f32x4 x = acc[ai][bj][m][n]; x[0] = __expf(x[0] - v); x[1] = __expf(x[1] - v); x[2] = __expf(x[2] - v); x[3] = __expf(x[3] - v); acc[ai][bj][m][n] = x; s += (x[0] + x[1]) + (x[2] + x[3]); }
                s += __shfl_xor(s, 16); s += __shfl_xor(s, 32);
                if (fq == 0) X[(ai * HALF + wr * 64 + m * 16 + fr) * 4 + wc] = (f32x2){v, s};
            }
        LDS_WAIT(); __builtin_amdgcn_s_barrier(); asm volatile("" ::: "memory");
        const int col0 = wc * 32 + 8 * fq;
#pragma unroll
        for (int ai = 0; ai < 2; ++ai)
#pragma unroll
            for (int m = 0; m < 4; ++m) {
                const int r = ai * HALF + wr * 64 + m * 16 + fr;
                const f32x4 p01 = *(const LAS f32x4*)(X + r * 4), p23 = *(const LAS f32x4*)(X + r * 4 + 2);
                const float M = fmaxf(fmaxf(p01[0], p01[2]), fmaxf(p23[0], p23[2]));
                const float S = p01[1] * __expf(p01[0] - M) + p01[3] * __expf(p01[2] - M) + p23[1] * __expf(p23[0] - M) + p23[3] * __expf(p23[2] - M);
                const float f = __expf(X[r * 4 + wc][0] - M) * __builtin_amdgcn_rcpf(S);
                bf16* rowp = (bf16*)u.c + (size_t)r * ldc + col0;
#pragma unroll
                for (int bj = 0; bj < 2; ++bj) { const f32x4 v0 = acc[ai][bj][m][0] * f, v1 = acc[ai][bj][m][1] * f;
                    u32x4 w; w.x = cvt_pk_bf16(v0[0], v0[1]); w.y = cvt_pk_bf16(v0[2], v0[3]); w.z = cvt_pk_bf16(v1[0], v1[1]); w.w = cvt_pk_bf16(v1[2], v1[3]);
                    *(u32x4*)(rowp + bj * HALF) = w; }
                asm volatile("" ::: "memory");
            }
    }
};
struct EpiSwiglu {
    static constexpr bool PERM = true;
    const float* bgu;
    DI void issue(const Unit& u, LAS unsigned char* lds, int wid, int lane) const {
        __builtin_amdgcn_global_load_lds((const unsigned*)(bgu + (size_t)u.aux * 2048 + (lane >> 5) * 1024 + u.pn * 128 + (wid & 3) * 32 + (lane & 31)), (LAS unsigned*)(lds + LDS_X + wid * 256), 4, 0, 0);
    }
    DI void operator()(f32x4 (&acc)[2][2][4][2], const Unit& u, int wr, int wc, int fr, int fq, LAS unsigned char* lds) const {
        f32x4 bg[2], bl[2];
        lds_rd2x16((unsigned)(size_t)lds + LDS_X + (wr * 4 + wc) * 256 + fq * 32, bg[0], bg[1]);
        lds_rd2x16((unsigned)(size_t)lds + LDS_X + (wr * 4 + wc) * 256 + 128 + fq * 32, bl[0], bl[1]);
#pragma unroll
        for (int ai = 0; ai < 2; ++ai)
#pragma unroll
            for (int m = 0; m < 4; ++m) {
                float o[8];
#pragma unroll
                for (int n = 0; n < 2; ++n)
#pragma unroll
                    for (int j = 0; j < 4; ++j) {
                        const float glu = fminf(acc[ai][0][m][n][j] + bg[n][j], 7.0f);
                        const float lin = fminf(fmaxf(acc[ai][1][m][n][j] + bl[n][j], -7.0f), 7.0f);
                        o[4 * n + j] = (lin + 1.0f) * glu * sigmoidf_(1.702f * glu);
                    }
                u32x4 w; w.x = cvt_pk_bf16(o[0], o[1]); w.y = cvt_pk_bf16(o[2], o[3]); w.z = cvt_pk_bf16(o[4], o[5]); w.w = cvt_pk_bf16(o[6], o[7]);
                *(u32x4*)((bf16*)u.c + (size_t)(ai * HALF + wr * 64 + m * 16 + fr) * 1024 + wc * 32 + 8 * fq) = w;
            }
    }
};

template <class Epi, class Sched, bool GATHER = false>
__device__ __forceinline__ void gemm_phase(LAS unsigned char* lds, const int lda, const int ldb, const int nt, const Sched& S, const Epi& E, const unsigned* rowtab = nullptr) {
    int tid = threadIdx.x; asm volatile("" : "+v"(tid));
    const int wid = __builtin_amdgcn_readfirstlane(tid >> 6), lane = tid & 63, wr = wid >> 2, wc = wid & 3, fr = lane & 15, fq = lane >> 4;
    unsigned voffA[2], voffB[2];
#pragma unroll
    for (int i = 0; i < 2; ++i) { int R, C; stage_rc(tid * 16 + i * 8192, R, C); const int Rb = Epi::PERM ? ((R & ~31) + perm32(R & 31)) : R;
        voffA[i] = GATHER ? 0u : (unsigned)(R * lda + C * 2); voffB[i] = (unsigned)(Rb * ldb + C * 2); }
    unsigned gc[2][2] = {{0u, 0u}, {0u, 0u}}, gn[2][2] = {{0u, 0u}, {0u, 0u}};
#define PG8_GLOAD(dst, pm_) do { int _t = tid; asm volatile("" : "+v"(_t)); _Pragma("unroll") for (int _i = 0; _i < 2; ++_i) { int _R, _C; stage_rc(_t * 16 + _i * 8192, _R, _C); \
        _Pragma("unroll") for (int _h = 0; _h < 2; ++_h) dst[_h][_i] = __hip_atomic_load(rowtab + (size_t)(pm_) * 256 + _h * 128 + _R, __ATOMIC_RELAXED, __HIP_MEMORY_SCOPE_AGENT) * (unsigned)lda + (unsigned)(_C * 2); } } while (0)
    const size_t kstep = (size_t)(BK * 2);
    const size_t hstepA = (size_t)HALF * lda, hstepB = (size_t)HALF * ldb;
    const unsigned ldsw = (unsigned)wid * 1024u;
    const int aoff = lds_byte(wr * 64 + fr, fq * 8), boff = lds_byte(wc * 32 + fr, fq * 8);
#define PG8_SA(b, h) (((b) * 2 + (h)) * HTB)
#define PG8_SB(b, h) ((4 + (b) * 2 + (h)) * HTB)
#define PG8_STAGE(bufoff, gbase, voff) do { _Pragma("unroll") for (int _i = 0; _i < 2; ++_i) \
        __builtin_amdgcn_global_load_lds((const unsigned*)((const char*)(gbase) + (voff)[_i]), (LAS unsigned*)(lds + (bufoff) + ldsw + _i * 8192), 16, 0, 0); } while (0)
#define PG8_STAGE_A(bufoff, gbase, hh, nx) do { if (GATHER) { _Pragma("unroll") for (int _i = 0; _i < 2; ++_i) \
        __builtin_amdgcn_global_load_lds((const unsigned*)((const char*)(gbase) + ((nx) ? gn[hh][_i] : gc[hh][_i])), (LAS unsigned*)(lds + (bufoff) + ldsw + _i * 8192), 16, 0, 0); } \
        else PG8_STAGE(bufoff, (gbase) + (hh) * hstepA, voffA); } while (0)
#define PG8_LDA(dst, b, h) do { _Pragma("unroll") for (int m = 0; m < 4; ++m) _Pragma("unroll") for (int k = 0; k < 2; ++k) dst[m][k] = *(const LAS bf16x8*)(lds + PG8_SA(b, h) + aoff + m * 2048 + k * 1024); } while (0)
#define PG8_LDB(dst, b, h) do { _Pragma("unroll") for (int n = 0; n < 2; ++n) _Pragma("unroll") for (int k = 0; k < 2; ++k) dst[n][k] = *(const LAS bf16x8*)(lds + PG8_SB(b, h) + boff + n * 2048 + k * 1024); } while (0)
#define PG8_MMA(ai, bj, At, Bt) do { __builtin_amdgcn_s_setprio(1); _Pragma("unroll") for (int m = 0; m < 4; ++m) _Pragma("unroll") for (int n = 0; n < 2; ++n) _Pragma("unroll") for (int k = 0; k < 2; ++k) \
        acc[ai][bj][m][n] = __builtin_amdgcn_mfma_f32_16x16x32_bf16(Bt[n][k], At[m][k], acc[ai][bj][m][n], 0, 0, 0); __builtin_amdgcn_s_setprio(0); } while (0)
#define PG8_WAIT_V(n) asm volatile("s_waitcnt vmcnt(" #n ")" ::: "memory")
#define PG8_WAIT_L(n) asm volatile("s_waitcnt lgkmcnt(" #n ")" ::: "memory")
#define PG8_BAR __builtin_amdgcn_s_barrier()
#define PG8_SCHED __builtin_amdgcn_sched_barrier(0)
    Unit cur, nxt; int ui = 0;
    if (!S.next(0, cur)) return;
    f32x4 acc[2][2][4][2];
#pragma unroll
    for (int a = 0; a < 2; ++a)
#pragma unroll
        for (int b = 0; b < 2; ++b)
#pragma unroll
            for (int m = 0; m < 4; ++m)
#pragma unroll
                for (int n = 0; n < 2; ++n) acc[a][b][m][n] = (f32x4){0.f, 0.f, 0.f, 0.f};
    bf16x8 At[4][2], B0[2][2], B1[2][2];
    const char* cA = cur.a; const char* cB = cur.b;
    if (GATHER) { PG8_GLOAD(gc, cur.pm); }
    PG8_STAGE(PG8_SB(0, 0), cB, voffB); PG8_STAGE(PG8_SB(0, 1), cB + hstepB, voffB); PG8_STAGE_A(PG8_SA(0, 0), cA, 0, false); PG8_STAGE_A(PG8_SA(0, 1), cA, 1, false);
    if (wr == 1) PG8_BAR;
    PG8_WAIT_V(2); PG8_BAR;
    PG8_STAGE(PG8_SB(1, 0), cB + kstep, voffB); PG8_STAGE_A(PG8_SA(1, 0), cA + kstep, 0, false); PG8_STAGE(PG8_SB(1, 1), cB + hstepB + kstep, voffB);
    PG8_WAIT_V(6); PG8_BAR;
    for (;;) {
        const bool has_next = S.next(ui + 1, nxt);
        const char* nA = has_next ? nxt.a : cA; const char* nB = has_next ? nxt.b : cB;
        if (GATHER) { if (has_next) { PG8_GLOAD(gn, nxt.pm); } else { _Pragma("unroll") for (int _h = 0; _h < 2; ++_h) { gn[_h][0] = gc[_h][0]; gn[_h][1] = gc[_h][1]; } } }
#pragma unroll 1
        for (int t = 0; t < nt; t += 2) {
            const bool last = (t == nt - 2);
            const char* a1 = cA + (size_t)(t + 1) * kstep;
            const char* a2 = last ? nA : cA + (size_t)(t + 2) * kstep; const char* b2 = last ? nB : cB + (size_t)(t + 2) * kstep;
            const char* a3 = a2 + kstep; const char* b3 = b2 + kstep;
            PG8_LDB(B0, 0, 0); PG8_LDB(B1, 0, 1); PG8_SCHED; PG8_LDA(At, 0, 0); PG8_STAGE_A(PG8_SA(1, 1), a1, 1, false);
            if (t == 0) E.issue(cur, lds, wid, lane);
            PG8_WAIT_V(8); PG8_WAIT_L(0); PG8_BAR; PG8_MMA(0, 0, At, B0); PG8_MMA(0, 1, At, B1); PG8_BAR; PG8_SCHED;
            PG8_LDA(At, 0, 1); PG8_STAGE(PG8_SB(0, 0), b2, voffB); PG8_STAGE(PG8_SB(0, 1), b2 + hstepB, voffB); PG8_STAGE_A(PG8_SA(0, 0), a2, 0, last);
            PG8_WAIT_V(8); PG8_WAIT_L(0); PG8_BAR; PG8_MMA(1, 0, At, B0); PG8_MMA(1, 1, At, B1); PG8_BAR; PG8_SCHED;
            PG8_LDB(B0, 1, 0); PG8_LDB(B1, 1, 1); PG8_SCHED; PG8_LDA(At, 1, 0); PG8_STAGE_A(PG8_SA(0, 1), a2, 1, last);
            PG8_WAIT_V(8); PG8_WAIT_L(0); PG8_BAR; PG8_MMA(0, 0, At, B0); PG8_MMA(0, 1, At, B1); PG8_BAR; PG8_SCHED;
            PG8_LDA(At, 1, 1); PG8_STAGE(PG8_SB(1, 0), b3, voffB); PG8_STAGE(PG8_SB(1, 1), b3 + hstepB, voffB); PG8_STAGE_A(PG8_SA(1, 0), a3, 0, last);
            PG8_WAIT_V(8); PG8_WAIT_L(0); PG8_BAR; PG8_MMA(1, 0, At, B0); PG8_MMA(1, 1, At, B1); PG8_BAR; PG8_SCHED;
        }
        if (wr == 0) PG8_BAR;
        { int fr_e = fr, fq_e = fq; asm volatile("" : "+v"(fr_e), "+v"(fq_e)); E(acc, cur, wr, wc, fr_e, fq_e, lds); }
        if (!has_next) break;
#pragma unroll
        for (int a = 0; a < 2; ++a)
#pragma unroll
            for (int b = 0; b < 2; ++b)
#pragma unroll
                for (int m = 0; m < 4; ++m)
#pragma unroll
                    for (int n = 0; n < 2; ++n) acc[a][b][m][n] = (f32x4){0.f, 0.f, 0.f, 0.f};
        cur = nxt; cA = nA; cB = nB; ++ui;
        if (GATHER) { _Pragma("unroll") for (int _h = 0; _h < 2; ++_h) { gc[_h][0] = gn[_h][0]; gc[_h][1] = gn[_h][1]; } }
        if (wr == 1) PG8_BAR;
    }
    PG8_WAIT_V(0);
    PG8_BAR;
#undef PG8_SA
#undef PG8_SB
#undef PG8_STAGE
#undef PG8_LDA
#undef PG8_STAGE_A
#undef PG8_GLOAD
#undef PG8_LDB
#undef PG8_MMA
#undef PG8_WAIT_V
#undef PG8_WAIT_L
#undef PG8_BAR
#undef PG8_SCHED
}
}

struct Args { const float* in[27]; float* out; unsigned char* ws; int ph_lo, ph_hi; };
struct Ctx {
    LAS unsigned char* lds; unsigned char* ws; unsigned* ctl;
    int tid, lane, wave, vcu, G;
};
constexpr int LDS_PTAB = LDS_MISC + 1024;
DI void refresh(Ctx& F, unsigned char* wsb) { int t = threadIdx.x; asm volatile("" : "+v"(t)); F.tid = t; F.lane = t & 63; F.wave = __builtin_amdgcn_readfirstlane(t >> 6);
    unsigned lo = (unsigned)(unsigned long long)wsb, hi = (unsigned)((unsigned long long)wsb >> 32); asm volatile("" : "+v"(lo), "+v"(hi));
    lo = __builtin_amdgcn_readfirstlane(lo); hi = __builtin_amdgcn_readfirstlane(hi); F.ws = (unsigned char*)(GAS unsigned char*)(((unsigned long long)hi << 32) | lo); F.ctl = (unsigned*)F.ws;
    int bx = blockIdx.x; asm volatile("" : "+v"(bx)); bx = __builtin_amdgcn_readfirstlane(bx); F.G = 256; F.vcu = (bx & 7) * 32 + (bx >> 3);
    unsigned zb = 0u; asm volatile("" : "+v"(zb)); F.lds = (LAS unsigned char*)(unsigned)__builtin_amdgcn_readfirstlane(zb); }
DI const float* inp(const Ctx& F, int i) {
    const LAS unsigned* p = (const LAS unsigned*)(F.lds + LDS_PTAB) + 2 * i; const unsigned lo = __builtin_amdgcn_readfirstlane(p[0]), hi = __builtin_amdgcn_readfirstlane(p[1]);
    return (const float*)(GAS const float*)(((unsigned long long)hi << 32) | lo);
}
DI unsigned ldu(const unsigned* p) { return __hip_atomic_load(p, __ATOMIC_RELAXED, __HIP_MEMORY_SCOPE_AGENT); }
DI float ldf(const float* p) { return __uint_as_float(__hip_atomic_load((const unsigned*)p, __ATOMIC_RELAXED, __HIP_MEMORY_SCOPE_AGENT)); }

template <int MAP> DI int map_row(int n) {
    if (MAP == 0) return n;
    if (MAP == 1) return n < 1536 ? n : (n < 1544 ? -1 : (n < 3592 ? n - 8 : -1));
    return 256 * ((n & 1023) >> 7) + 128 * (n >> 10) + (n & 127);
}
template <int MAP> DI void tr_item(const float* W, int K, int N, bf16* WT, LAS float* scr, int item, int lane) {
    const int nblk = (N + 31) / 32, kb = item / nblk, nb = item % nblk, k0 = 64 * kb, n0 = 32 * nb;
    const int c4 = 4 * (lane & 7), nl = n0 + c4;
    f32x4 ld[8];
#pragma unroll
    for (int i = 0; i < 8; ++i) { const int kk = 8 * i + (lane >> 3); ld[i] = nl < N ? __builtin_nontemporal_load((const f32x4*)(W + (size_t)(k0 + kk) * N + nl)) : (f32x4){0.f, 0.f, 0.f, 0.f}; }
#pragma unroll
    for (int i = 0; i < 8; ++i) { const int kk = 8 * i + (lane >> 3); LAS float* d = scr + kk * 33 + c4; d[0] = ld[i][0]; d[1] = ld[i][1]; d[2] = ld[i][2]; d[3] = ld[i][3]; }
    LDS_WAIT(); asm volatile("" ::: "memory");
    const int c = lane & 7;
#pragma unroll
    for (int j = 0; j < 4; ++j) { const int nn = (lane >> 3) + 8 * j; const int n = n0 + nn; const LAS float* s = scr + (8 * c) * 33 + nn;
        const int dr = n < N ? map_row<MAP>(n) : -1;
        u32x4 o; o.x = cvt_pk_bf16(s[0 * 33], s[1 * 33]); o.y = cvt_pk_bf16(s[2 * 33], s[3 * 33]); o.z = cvt_pk_bf16(s[4 * 33], s[5 * 33]); o.w = cvt_pk_bf16(s[6 * 33], s[7 * 33]);
        if (dr >= 0) __builtin_nontemporal_store(o, (u32x4*)(WT + (size_t)dr * K + k0 + 8 * c)); }
    LDS_WAIT(); asm volatile("" ::: "memory");
}
DI void phase_convert(Ctx& F, const Args& a) {
    LAS float* scr = (LAS float*)(F.lds + F.wave * 16384);
    const int gw = F.vcu * NWAVES + F.wave, NGW = F.G * NWAVES;
    constexpr int I_WIN = 16 * 113, I_SQ = 16 * 32, I_GU = 16 * 64;
    constexpr int E0 = 4 * I_WIN, E1 = E0 + 4 * I_SQ, E2 = E1 + 4 * I_SQ, E3 = E2 + 4 * I_SQ, E4 = E3 + 4 * I_SQ, E5 = E4 + 128 * I_GU, E6 = E5 + 128 * I_SQ;
    for (int it = gw; it < E6; it += NGW) {
        if (it < E0) { const int l = it / I_WIN, r = it % I_WIN; tr_item<1>(inp(F, 2) + (size_t)l * D * 3600, D, 3600, (bf16*)(F.ws + WS_WIN) + (size_t)l * NPROJ * D, scr, r, F.lane); }
        else if (it < E1) { const int q = it - E0, l = q / I_SQ, r = q % I_SQ; tr_item<0>(inp(F, 10) + (size_t)l * D * D, D, D, (bf16*)(F.ws + WS_WOUT) + (size_t)l * D * D, scr, r, F.lane); }
        else if (it < E2) { const int q = it - E1, l = q / I_SQ, r = q % I_SQ; tr_item<0>(inp(F, 14) + (size_t)l * D * D, D, D, (bf16*)(F.ws + WS_WKV) + (size_t)(2 * l) * D * D, scr, r, F.lane); }
        else if (it < E3) { const int q = it - E2, l = q / I_SQ, r = q % I_SQ; tr_item<0>(inp(F, 15) + (size_t)l * D * D, D, D, (bf16*)(F.ws + WS_WKV) + (size_t)(2 * l + 1) * D * D, scr, r, F.lane); }
        else if (it < E4) { const int q = it - E3, l = q / I_SQ, r = q % I_SQ; tr_item<0>(inp(F, 16) + (size_t)l * D * D, D, D, (bf16*)(F.ws + WS_WO) + (size_t)l * D * D, scr, r, F.lane); }
        else if (it < E5) { const int q = it - E4, le = q / I_GU, r = q % I_GU; tr_item<2>(inp(F, 21) + (size_t)le * D * 2048, D, 2048, (bf16*)(F.ws + WS_WGU) + (size_t)le * 2048 * D, scr, r, F.lane); }
        else { const int q = it - E5, le = q / I_SQ, r = q % I_SQ; tr_item<0>(inp(F, 23) + (size_t)le * D * D, D, D, (bf16*)(F.ws + WS_WDN) + (size_t)le * D * D, scr, r, F.lane); }
    }
    const size_t gt = (size_t)blockIdx.x * NTHREADS + F.tid, NGT = (size_t)F.G * NTHREADS;
    for (size_t i = gt; i < (4ull * D * D + 2048ull * D) / 8; i += NGT) {
        const bool isq = i < 4ull * D * D / 8; const size_t j = isq ? i : i - 4ull * D * D / 8;
        const float* src = (isq ? inp(F, 13) : inp(F, 1)) + j * 8; bf16* dst = (bf16*)(F.ws + (isq ? WS_WQ : WS_MEMB)) + j * 8;
        const f32x4 v0 = *(const f32x4*)src, v1 = *(const f32x4*)(src + 4);
        u32x4 o; o.x = cvt_pk_bf16(v0[0], v0[1]); o.y = cvt_pk_bf16(v0[2], v0[3]); o.z = cvt_pk_bf16(v1[0], v1[1]); o.w = cvt_pk_bf16(v1[2], v1[3]);
        *(u32x4*)dst = o;
    }
    for (size_t i = gt; i < 4ull * 48 * D; i += NGT) {
        const int l = (int)(i / (48 * D)), r = (int)(i % (48 * D)), j = r / D, k = r % D;
        float w; bf16* dh; bf16* dl;
        if (j < 16) { const int col = j < 8 ? 1536 + j : 3592 + (j - 8); w = inp(F, 2)[((size_t)l * D + k) * 3600 + col];
            dh = (bf16*)(F.ws + WS_WGATE) + ((size_t)(l * 2 + 0) * 16 + j) * D + k; dl = dh + 16 * D; }
        else { const int e = j - 16; w = inp(F, 19)[((size_t)l * D + k) * 32 + e];
            dh = (bf16*)(F.ws + WS_WRT) + ((size_t)(l * 2 + 0) * 32 + e) * D + k; dl = dh + 32 * D; }
        const bf16 h = f2bf(w); *dh = h; *dl = f2bf(w - bf2f(h));
    }
}

DI void unpack8(const u32x4 w, float* v) { v[0] = bflo(w.x); v[1] = bfhi(w.x); v[2] = bflo(w.y); v[3] = bfhi(w.y); v[4] = bflo(w.z); v[5] = bfhi(w.z); v[6] = bflo(w.w); v[7] = bfhi(w.w); }
DI u32x4 pack8(const float* v) { u32x4 o; o.x = cvt_pk_bf16(v[0], v[1]); o.y = cvt_pk_bf16(v[2], v[3]); o.z = cvt_pk_bf16(v[4], v[5]); o.w = cvt_pk_bf16(v[6], v[7]); return o; }
#define PROF_RP(k) do { if (MODE == 2 && ((PROF_MASK) >> 23)) { if (blockIdx.x == 0 && threadIdx.x == 0) { volatile LAS unsigned long long* pw = (volatile LAS unsigned long long*)(F.lds + LDS_MISC + 128); \
        const unsigned long long now_ = __builtin_amdgcn_s_memrealtime(); if ((k) >= 0 && (((PROF_MASK) >> (23 + (k))) & 1)) pw[1] += now_ - pw[3]; pw[3] = now_; } } } while (0)
DI void ld2x16_sc1(const void* p0, const void* p1, u32x4& a, u32x4& b) {
    asm volatile("global_load_dwordx4 %0, %2, off sc0 sc1\n\tglobal_load_dwordx4 %1, %3, off sc0 sc1\n\ts_waitcnt vmcnt(0)" : "=&v"(a), "=&v"(b) : "v"(p0), "v"(p1) : "memory");
}
template <int MODE> DI void row_pass(Ctx& F, const Args& a, int l, const bool dummy = false) {
    const int lane = F.lane, r0 = (F.vcu * NWAVES + F.wave) * 16;
    bf16* XB = (bf16*)(F.ws + WS_XB); bf16* XBo = dummy ? (bf16*)(F.ws + WS_XG + 16 * MiB) : XB; const bf16* HB = (const bf16*)(F.ws + WS_HB); const bf16* Y = (const bf16*)(F.ws + WS_Y);
    const int c0 = 8 * lane, c1 = 512 + 8 * lane;
    LAS unsigned* ecnt = (LAS unsigned*)(F.lds + LDS_MISC + 256);
    if (MODE == 2) { if (F.tid < 64 && !dummy) ecnt[F.tid] = 0u; __syncthreads(); }
    PROF_RP(-1);
    constexpr int N16 = (MODE == 2) ? 2 : 1, NN = 16 * N16, NBLK = 32 * N16 * 2;
    const bool has_tail = !(MODE == 1 || (MODE == 3 && l == NL - 1));
    const bf16* Wb = (MODE == 2) ? (const bf16*)(F.ws + WS_WRT) + (size_t)l * 2 * 32 * D : (const bf16*)(F.ws + WS_WGATE) + (size_t)(MODE == 0 ? 0 : (l + 1 < NL ? l + 1 : 0)) * 2 * 16 * D;
    if (has_tail) {
#pragma unroll
        for (int q = 0; q < NBLK / 8; ++q) { const int blk = F.wave * (NBLK / 8) + q, ks = blk / (2 * N16), n = (blk >> 1) % N16, hl = blk & 1;
            __builtin_amdgcn_global_load_lds((const unsigned*)(Wb + (size_t)(hl * NN + n * 16 + (lane & 15)) * D + 32 * ks + 8 * (lane >> 4)), (LAS unsigned*)(F.lds + blk * 1024), 16, 0, 0); }
    }
    float g[16], bb[16];
    if (MODE >= 1) {
        const float* gp = inp(F, MODE == 1 ? 11 : (MODE == 2 ? 17 : 25)) + (size_t)l * D; const float* bp = inp(F, MODE == 1 ? 12 : (MODE == 2 ? 18 : 26)) + (size_t)l * D;
#pragma unroll
        for (int q = 0; q < 2; ++q) { const int c = q ? c1 : c0;
            const f32x4 g0 = *(const f32x4*)(gp + c), g1 = *(const f32x4*)(gp + c + 4), b0 = *(const f32x4*)(bp + c), b1 = *(const f32x4*)(bp + c + 4);
#pragma unroll
            for (int j = 0; j < 4; ++j) { g[8 * q + j] = g0[j]; g[8 * q + 4 + j] = g1[j]; bb[8 * q + j] = b0[j]; bb[8 * q + 4 + j] = b1[j]; } }
    }
    constexpr int RB = (MODE == 3) ? 2 : 4;
#pragma unroll 1
    for (int i0 = 0; i0 < 16; i0 += RB) {
        float v[RB][16];
        if (MODE == 0) {
            f32x4 xi[RB][4];
#pragma unroll
            for (int q = 0; q < RB; ++q) { const float* xr = inp(F, 0) + (size_t)(r0 + i0 + q) * D;
                xi[q][0] = *(const f32x4*)(xr + c0); xi[q][1] = *(const f32x4*)(xr + c0 + 4); xi[q][2] = *(const f32x4*)(xr + c1); xi[q][3] = *(const f32x4*)(xr + c1 + 4); }
#pragma unroll
            for (int q = 0; q < RB; ++q)
#pragma unroll
                for (int j = 0; j < 4; ++j) { v[q][j] = xi[q][0][j]; v[q][4 + j] = xi[q][1][j]; v[q][8 + j] = xi[q][2][j]; v[q][12 + j] = xi[q][3][j]; }
        } else {
            u32x4 xr[RB][2];
#pragma unroll
            for (int q = 0; q < RB; ++q) { xr[q][0] = *(const u32x4*)(XB + (size_t)(r0 + i0 + q) * D + c0); xr[q][1] = *(const u32x4*)(XB + (size_t)(r0 + i0 + q) * D + c1); }
            if (MODE == 3) {
                int slv = 0; float gkv = 0.f;
                if (lane < 4 * RB) { slv = (int)ldu((const unsigned*)(F.ws + WS_SLOT) + (size_t)(r0 + i0) * 4 + lane); gkv = ldf((const float*)(F.ws + WS_TOPG) + (size_t)(r0 + i0) * 4 + lane); }
                u32x4 yr[RB][4][2]; float gk[RB][4];
#pragma unroll
                for (int q = 0; q < RB; ++q)
#pragma unroll
                    for (int k = 0; k < 4; ++k) { const int sl = __shfl(slv, q * 4 + k); gk[q][k] = __shfl(gkv, q * 4 + k);
                        yr[q][k][0] = __builtin_nontemporal_load((const u32x4*)(Y + (size_t)sl * D + c0)); yr[q][k][1] = __builtin_nontemporal_load((const u32x4*)(Y + (size_t)sl * D + c1)); }
#pragma unroll
                for (int q = 0; q < RB; ++q) { float xv[16]; unpack8(xr[q][0], xv); unpack8(xr[q][1], xv + 8);
#pragma unroll
                    for (int j = 0; j < 16; ++j) v[q][j] = DN_ALPHA * xv[j];
#pragma unroll
                    for (int k = 0; k < 4; ++k) { float yv[16]; unpack8(yr[q][k][0], yv); unpack8(yr[q][k][1], yv + 8);
#pragma unroll
                        for (int j = 0; j < 16; ++j) v[q][j] += gk[q][k] * yv[j]; } }
            } else {
                u32x4 hr[RB][2];
#pragma unroll
                for (int q = 0; q < RB; ++q) { hr[q][0] = __builtin_nontemporal_load((const u32x4*)(HB + (size_t)(r0 + i0 + q) * D + c0)); hr[q][1] = __builtin_nontemporal_load((const u32x4*)(HB + (size_t)(r0 + i0 + q) * D + c1)); }
#pragma unroll
                for (int q = 0; q < RB; ++q) { float xv[16], hv[16]; unpack8(xr[q][0], xv); unpack8(xr[q][1], xv + 8); unpack8(hr[q][0], hv); unpack8(hr[q][1], hv + 8);
#pragma unroll
                    for (int j = 0; j < 16; ++j) v[q][j] = DN_ALPHA * xv[j] + hv[j]; }
            }
            float sm[RB];
#pragma unroll
            for (int q = 0; q < RB; ++q) { float t = 0.f;
#pragma unroll
                for (int j = 0; j < 16; ++j) t += v[q][j];
                sm[q] = t; }
#pragma unroll
            for (int o = 1; o < 64; o <<= 1)
#pragma unroll
                for (int q = 0; q < RB; ++q) sm[q] += __shfl_xor(sm[q], o);
            float sq[RB];
#pragma unroll
            for (int q = 0; q < RB; ++q) { const float mean = sm[q] * (1.f / D); float t = 0.f;
#pragma unroll
                for (int j = 0; j < 16; ++j) { v[q][j] -= mean; t += v[q][j] * v[q][j]; }
                sq[q] = t; }
#pragma unroll
            for (int o = 1; o < 64; o <<= 1)
#pragma unroll
                for (int q = 0; q < RB; ++q) sq[q] += __shfl_xor(sq[q], o);
#pragma unroll
            for (int q = 0; q < RB; ++q) { const float rstd = rsqrtf(sq[q] * (1.f / D) + 1e-5f);
#pragma unroll
                for (int j = 0; j < 16; ++j) v[q][j] = v[q][j] * rstd * g[j] + bb[j]; }
        }
#pragma unroll
        for (int q = 0; q < RB; ++q) { const int r = r0 + i0 + q;
            if (MODE == 3 && l == NL - 1) {
                float* orow = (float*)inp(F, 27) + (size_t)r * D;
                *(f32x4*)(orow + c0) = (f32x4){v[q][0], v[q][1], v[q][2], v[q][3]}; *(f32x4*)(orow + c0 + 4) = (f32x4){v[q][4], v[q][5], v[q][6], v[q][7]};
                *(f32x4*)(orow + c1) = (f32x4){v[q][8], v[q][9], v[q][10], v[q][11]}; *(f32x4*)(orow + c1 + 4) = (f32x4){v[q][12], v[q][13], v[q][14], v[q][15]};
            } else {
                *(u32x4*)(XBo + (size_t)r * D + c0) = pack8(v[q]); *(u32x4*)(XBo + (size_t)r * D + c1) = pack8(v[q] + 8);
            } }
    }
    if (MODE == 1 || (MODE == 3 && l == NL - 1)) return;
#ifdef DBG_NOROUTER
    if (MODE == 2) return;
#endif
    VM_WAIT(); __syncthreads(); PROF_RP(0); asm volatile("" ::: "memory");
    const bf16* arow = XBo + (size_t)(r0 + (lane & 15)) * D + 8 * (lane >> 4);
    f32x4 acc[N16];
#pragma unroll
    for (int n = 0; n < N16; ++n) acc[n] = (f32x4){0.f, 0.f, 0.f, 0.f};
#pragma unroll 8
    for (int ks = 0; ks < 32; ++ks) {
        const bf16x8 af = *(const bf16x8*)(arow + 32 * ks);
#pragma unroll
        for (int n = 0; n < N16; ++n) {
            const bf16x8 bh = *(const LAS bf16x8*)(F.lds + ((ks * N16 + n) * 2 + 0) * 1024 + lane * 16), bl = *(const LAS bf16x8*)(F.lds + ((ks * N16 + n) * 2 + 1) * 1024 + lane * 16);
            acc[n] = MFMA16(af, bh, acc[n]); acc[n] = MFMA16(af, bl, acc[n]);
        }
    }
    if (MODE != 2) {
        float* G = dummy ? (float*)(F.ws + WS_XG + 160 * MiB) : (float*)(F.ws + WS_GATES);
#pragma unroll
        for (int i = 0; i < 4; ++i) G[(size_t)(r0 + 4 * (lane >> 4) + i) * 16 + (lane & 15)] = acc[0][i];
        return;
    }
    if (MODE == 2) {
        if ((PROF_MASK) >> 23) __syncthreads(); PROF_RP(1);
        LAS float* LG = (LAS float*)(F.lds + 131072 + F.wave * 2176);
#pragma unroll
        for (int n = 0; n < N16; ++n)
#pragma unroll
            for (int i = 0; i < 4; ++i) LG[(4 * (lane >> 4) + i) * 33 + n * 16 + (lane & 15)] = acc[n][i];
        LDS_WAIT(); asm volatile("" ::: "memory");
        int te[4] = {0, 0, 0, 0}; float tv[4] = {0.f, 0.f, 0.f, 0.f}; unsigned rk[4] = {0u, 0u, 0u, 0u};
        if (lane < 16) {
            float lg[32]; const float* rb = inp(F, 20) + (size_t)l * 32;
#pragma unroll
            for (int e = 0; e < 32; ++e) lg[e] = LG[lane * 33 + e] + rb[e];
#pragma unroll
            for (int k = 0; k < 4; ++k) {
                float best = -3.0e38f; int bi = 0;
#pragma unroll
                for (int e = 0; e < 32; ++e) { const bool gt = lg[e] > best; best = gt ? lg[e] : best; bi = gt ? e : bi; }
                te[k] = bi; tv[k] = best;
#pragma unroll
                for (int e = 0; e < 32; ++e) lg[e] = (e == bi) ? -3.0e38f : lg[e];
            }
            const float e1 = __expf(tv[1] - tv[0]), e2 = __expf(tv[2] - tv[0]), e3 = __expf(tv[3] - tv[0]); const float inv = 1.f / (1.f + e1 + e2 + e3);
            tv[0] = inv; tv[1] = e1 * inv; tv[2] = e2 * inv; tv[3] = e3 * inv;
#pragma unroll
            for (int k = 0; k < 4; ++k) rk[k] = __hip_atomic_fetch_add(ecnt + (dummy ? 40 : 0) + te[k], 1u, __ATOMIC_RELAXED, __HIP_MEMORY_SCOPE_WORKGROUP);
        }
        __syncthreads(); PROF_RP(2);
        if (F.tid < 32 && !dummy) ecnt[32 + F.tid] = __hip_atomic_fetch_add(F.ctl + CW_ECNT + (l * 32 + F.tid) * 64, ecnt[F.tid], __ATOMIC_RELAXED, __HIP_MEMORY_SCOPE_AGENT);
        __syncthreads();
        if (lane < 16 && !dummy) {
            const int r = r0 + lane; int* pe = (int*)(F.ws + WS_TOPE) + (size_t)r * 4; int* pp = (int*)(F.ws + WS_TOPP) + (size_t)r * 4; float* pg = (float*)(F.ws + WS_TOPG) + (size_t)r * 4;
#pragma unroll
            for (int k = 0; k < 4; ++k) { pe[k] = te[k]; pp[k] = (int)(ecnt[32 + te[k]] + rk[k]); pg[k] = tv[k]; }
        }
        if ((PROF_MASK) >> 23) { VM_WAIT(); __syncthreads(); } PROF_RP(3);
    }
}

DI void phase_scatter(Ctx& F, int l) {
    LAS int* ts = (LAS int*)(F.lds + LDS_MISC + 512);
    if (F.tid < 64) {
        const int lane = F.tid; const int nt_ = (lane < 32) ? (int)((ldu(F.ctl + CW_ECNT + (l * 32 + lane) * 64) + 255u) >> 8) : 0;
        int inc = nt_;
#pragma unroll
        for (int o = 1; o < 32; o <<= 1) { const int t_ = __shfl_up(inc, o); inc += (lane >= o) ? t_ : 0; }
        if (lane < 32) ts[lane] = inc - nt_;
        if (lane == 31) ts[32] = inc; }
    __syncthreads();
    if (blockIdx.x == 0) {
        if (F.tid == 0) __hip_atomic_store(F.ctl + CW_NT + l, (unsigned)ts[32], __ATOMIC_RELAXED, __HIP_MEMORY_SCOPE_AGENT);
        for (int t = F.tid; t < ts[32]; t += NTHREADS) { int e = 0; while (e < 31 && t >= ts[e + 1]) ++e; F.ctl[CW_TILE_E + l * MAXTILES + t] = (unsigned)e; }
    }
    { const int r = F.vcu * 128 + (F.tid >> 2), k = F.tid & 3;
      const int e = ((const int*)(F.ws + WS_TOPE))[(size_t)r * 4 + k], p = ((const int*)(F.ws + WS_TOPP))[(size_t)r * 4 + k];
      const int slot = ts[e] * 256 + p;
      ((int*)(F.ws + WS_SLOT))[(size_t)r * 4 + k] = slot; ((unsigned*)(F.ws + WS_ROWTAB))[slot] = (unsigned)r; }
}
struct MoeOrder {
    const char* A; const char* B; char* C; const unsigned* tile_e; int NT, nN; size_t bE, bN, cN; int G, c0, gather, rev;
    DI bool next(int i, g8::Unit& u) const {
        const int L = i * G + c0; if (L >= NT * nN) return false;
        int pm, pn; g8::tile_of(L, NT, nN, pm, pn); if (rev) pm = NT - 1 - pm;
        const int e = __builtin_amdgcn_readfirstlane((int)ldu(tile_e + pm));
        u.pm = pm; u.pn = pn; u.aux = e; u.a = gather ? A : A + (size_t)pm * 256 * 2048; u.b = B + (size_t)e * bE + (size_t)pn * bN; u.c = C + (size_t)pm * 256 * 2048 + (size_t)pn * cN; return true;
    }
};

DI unsigned lds_addr(const LAS void* p) { return (unsigned)(size_t)p; }
DI bf16x8 tr_frag8(unsigned img, int ld_bytes, int row_lo, int row_hi, int m0, int lane) {
    const int i = lane & 15; const unsigned a_lo = img + (unsigned)((row_lo + (i >> 2)) * ld_bytes + (m0 + 4 * (i & 3)) * 2), a_hi = img + (unsigned)((row_hi + (i >> 2)) * ld_bytes + (m0 + 4 * (i & 3)) * 2);
    s16x4 lo, hi;
    asm volatile("ds_read_b64_tr_b16 %0, %2\n\tds_read_b64_tr_b16 %1, %3\n\ts_waitcnt lgkmcnt(0)" : "=&v"(lo), "=&v"(hi) : "v"(a_lo), "v"(a_hi) : "memory");
    return __builtin_shufflevector(lo, hi, 0, 1, 2, 3, 4, 5, 6, 7);
}
DI s16x4 tr_read4(unsigned addr) { s16x4 r; asm volatile("ds_read_b64_tr_b16 %0, %1\n\ts_waitcnt lgkmcnt(0)" : "=&v"(r) : "v"(addr) : "memory"); return r; }
DI bf16x8 pack_frag(const f32x4 a, const f32x4 b) {
    u32x4 p; p.x = cvt_pk_bf16(a[0], a[1]); p.y = cvt_pk_bf16(a[2], a[3]); p.z = cvt_pk_bf16(b[0], b[1]); p.w = cvt_pk_bf16(b[2], b[3]); return __builtin_bit_cast(bf16x8, p);
}
DI u32x2 pack4(const f32x4 a) { u32x2 p; p.x = cvt_pk_bf16(a[0], a[1]); p.y = cvt_pk_bf16(a[2], a[3]); return p; }
DI f32x4 unpack4(const u32x2 w) { return (f32x4){bflo(w.x), bfhi(w.x), bflo(w.y), bfhi(w.y)}; }
DI float softcap15(float x) { const float y = x * (1.f / 15.f); const float e = __expf(2.f * y); return 15.f * (1.f - 2.f * __builtin_amdgcn_rcpf(e + 1.f)); }
DI float log_sigmoid(float x) { return fminf(x, 0.f) - log1pf(__expf(-fabsf(x))); }
DI float softplusf_(float x) { return fmaxf(x, 0.f) + log1pf(__expf(-fabsf(x))); }
DI float wave_incl_sum(float v, int lane) {
#pragma unroll
    for (int o = 1; o < 64; o <<= 1) { const float t = __shfl_up(v, o); v += (lane >= o) ? t : 0.f; }
    return v;
}
DI float wave_incl_max(float v, int lane) {
#pragma unroll
    for (int o = 1; o < 64; o <<= 1) { const float t = __shfl_up(v, o); v = (lane >= o) ? fmaxf(v, t) : v; }
    return v;
}
constexpr int GA_QH = 0, GA_KH = 17408, GA_VB = 34816, GA_KB = 52224, GA_NA = 69632, GA_AD = 78848, GA_TI = 82944, GA_GC = 84992, GA_KEI = 86016;
constexpr int LDI = 136 * 2;
constexpr int LDK = 72 * 2;

#define DMA16(src, dst) __builtin_amdgcn_global_load_lds((const unsigned*)(src), (LAS unsigned*)(dst), 16, 0, 0)
#define DMA16NT(src, dst) __builtin_amdgcn_global_load_lds((const unsigned*)(src), (LAS unsigned*)(dst), 16, 0, 2)
DI u32x2 gld8(const void* p) { u32x2 r; asm volatile("global_load_dwordx2 %0, %1, off" : "=v"(r) : "v"(p) : "memory"); return r; }
DI float gld4(const void* p) { float r; asm volatile("global_load_dword %0, %1, off" : "=v"(r) : "v"(p) : "memory"); return r; }
DI u32x4 gld16(const void* p) { u32x4 r; asm volatile("global_load_dwordx4 %0, %1, off nt" : "=v"(r) : "v"(p) : "memory"); return r; }
struct MlAPre { u32x4 kraw, vraw[2]; float gi, gf; };
#define PROF_SUB(k) do { if ((PROF_MASK) >> 16) { if (blockIdx.x == 0 && threadIdx.x == 0) { volatile LAS unsigned long long* pw = (volatile LAS unsigned long long*)(F.lds + LDS_MISC + 128); \
        const unsigned long long now_ = __builtin_amdgcn_s_memrealtime(); if (((PROF_MASK) >> (16 + (k))) & 1) pw[1] += now_ - pw[3]; pw[3] = now_; } } } while (0)
DI void ml_a_fetch(Ctx& F, int cid, MlAPre& P) {
    const int b = cid >> 8, h = (cid >> 6) & 3, n = cid & 63, t0 = b * SEQ + n * CH, tid = F.tid, lane = F.lane;
    const bf16* PROJ = (const bf16*)(F.ws + WS_PROJ); const float* GT = (const float*)(F.ws + WS_GATES);
    P.kraw = gld16(PROJ + (size_t)(t0 + (tid >> 3)) * NPROJ + 256 + h * 64 + (tid & 7) * 8);
#pragma unroll
    for (int q = 0; q < 2; ++q) { const int idx = tid + 512 * q; P.vraw[q] = gld16(PROJ + (size_t)(t0 + (idx >> 4)) * NPROJ + 512 + h * 128 + (idx & 15) * 8); }
    P.gi = gld4(GT + (size_t)(t0 + lane) * 16 + h); P.gf = gld4(GT + (size_t)(t0 + lane) * 16 + 4 + h);
}
DI void ml_a_unit(Ctx& F, int l, int cid, int par, MlAPre& P, float bi, float bf_, float& gb, float& ga, float nalog, float dtb) {
    int tid = F.tid; asm volatile("" : "+v"(tid)); const int lane = tid & 63;
    LAS unsigned char* KE = F.lds + par * 45056; LAS unsigned char* VI = KE + 16384; LAS float* es = (LAS float*)(KE + 40960);
    asm volatile("s_waitcnt vmcnt(7)" : "+v"(P.kraw), "+v"(P.vraw[0]), "+v"(P.vraw[1]), "+v"(P.gi), "+v"(P.gf), "+v"(gb), "+v"(ga) :: "memory");
    const int ks_ = tid >> 3, kc8 = (tid & 7) * 8;
    const u32x4 kraw = P.kraw; const u32x4 vraw[2] = {P.vraw[0], P.vraw[1]};
    if (F.wave == 7) {
        const float ip = softcap15(P.gi + bi), fp = softcap15(P.gf + bf_);
        const float bc = wave_incl_sum(log_sigmoid(fp), lane), blast = __shfl(bc, 63), lw = blast - bc + ip, amax = wave_max(lw);
        es[lane] = __expf(lw - amax);
        if (lane == 0) { float* sc = (float*)(F.ws + WS_MLSC) + (size_t)cid * 4; sc[0] = blast; sc[1] = amax; }
    }
    if (F.wave == 6) {
        LAS float* gcs = (LAS float*)(F.lds + GA_GC); LAS float* bts = gcs + 64;
        const float beta = sigmoidf_(gb), gg = nalog * softplusf_(ga + dtb), gc = wave_incl_sum(gg, lane);
        gcs[lane] = gc; bts[lane] = beta;
        if (lane == 63) ((float*)(F.ws + WS_GDGL))[cid] = __expf(gc);
    }
#pragma unroll
    for (int q = 0; q < 2; ++q) { const int idx = tid + 512 * q, s_ = idx >> 4, c8 = (idx & 15) * 8; *(LAS u32x4*)(VI + s_ * LDI + c8 * 2) = vraw[q]; }
    __syncthreads();
    { float v[8]; unpack8(kraw, v); const float e = es[ks_];
#pragma unroll
      for (int j = 0; j < 8; ++j) v[j] *= e;
      *(LAS u32x4*)(KE + ks_ * LDK + kc8 * 2) = pack8(v); }
    __syncthreads();
    { const int g = lane >> 4, w = F.wave, ln = lane & 15; f32x4 acc[4], kacc[4];
#pragma unroll
      for (int nt = 0; nt < 4; ++nt) { acc[nt] = (f32x4){0.f, 0.f, 0.f, 0.f}; kacc[nt] = (f32x4){0.f, 0.f, 0.f, 0.f}; }
      const bf16x8 ones = (ln == 0) ? (bf16x8){0x3f80, 0x3f80, 0x3f80, 0x3f80, 0x3f80, 0x3f80, 0x3f80, 0x3f80} : (bf16x8){0, 0, 0, 0, 0, 0, 0, 0};
#pragma unroll
      for (int ks = 0; ks < 2; ++ks) { const int rb = 32 * ks + 8 * g;
          const bf16x8 af = tr_frag8(lds_addr(VI), LDI, rb, rb + 4, 16 * w, lane);
#pragma unroll
          for (int nt = 0; nt < 4; ++nt) { const bf16x8 bf = tr_frag8(lds_addr(KE), LDK, rb, rb + 4, 16 * nt, lane); acc[nt] = MFMA16(bf, af, acc[nt]);
              if (w == 0) kacc[nt] = MFMA16(ones, bf, kacc[nt]); } }
      bf16* U = (bf16*)(F.ws + WS_MLU) + (size_t)cid * 8192;
#pragma unroll
      for (int nt = 0; nt < 4; ++nt)
          *(u32x2*)(U + (w * 2 + (nt >> 1)) * 512 + ((2 * (nt & 1) + (g >> 1)) * 16 + ln) * 8 + 4 * (g & 1)) = pack4(acc[nt]);
      if (w == 0 && g == 0) {
#pragma unroll
          for (int nt = 0; nt < 4; ++nt) ((float*)(F.ws + WS_MLKN))[(size_t)cid * 64 + 16 * nt + ln] = kacc[nt][0]; }
    }
}
struct MlBBatch { u32x2 ub[8]; float kv[8]; u32x2 sc; };
DI void ml_b_fetch(const bf16* U, const float* SC, const float* KN, size_t cid0, int e0, int t, bool dn, MlBBatch& B) {
#pragma unroll
    for (int q = 0; q < 8; ++q) { const size_t cid = cid0 + q;
        B.ub[q] = gld8(U + cid * 8192 + e0);
        B.kv[q] = 0.f; if (dn) asm volatile("global_load_dword %0, %1, off" : "+v"(B.kv[q]) : "v"(KN + cid * 64 + t) : "memory"); }
    B.sc = gld8(SC + (cid0 + (t & 7)) * 4);
}
DI void ml_b_compute(const MlBBatch& B, bf16* CT, float* NP, float* MP, size_t cid0, int e0, int t, int p, bool dn, f32x4& C, float& nv, float& m) {
#pragma unroll
    for (int q = 0; q < 8; ++q) { const size_t cid = cid0 + q;
        *(u32x2*)(CT + cid * 8192 + e0) = pack4(C);
        if (dn) NP[cid * 64 + t] = nv; if (p == 0 && t == 0) MP[cid] = m;
        const float blq = __uint_as_float(__builtin_amdgcn_readlane(B.sc.x, q)), amq = __uint_as_float(__builtin_amdgcn_readlane(B.sc.y, q));
        const float mn = fmaxf(blq + m, amq), d1 = __expf(blq + m - mn), d2 = __expf(amq - mn);
        const f32x4 uv = unpack4(B.ub[q]);
#pragma unroll
        for (int k = 0; k < 4; ++k) C[k] = d1 * C[k] + d2 * uv[k];
        nv = d1 * nv + d2 * (dn ? B.kv[q] : 0.f); m = mn; }
}
#define MLB_TIE(B) do { _Pragma("unroll") for (int q_ = 0; q_ < 8; ++q_) asm volatile("" : "+v"(B.ub[q_]), "+v"(B.kv[q_])); asm volatile("" : "+v"(B.sc)); } while (0)
DI void ml_b_unit(Ctx& F, int u) {
    const int bh = u >> 3, p = u & 7, t = F.tid - 256, e0 = p * 1024 + 4 * t;
    const bf16* U = (const bf16*)(F.ws + WS_MLU); const float* SC = (const float*)(F.ws + WS_MLSC); const float* KN = (const float*)(F.ws + WS_MLKN);
    bf16* CT = (bf16*)(F.ws + WS_MLCT); float* NP = (float*)(F.ws + WS_MLNP); float* MP = (float*)(F.ws + WS_MLMP);
    f32x4 C = (f32x4){0.f, 0.f, 0.f, 0.f}; float nv = 0.f, m = 0.f; const bool dn = (p == 0 && t < 64);
    const size_t c0 = (size_t)bh * 64;
    MlBBatch A, B;
    ml_b_fetch(U, SC, KN, c0, e0, t, dn, A);
#pragma unroll
    for (int nb = 0; nb < 8; nb += 2) {
        ml_b_fetch(U, SC, KN, c0 + 8 * (nb + 1), e0, t, dn, B); asm volatile("s_waitcnt vmcnt(9)" ::: "memory"); MLB_TIE(A);
        ml_b_compute(A, CT, NP, MP, c0 + 8 * nb, e0, t, p, dn, C, nv, m);
        if (nb + 2 < 8) { ml_b_fetch(U, SC, KN, c0 + 8 * (nb + 2), e0, t, dn, A); asm volatile("s_waitcnt vmcnt(9)" ::: "memory"); } else asm volatile("s_waitcnt vmcnt(0)" ::: "memory");
        MLB_TIE(B);
        ml_b_compute(B, CT, NP, MP, c0 + 8 * (nb + 1), e0, t, p, dn, C, nv, m);
    }
}
DI void ml_c_unit(Ctx& F, const Args& a, int l, int cid, int par) {
    const int b = cid >> 8, h = (cid >> 6) & 3, n = cid & 63, t0 = b * SEQ + n * CH, lane = F.lane, tid = F.tid, g = lane >> 4, ln = lane & 15, w = F.wave, tt = w & 3, dh = w >> 2;
    const bf16* PROJ = (const bf16*)(F.ws + WS_PROJ); const float* GT = (const float*)(F.ws + WS_GATES);
    LAS unsigned char* VI = F.lds + par * 24576; LAS float* ib = (LAS float*)(VI + 20480); LAS float* Mt = ib + 64; LAS float* bcs = ib + 128; LAS float* ss = ib + 192;
    const float mprev = ldf((const float*)(F.ws + WS_MLMP) + cid);
    const bf16* CT = (const bf16*)(F.ws + WS_MLCT) + (size_t)cid * 8192; const float* NPv = (const float*)(F.ws + WS_MLNP) + (size_t)cid * 64;
    const int tl = 16 * tt + ln;
    bf16x8 qf[2], kf[4][2], ctf[5][2]; u32x2 ogr[4]; f32x4 nwr[4]; u32x4 vraw[2];
#pragma unroll
    for (int ks = 0; ks < 2; ++ks) { qf[ks] = *(const bf16x8*)(PROJ + (size_t)(t0 + tl) * NPROJ + h * 64 + 32 * ks + 8 * g);
#pragma unroll
        for (int ms = 0; ms < 4; ++ms) kf[ms][ks] = *(const bf16x8*)(PROJ + (size_t)(t0 + 16 * ms + ln) * NPROJ + 256 + h * 64 + 32 * ks + 8 * g);
#pragma unroll
        for (int mt = 0; mt < 4; ++mt) ctf[mt][ks] = *(const bf16x8*)(CT + (size_t)(16 * (4 * dh + mt) + ln) * 64 + 32 * ks + 8 * g);
        const f32x4 n0 = *(const f32x4*)(NPv + 32 * ks + 8 * g), n1 = *(const f32x4*)(NPv + 32 * ks + 8 * g + 4);
        float nvv[8];
#pragma unroll
        for (int j = 0; j < 4; ++j) { nvv[j] = (ln == 0) ? n0[j] : 0.f; nvv[4 + j] = (ln == 0) ? n1[j] : 0.f; }
        ctf[4][ks] = __builtin_bit_cast(bf16x8, pack8(nvv)); }
#pragma unroll
    for (int mt = 0; mt < 4; ++mt) { const int dv = 16 * (4 * dh + mt) + 4 * g;
        nwr[mt] = *(const f32x4*)(inp(F, 5) + (size_t)l * 512 + h * 128 + dv); ogr[mt] = *(const u32x2*)(PROJ + (size_t)(t0 + tl) * NPROJ + 1024 + h * 128 + dv); }
#pragma unroll
    for (int q = 0; q < 2; ++q) { const int idx = tid + 512 * q, s_ = idx >> 4, c8 = (idx & 15) * 8; vraw[q] = *(const u32x4*)(PROJ + (size_t)(t0 + s_) * NPROJ + 512 + h * 128 + c8); }
    if (w == 7) {
        const float ip = softcap15(GT[(size_t)(t0 + lane) * 16 + h] + inp(F, 3)[l * 4 + h]), fp = softcap15(GT[(size_t)(t0 + lane) * 16 + 4 + h] + inp(F, 4)[l * 4 + h]);
        const float bc = wave_incl_sum(log_sigmoid(fp), lane), ibs = ip - bc, pm = wave_incl_max(ibs, lane);
        ib[lane] = ibs; Mt[lane] = fmaxf(mprev, pm); bcs[lane] = bc;
    }
#pragma unroll
    for (int q = 0; q < 2; ++q) { const int idx = tid + 512 * q, s_ = idx >> 4, c8 = (idx & 15) * 8; *(LAS u32x4*)(VI + s_ * LDI + c8 * 2) = vraw[q]; }
    __syncthreads();
    f32x4 sacc[4];
#pragma unroll
    for (int ms = 0; ms < 4; ++ms) { sacc[ms] = (f32x4){0.f, 0.f, 0.f, 0.f};
#pragma unroll
        for (int ks = 0; ks < 2; ++ks) sacc[ms] = MFMA16(kf[ms][ks], qf[ks], sacc[ms]); }
    const float Mtt = Mt[tl];
#pragma unroll
    for (int ms = 0; ms < 4; ++ms) { const f32x4 ibv = *(const LAS f32x4*)(ib + 16 * ms + 4 * g);
#pragma unroll
        for (int i = 0; i < 4; ++i) { const int s = 16 * ms + 4 * g + i; sacc[ms][i] = (s <= tl) ? sacc[ms][i] * 0.125f * __expf(ibv[i] - Mtt) : 0.f; } }
    bf16x8 sb[2]; sb[0] = pack_frag(sacc[0], sacc[1]); sb[1] = pack_frag(sacc[2], sacc[3]);
    f32x4 xacc[5];
#pragma unroll
    for (int mt = 0; mt < 5; ++mt) { xacc[mt] = (f32x4){0.f, 0.f, 0.f, 0.f};
#pragma unroll
        for (int ks = 0; ks < 2; ++ks) xacc[mt] = MFMA16(ctf[mt][ks], qf[ks], xacc[mt]); }
    const float wint = 0.125f * __expf(mprev - Mtt);
#pragma unroll
    for (int mt = 0; mt < 5; ++mt) xacc[mt] *= wint;
    const bf16x8 ones = (ln == 0) ? (bf16x8){0x3f80, 0x3f80, 0x3f80, 0x3f80, 0x3f80, 0x3f80, 0x3f80, 0x3f80} : (bf16x8){0, 0, 0, 0, 0, 0, 0, 0};
#pragma unroll
    for (int kk = 0; kk < 2; ++kk) {
#pragma unroll
        for (int mt = 0; mt < 4; ++mt) { const bf16x8 vf = tr_frag8(lds_addr(VI), LDI, 32 * kk + 4 * g, 32 * kk + 16 + 4 * g, 16 * (4 * dh + mt), lane); xacc[mt] = MFMA16(vf, sb[kk], xacc[mt]); }
        xacc[4] = MFMA16(ones, sb[kk], xacc[4]);
    }
    const float den = __shfl(xacc[4][0], ln), mt_ = bcs[tl] + Mtt, dinv = __builtin_amdgcn_rcpf(fmaxf(fabsf(den), __expf(-mt_)));
    float ssq = 0.f;
#pragma unroll
    for (int mt = 0; mt < 4; ++mt) { xacc[mt] *= dinv; ssq += (xacc[mt][0] * xacc[mt][0] + xacc[mt][1] * xacc[mt][1]) + (xacc[mt][2] * xacc[mt][2] + xacc[mt][3] * xacc[mt][3]); }
    ssq += __shfl_xor(ssq, 16); ssq += __shfl_xor(ssq, 32);
    if (g == 0) ss[tl * 2 + dh] = ssq;
    __syncthreads();
    const float rinv = rsqrtf((ss[tl * 2] + ss[tl * 2 + 1]) * (1.f / 128.f) + 1e-6f);
    bf16* MX = (bf16*)(F.ws + WS_MIXED);
#pragma unroll
    for (int mt = 0; mt < 4; ++mt) { const int dv = 16 * (4 * dh + mt) + 4 * g;
        const f32x4 nw = nwr[mt]; const f32x4 og = unpack4(ogr[mt]);
        f32x4 o;
#pragma unroll
        for (int i = 0; i < 4; ++i) o[i] = xacc[mt][i] * rinv * nw[i] * sigmoidf_(og[i]);
        *(u32x2*)(MX + (size_t)(t0 + tl) * D + h * 128 + dv) = pack4(o); }
}

constexpr int GA_WT = 155648;
constexpr int GA_ST = 103424;
DI void gd_a_issue(Ctx& F, int cid, int w, int lane) {
    const int b = cid >> 8, h = (cid >> 6) & 3, n = cid & 63, t0 = b * SEQ + n * CH;
    const bf16* PROJ = (const bf16*)(F.ws + WS_PROJ);
#pragma unroll
    for (int q = 0; q < 7; ++q) { const int jj = (w + 8 * q) % 51, ten = jj / 17, grp = jj % 17;
        DMA16NT(PROJ + ((long)t0 - 3 + 4 * grp + (lane >> 4)) * NPROJ + 1536 + ten * 512 + h * 128 + 8 * (lane & 15), F.lds + GA_ST + ten * 17408 + grp * 1024); }
}
DI void gd_a_unit(Ctx& F, int l, int cid, float& gb, float& ga, float nalog, float dtb, bool has_next, MlAPre& P) {
    int tid = F.tid; asm volatile("" : "+v"(tid));
    const int b = cid >> 8, h = (cid >> 6) & 3, n = cid & 63, t0 = b * SEQ + n * CH, lane = tid & 63, g = lane >> 4, ln = lane & 15, w = F.wave;
    const float* GT = (const float*)(F.ws + WS_GATES);
    LAS unsigned char* L = F.lds; LAS float* gcs = (LAS float*)(L + GA_GC); LAS float* bts = gcs + 64;
    const int ten = tid >> 7, tg = (tid >> 4) & 7, cg = tid & 15;
    asm volatile("s_waitcnt vmcnt(0)" ::: "memory");
    __syncthreads();
    u32x4 raw[11];
    if (ten < 3) { const unsigned sa = lds_addr(L) + GA_ST + ten * 17408 + (8 * tg) * 256 + cg * 16;
        asm volatile("ds_read_b128 %0, %11\n\tds_read_b128 %1, %11 offset:256\n\tds_read_b128 %2, %11 offset:512\n\tds_read_b128 %3, %11 offset:768\n\tds_read_b128 %4, %11 offset:1024\n\tds_read_b128 %5, %11 offset:1280\n\t"
                     "ds_read_b128 %6, %11 offset:1536\n\tds_read_b128 %7, %11 offset:1792\n\tds_read_b128 %8, %11 offset:2048\n\tds_read_b128 %9, %11 offset:2304\n\tds_read_b128 %10, %11 offset:2560\n\ts_waitcnt lgkmcnt(0)"
                     : "=&v"(raw[0]), "=&v"(raw[1]), "=&v"(raw[2]), "=&v"(raw[3]), "=&v"(raw[4]), "=&v"(raw[5]), "=&v"(raw[6]), "=&v"(raw[7]), "=&v"(raw[8]), "=&v"(raw[9]), "=&v"(raw[10]) : "v"(sa) : "memory");
        if (n == 0 && tg == 0) { raw[0] = (u32x4){0u, 0u, 0u, 0u}; raw[1] = raw[0]; raw[2] = raw[0]; }
    }
    float wv[4][8];
#pragma unroll
    for (int j = 0; j < 4; ++j) unpack8(*(const LAS u32x4*)(L + GA_WT + (((ten < 3 ? ten : 0) * 4 + j) * 128 + 8 * cg) * 2), wv[j]);
    const float glast = gcs[63];
    bf16* qgb = (bf16*)(F.ws + WS_GDQG) + (size_t)cid * 8192 + (8 * tg) * 128 + 8 * cg; asm volatile("" : "+v"(qgb));
    if (ten < 3) {
#pragma unroll
        for (int i = 0; i < 8; ++i) { const int t = 8 * tg + i; float y[8];
#pragma unroll
            for (int c = 0; c < 8; ++c) y[c] = 0.f;
#pragma unroll
            for (int j = 0; j < 4; ++j) { float xv[8]; unpack8(raw[i + j], xv);
#pragma unroll
                for (int c = 0; c < 8; ++c) y[c] += wv[j][c] * xv[c]; }
#pragma unroll
            for (int c = 0; c < 8; ++c) y[c] = y[c] * sigmoidf_(y[c]);
            const float gct = gcs[t], bt = bts[t];
            if (ten < 2) { float s2 = 0.f;
#pragma unroll
                for (int c = 0; c < 8; ++c) s2 += y[c] * y[c];
                s2 += __shfl_xor(s2, 1); s2 += __shfl_xor(s2, 2); s2 += __shfl_xor(s2, 4); s2 += __shfl_xor(s2, 8);
                const float rn = rsqrtf(s2 + 1e-6f) * (ten == 0 ? 0.08838834764831845f : 1.f);
#pragma unroll
                for (int c = 0; c < 8; ++c) y[c] *= rn; }
            float z[8];
            if (ten == 0) { *(LAS u32x4*)(L + GA_QH + t * LDI + 16 * cg) = pack8(y); const float e = __expf(gct);
#pragma unroll
                for (int c = 0; c < 8; ++c) z[c] = y[c] * e;
                *(u32x4*)(qgb + i * 128) = pack8(z); }
            else if (ten == 1) { *(LAS u32x4*)(L + GA_KH + t * LDI + 16 * cg) = pack8(y); const float e1 = bt * __expf(gct), e2 = __expf(glast - gct);
#pragma unroll
                for (int c = 0; c < 8; ++c) z[c] = y[c] * e1;
                *(LAS u32x4*)(L + GA_KB + t * LDI + 16 * cg) = pack8(z);
#pragma unroll
                for (int c = 0; c < 8; ++c) z[c] = y[c] * e2;
                *(LAS u32x4*)(L + GA_KEI + t * LDI + 16 * cg) = pack8(z); }
            else {
#pragma unroll
                for (int c = 0; c < 8; ++c) z[c] = y[c] * bt;
                *(LAS u32x4*)(L + GA_VB + t * LDI + 16 * cg) = pack8(z); }
        }
    }
    __syncthreads(); PROF_SUB(1);
    if (has_next) {
        ml_a_fetch(F, cid + 256, P);
        gb = gld4(GT + (size_t)(t0 + SEQ + lane) * 16 + 8 + h); ga = gld4(GT + (size_t)(t0 + SEQ + lane) * 16 + 12 + h);
        gd_a_issue(F, cid + 256, w, lane); }
    { const int ti = w & 3, kind = w >> 2; const int tl = 16 * ti + ln; const float gct = gcs[tl], bt = bts[tl];
      bf16* QKD = (bf16*)(F.ws + WS_GDQK) + (size_t)cid * 4096;
#pragma unroll
      for (int si = 0; si < 4; ++si) {
          if (si <= ti) {
              f32x4 acc = (f32x4){0.f, 0.f, 0.f, 0.f};
#pragma unroll
              for (int ks = 0; ks < 4; ++ks) { const bf16x8 af = *(const LAS bf16x8*)(L + GA_KH + (16 * si + ln) * LDI + (32 * ks + 8 * g) * 2);
                  const bf16x8 bfr = *(const LAS bf16x8*)(L + (kind ? GA_QH : GA_KH) + tl * LDI + (32 * ks + 8 * g) * 2); acc = MFMA16(af, bfr, acc); }
              const f32x4 gs = *(const LAS f32x4*)(gcs + 16 * si + 4 * g);
              f32x4 v;
#pragma unroll
              for (int i = 0; i < 4; ++i) { const int s = 16 * si + 4 * g + i; const float dec = __expf(gct - gs[i]);
                  v[i] = kind ? ((s <= tl) ? acc[i] * dec : 0.f) : ((s < tl) ? bt * acc[i] * dec : 0.f); }
              if (kind) *(u32x2*)(QKD + (ti * 2 + (si >> 1)) * 512 + ((2 * (si & 1) + (g >> 1)) * 16 + ln) * 8 + (g & 1) * 4) = pack4(v);
              else { *(LAS u32x2*)(L + GA_NA + tl * LDK + (16 * si + 4 * g) * 2) = pack4(-v);
                  if (si == ti) { LAS float* AD = (LAS float*)(L + GA_AD) + ti * 256 + ln * 16 + 4 * g; AD[0] = v[0]; AD[1] = v[1]; AD[2] = v[2]; AD[3] = v[3]; } }
          } else if (kind) *(u32x2*)(QKD + (ti * 2 + (si >> 1)) * 512 + ((2 * (si & 1) + (g >> 1)) * 16 + ln) * 8 + (g & 1) * 4) = (u32x2){0u, 0u};
      } }
    __syncthreads(); PROF_SUB(2);
    if (w == 0) {
        const LAS float* AD = (const LAS float*)(L + GA_AD) + g * 256; float a_[16][16], acc[16];
#pragma unroll
        for (int t = 1; t < 16; ++t)
#pragma unroll
            for (int q = 0; q < 4; ++q) { if (4 * q < t) { const f32x4 r = *(const LAS f32x4*)(AD + t * 16 + 4 * q); a_[t][4 * q] = r[0]; a_[t][4 * q + 1] = r[1]; a_[t][4 * q + 2] = r[2]; a_[t][4 * q + 3] = r[3]; } }
#pragma unroll
        for (int t = 0; t < 16; ++t) acc[t] = (t == ln) ? 1.f : 0.f;
#pragma unroll
        for (int s_ = 0; s_ < 16; ++s_) { const float tc = acc[s_]; *(LAS bf16*)(L + GA_TI + (16 * g + s_) * 32 + ln * 2) = f2bf(tc);
#pragma unroll
            for (int t = s_ + 1; t < 16; ++t) acc[t] -= a_[t][s_] * tc; }
    }
    __syncthreads(); PROF_SUB(3);
    { const int src = (w < 4) ? GA_VB : GA_KB, cb = 32 * (w & 3);
      u32x2 Ub[4][2]; bf16* UT = (bf16*)(F.ws + WS_GDUT) + (size_t)cid * 8192;
#pragma unroll
      for (int i = 0; i < 4; ++i) {
          f32x4 acc[2];
#pragma unroll
          for (int nt = 0; nt < 2; ++nt)
#pragma unroll
              for (int r = 0; r < 4; ++r) acc[nt][r] = bf2f(*(const LAS bf16*)(L + src + (16 * i + 4 * g + r) * LDI + (cb + 16 * nt + ln) * 2));
#pragma unroll
          for (int jp = 0; jp < 2; ++jp) { if (2 * jp < i) {
              const u32x2 alo = *(const LAS u32x2*)(L + GA_NA + (16 * i + ln) * LDK + (32 * jp + 4 * g) * 2);
              const u32x2 ahi = (2 * jp + 1 < i) ? *(const LAS u32x2*)(L + GA_NA + (16 * i + ln) * LDK + (32 * jp + 16 + 4 * g) * 2) : (u32x2){0u, 0u};
              const bf16x8 af = __builtin_bit_cast(bf16x8, (u32x4){alo.x, alo.y, ahi.x, ahi.y});
#pragma unroll
              for (int nt = 0; nt < 2; ++nt) { const u32x2 blo = Ub[2 * jp][nt], bhi = (2 * jp + 1 < i) ? Ub[2 * jp + 1][nt] : (u32x2){0u, 0u};
                  acc[nt] = MFMA16(af, __builtin_bit_cast(bf16x8, (u32x4){blo.x, blo.y, bhi.x, bhi.y}), acc[nt]); } } }
          const u32x2 tlo = *(const LAS u32x2*)(L + GA_TI + (16 * i + ln) * 32 + (4 * g) * 2);
          const bf16x8 tf = __builtin_bit_cast(bf16x8, (u32x4){tlo.x, tlo.y, 0u, 0u});
#pragma unroll
          for (int nt = 0; nt < 2; ++nt) { const u32x2 p = pack4(acc[nt]);
              const f32x4 u = MFMA16(tf, __builtin_bit_cast(bf16x8, (u32x4){p.x, p.y, 0u, 0u}), ((f32x4){0.f, 0.f, 0.f, 0.f}));
              Ub[i][nt] = pack4(u);
              if (w < 4) *(u32x2*)(UT + ((cb >> 4) + nt) * 1024 + i * 256 + lane * 4) = Ub[i][nt];
              else {
#pragma unroll
                  for (int r = 0; r < 4; ++r) *(LAS bf16*)(L + GA_QH + (16 * i + 4 * g + r) * LDI + (cb + 16 * nt + ln) * 2) = f2bf(-u[r]); } }
      } }
    __syncthreads(); PROF_SUB(4);
    { bf16* W = (bf16*)(F.ws + WS_GDW) + (size_t)cid * 8192; bf16* KET = (bf16*)(F.ws + WS_GDKE) + (size_t)cid * 8192;
#pragma unroll
      for (int q = 0; q < 2; ++q) { const int item = tid + 512 * q, f = item >> 6, lp = item & 63, t = 16 * (f >> 2) + (lp & 15), kk = f & 3, gp = lp >> 4;
          const u32x2 lo = *(const LAS u32x2*)(L + GA_QH + t * LDI + (32 * kk + 4 * gp) * 2), hi = *(const LAS u32x2*)(L + GA_QH + t * LDI + (32 * kk + 16 + 4 * gp) * 2);
          *(u32x4*)(W + item * 8) = (u32x4){lo.x, lo.y, hi.x, hi.y}; }
#pragma unroll
      for (int q = 0; q < 4; ++q) { const int rg = 4 * q + g, kk = rg >> 3, idx = rg & 7, pos = 32 * kk + ((idx < 4) ? 8 * idx : 8 * (idx - 4) + 4);
          const int trow = 32 * kk + ((idx < 4) ? 4 * idx : 16 + 4 * (idx - 4));
          const s16x4 v = tr_read4(lds_addr(L + GA_KEI) + (unsigned)((trow + (ln >> 2)) * LDI + (16 * w + 4 * (ln & 3)) * 2));
          *(s16x4*)(KET + (w * 2 + kk) * 512 + ((idx & 3) * 16 + ln) * 8 + ((idx < 4) ? 0 : 4)) = v; }
    }
    __syncthreads(); PROF_SUB(5);
}
constexpr int GB_STAGE = 36864;
DI void gd_b_issue(const bf16* W, const bf16* KET, const bf16* UT, size_t cid, int dv0, int ln, int g, LAS unsigned char* buf) {
#pragma unroll
    for (int mt = 0; mt < 4; ++mt)
#pragma unroll
        for (int kk = 0; kk < 4; ++kk) __builtin_amdgcn_global_load_lds((const unsigned*)(W + cid * 8192 + (mt * 4 + kk) * 512 + (16 * g + ln) * 8), (LAS unsigned*)(buf + (mt * 4 + kk) * 1024), 16, 0, 2);
#pragma unroll
    for (int j = 0; j < 8; ++j)
#pragma unroll
        for (int k2 = 0; k2 < 2; ++k2) __builtin_amdgcn_global_load_lds((const unsigned*)(KET + cid * 8192 + (j * 2 + k2) * 512 + (16 * g + ln) * 8), (LAS unsigned*)(buf + (16 + j * 2 + k2) * 1024), 16, 0, 2);
#pragma unroll
    for (int q = 0; q < 2; ++q) __builtin_amdgcn_global_load_lds((const unsigned*)(UT + cid * 8192 + dv0 * 64 + q * 512 + (16 * g + ln) * 8), (LAS unsigned*)(buf + (32 + q) * 1024), 16, 0, 2);
}
#define GB_RD16(f, addr, WAITSTR) asm volatile( \
    "ds_read_b128 %0, %16\n\tds_read_b128 %1, %16 offset:1024\n\tds_read_b128 %2, %16 offset:2048\n\tds_read_b128 %3, %16 offset:3072\n\t" \
    "ds_read_b128 %4, %16 offset:4096\n\tds_read_b128 %5, %16 offset:5120\n\tds_read_b128 %6, %16 offset:6144\n\tds_read_b128 %7, %16 offset:7168\n\t" \
    "ds_read_b128 %8, %16 offset:8192\n\tds_read_b128 %9, %16 offset:9216\n\tds_read_b128 %10, %16 offset:10240\n\tds_read_b128 %11, %16 offset:11264\n\t" \
    "ds_read_b128 %12, %16 offset:12288\n\tds_read_b128 %13, %16 offset:13312\n\tds_read_b128 %14, %16 offset:14336\n\tds_read_b128 %15, %16 offset:15360" WAITSTR \
    : "=&v"(f[0]), "=&v"(f[1]), "=&v"(f[2]), "=&v"(f[3]), "=&v"(f[4]), "=&v"(f[5]), "=&v"(f[6]), "=&v"(f[7]), \
      "=&v"(f[8]), "=&v"(f[9]), "=&v"(f[10]), "=&v"(f[11]), "=&v"(f[12]), "=&v"(f[13]), "=&v"(f[14]), "=&v"(f[15]) : "v"(addr) : "memory")
constexpr int GB_NS = 4, GB_FLAGS = LDS_MISC + 512, GB_SPIN_CAP = 1 << 22;
DI void gd_b_step(Ctx& F, f32x4 (&S)[8], size_t cid, int dv0, int lane, int ln, int g, float egl, unsigned stage_base, int n) {
    const unsigned base = stage_base + (unsigned)lane * 16u;
    bf16* VNT = (bf16*)(F.ws + WS_GDVN); bf16* SPT = (bf16*)(F.ws + WS_GDSP);
    bf16x8 wf[16], kef[16]; u32x2 ui[4];
    asm volatile("ds_read_b64 %0, %4 offset:32768\n\tds_read_b64 %1, %4 offset:33280\n\tds_read_b64 %2, %4 offset:33792\n\tds_read_b64 %3, %4 offset:34304"
                 : "=&v"(ui[0]), "=&v"(ui[1]), "=&v"(ui[2]), "=&v"(ui[3]) : "v"(stage_base + (unsigned)lane * 8u) : "memory");
    GB_RD16(wf, base, "\n\ts_waitcnt lgkmcnt(0)");
    asm volatile("" : "+v"(ui[0]), "+v"(ui[1]), "+v"(ui[2]), "+v"(ui[3]));
    GB_RD16(kef, base + 16384u, "");
    f32x4 vacc[4]; bf16x8 sbn[4];
#pragma unroll
    for (int kk = 0; kk < 4; ++kk) sbn[kk] = pack_frag(S[2 * kk], S[2 * kk + 1]);
#pragma unroll
    for (int j = 0; j < 8; ++j) *(u32x2*)(SPT + cid * 16384 + ((dv0 >> 4) * 4 + (j >> 1)) * 512 + ((2 * (j & 1) + (g >> 1)) * 16 + ln) * 8 + (g & 1) * 4) = pack4(S[j]);
#pragma unroll
    for (int mt = 0; mt < 4; ++mt) vacc[mt] = unpack4(ui[mt]);
#pragma unroll
    for (int kk = 0; kk < 4; ++kk)
#pragma unroll
        for (int mt = 0; mt < 4; ++mt) vacc[mt] = MFMA16(wf[mt * 4 + kk], sbn[kk], vacc[mt]);
#pragma unroll
    for (int mt = 0; mt < 4; ++mt) *(u32x2*)(VNT + cid * 8192 + ((dv0 >> 4) * 2 + (mt >> 1)) * 512 + ((2 * (mt & 1) + (g >> 1)) * 16 + ln) * 8 + (g & 1) * 4) = pack4(vacc[mt]);
    bf16x8 vb[2]; vb[0] = pack_frag(vacc[0], vacc[1]); vb[1] = pack_frag(vacc[2], vacc[3]);
    asm volatile("s_waitcnt lgkmcnt(0)" : "+v"(kef[0]), "+v"(kef[1]), "+v"(kef[2]), "+v"(kef[3]), "+v"(kef[4]), "+v"(kef[5]), "+v"(kef[6]), "+v"(kef[7]),
                 "+v"(kef[8]), "+v"(kef[9]), "+v"(kef[10]), "+v"(kef[11]), "+v"(kef[12]), "+v"(kef[13]), "+v"(kef[14]), "+v"(kef[15]) :: "memory");
    if (lane == 0) ((volatile LAS unsigned*)(F.lds + GB_FLAGS))[4] = (unsigned)(n + 1);
#pragma unroll
    for (int j = 0; j < 8; ++j) S[j] *= egl;
#pragma unroll
    for (int k2 = 0; k2 < 2; ++k2)
#pragma unroll
        for (int j = 0; j < 8; ++j) S[j] = MFMA16(kef[j * 2 + k2], vb[k2], S[j]);
}
DI void gd_b_task(Ctx& F, int task) {
    const int bh = task >> 3, dv0 = 16 * (task & 7), lane = F.lane, g = lane >> 4, ln = lane & 15;
    const float* GL = (const float*)(F.ws + WS_GDGL);
    volatile LAS unsigned* fl = (volatile LAS unsigned*)(F.lds + GB_FLAGS);
    f32x4 S[8];
#pragma unroll
    for (int j = 0; j < 8; ++j) S[j] = (f32x4){0.f, 0.f, 0.f, 0.f};
    const size_t c0 = (size_t)bh * 64;
    const float eglv = ldf(GL + c0 + lane);
    asm volatile("s_waitcnt vmcnt(0)" ::: "memory");
    const unsigned L0 = lds_addr(F.lds);
#pragma unroll 1
    for (int n = 0; n < 64; ++n) {
        unsigned spins = 0;
        unsigned long long tp0_ = 0; if (((PROF_MASK) >> 22) & 1) tp0_ = __builtin_amdgcn_s_memrealtime();
        while (fl[n & 3] < (unsigned)(n + 1)) { __builtin_amdgcn_s_sleep(1); if (++spins > (unsigned)GB_SPIN_CAP) { fl[5] = 1u; break; } }
        if (((PROF_MASK) >> 22) & 1) { if (blockIdx.x == 0 && lane == 0) { volatile LAS unsigned long long* pw = (volatile LAS unsigned long long*)(F.lds + LDS_MISC + 128); pw[1] += __builtin_amdgcn_s_memrealtime() - tp0_; } }
        gd_b_step(F, S, c0 + n, dv0, lane, ln, g, __builtin_amdgcn_readlane(eglv, n), L0 + (unsigned)(n & 3) * GB_STAGE, n);
    }
}
DI void gd_b_loader(Ctx& F, int task, int li) {
    const int bh = task >> 3, dv0 = 16 * (task & 7), lane = F.lane, g = lane >> 4, ln = lane & 15;
    const bf16* UT = (const bf16*)(F.ws + WS_GDUT); const bf16* W = (const bf16*)(F.ws + WS_GDW); const bf16* KET = (const bf16*)(F.ws + WS_GDKE);
    volatile LAS unsigned* fl = (volatile LAS unsigned*)(F.lds + GB_FLAGS);
    const size_t c0 = (size_t)bh * 64;
    int prev = -1;
#pragma unroll 1
    for (int n = li; n < 64; n += 2) {
        if (n >= GB_NS) { unsigned spins = 0; while (fl[4] < (unsigned)(n - GB_NS + 1)) { __builtin_amdgcn_s_sleep(1); if (++spins > (unsigned)GB_SPIN_CAP) { fl[5] = 1u; break; } } }
        gd_b_issue(W, KET, UT, c0 + n, dv0, ln, g, F.lds + (n & 3) * GB_STAGE);
        if (prev >= 0) { asm volatile("s_waitcnt vmcnt(34)" ::: "memory"); if (lane == 0) fl[prev & 3] = (unsigned)(prev + 1); }
        prev = n;
    }
    asm volatile("s_waitcnt vmcnt(0)" ::: "memory"); if (lane == 0) fl[prev & 3] = (unsigned)(prev + 1);
}
DI void gd_c_unit(Ctx& F, const Args& a, int l, int cid, int par) {
    const int b = cid >> 8, h = (cid >> 6) & 3, n = cid & 63, t0 = b * SEQ + n * CH, lane = F.lane, g = lane >> 4, ln = lane & 15, w = F.wave, tt = w & 3, dh = w >> 2, tl = 16 * tt + ln;
    const bf16* PROJ = (const bf16*)(F.ws + WS_PROJ);
    const bf16* SPT = (const bf16*)(F.ws + WS_GDSP) + (size_t)cid * 16384; const bf16* QG = (const bf16*)(F.ws + WS_GDQG) + (size_t)cid * 8192;
    const bf16* VNT = (const bf16*)(F.ws + WS_GDVN) + (size_t)cid * 8192; const bf16* QKD = (const bf16*)(F.ws + WS_GDQK) + (size_t)cid * 4096;
    LAS float* ss = (LAS float*)(F.lds + par * 1024);
    bf16x8 qf[4], pf[2];
#pragma unroll
    for (int ks = 0; ks < 4; ++ks) qf[ks] = *(const bf16x8*)(QG + tl * 128 + 32 * ks + 8 * g);
#pragma unroll
    for (int ks = 0; ks < 2; ++ks) pf[ks] = *(const bf16x8*)(QKD + tl * 64 + 32 * ks + 8 * g);
    u32x2 zr[4]; f32x4 nwr[4];
#pragma unroll
    for (int mt = 0; mt < 4; ++mt) { const int dv = 16 * (4 * dh + mt) + 4 * g; nwr[mt] = *(const f32x4*)(inp(F, 9) + (size_t)l * 128 + dv); zr[mt] = *(const u32x2*)(PROJ + (size_t)(t0 + tl) * NPROJ + 3072 + h * 128 + dv); }
    f32x4 o[4]; float ssq = 0.f;
#pragma unroll
    for (int mt = 0; mt < 4; ++mt) { o[mt] = (f32x4){0.f, 0.f, 0.f, 0.f}; const int dvr = 16 * (4 * dh + mt) + ln;
#pragma unroll
        for (int ks = 0; ks < 4; ++ks) o[mt] = MFMA16(*(const bf16x8*)(SPT + (size_t)dvr * 128 + 32 * ks + 8 * g), qf[ks], o[mt]);
#pragma unroll
        for (int ks = 0; ks < 2; ++ks) o[mt] = MFMA16(*(const bf16x8*)(VNT + (size_t)dvr * 64 + 32 * ks + 8 * g), pf[ks], o[mt]);
        ssq += (o[mt][0] * o[mt][0] + o[mt][1] * o[mt][1]) + (o[mt][2] * o[mt][2] + o[mt][3] * o[mt][3]); }
    ssq += __shfl_xor(ssq, 16); ssq += __shfl_xor(ssq, 32);
    if (g == 0) ss[tl * 2 + dh] = ssq;
    __syncthreads();
    const float rinv = rsqrtf((ss[tl * 2] + ss[tl * 2 + 1]) * (1.f / 128.f) + 1e-6f);
    bf16* MX = (bf16*)(F.ws + WS_MIXED);
#pragma unroll
    for (int mt = 0; mt < 4; ++mt) { const int dv = 16 * (4 * dh + mt) + 4 * g;
        const f32x4 nw = nwr[mt]; const f32x4 z = unpack4(zr[mt]);
        f32x4 r;
#pragma unroll
        for (int i = 0; i < 4; ++i) r[i] = o[mt][i] * rinv * nw[i] * z[i] * sigmoidf_(z[i]);
        *(u32x2*)(MX + (size_t)(t0 + tl) * D + 512 + h * 128 + dv) = pack4(r); }
}

DI void phase_a(Ctx& F, const Args& a, int l) {
    const int h = (F.vcu >> 6) & 3, lane = F.lane, tid = F.tid, w = F.wave;
    const float* GT = (const float*)(F.ws + WS_GATES);
    for (int e = tid; e < 3 * 4 * 128; e += NTHREADS) { const int ten = e / 512, j = (e >> 7) & 3, c = e & 127;
        *(LAS bf16*)(F.lds + GA_WT + e * 2) = f2bf(inp(F, 6)[((size_t)l * 4 + j) * 1536 + ten * 512 + h * 128 + c]); }
    const float bi = inp(F, 3)[l * 4 + h], bf_ = inp(F, 4)[l * 4 + h], nalog = -__expf(inp(F, 7)[l * 4 + h]), dtb = inp(F, 8)[l * 4 + h];
    asm volatile("s_waitcnt vmcnt(0)" ::: "memory");
    const int t00 = (F.vcu & 63) * CH;
    {
        MlAPre P0; ml_a_fetch(F, F.vcu, P0);
        float gb0 = gld4(GT + (size_t)(t00 + lane) * 16 + 8 + h), ga0 = gld4(GT + (size_t)(t00 + lane) * 16 + 12 + h);
        gd_a_issue(F, F.vcu, w, lane);
        ml_a_unit(F, l, F.vcu, 0, P0, bi, bf_, gb0, ga0, nalog, dtb);
    }
#pragma unroll 1
    for (int i = 0; i < 8; ++i) {
        const int cid = F.vcu + 256 * i;
        MlAPre P; float gb = 0.f, ga = 0.f;
        gd_a_unit(F, l, cid, gb, ga, nalog, dtb, i + 1 < 8, P);
        if (i + 1 < 8) ml_a_unit(F, l, cid + 256, (i + 1) & 1, P, bi, bf_, gb, ga, nalog, dtb);
    }
    asm volatile("s_waitcnt vmcnt(0)" ::: "memory"); __syncthreads();
}
constexpr int CS_K = 0, CS_Q = 8192, CS_CT = 16384, CS_V = 32768, CS_NP = 49152, CS_SC = 49408, CS_GI = 50688, CS_GF = 50944, GS_SP = 51200, GS_QG = 83968, GS_VN = 100352, GS_QK = 116736, GS_SS = 124928;
constexpr int CS_OG = 126464, GS_Z = 142848, CS_MP = 159232;
DI void lds_rd4x8_nowait(unsigned addr, u32x2& a, u32x2& b, u32x2& c, u32x2& d) { asm volatile("ds_read_b64 %0, %4\n\tds_read_b64 %1, %4 offset:32\n\tds_read_b64 %2, %4 offset:64\n\tds_read_b64 %3, %4 offset:96" : "=&v"(a), "=&v"(b), "=&v"(c), "=&v"(d) : "v"(addr) : "memory"); }
DI float lds_rd4(unsigned addr) { float r; asm volatile("ds_read_b32 %0, %1\n\ts_waitcnt lgkmcnt(0)" : "=v"(r) : "v"(addr) : "memory"); return r; }
DI bf16x8 lds_frag(unsigned addr) { bf16x8 r; asm volatile("ds_read_b128 %0, %1" : "=v"(r) : "v"(addr) : "memory"); return r; }
DI f32x2 lds_rd8(unsigned addr) { f32x2 r; asm volatile("ds_read_b64 %0, %1\n\ts_waitcnt lgkmcnt(0)" : "=v"(r) : "v"(addr) : "memory"); return r; }
DI void mlc_issue(Ctx& F, int cid, int w, int lane) {
    const int b = cid >> 8, h = (cid >> 6) & 3, n = cid & 63, t0 = b * SEQ + n * CH, g = lane >> 4, ln = lane & 15;
    const bf16* PROJ = (const bf16*)(F.ws + WS_PROJ); const bf16* CT = (const bf16*)(F.ws + WS_MLCT) + (size_t)cid * 8192;
    DMA16NT(PROJ + (size_t)(t0 + 16 * (w >> 1) + ln) * NPROJ + 256 + h * 64 + 32 * (w & 1) + 8 * g, F.lds + CS_K + w * 1024);
    DMA16NT(PROJ + (size_t)(t0 + 16 * (w >> 1) + ln) * NPROJ + h * 64 + 32 * (w & 1) + 8 * g, F.lds + CS_Q + w * 1024);
#pragma unroll
    for (int ks = 0; ks < 2; ++ks) DMA16NT(CT + (2 * w + ks) * 512 + lane * 8, F.lds + CS_CT + (2 * w + ks) * 1024);
#pragma unroll
    for (int q = 0; q < 2; ++q) { const int j = 2 * w + q; DMA16NT(PROJ + (size_t)(t0 + 4 * j + g) * NPROJ + 512 + h * 128 + 8 * ln, F.lds + CS_V + j * 1024); }
#pragma unroll
    for (int q = 0; q < 2; ++q) { const int j = 2 * w + q; DMA16NT(PROJ + (size_t)(t0 + 4 * j + g) * NPROJ + 1024 + h * 128 + 8 * ln, F.lds + CS_OG + j * 1024); }
    if (w == 7) {
        __builtin_amdgcn_global_load_lds((const unsigned*)((const float*)(F.ws + WS_MLNP) + (size_t)cid * 64 + lane), (LAS unsigned*)(F.lds + CS_NP), 4, 0, 0);
        const float* GT = (const float*)(F.ws + WS_GATES);
        __builtin_amdgcn_global_load_lds((const unsigned*)(GT + (size_t)(t0 + lane) * 16 + h), (LAS unsigned*)(F.lds + CS_GI), 4, 0, 0);
        __builtin_amdgcn_global_load_lds((const unsigned*)(GT + (size_t)(t0 + lane) * 16 + 4 + h), (LAS unsigned*)(F.lds + CS_GF), 4, 0, 0);
        __builtin_amdgcn_global_load_lds((const unsigned*)((const float*)(F.ws + WS_MLMP) + cid), (LAS unsigned*)(F.lds + CS_MP), 4, 0, 0);
    }
}
DI void gdc_issue(Ctx& F, int cid, int w, int lane) {
    const int g = lane >> 4, ln = lane & 15;
    const bf16* SPT = (const bf16*)(F.ws + WS_GDSP) + (size_t)cid * 16384; const bf16* QG = (const bf16*)(F.ws + WS_GDQG) + (size_t)cid * 8192;
    const bf16* VNT = (const bf16*)(F.ws + WS_GDVN) + (size_t)cid * 8192; const bf16* QKD = (const bf16*)(F.ws + WS_GDQK) + (size_t)cid * 4096;
#pragma unroll
    for (int ks = 0; ks < 4; ++ks) DMA16NT(SPT + (4 * w + ks) * 512 + lane * 8, F.lds + GS_SP + (4 * w + ks) * 1024);
#pragma unroll
    for (int q = 0; q < 2; ++q) { const int bq = 2 * w + q; DMA16NT(QG + (size_t)(16 * (bq >> 2) + ln) * 128 + 32 * (bq & 3) + 8 * g, F.lds + GS_QG + bq * 1024); }
#pragma unroll
    for (int ks = 0; ks < 2; ++ks) DMA16NT(VNT + (2 * w + ks) * 512 + lane * 8, F.lds + GS_VN + (2 * w + ks) * 1024);
    DMA16NT(QKD + w * 512 + lane * 8, F.lds + GS_QK + w * 1024);
    { const int b = cid >> 8, h = (cid >> 6) & 3, n = cid & 63, t0 = b * SEQ + n * CH; const bf16* PROJ = (const bf16*)(F.ws + WS_PROJ);
#pragma unroll
      for (int q = 0; q < 2; ++q) { const int j = 2 * w + q; DMA16NT(PROJ + (size_t)(t0 + 4 * j + g) * NPROJ + 3072 + h * 128 + 8 * ln, F.lds + GS_Z + j * 1024); } }
}
constexpr int GS_NW = 125440;
DI void phase_c(Ctx& F, const Args& a, int l) {
    const int lane = F.lane, g = lane >> 4, ln = lane & 15, w = F.wave, tt = w & 3, dh = w >> 2, tl = 16 * tt + ln;
    const int h = (F.vcu >> 6) & 3, n = F.vcu & 63;
    const bf16* PROJ = (const bf16*)(F.ws + WS_PROJ); const float* GT = (const float*)(F.ws + WS_GATES); bf16* MX = (bf16*)(F.ws + WS_MIXED);
    const unsigned L0 = lds_addr(F.lds);
    LAS float* ib = (LAS float*)(F.lds + CS_SC); LAS float* Mt = ib + 64; LAS float* bcs = ib + 128;
    if (F.tid < 256) ((LAS float*)(F.lds + GS_NW))[F.tid] = (F.tid < 128) ? inp(F, 5)[(size_t)l * 512 + h * 128 + F.tid] : inp(F, 9)[(size_t)l * 128 + F.tid - 128];
    const float bi = inp(F, 3)[l * 4 + h], bf_ = inp(F, 4)[l * 4 + h];
    asm volatile("s_waitcnt vmcnt(0)" ::: "memory");
    __syncthreads();
    mlc_issue(F, F.vcu, w, lane);
    gdc_issue(F, F.vcu, w, lane);
#pragma unroll 1
    for (int i = 0; i < 8; ++i) {
        const int cid = F.vcu + 256 * i, t0 = i * SEQ + n * CH;
        asm volatile("s_waitcnt vmcnt(11)" ::: "memory");
        float mpv = 0.f;
        if (w == 7) { mpv = lds_rd4(L0 + CS_MP + lane * 4);
            const float gi = lds_rd4(L0 + CS_GI + lane * 4), gf = lds_rd4(L0 + CS_GF + lane * 4); const float ip = softcap15(gi + bi), fp = softcap15(gf + bf_);
            const float bc = wave_incl_sum(log_sigmoid(fp), lane), ibs = ip - bc, pm = wave_incl_max(ibs, lane);
            ib[lane] = ibs; Mt[lane] = fmaxf(mpv, pm); bcs[lane] = bc; }
        asm volatile("s_waitcnt lgkmcnt(0)" ::: "memory"); __builtin_amdgcn_s_barrier(); asm volatile("" ::: "memory");
        if (w != 7) mpv = lds_rd4(L0 + CS_MP + lane * 4);
        const float mprev = mpv;
        const float Mtt = lds_rd8(L0 + CS_SC + 256 + (tl & ~1) * 4)[tl & 1], bct = lds_rd8(L0 + CS_SC + 512 + (tl & ~1) * 4)[tl & 1];
        bf16x8 qf[2], kf[4][2];
#pragma unroll
        for (int ks = 0; ks < 2; ++ks) { qf[ks] = lds_frag(L0 + CS_Q + (tt * 2 + ks) * 1024 + lane * 16);
#pragma unroll
            for (int ms = 0; ms < 4; ++ms) kf[ms][ks] = lds_frag(L0 + CS_K + (ms * 2 + ks) * 1024 + lane * 16); }
        f32x4 ibv[4], dum_;
#pragma unroll
        for (int ms = 0; ms < 4; ++ms) g8::lds_rd2x16(L0 + CS_SC + (16 * ms + 4 * g) * 4, ibv[ms], dum_);
        asm volatile("" : "+v"(qf[0]), "+v"(qf[1]), "+v"(kf[0][0]), "+v"(kf[0][1]), "+v"(kf[1][0]), "+v"(kf[1][1]), "+v"(kf[2][0]), "+v"(kf[2][1]), "+v"(kf[3][0]), "+v"(kf[3][1]));
        f32x4 sacc[4];
#pragma unroll
        for (int ms = 0; ms < 4; ++ms) { sacc[ms] = (f32x4){0.f, 0.f, 0.f, 0.f};
#pragma unroll
            for (int ks = 0; ks < 2; ++ks) sacc[ms] = MFMA16(kf[ms][ks], qf[ks], sacc[ms]); }
#pragma unroll
        for (int ms = 0; ms < 4; ++ms)
#pragma unroll
            for (int q = 0; q < 4; ++q) { const int s_ = 16 * ms + 4 * g + q; sacc[ms][q] = (s_ <= tl) ? sacc[ms][q] * 0.125f * __expf(ibv[ms][q] - Mtt) : 0.f; }
        bf16x8 sb[2]; sb[0] = pack_frag(sacc[0], sacc[1]); sb[1] = pack_frag(sacc[2], sacc[3]);
        bf16x8 ctf[5][2]; f32x4 npa[2], npb[2];
#pragma unroll
        for (int ks = 0; ks < 2; ++ks)
#pragma unroll
            for (int mt = 0; mt < 4; ++mt) ctf[mt][ks] = lds_frag(L0 + CS_CT + ((4 * dh + mt) * 2 + ks) * 1024 + lane * 16);
        g8::lds_rd2x16(L0 + CS_NP + (8 * g) * 4, npa[0], npa[1]); g8::lds_rd2x16(L0 + CS_NP + (32 + 8 * g) * 4, npb[0], npb[1]);
        asm volatile("" : "+v"(ctf[0][0]), "+v"(ctf[0][1]), "+v"(ctf[1][0]), "+v"(ctf[1][1]), "+v"(ctf[2][0]), "+v"(ctf[2][1]), "+v"(ctf[3][0]), "+v"(ctf[3][1]));
        { float nvv[8];
#pragma unroll
          for (int j = 0; j < 4; ++j) { nvv[j] = (ln == 0) ? npa[0][j] : 0.f; nvv[4 + j] = (ln == 0) ? npa[1][j] : 0.f; }
          ctf[4][0] = __builtin_bit_cast(bf16x8, pack8(nvv));
#pragma unroll
          for (int j = 0; j < 4; ++j) { nvv[j] = (ln == 0) ? npb[0][j] : 0.f; nvv[4 + j] = (ln == 0) ? npb[1][j] : 0.f; }
          ctf[4][1] = __builtin_bit_cast(bf16x8, pack8(nvv)); }
        f32x4 xacc[5];
#pragma unroll
        for (int mt = 0; mt < 5; ++mt) { xacc[mt] = (f32x4){0.f, 0.f, 0.f, 0.f};
#pragma unroll
            for (int ks = 0; ks < 2; ++ks) xacc[mt] = MFMA16(ctf[mt][ks], qf[ks], xacc[mt]); }
        const float wint = 0.125f * __expf(mprev - Mtt);
#pragma unroll
        for (int mt = 0; mt < 5; ++mt) xacc[mt] *= wint;
        const bf16x8 ones = (ln == 0) ? (bf16x8){0x3f80, 0x3f80, 0x3f80, 0x3f80, 0x3f80, 0x3f80, 0x3f80, 0x3f80} : (bf16x8){0, 0, 0, 0, 0, 0, 0, 0};
#pragma unroll
        for (int kk = 0; kk < 2; ++kk) {
#pragma unroll
            for (int mt = 0; mt < 4; ++mt) { const bf16x8 vf = tr_frag8(L0 + CS_V, 256, 32 * kk + 4 * g, 32 * kk + 16 + 4 * g, 16 * (4 * dh + mt), lane); xacc[mt] = MFMA16(vf, sb[kk], xacc[mt]); }
            xacc[4] = MFMA16(ones, sb[kk], xacc[4]); }
        const float den = __shfl(xacc[4][0], ln), dinv = __builtin_amdgcn_rcpf(fmaxf(fabsf(den), __expf(-(bct + Mtt))));
        float ssq = 0.f;
#pragma unroll
        for (int mt = 0; mt < 4; ++mt) { xacc[mt] *= dinv; ssq += (xacc[mt][0] * xacc[mt][0] + xacc[mt][1] * xacc[mt][1]) + (xacc[mt][2] * xacc[mt][2] + xacc[mt][3] * xacc[mt][3]); }
        ssq += __shfl_xor(ssq, 16); ssq += __shfl_xor(ssq, 32);
        if (g == 0) *(LAS float*)(F.lds + CS_SC + 768 + (tl * 2 + dh) * 4) = ssq;
        u32x2 og0, og1, og2, og3; lds_rd4x8_nowait(L0 + CS_OG + tl * 256 + (16 * 4 * dh + 4 * g) * 2, og0, og1, og2, og3);
        asm volatile("s_waitcnt lgkmcnt(0)" : "+v"(og0), "+v"(og1), "+v"(og2), "+v"(og3) :: "memory"); __builtin_amdgcn_s_barrier(); asm volatile("" ::: "memory");
        if (i + 1 < 8) mlc_issue(F, cid + 256, w, lane);
        { const f32x2 s2 = lds_rd8(L0 + CS_SC + 768 + tl * 8); const float rinv = rsqrtf((s2[0] + s2[1]) * (1.f / 128.f) + 1e-6f);
#pragma unroll
          for (int mt = 0; mt < 4; ++mt) { const int dv = 16 * (4 * dh + mt) + 4 * g; const f32x4 og = unpack4(mt == 0 ? og0 : (mt == 1 ? og1 : (mt == 2 ? og2 : og3))); f32x4 nw, o; g8::lds_rd2x16(L0 + GS_NW + dv * 4, nw, dum_);
#pragma unroll
              for (int q = 0; q < 4; ++q) o[q] = xacc[mt][q] * rinv * nw[q] * sigmoidf_(og[q]);
              *(u32x2*)(MX + (size_t)(t0 + tl) * D + h * 128 + dv) = pack4(o); } }
        if (i + 1 < 8) asm volatile("s_waitcnt vmcnt(8)" ::: "memory");
        else asm volatile("s_waitcnt vmcnt(0)" ::: "memory");
        __builtin_amdgcn_s_barrier(); asm volatile("" ::: "memory");
        bf16x8 gq[4], gp[2];
#pragma unroll
        for (int ks = 0; ks < 4; ++ks) gq[ks] = lds_frag(L0 + GS_QG + (tt * 4 + ks) * 1024 + lane * 16);
#pragma unroll
        for (int ks = 0; ks < 2; ++ks) gp[ks] = lds_frag(L0 + GS_QK + (tt * 2 + ks) * 1024 + lane * 16);
        f32x4 o[4]; float sq2 = 0.f;
#pragma unroll
        for (int mt = 0; mt < 4; ++mt) { bf16x8 gs[4], gv[2];
#pragma unroll
            for (int ks = 0; ks < 4; ++ks) gs[ks] = lds_frag(L0 + GS_SP + ((4 * dh + mt) * 4 + ks) * 1024 + lane * 16);
#pragma unroll
            for (int ks = 0; ks < 2; ++ks) gv[ks] = lds_frag(L0 + GS_VN + ((4 * dh + mt) * 2 + ks) * 1024 + lane * 16);
            asm volatile("s_waitcnt lgkmcnt(0)" : "+v"(gs[0]), "+v"(gs[1]), "+v"(gs[2]), "+v"(gs[3]), "+v"(gv[0]), "+v"(gv[1]), "+v"(gq[0]), "+v"(gq[1]), "+v"(gq[2]), "+v"(gq[3]), "+v"(gp[0]), "+v"(gp[1]) :: "memory");
            o[mt] = (f32x4){0.f, 0.f, 0.f, 0.f};
#pragma unroll
            for (int ks = 0; ks < 4; ++ks) o[mt] = MFMA16(gs[ks], gq[ks], o[mt]);
#pragma unroll
            for (int ks = 0; ks < 2; ++ks) o[mt] = MFMA16(gv[ks], gp[ks], o[mt]);
            sq2 += (o[mt][0] * o[mt][0] + o[mt][1] * o[mt][1]) + (o[mt][2] * o[mt][2] + o[mt][3] * o[mt][3]); }
        sq2 += __shfl_xor(sq2, 16); sq2 += __shfl_xor(sq2, 32);
        if (g == 0) *(LAS float*)(F.lds + GS_SS + (tl * 2 + dh) * 4) = sq2;
        u32x2 z0, z1, z2, z3; lds_rd4x8_nowait(L0 + GS_Z + tl * 256 + (16 * 4 * dh + 4 * g) * 2, z0, z1, z2, z3);
        asm volatile("s_waitcnt lgkmcnt(0)" : "+v"(z0), "+v"(z1), "+v"(z2), "+v"(z3) :: "memory"); __builtin_amdgcn_s_barrier(); asm volatile("" ::: "memory");
        if (i + 1 < 8) gdc_issue(F, cid + 256, w, lane);
        { const f32x2 s2 = lds_rd8(L0 + GS_SS + tl * 8); const float rinv = rsqrtf((s2[0] + s2[1]) * (1.f / 128.f) + 1e-6f);
#pragma unroll
          for (int mt = 0; mt < 4; ++mt) { const int dv = 16 * (4 * dh + mt) + 4 * g; const f32x4 z = unpack4(mt == 0 ? z0 : (mt == 1 ? z1 : (mt == 2 ? z2 : z3))); f32x4 nw, r; g8::lds_rd2x16(L0 + GS_NW + 512 + dv * 4, nw, dum_);
#pragma unroll
              for (int q = 0; q < 4; ++q) r[q] = o[mt][q] * rinv * nw[q] * z[q] * sigmoidf_(z[q]);
              *(u32x2*)(MX + (size_t)(t0 + tl) * D + 512 + h * 128 + dv) = pack4(r); } }
    }
    asm volatile("s_waitcnt vmcnt(0)" ::: "memory"); __syncthreads();
}
struct P2Order {
    unsigned char* ws; int G, c0;
    DI bool next(int i, g8::Unit& u) const {
        const int L = i * G + c0; if (L >= 1024) return false;
        const int q = L & 511, t4 = q & 3, h = (q >> 2) & 3, b = (q >> 4) & 7, l = q >> 7;
        if (L < 512) { u.a = (const char*)(ws + WS_KV) + ((size_t)(2 * l) * 2048 + b * 256) * 2048 + h * 512; u.b = (const char*)(ws + WS_WQ) + ((size_t)l * 1024 + t4 * 256) * 2048 + h * 512;
            u.c = (char*)(ws + WS_WQK) + ((size_t)(l * 8 + b) * 1024 + h * 256) * 2048 + t4 * 512; u.aux = -1; }
        else { u.a = (const char*)(ws + WS_WO) + ((size_t)l * 1024 + t4 * 256) * 2048 + h * 512; u.b = (const char*)(ws + WS_KV) + ((size_t)(2 * l + 1) * 2048 + b * 256) * 2048 + h * 512;
            u.c = (char*)(ws + WS_WVO) + ((size_t)(l * 8 + b) * 1024 + t4 * 256) * 2048 + h * 512; u.aux = 0; }
        u.pm = 0; u.pn = 0; return true;
    }
};

constexpr int NPH_LAYER = 13, NPH = 3 + NL * NPH_LAYER;
__global__ void __launch_bounds__(NTHREADS, 2) mega(Args a) {
    extern __shared__ __attribute__((aligned(16))) unsigned char lds_raw[];
    Ctx F; F.lds = (LAS unsigned char*)0u; F.ws = a.ws; F.ctl = (unsigned*)(a.ws + WS_CTL);
    F.tid = threadIdx.x; F.lane = F.tid & 63; F.wave = __builtin_amdgcn_readfirstlane(F.tid >> 6); F.G = gridDim.x;
    { const int bx = blockIdx.x; F.vcu = (F.G % 8 == 0) ? (bx % 8) * (F.G / 8) + bx / 8 : bx; }
    volatile LAS unsigned* MISC = (volatile LAS unsigned*)(F.lds + LDS_MISC);
    if (F.tid < 64) MISC[F.tid] = 0u;
    if ((unsigned)(size_t)(LAS unsigned char*)lds_raw != 0u) { if (F.tid == 0) atomicAdd(F.ctl + CW_BAR + XB_TMO, 1u); }
    if (F.tid < 28) { const unsigned long long pv = (unsigned long long)(F.tid < 27 ? (const void*)a.in[F.tid] : (const void*)a.out); ((LAS unsigned long long*)(F.lds + LDS_PTAB))[F.tid] = pv; }
    __syncthreads();
    const bool multi = (a.ph_hi - a.ph_lo) > 1;
    XcdBarrier bar; bar.bar = F.ctl + CW_BAR; bar.x = 0; bar.st = MISC;
    if (multi) bar = xcd_barrier_post(F.ctl + CW_BAR, MISC);
    if (PROF_MASK) { if (blockIdx.x == 0 && threadIdx.x == 0) { volatile LAS unsigned long long* pw = (volatile LAS unsigned long long*)(F.lds + LDS_MISC + 128); const unsigned long long t0_ = __builtin_amdgcn_s_memrealtime(); pw[0] = t0_; pw[1] = 0ull; pw[2] = t0_; } }
#ifndef PMASK
#define PMASK 0xffff
#endif
#define EN(j) (((PMASK) >> (j)) & 1)
#ifndef REPMASK
#define REPMASK 0x0
#endif
#define NREP(j) ((((REPMASK) >> (j)) & 1) ? 2 : 1)
#if REPMASK
#define REPLOOP(j) for (int rep_ = 0; rep_ < NREP(j); ++rep_, __syncthreads())
#else
#define REPLOOP(j)
#endif
#define PH(k) (a.ph_lo <= (k) && (k) < a.ph_hi && (refresh(F, a.ws), true))
#define PROF_TICK(k) do { if (PROF_MASK) { if (blockIdx.x == 0 && threadIdx.x == 0) { volatile LAS unsigned long long* pw = (volatile LAS unsigned long long*)(F.lds + LDS_MISC + 128); \
        const unsigned long long now_ = __builtin_amdgcn_s_memrealtime(); const int j_ = ((k) < 3) ? 13 + (k) : ((k) - 3) % NPH_LAYER; \
        if (((PROF_MASK) >> j_) & 1) pw[1] += now_ - pw[0]; pw[0] = now_; } } } while (0)
#define SEAM(k) do { if (PH(k) && PH((k) + 1)) { xcd_barrier(bar); if (((REPMASK) >> 16) & 1) xcd_barrier(bar); PROF_TICK(k); } } while (0)

    if (EN(13) && PH(0)) REPLOOP(13) { phase_convert(F, a); }
    SEAM(0);
    if (EN(14) && PH(1)) REPLOOP(14) {
        g8::AffineOrder S; S.A = (const char*)(F.ws + WS_MEMB); S.B = (const char*)(F.ws + WS_WKV); S.C = (char*)(F.ws + WS_KV);
        S.aM = 256ull * 2048; S.bB = 0; S.bN = 256ull * 2048; S.cM = 256ull * 2048; S.cS = 2048ull * 2048; S.cN = 512; S.nM = 8; S.nN = 32; S.bdiv = 1 << 30; S.csp = 4; S.G = F.G; S.c0 = F.vcu;
        g8::EpiBf16 E{1024, nullptr, 0, 1.f};
        g8::gemm_phase(F.lds, 2048, 2048, 16, S, E);
        row_pass<0>(F, a, 0);
    }
    SEAM(1);
    if (EN(15) && PH(2)) REPLOOP(15) { P2Order S{F.ws, F.G, F.vcu}; g8::EpiBf16 E{1024, nullptr, 0, 0.0625f}; g8::gemm_phase(F.lds, 2048, 2048, 4, S, E); }
    SEAM(2);
#pragma unroll 1
    for (int l = 0; l < NL; ++l) {
        const int pb = 3 + l * NPH_LAYER;
        if (EN(0) && PH(pb + 0)) REPLOOP(0) {
            g8::AffineOrder S = g8::dense_order(F.ws + WS_XB, F.ws + WS_WIN + (size_t)l * NPROJ * D * 2, F.ws + WS_PROJ, T, NPROJ, D, NPROJ * 2, 2, F.G, F.vcu);
            g8::EpiBf16 E{NPROJ, nullptr, 0, 1.f}; g8::gemm_phase(F.lds, 2048, 2048, 16, S, E);
        }
        SEAM(pb + 0);
        if (EN(1) && PH(pb + 1)) REPLOOP(1) {
            phase_a(F, a, l);
        }
        SEAM(pb + 1);
        if (EN(2) && PH(pb + 2)) REPLOOP(2) {
            if (F.tid < 8) ((volatile LAS unsigned*)(F.lds + GB_FLAGS))[F.tid] = 0u;
            __syncthreads();
            if (F.wave == 0) gd_b_task(F, F.vcu);
            else if (F.wave <= 2) gd_b_loader(F, F.vcu, F.wave - 1);
            else if (F.wave >= 4) ml_b_unit(F, F.vcu);
        }
        SEAM(pb + 2);
        if (EN(3) && PH(pb + 3)) REPLOOP(3) {
            phase_c(F, a, l);
        }
        SEAM(pb + 3);
        if (EN(4) && PH(pb + 4)) REPLOOP(4) {
            g8::AffineOrder S = g8::dense_order(F.ws + WS_MIXED, F.ws + WS_WOUT + (size_t)l * D * D * 2, F.ws + WS_HB, T, D, D, D * 2, 2, F.G, F.vcu);
            g8::EpiBf16 E{D, nullptr, 0, 1.f}; g8::gemm_phase(F.lds, 2048, 2048, 16, S, E);
        }
        SEAM(pb + 4);
        if (EN(5) && PH(pb + 5)) { row_pass<1>(F, a, l); if (NREP(5) == 2) { __syncthreads(); row_pass<1>(F, a, l, true); } }
        SEAM(pb + 5);
        if (EN(6) && PH(pb + 6)) REPLOOP(6) {
            g8::AffineOrder S = g8::dense_order(F.ws + WS_XB, F.ws + WS_WQK + (size_t)l * 8 * D * D * 2, F.ws + WS_PB, T, D, D, D * 2, 2, F.G, F.vcu);
            S.bB = (size_t)D * D * 2; S.bdiv = 16;
            g8::EpiSoftmax E{D}; g8::gemm_phase(F.lds, 2048, 2048, 16, S, E);
        }
        SEAM(pb + 6);
        if (EN(7) && PH(pb + 7)) REPLOOP(7) {
            g8::AffineOrder S = g8::dense_order(F.ws + WS_PB, F.ws + WS_WVO + (size_t)l * 8 * D * D * 2, F.ws + WS_HB, T, D, D, D * 2, 2, F.G, F.vcu);
            S.bB = (size_t)D * D * 2; S.bdiv = 16;
            g8::EpiBf16 E{D, nullptr, 0, 1.f}; g8::gemm_phase(F.lds, 2048, 2048, 16, S, E);
        }
        SEAM(pb + 7);
        if (EN(8) && PH(pb + 8)) { row_pass<2>(F, a, l); if (NREP(8) == 2) { __syncthreads(); row_pass<2>(F, a, l, true); } }
        SEAM(pb + 8);
        if (EN(9) && PH(pb + 9)) phase_scatter(F, l);
        SEAM(pb + 9);
        if (EN(10) && PH(pb + 10)) REPLOOP(10) {
            MoeOrder S; S.gather = 1; S.rev = 0; S.A = (const char*)(F.ws + WS_XB); S.B = (const char*)(F.ws + WS_WGU) + (size_t)l * 32 * 2048 * D * 2; S.C = (char*)(F.ws + WS_ACT); S.tile_e = F.ctl + CW_TILE_E + l * MAXTILES;
            S.NT = __builtin_amdgcn_readfirstlane((int)ldu(F.ctl + CW_NT + l)); S.nN = 8; S.bE = 2048ull * D * 2; S.bN = 256ull * 2048; S.cN = 256; S.G = F.G; S.c0 = F.vcu;
            g8::EpiSwiglu E{inp(F, 22) + (size_t)l * 32 * 2048}; g8::gemm_phase<g8::EpiSwiglu, MoeOrder, true>(F.lds, 2048, 2048, 16, S, E, (const unsigned*)(F.ws + WS_ROWTAB));
        }
        SEAM(pb + 10);
        if (EN(11) && PH(pb + 11)) REPLOOP(11) {
            MoeOrder S; S.gather = 0; S.rev = 1; S.A = (const char*)(F.ws + WS_ACT); S.B = (const char*)(F.ws + WS_WDN) + (size_t)l * 32 * D * D * 2; S.C = (char*)(F.ws + WS_Y); S.tile_e = F.ctl + CW_TILE_E + l * MAXTILES;
            S.NT = __builtin_amdgcn_readfirstlane((int)ldu(F.ctl + CW_NT + l)); S.nN = 4; S.bE = (size_t)D * D * 2; S.bN = 256ull * 2048; S.cN = 512; S.G = F.G; S.c0 = F.vcu;
            g8::EpiBf16 E{D, inp(F, 24) + (size_t)l * 32 * D, D, 1.f}; g8::gemm_phase(F.lds, 2048, 2048, 16, S, E);
        }
        SEAM(pb + 11);
        if (EN(12) && PH(pb + 12)) { row_pass<3>(F, a, l); if (NREP(12) == 2 && l < NL - 1) { __syncthreads(); row_pass<3>(F, a, l, true); } }
        SEAM(pb + 12);
    }
    if (PROF_MASK) {
        refresh(F, a.ws);
        xcd_barrier(bar); PROF_TICK(NPH - 1);
        if (blockIdx.x == 0 && threadIdx.x == 0) { volatile LAS unsigned long long* pw = (volatile LAS unsigned long long*)(F.lds + LDS_MISC + 128);
            const float f = (float)(double)pw[1] / (float)(double)(pw[0] - pw[2]); const float q = fminf(1.f, floorf(f * (float)(PROF_SCALE) * 32.f + (float)(PROF_OFS) * 0.5f) * (1.f / 32.f));
            __hip_atomic_store(F.ctl + CW_DBG, __float_as_uint(sqrtf(100.f * q)), __ATOMIC_RELAXED, __HIP_MEMORY_SCOPE_AGENT); }
        xcd_barrier(bar);
        const float c = __uint_as_float(ldu(F.ctl + CW_DBG)); float* o = (float*)inp(F, 27);
        for (size_t i = (size_t)blockIdx.x * NTHREADS + threadIdx.x; i < (size_t)T * D; i += (size_t)gridDim.x * NTHREADS) o[i] = c;
    }
}

#ifndef DBG_STOP
#define DBG_STOP 0
#endif
#ifndef DBG_OFF
#define DBG_OFF WS_XB
#endif
#ifndef DBG_N
#define DBG_N ((size_t)T * D)
#endif
#ifndef DBG_F32
#define DBG_F32 0
#endif
__global__ void dbg_dump(const unsigned char* ws, float* out, size_t off) {
    const bf16* b = (const bf16*)(ws + off); const float* f = (const float*)(ws + off);
    for (size_t i = (size_t)blockIdx.x * blockDim.x + threadIdx.x; i < (size_t)T * D; i += (size_t)gridDim.x * blockDim.x) out[i] = (i < (size_t)(DBG_N)) ? (DBG_F32 ? f[i] : bf2f(b[i])) : 0.f;
}
#ifndef N_LAUNCH_MODE
#define N_LAUNCH_MODE 1
#endif
extern "C" void kernel_launch(void* const* d_in, const int* in_sizes, int n_in, void* d_out, int out_size, void* d_ws, size_t ws_size, hipStream_t stream) {
    static int ready = 0;
    if (ready == 0) {
        if (n_in != 27 || ws_size < WS_END) { fprintf(stderr, "kernel_launch: need 27 inputs and %zu bytes of workspace (got %d, %zu)\n", (size_t)WS_END, n_in, ws_size); ready = -1; return; }
        if (hipFuncSetAttribute((const void*)mega, hipFuncAttributeMaxDynamicSharedMemorySize, LDS_BYTES) != hipSuccess) { fprintf(stderr, "kernel_launch: hipFuncSetAttribute failed\n"); ready = -1; return; }
        int per_cu = 0; (void)hipOccupancyMaxActiveBlocksPerMultiprocessor(&per_cu, (const void*)mega, NTHREADS, LDS_BYTES); (void)hipGetLastError();
        ready = 1;
    }
    if (ready < 0) return;
    (void)hipMemsetAsync((char*)d_ws + WS_CTL, 0, 1 << 20, stream);
    Args a{};
    for (int i = 0; i < 27; ++i) a.in[i] = (const float*)d_in[i];
    a.out = (float*)d_out; a.ws = (unsigned char*)d_ws;
#if N_LAUNCH_MODE == 1
    a.ph_lo = 0; a.ph_hi = (DBG_STOP > 0 ? DBG_STOP : NPH);
    hipLaunchKernelGGL(mega, dim3(256), dim3(NTHREADS), LDS_BYTES, stream, a);
    if (DBG_STOP > 0) hipLaunchKernelGGL(dbg_dump, dim3(2048), dim3(256), 0, stream, (const unsigned char*)d_ws, (float*)d_out, (size_t)(DBG_OFF));
#else
    for (int p = 0; p < (DBG_STOP > 0 ? DBG_STOP : NPH); ++p) { a.ph_lo = p; a.ph_hi = p + 1; hipLaunchKernelGGL(mega, dim3(256), dim3(NTHREADS), LDS_BYTES, stream, a); }
    if (DBG_STOP > 0) hipLaunchKernelGGL(dbg_dump, dim3(2048), dim3(256), 0, stream, (const unsigned char*)d_ws, (float*)d_out, (size_t)(DBG_OFF));
#endif
}
```
